# Optimizing an MI355X kernel written in HIP

```python
import jax, jax.numpy as jnp
from jax import lax
import numpy as np

D_MODEL = 2048
BATCH = 1
SEQ = 8192
DEPTH = 4

MLA_HEADS = D_MODEL // 128
Q_LORA = 512
KV_LORA = 512
NOPE_DIM = 128
ROPE_DIM = 64
V_DIM = 128
ROPE_THETA = 10000.0
Q_BLOCK = 128
MASK_VALUE = -1e30
HGRN_HEADS = D_MODEL // 128
HGRN_DK = 128
HGRN_DV = 128
HGRN_K = HGRN_HEADS * HGRN_DK
HGRN_V = HGRN_HEADS * HGRN_DV
CHUNK = 64
MIN_FORGET = 1e-30
D_FF = ((8 * D_MODEL // 3 + 255) // 256) * 256
CONV_WIDTH = 3
EPS = 1e-6
IN_SPLITS = (Q_LORA, KV_LORA, ROPE_DIM, HGRN_K, HGRN_K, HGRN_V, HGRN_V, D_MODEL, D_MODEL)
IN_WIDTH = sum(IN_SPLITS)

kernel_name = "hybrid_mla_hgrn2_convffn_trunk"


def rmsnorm(x, g):
    xf = x.astype(jnp.float32)
    y = xf * lax.rsqrt(jnp.mean(xf * xf, axis=-1, keepdims=True) + EPS)
    return (y * g.astype(jnp.float32)).astype(x.dtype)


def rope_tables(positions):
    inv_freq = ROPE_THETA ** (-jnp.arange(0, ROPE_DIM, 2, dtype=jnp.float32) / ROPE_DIM)
    ang = positions.astype(jnp.float32)[..., None] * inv_freq
    return jnp.cos(ang)[:, :, None, :], jnp.sin(ang)[:, :, None, :]


def apply_rope(x, cos, sin):
    xf = x.astype(jnp.float32)
    x1, x2 = jnp.split(xf, 2, axis=-1)
    return jnp.concatenate([x1 * cos - x2 * sin, x2 * cos + x1 * sin], axis=-1).astype(x.dtype)


def causal_block_attention(q, k, v):
    B, S, H, Dqk = q.shape
    nb = S // Q_BLOCK
    scale = Dqk ** -0.5
    qb = q.reshape(B, nb, Q_BLOCK, H, Dqk).transpose(1, 0, 2, 3, 4)
    key_pos = jnp.arange(S)

    def one_block(args):
        q_blk, blk = args
        s = jnp.einsum('bqhd,bkhd->bhqk', q_blk, k).astype(jnp.float32) * scale
        q_pos = blk * Q_BLOCK + jnp.arange(Q_BLOCK)
        s = jnp.where(key_pos[None, :] <= q_pos[:, None], s, MASK_VALUE)
        p = jax.nn.softmax(s, axis=-1).astype(v.dtype)
        return jnp.einsum('bhqk,bkhd->bqhd', p, v)

    out = lax.map(one_block, (qb, jnp.arange(nb)))
    return out.transpose(1, 0, 2, 3, 4).reshape(B, S, H, v.shape[-1])


def hgrn2_chunkwise(q, k, log_f, v):
    B, S, H, DK = q.shape
    DV = v.shape[-1]
    nc = S // CHUNK

    def to_chunks(t):
        return t.astype(jnp.float32).reshape(B, nc, CHUNK, H, t.shape[-1]).transpose(1, 0, 3, 2, 4)

    qc, kc, gc, vc = to_chunks(q), to_chunks(k), to_chunks(log_f), to_chunks(v)
    causal = jnp.tril(jnp.ones((CHUNK, CHUNK), dtype=bool))[:, :, None]

    def step(state, inp):
        q_, k_, g_, v_ = inp
        b = jnp.cumsum(g_, axis=-2)
        diff = b[..., :, None, :] - b[..., None, :, :]
        decay = jnp.where(causal, jnp.exp(jnp.where(causal, diff, 0.0)), 0.0)
        scores = jnp.einsum('bhtd,bhsd,bhtsd->bhts', q_, k_, decay)
        o_intra = jnp.einsum('bhts,bhsv->bhtv', scores, v_)
        o_inter = jnp.einsum('bhtd,bhdv->bhtv', q_ * jnp.exp(b), state)
        b_last = b[..., -1:, :]
        k_dec = k_ * jnp.exp(b_last - b)
        new_state = state * jnp.exp(b_last[..., 0, :])[..., None] + jnp.einsum('bhsd,bhsv->bhdv', k_dec, v_)
        return new_state, o_intra + o_inter

    state0 = jnp.zeros((B, H, DK, DV), jnp.float32)
    _, out = lax.scan(step, state0, (qc, kc, gc, vc))
    return out.transpose(1, 0, 3, 2, 4).reshape(B, S, H, DV)


def causal_dwconv(u, w, b):
    S = u.shape[1]
    up = jnp.pad(u, ((0, 0), (CONV_WIDTH - 1, 0), (0, 0)))
    y = b
    for j in range(CONV_WIDTH):
        y = y + w[j] * up[:, j:j + S, :]
    return y


def setup_inputs(seed: int = 0) -> dict:
    key = jax.random.key(seed)
    ks = jax.random.split(key, 24)
    f32 = jnp.float32

    def nrm(k, shape, scale):
        return jax.random.normal(k, shape, f32) * scale

    def gain(k, shape):
        return 1.0 + 0.02 * jax.random.normal(k, shape, f32)

    res_scale = (2.0 * DEPTH) ** -0.5
    x = jax.random.normal(ks[0], (BATCH, SEQ, D_MODEL), f32)
    offsets = jax.random.randint(ks[1], (BATCH, 1), 0, 4096, dtype=jnp.int32)
    positions = offsets + jnp.arange(SEQ, dtype=jnp.int32)[None, :]
    return {
        "x": x,
        "positions": positions,
        "attn_norm_g": gain(ks[2], (DEPTH, D_MODEL)),
        "w_in": nrm(ks[3], (DEPTH, D_MODEL, IN_WIDTH), D_MODEL ** -0.5),
        "q_norm_g": gain(ks[4], (DEPTH, Q_LORA)),
        "w_uq": nrm(ks[5], (DEPTH, Q_LORA, MLA_HEADS * (NOPE_DIM + ROPE_DIM)), Q_LORA ** -0.5),
        "kv_norm_g": gain(ks[6], (DEPTH, KV_LORA)),
        "w_ukv": nrm(ks[7], (DEPTH, KV_LORA, MLA_HEADS * (NOPE_DIM + V_DIM)), KV_LORA ** -0.5),
        "hgrn_lb_logits": nrm(ks[8], (DEPTH, HGRN_K), 0.5),
        "hgrn_out_norm_g": gain(ks[9], (DEPTH, HGRN_DV)),
        "w_branch_a": nrm(ks[10], (DEPTH, MLA_HEADS * V_DIM, D_MODEL), (MLA_HEADS * V_DIM) ** -0.5),
        "w_branch_b": nrm(ks[11], (DEPTH, HGRN_V, D_MODEL), HGRN_V ** -0.5),
        "w_out": nrm(ks[12], (DEPTH, D_MODEL, D_MODEL), D_MODEL ** -0.5 * res_scale),
        "ffn_norm_g": gain(ks[13], (DEPTH, D_MODEL)),
        "w_up": nrm(ks[14], (DEPTH, D_MODEL, 2 * D_FF), D_MODEL ** -0.5),
        "conv_w": nrm(ks[15], (DEPTH, CONV_WIDTH, 2 * D_FF), CONV_WIDTH ** -0.5),
        "conv_b": nrm(ks[16], (DEPTH, 2 * D_FF), 0.01),
        "w_down": nrm(ks[17], (DEPTH, D_FF, D_MODEL), D_FF ** -0.5 * res_scale),
        "final_norm_g": gain(ks[18], (D_MODEL,)),
    }


def reference(x, positions, attn_norm_g, w_in, q_norm_g, w_uq, kv_norm_g, w_ukv, hgrn_lb_logits,
              hgrn_out_norm_g, w_branch_a, w_branch_b, w_out, ffn_norm_g, w_up, conv_w, conv_b,
              w_down, final_norm_g):
    B, S, _ = x.shape
    cos, sin = rope_tables(positions)
    p = jax.nn.softmax(hgrn_lb_logits.astype(jnp.float32), axis=0)
    lower_bounds = jnp.cumsum(p, axis=0) - p[0]
    split_points = [int(s) for s in np.cumsum(IN_SPLITS)[:-1]]

    for l in range(DEPTH):
        h = rmsnorm(x, attn_norm_g[l])
        proj = h @ w_in[l]
        c_q, c_kv, k_rope, hq, hf, hi, hg, gate_a, gate_b = jnp.split(proj, split_points, axis=-1)

        q = (rmsnorm(c_q, q_norm_g[l]) @ w_uq[l]).reshape(B, S, MLA_HEADS, NOPE_DIM + ROPE_DIM)
        kv = (rmsnorm(c_kv, kv_norm_g[l]) @ w_ukv[l]).reshape(B, S, MLA_HEADS, NOPE_DIM + V_DIM)
        q_nope, q_pe = q[..., :NOPE_DIM], q[..., NOPE_DIM:]
        k_nope, v = kv[..., :NOPE_DIM], kv[..., NOPE_DIM:]
        q_pe = apply_rope(q_pe, cos, sin)
        k_pe = jnp.broadcast_to(apply_rope(k_rope[:, :, None, :], cos, sin), (B, S, MLA_HEADS, ROPE_DIM))
        attn = causal_block_attention(jnp.concatenate([q_nope, q_pe], axis=-1),
                                      jnp.concatenate([k_nope, k_pe], axis=-1), v)
        attn = attn.reshape(B, S, MLA_HEADS * V_DIM)

        lb = lower_bounds[l]
        z = hf.astype(jnp.float32)
        forget = lb + (1.0 - lb) * jax.nn.sigmoid(z)
        log_f = jnp.log(jnp.maximum(forget, MIN_FORGET))
        k_in = 1.0 - forget
        rec = hgrn2_chunkwise(jax.nn.silu(hq).reshape(B, S, HGRN_HEADS, HGRN_DK),
                              k_in.reshape(B, S, HGRN_HEADS, HGRN_DK),
                              log_f.reshape(B, S, HGRN_HEADS, HGRN_DK),
                              hi.reshape(B, S, HGRN_HEADS, HGRN_DV)).astype(x.dtype)
        rec = rmsnorm(rec, hgrn_out_norm_g[l]) * jax.nn.silu(hg.reshape(B, S, HGRN_HEADS, HGRN_DV))
        rec = rec.reshape(B, S, HGRN_V)

        merged = (jax.nn.sigmoid(gate_a) * (attn @ w_branch_a[l])
                  + jax.nn.sigmoid(gate_b) * (rec @ w_branch_b[l]))
        x = x + merged @ w_out[l]

        h = rmsnorm(x, ffn_norm_g[l])
        u = causal_dwconv(h @ w_up[l], conv_w[l], conv_b[l])
        g, up = jnp.split(u, 2, axis=-1)
        x = x + (jax.nn.silu(g) * up) @ w_down[l]

    return rmsnorm(x, final_norm_g)
```

```cpp
#include <hip/hip_runtime.h>
#include <cstdio>
#include <cstdint>
namespace pg8 {
#define PG8_LAS __attribute__((address_space(3)))
typedef unsigned short bf16_t;
typedef short bf16x8 __attribute__((ext_vector_type(8)));
typedef float f32x4 __attribute__((ext_vector_type(4)));
typedef unsigned u32x4 __attribute__((ext_vector_type(4)));
constexpr int BM = 256, BK = 64, HALF = 128, HTB = HALF * BK * 2  , STAGE_BYTES = 8 * HTB, NXCD = 8, WGM = 8;

__host__ __device__ __forceinline__ int lds_byte(int r, int c) { const int st = (r >> 4) * 2 + (c >> 5), rr = r & 15, cc = c & 31, ob = rr * 64 + cc * 2; return st * 1024 + (ob ^ (((ob >> 9) & 1) << 5)); }
__host__ __device__ __forceinline__ void stage_rc(int b, int& R, int& C) { const int st = b / 1024, sb = b % 1024, swz = sb ^ (((sb >> 9) & 1) << 5); R = (st >> 1) * 16 + swz / 64; C = (st & 1) * 32 + (swz % 64) / 2; }
__host__ __device__ __forceinline__ int perm32(int rho) { const int n = rho >> 4, i = rho & 15; return 8 * (i >> 2) + 4 * n + (i & 3); }

struct Unit { int pm, pn; };
struct Gemm { const bf16_t* A; const bf16_t* Bt; int M, N, K, lda, ldb; };

struct StaticOrder {
    int nM, nN, nwg, G, c;
    __host__ __device__ void init(int M, int N, int G_, int c_) { nM = M / BM; nN = N / BM; nwg = nM * nN; G = G_; c = c_; }
    __host__ __device__ bool next(int i, Unit& u) const {
        const long L = (long)i * G + c; if (L >= nwg) return false;
        int wgid = (int)L; { const int q = nwg / NXCD, r = nwg % NXCD, xcd = wgid % NXCD, off = wgid / NXCD; wgid = (xcd < r ? xcd * (q + 1) : r * (q + 1) + (xcd - r) * q) + off; }
        const int nig = WGM * nN, gid = wgid / nig, fm = gid * WGM, gsz = (nM - fm) < WGM ? (nM - fm) : WGM;
        u.pm = fm + ((wgid % nig) % gsz); u.pn = (wgid % nig) / gsz; return true;
    }
    __device__ __forceinline__ void a_ready(const Unit&) const {}
    __device__ __forceinline__ void done(const Unit&) const {}
};

__device__ __forceinline__ unsigned cvt_pk_bf16(float lo, float hi) { unsigned r; asm volatile("v_cvt_pk_bf16_f32 %0, %1, %2" : "=v"(r) : "v"(lo), "v"(hi)); return r; }
template <class Epi, class Sched, bool ALIGN_EPI = false, bool SP2 = false>
__device__ __forceinline__ void gemm_phase(PG8_LAS unsigned char* lds, const Gemm g, const Sched& S, const Epi& E) {
    int tid = threadIdx.x; asm volatile("" : "+v"(tid));
    const int wid = __builtin_amdgcn_readfirstlane(tid >> 6), lane = tid & 63, wr = wid >> 2, wc = wid & 3, fr = lane & 15, fq = lane >> 4;
    const int K = g.K, nt = K / BK;
    unsigned voffA[2], voffB[2];
#pragma unroll
    for (int i = 0; i < 2; ++i) { int R, C; stage_rc(tid * 16 + i * 8192, R, C); const int Rb = Epi::PERM ? ((R & ~31) + perm32(R & 31)) : R;
        voffA[i] = (unsigned)(R * g.lda + C) * 2u; voffB[i] = (unsigned)(Rb * g.ldb + C) * 2u; }
    const size_t kstep = (size_t)(BK * 2);
    const size_t hstepA = (size_t)HALF * g.lda * 2, hstepB = (size_t)HALF * g.ldb * 2;
    const size_t tstepA = 2 * hstepA, tstepB = 2 * hstepB;
    const unsigned ldsw = (unsigned)wid * 1024u;
    const int aoff = lds_byte(wr * 64 + fr, fq * 8), boff = lds_byte(wc * 32 + fr, fq * 8);
#define PG8_SA(b, h) (((b) * 2 + (h)) * HTB)
#define PG8_SB(b, h) ((4 + (b) * 2 + (h)) * HTB)
#define PG8_STAGE(bufoff, gbase, voff) do { _Pragma("unroll") for (int _i = 0; _i < 2; ++_i) \
        __builtin_amdgcn_global_load_lds((const unsigned*)((const char*)(gbase) + (voff)[_i]), (PG8_LAS unsigned*)(lds + (bufoff) + ldsw + _i * 8192), 16, 0, 0); } while (0)
#define PG8_LDA(dst, b, h) do { _Pragma("unroll") for (int m = 0; m < 4; ++m) _Pragma("unroll") for (int k = 0; k < 2; ++k) dst[m][k] = *(const PG8_LAS bf16x8*)(lds + PG8_SA(b, h) + aoff + m * 2048 + k * 1024); } while (0)
#define PG8_LDB(dst, b, h) do { _Pragma("unroll") for (int n = 0; n < 2; ++n) _Pragma("unroll") for (int k = 0; k < 2; ++k) dst[n][k] = *(const PG8_LAS bf16x8*)(lds + PG8_SB(b, h) + boff + n * 2048 + k * 1024); } while (0)
#define PG8_MMA(ai, bj, At, Bt) do { __builtin_amdgcn_s_setprio(1); _Pragma("unroll") for (int m = 0; m < 4; ++m) _Pragma("unroll") for (int n = 0; n < 2; ++n) _Pragma("unroll") for (int k = 0; k < 2; ++k) \
        acc[ai][bj][m][n] = __builtin_amdgcn_mfma_f32_16x16x32_bf16(Bt[n][k], At[m][k], acc[ai][bj][m][n], 0, 0, 0); __builtin_amdgcn_s_setprio(0); } while (0)
#define PG8_WAIT_V(n) asm volatile("s_waitcnt vmcnt(" #n ")" ::: "memory")
#define PG8_WAIT_L(n) asm volatile("s_waitcnt lgkmcnt(" #n ")" ::: "memory")
#define PG8_BAR __builtin_amdgcn_s_barrier()
#define PG8_SCHED __builtin_amdgcn_sched_barrier(0)
    Unit cur, nxt; int ui = 0;
    if (!S.next(0, cur)) return;
    f32x4 acc[2][2][4][2];
#pragma unroll
    for (int a = 0; a < 2; ++a)
#pragma unroll
        for (int b = 0; b < 2; ++b)
#pragma unroll
            for (int m = 0; m < 4; ++m)
#pragma unroll
                for (int n = 0; n < 2; ++n) acc[a][b][m][n] = (f32x4){0.f, 0.f, 0.f, 0.f};
    bf16x8 At[4][2], B0[2][2], B1[2][2];
    const char* cA = (const char*)g.A + (size_t)cur.pm * tstepA; const char* cB = (const char*)g.Bt + (size_t)cur.pn * tstepB;
    S.a_ready(cur);
    if constexpr (SP2) {
        PG8_STAGE(PG8_SB(0, 0), cB, voffB); PG8_STAGE(PG8_SB(0, 1), cB + hstepB, voffB); PG8_STAGE(PG8_SA(0, 0), cA, voffA); PG8_STAGE(PG8_SA(0, 1), cA + hstepA, voffA);
        if (wr == 1) PG8_BAR;
        PG8_WAIT_V(2); PG8_BAR;
        PG8_STAGE(PG8_SB(1, 0), cB + kstep, voffB); PG8_STAGE(PG8_SA(1, 0), cA + kstep, voffA); PG8_STAGE(PG8_SB(1, 1), cB + hstepB + kstep, voffB);
        PG8_WAIT_V(6); PG8_BAR;
    } else {
        PG8_STAGE(PG8_SB(0, 0), cB, voffB); PG8_STAGE(PG8_SA(0, 0), cA, voffA); PG8_STAGE(PG8_SB(0, 1), cB + hstepB, voffB); PG8_STAGE(PG8_SA(0, 1), cA + hstepA, voffA);
        if (wr == 1) PG8_BAR;
        PG8_WAIT_V(4); PG8_BAR;
        PG8_STAGE(PG8_SB(1, 0), cB + kstep, voffB); PG8_STAGE(PG8_SA(1, 0), cA + kstep, voffA); PG8_STAGE(PG8_SB(1, 1), cB + hstepB + kstep, voffB);
        PG8_WAIT_V(6); PG8_BAR;
    }
    for (;;) {
        const bool has_next = S.next(ui + 1, nxt);
        const char* nA = has_next ? (const char*)g.A + (size_t)nxt.pm * tstepA : cA; const char* nB = has_next ? (const char*)g.Bt + (size_t)nxt.pn * tstepB : cB;
        for (int t = 0; t < nt; t += 2) {
            const bool last = (t == nt - 2);
            const char* a1 = cA + (size_t)(t + 1) * kstep;
            const char* a2 = last ? nA : cA + (size_t)(t + 2) * kstep; const char* b2 = last ? nB : cB + (size_t)(t + 2) * kstep;
            const char* a3 = a2 + kstep; const char* b3 = b2 + kstep;
            if (last && has_next) S.a_ready(nxt);
            if constexpr (SP2) {
            PG8_LDB(B0, 0, 0); PG8_LDB(B1, 0, 1); PG8_SCHED; PG8_LDA(At, 0, 0); PG8_STAGE(PG8_SA(1, 1), a1 + hstepA, voffA);
            PG8_WAIT_V(8); PG8_WAIT_L(0); PG8_BAR; PG8_MMA(0, 0, At, B0); PG8_MMA(0, 1, At, B1); PG8_BAR; PG8_SCHED;
            PG8_LDA(At, 0, 1); PG8_STAGE(PG8_SB(0, 0), b2, voffB); PG8_STAGE(PG8_SB(0, 1), b2 + hstepB, voffB); PG8_STAGE(PG8_SA(0, 0), a2, voffA);
            PG8_WAIT_V(8); PG8_WAIT_L(0); PG8_BAR; PG8_MMA(1, 0, At, B0); PG8_MMA(1, 1, At, B1); PG8_BAR; PG8_SCHED;
            PG8_LDB(B0, 1, 0); PG8_LDB(B1, 1, 1); PG8_SCHED; PG8_LDA(At, 1, 0); PG8_STAGE(PG8_SA(0, 1), a2 + hstepA, voffA);
            PG8_WAIT_V(8); PG8_WAIT_L(0); PG8_BAR; PG8_MMA(0, 0, At, B0); PG8_MMA(0, 1, At, B1); PG8_BAR; PG8_SCHED;
            PG8_LDA(At, 1, 1); PG8_STAGE(PG8_SB(1, 0), b3, voffB); PG8_STAGE(PG8_SB(1, 1), b3 + hstepB, voffB); PG8_STAGE(PG8_SA(1, 0), a3, voffA);
            PG8_WAIT_V(8); PG8_WAIT_L(0); PG8_BAR; PG8_MMA(1, 0, At, B0); PG8_MMA(1, 1, At, B1); PG8_BAR; PG8_SCHED;
            } else {
            PG8_LDB(B0, 0, 0); PG8_SCHED; PG8_LDA(At, 0, 0); PG8_STAGE(PG8_SA(1, 1), a1 + hstepA, voffA);
            PG8_WAIT_L(8); PG8_BAR; PG8_WAIT_L(0); PG8_MMA(0, 0, At, B0); PG8_BAR; PG8_SCHED;
            PG8_LDB(B1, 0, 1); PG8_STAGE(PG8_SB(0, 0), b2, voffB);
            PG8_BAR; PG8_WAIT_L(0); PG8_MMA(0, 1, At, B1); PG8_BAR;
            PG8_LDA(At, 0, 1); PG8_STAGE(PG8_SA(0, 0), a2, voffA);
            PG8_BAR; PG8_WAIT_L(0); PG8_MMA(1, 0, At, B0); PG8_BAR; PG8_SCHED;
            PG8_STAGE(PG8_SB(0, 1), b2 + hstepB, voffB);
            PG8_WAIT_V(6); PG8_BAR; PG8_MMA(1, 1, At, B1); PG8_BAR;
            PG8_LDB(B0, 1, 0); PG8_SCHED; PG8_LDA(At, 1, 0); PG8_STAGE(PG8_SA(0, 1), a2 + hstepA, voffA);
            PG8_WAIT_L(8); PG8_BAR; PG8_WAIT_L(0); PG8_MMA(0, 0, At, B0); PG8_BAR; PG8_SCHED;
            PG8_LDB(B1, 1, 1); PG8_STAGE(PG8_SB(1, 0), b3, voffB);
            PG8_BAR; PG8_WAIT_L(0); PG8_MMA(0, 1, At, B1); PG8_BAR;
            PG8_LDA(At, 1, 1); PG8_STAGE(PG8_SA(1, 0), a3, voffA);
            PG8_BAR; PG8_WAIT_L(0); PG8_MMA(1, 0, At, B0); PG8_BAR; PG8_SCHED;
            PG8_STAGE(PG8_SB(1, 1), b3 + hstepB, voffB);
            PG8_WAIT_V(6); PG8_BAR; PG8_MMA(1, 1, At, B1); PG8_BAR;
            }
        }
        if constexpr (ALIGN_EPI) { if (wr == 0) PG8_BAR; }
        if constexpr (!Epi::AFTER_DRAIN) { E(acc, cur, wr, wc, fr, fq); S.done(cur); }
        if (!has_next) break;
#pragma unroll
        for (int a = 0; a < 2; ++a)
#pragma unroll
            for (int b = 0; b < 2; ++b)
#pragma unroll
                for (int m = 0; m < 4; ++m)
#pragma unroll
                    for (int n = 0; n < 2; ++n) acc[a][b][m][n] = (f32x4){0.f, 0.f, 0.f, 0.f};
        cur = nxt; cA = nA; cB = nB; ++ui;
        if constexpr (ALIGN_EPI) { if (wr == 1) PG8_BAR; }
    }
    PG8_WAIT_V(0);
    if constexpr (!ALIGN_EPI) { if (wr == 0) PG8_BAR; }
    PG8_BAR;
    if constexpr (Epi::AFTER_DRAIN) { E.fused(acc, cur, wr, wc, fr, fq, lds, wid, lane); S.done(cur); }
#undef PG8_SA
#undef PG8_SB
#undef PG8_STAGE
#undef PG8_LDA
#undef PG8_LDB
#undef PG8_MMA
#undef PG8_WAIT_V
#undef PG8_WAIT_L
#undef PG8_BAR
#undef PG8_SCHED
}
}

constexpr int S_ = 8192, DM = 2048, DEPTH = 4, NH = 16;
constexpr int QL = 512, KVL = 512, ROPE = 64, NOPE = 128, VD = 128;
constexpr int INW = 13376;
constexpr int DFF = 5632, DFF2 = 11264;
constexpr int NNAT = 11520;
constexpr int WINR = NNAT + 2048;
constexpr float EPS = 1e-6f;
constexpr float LOG2E = 1.4426950408889634f;
constexpr float QSCALE = 0.07216878364870323f * 1.4426950408889634f;
constexpr int NWAVES = 8, NTHR = 512;

constexpr size_t MiB = 1u << 20;
constexpr size_t WS_CTL = 0, CTL_ZERO_BYTES = 1 * MiB;
constexpr size_t WS_COS = 1 * MiB, WS_SIN = 2 * MiB, WS_LB = 3 * MiB, WS_SSQ = 4 * MiB;
constexpr size_t WS_W = 5 * MiB;
constexpr size_t LW_IN = 0, LW_UQ = 53 * MiB, LW_K = 56 * MiB, LW_V = 58 * MiB, LW_A = 60 * MiB, LW_B = 68 * MiB, LW_O = 76 * MiB, LW_UP = 84 * MiB, LW_DN = 128 * MiB, LW = 150 * MiB;
constexpr size_t WS_XN = WS_W + 4 * LW;
constexpr size_t WS_MIX = WS_XN + 32 * MiB;
constexpr size_t WS_CQKV = WS_MIX;
constexpr size_t WS_KPE = WS_CQKV + 16 * MiB;
constexpr size_t WS_HQ = WS_KPE + 1 * MiB;
constexpr size_t GSTRIDE = 32 * MiB;
constexpr size_t WS_HG = WS_HQ + GSTRIDE, WS_GA = WS_HQ + 2 * GSTRIDE, WS_GB = WS_HQ + 3 * GSTRIDE;
constexpr size_t WS_HF = WS_HQ + 4 * GSTRIDE;
constexpr size_t WS_VTH = WS_HF + 64 * MiB;
constexpr size_t WS_QN = WS_VTH + 32 * MiB;
constexpr size_t WS_QR = WS_QN + 32 * MiB;
constexpr size_t WS_KN = WS_QR + 16 * MiB;
constexpr size_t WS_VT = WS_KN + 32 * MiB;
constexpr size_t WS_ATT = WS_VT + 32 * MiB;
constexpr size_t WS_REC = WS_ATT + 32 * MiB;
constexpr size_t WS_RRAW = WS_REC + 32 * MiB;
constexpr size_t WS_HU = WS_RRAW + 64 * MiB;
constexpr size_t WS_HS = WS_HU + 128 * MiB;
constexpr size_t WS_M1 = WS_HS + 64 * MiB;
constexpr size_t WS_MRG = WS_M1 + 64 * MiB;
constexpr size_t WS_MIX_END = WS_MRG + 32 * MiB;
constexpr size_t WS_U = WS_MIX;
constexpr size_t WS_ACT = WS_U + 176 * MiB;
static_assert(WS_ACT + 88 * MiB <= WS_MIX_END, "FFN overlay fits the mixer region");
constexpr size_t WS_END = WS_MIX_END;
constexpr int CW_BAR = 4096;

constexpr int RING_OFF = 0, RING_BYTES = 131072;
constexpr int LDSCTL_OFF = RING_BYTES, MISC_OFF = LDSCTL_OFF + 320;
constexpr int LDS_BYTES = 147456;

#define GAS __attribute__((address_space(1)))
#define LAS __attribute__((address_space(3)))
typedef unsigned short bf16;
typedef unsigned v4u __attribute__((ext_vector_type(4)));
typedef unsigned v2u __attribute__((ext_vector_type(2)));
typedef float f32x4 __attribute__((ext_vector_type(4)));
typedef float f32x2 __attribute__((ext_vector_type(2)));
typedef short bf16x8 __attribute__((ext_vector_type(8)));
typedef GAS unsigned gu32;
#define LDS_WAIT() asm volatile("s_waitcnt lgkmcnt(0)" ::: "memory")
#define VM_WAIT() asm volatile("s_waitcnt vmcnt(0)" ::: "memory")
__device__ __forceinline__ unsigned f2bf(float f) { unsigned u = __builtin_bit_cast(unsigned, f); return (u + 0x7fffu + ((u >> 16) & 1u)) >> 16; }
__device__ __forceinline__ unsigned pk2(float lo, float hi) { return f2bf(lo) | (f2bf(hi) << 16); }
__device__ __forceinline__ float bflo(unsigned u) { return __builtin_bit_cast(float, u << 16); }
__device__ __forceinline__ float bfhi(unsigned u) { return __builtin_bit_cast(float, u & 0xffff0000u); }
__device__ __forceinline__ float sigm(float x) { return __builtin_amdgcn_rcpf(1.f + __builtin_amdgcn_exp2f(-LOG2E * x)); }
__device__ __forceinline__ float wave_sum(float v) {
#pragma unroll
    for (int o = 1; o < 64; o <<= 1) v += __shfl_xor(v, o);
    return v;
}
__device__ __forceinline__ float wave_max(float v) {
#pragma unroll
    for (int o = 1; o < 64; o <<= 1) v = fmaxf(v, __shfl_xor(v, o));
    return v;
}

namespace pg8 {
__device__ __forceinline__ u32x4 pack8(f32x4 a, f32x4 b) { u32x4 w; w.x = cvt_pk_bf16(a[0], a[1]); w.y = cvt_pk_bf16(a[2], a[3]); w.z = cvt_pk_bf16(b[0], b[1]); w.w = cvt_pk_bf16(b[2], b[3]); return w; }
__device__ __forceinline__ f32x4 silu4(f32x4 v) { f32x4 r; r[0] = v[0] * sigm(v[0]); r[1] = v[1] * sigm(v[1]); r[2] = v[2] * sigm(v[2]); r[3] = v[3] * sigm(v[3]); return r; }
__device__ __forceinline__ f32x4 sigm4(f32x4 v) { f32x4 r; r[0] = sigm(v[0]); r[1] = sigm(v[1]); r[2] = sigm(v[2]); r[3] = sigm(v[3]); return r; }
__device__ __forceinline__ float sum8(const float* p) { const f32x4 a = *(const f32x4*)p, b = *(const f32x4*)(p + 4); return ((a[0] + a[1]) + (a[2] + a[3])) + ((b[0] + b[1]) + (b[2] + b[3])); }
__device__ __forceinline__ void rope8(f32x4& v0, f32x4& v1, const f32x4 cs, const f32x4 sn) {
    f32x4 a, b;
    a[0] = v0[0] * cs[0] - v0[1] * sn[0]; a[1] = v0[1] * cs[0] + v0[0] * sn[0];
    a[2] = v0[2] * cs[1] - v0[3] * sn[1]; a[3] = v0[3] * cs[1] + v0[2] * sn[1];
    b[0] = v1[0] * cs[2] - v1[1] * sn[2]; b[1] = v1[1] * cs[2] + v1[0] * sn[2];
    b[2] = v1[2] * cs[3] - v1[3] * sn[3]; b[3] = v1[3] * cs[3] + v1[2] * sn[3];
    v0 = a; v1 = b;
}

struct EpiIn {
    static constexpr bool PERM = true, AFTER_DRAIN = false;
    unsigned char* ws;
    __device__ __forceinline__ void operator()(const f32x4 (&acc)[2][2][4][2], const Unit& u, int wr, int wc, int fr, int fq) const {
        const int pn = u.pn, row0 = u.pm * BM + wr * 64 + fr, lc = wc * 32 + 8 * fq;
        if (pn == 4) {
            if (wc < 2) {
                const float* COS = (const float*)(ws + WS_COS); const float* SIN = (const float*)(ws + WS_SIN); bf16_t* KPE = (bf16_t*)(ws + WS_KPE);
#pragma unroll
                for (int ai = 0; ai < 2; ++ai)
#pragma unroll
                    for (int m = 0; m < 4; ++m) { const int row = row0 + ai * HALF + m * 16;
                        f32x4 v0 = acc[ai][0][m][0], v1 = acc[ai][0][m][1];
                        const f32x4 cs = *(const f32x4*)(COS + (size_t)row * 32 + wc * 16 + 4 * fq), sn = *(const f32x4*)(SIN + (size_t)row * 32 + wc * 16 + 4 * fq);
                        rope8(v0, v1, cs, sn);
                        *(u32x4*)(KPE + (size_t)row * 64 + lc) = pack8(v0, v1);
                        if (m & 1) asm volatile("" ::: "memory"); }
            }
        } else if (pn >= 13 && pn < 21) {
            float* HF = (float*)(ws + WS_HF);
#pragma unroll
            for (int ai = 0; ai < 2; ++ai)
#pragma unroll
                for (int m = 0; m < 4; ++m) { float* rp = HF + (size_t)(row0 + ai * HALF + m * 16) * 2048 + (pn - 13) * 256 + lc;
#pragma unroll
                    for (int bj = 0; bj < 2; ++bj) { *(f32x4*)(rp + bj * HALF) = acc[ai][bj][m][0]; *(f32x4*)(rp + bj * HALF + 4) = acc[ai][bj][m][1]; } }
        } else {
            bf16_t* base; int ldc, act;
            if (pn < 4) { base = (bf16_t*)(ws + WS_CQKV) + pn * 256; ldc = 1024; act = 0; }
            else { const int gi = (pn < 13) ? 0 : ((pn - 13) >> 3), ct = (pn < 13) ? (pn - 5) : ((pn - 13) & 7);
                   base = (bf16_t*)(ws + WS_HQ + (size_t)gi * GSTRIDE) + ct * 256; ldc = 2048; act = (gi <= 1) ? 1 : 2; }
#pragma unroll
            for (int ai = 0; ai < 2; ++ai)
#pragma unroll
                for (int m = 0; m < 4; ++m) { bf16_t* rp = base + (size_t)(row0 + ai * HALF + m * 16) * ldc + lc;
#pragma unroll
                    for (int bj = 0; bj < 2; ++bj) { f32x4 v0 = acc[ai][bj][m][0], v1 = acc[ai][bj][m][1];
                        if (act == 1) { v0 = silu4(v0); v1 = silu4(v1); }
                        else if (act == 2) { v0 = sigm4(v0); v1 = sigm4(v1); }
                        *(u32x4*)(rp + bj * HALF) = pack8(v0, v1); } }
        }
    }
};
struct EpiStore {
    static constexpr bool PERM = true, AFTER_DRAIN = false;
    bf16_t* O; int ldc;
    __device__ __forceinline__ void operator()(const f32x4 (&acc)[2][2][4][2], const Unit& u, int wr, int wc, int fr, int fq) const {
        const int row0 = u.pm * BM + wr * 64 + fr, col0 = u.pn * BM + wc * 32 + 8 * fq;
#pragma unroll
        for (int ai = 0; ai < 2; ++ai)
#pragma unroll
            for (int m = 0; m < 4; ++m) { bf16_t* rp = O + (size_t)(row0 + ai * HALF + m * 16) * ldc + col0;
#pragma unroll
                for (int bj = 0; bj < 2; ++bj) *(u32x4*)(rp + bj * HALF) = pack8(acc[ai][bj][m][0], acc[ai][bj][m][1]); }
    }
};
struct EpiQ {
    static constexpr bool PERM = true, AFTER_DRAIN = false;
    unsigned char* ws;
    __device__ __forceinline__ void operator()(const f32x4 (&acc)[2][2][4][2], const Unit& u, int wr, int wc, int fr, int fq) const {
        const int pn = u.pn, row0 = u.pm * BM + wr * 64 + fr, lc = wc * 32 + 8 * fq;
        if (pn < 8) {
            bf16_t* base = (bf16_t*)(ws + WS_QN) + pn * 256 + lc;
#pragma unroll
            for (int ai = 0; ai < 2; ++ai)
#pragma unroll
                for (int m = 0; m < 4; ++m)
#pragma unroll
                    for (int bj = 0; bj < 2; ++bj) *(u32x4*)(base + (size_t)(row0 + ai * HALF + m * 16) * 2048 + bj * HALF) = pack8(acc[ai][bj][m][0] * QSCALE, acc[ai][bj][m][1] * QSCALE);
        } else {
            const float* COS = (const float*)(ws + WS_COS); const float* SIN = (const float*)(ws + WS_SIN);
            bf16_t* base = (bf16_t*)(ws + WS_QR) + (pn - 8) * 256 + lc; const int p0 = (wc & 1) * 16 + 4 * fq;
#pragma unroll
            for (int ai = 0; ai < 2; ++ai)
#pragma unroll
                for (int m = 0; m < 4; ++m) { const int row = row0 + ai * HALF + m * 16;
                    const f32x4 cs = *(const f32x4*)(COS + (size_t)row * 32 + p0), sn = *(const f32x4*)(SIN + (size_t)row * 32 + p0);
#pragma unroll
                    for (int bj = 0; bj < 2; ++bj) { f32x4 v0 = acc[ai][bj][m][0] * QSCALE, v1 = acc[ai][bj][m][1] * QSCALE; rope8(v0, v1, cs, sn);
                        *(u32x4*)(base + (size_t)row * 1024 + bj * HALF) = pack8(v0, v1); }
                    if (m & 1) asm volatile("" ::: "memory"); }
        }
    }
};
struct EpiGateA {
    static constexpr bool PERM = true, AFTER_DRAIN = false;
    unsigned char* ws;
    __device__ __forceinline__ void operator()(const f32x4 (&acc)[2][2][4][2], const Unit& u, int wr, int wc, int fr, int fq) const {
        const int row0 = u.pm * BM + wr * 64 + fr, col0 = u.pn * BM + wc * 32 + 8 * fq;
        const bf16_t* G = (const bf16_t*)(ws + WS_GA); float* M1 = (float*)(ws + WS_M1);
#pragma unroll
        for (int ai = 0; ai < 2; ++ai)
#pragma unroll
            for (int m = 0; m < 4; ++m) { const size_t off = (size_t)(row0 + ai * HALF + m * 16) * 2048 + col0;
#pragma unroll
                for (int bj = 0; bj < 2; ++bj) { const u32x4 g = *(const u32x4*)(G + off + bj * HALF);
                    const f32x4 g0 = {bflo(g.x), bfhi(g.x), bflo(g.y), bfhi(g.y)}, g1 = {bflo(g.z), bfhi(g.z), bflo(g.w), bfhi(g.w)};
                    *(f32x4*)(M1 + off + bj * HALF) = acc[ai][bj][m][0] * g0; *(f32x4*)(M1 + off + bj * HALF + 4) = acc[ai][bj][m][1] * g1; }
                if (m & 1) asm volatile("" ::: "memory"); }
    }
};
struct EpiGateB {
    static constexpr bool PERM = true, AFTER_DRAIN = false;
    unsigned char* ws;
    __device__ __forceinline__ void operator()(const f32x4 (&acc)[2][2][4][2], const Unit& u, int wr, int wc, int fr, int fq) const {
        const int row0 = u.pm * BM + wr * 64 + fr, col0 = u.pn * BM + wc * 32 + 8 * fq;
        const bf16_t* G = (const bf16_t*)(ws + WS_GB); const float* M1 = (const float*)(ws + WS_M1); bf16_t* O = (bf16_t*)(ws + WS_MRG);
#pragma unroll
        for (int ai = 0; ai < 2; ++ai)
#pragma unroll
            for (int m = 0; m < 4; ++m) { const size_t off = (size_t)(row0 + ai * HALF + m * 16) * 2048 + col0;
#pragma unroll
                for (int bj = 0; bj < 2; ++bj) { const u32x4 g = *(const u32x4*)(G + off + bj * HALF);
                    const f32x4 g0 = {bflo(g.x), bfhi(g.x), bflo(g.y), bfhi(g.y)}, g1 = {bflo(g.z), bfhi(g.z), bflo(g.w), bfhi(g.w)};
                    const f32x4 m0 = *(const f32x4*)(M1 + off + bj * HALF), m1 = *(const f32x4*)(M1 + off + bj * HALF + 4);
                    *(u32x4*)(O + off + bj * HALF) = pack8(m0 + acc[ai][bj][m][0] * g0, m1 + acc[ai][bj][m][1] * g1); }
                if (m & 1) asm volatile("" ::: "memory"); }
    }
};
struct EpiRes {
    static constexpr bool PERM = true, AFTER_DRAIN = false;
    float* X;
    __device__ __forceinline__ void operator()(const f32x4 (&acc)[2][2][4][2], const Unit& u, int wr, int wc, int fr, int fq) const {
        const int row0 = u.pm * BM + wr * 64 + fr, col0 = u.pn * BM + wc * 32 + 8 * fq;
#pragma unroll
        for (int ai = 0; ai < 2; ++ai)
#pragma unroll
            for (int m = 0; m < 4; ++m) { float* rp = X + (size_t)(row0 + ai * HALF + m * 16) * 2048 + col0;
#pragma unroll
                for (int bj = 0; bj < 2; ++bj) { const f32x4 a = *(const f32x4*)(rp + bj * HALF), b = *(const f32x4*)(rp + bj * HALF + 4);
                    *(f32x4*)(rp + bj * HALF) = a + acc[ai][bj][m][0]; *(f32x4*)(rp + bj * HALF + 4) = b + acc[ai][bj][m][1]; }
                if (m & 1) asm volatile("" ::: "memory"); }
    }
};
}
#define XB_TMO      128
#define XB_XCNT(j)  (256  + 64 * (j))
#define XB_XSUB(j)  (1280 + 64 * (j))
#define XB_XGEN(j)  (2304 + 64 * (j))
#define XB_TOP      3328
#define XB_TOPGEN   3392
#define XCD_BAR_WORDS 3456
#define XB_SPIN_CAP (1u << 18)

__device__ __forceinline__ unsigned xb_ld(unsigned* p)              { return __hip_atomic_load(p, __ATOMIC_RELAXED, __HIP_MEMORY_SCOPE_AGENT); }
__device__ __forceinline__ unsigned xb_add(unsigned* p, unsigned v) { return __hip_atomic_fetch_add(p, v, __ATOMIC_RELAXED, __HIP_MEMORY_SCOPE_AGENT); }
__device__ __forceinline__ unsigned xb_xcc_id() { return (unsigned)__builtin_amdgcn_s_getreg((3 << 11) | 20) & 0xFu; }
#define XB_SPIN(cond, bar) do { unsigned _sp = 0; while (cond) { __builtin_amdgcn_s_sleep(1); \
    if ((++_sp & 255u) == 0u) { if (xb_ld(&(bar)[XB_TMO])) break; if (_sp > XB_SPIN_CAP) { atomicAdd(&(bar)[XB_TMO], 1u); break; } } } } while (0)

struct XcdBarrier {
    unsigned* bar; unsigned x;
    volatile LAS unsigned* st;
};

__device__ __forceinline__ XcdBarrier xcd_barrier_post(unsigned* bar, volatile LAS unsigned* st) {
    XcdBarrier b; b.bar = bar; b.x = xb_xcc_id(); b.st = st;
    if (threadIdx.x == 0) (void)xb_add(&bar[XB_XCNT(b.x)], 1u);
    return b;
}
__device__ __forceinline__ void xcd_barrier_complete(unsigned* bar, unsigned x, unsigned& nloc, unsigned& nx) {
    const unsigned G = gridDim.x * gridDim.y * gridDim.z;
    unsigned sum, cnt, mine, sp = 0u;
    for (;;) {
        sum = 0u; cnt = 0u; mine = 0u;
#pragma unroll
        for (unsigned j = 0; j < 16; ++j) { const unsigned c = xb_ld(&bar[XB_XCNT(j)]); sum += c; cnt += (c > 0u) ? 1u : 0u; mine = (j == x) ? c : mine; }
        if (sum == G) break;
        __builtin_amdgcn_s_sleep(1);
        if ((++sp & 255u) == 0u) { if (xb_ld(&bar[XB_TMO])) break; if (sp > XB_SPIN_CAP) { atomicAdd(&bar[XB_TMO], 1u); break; } }
    }
    nloc = mine > 0u ? mine : 1u; nx = cnt > 0u ? cnt : 1u;
}

__device__ __forceinline__ void xcd_barrier(const XcdBarrier& b) {
    asm volatile("s_waitcnt vmcnt(0)" ::: "memory");
    __syncthreads();
    if (threadIdx.x == 0) {
        GAS unsigned* gbar_ = (GAS unsigned*)b.bar; unsigned bx_ = b.x; asm volatile("" : "+s"(gbar_), "+s"(bx_)); unsigned* bar = (unsigned*)gbar_;
        __builtin_amdgcn_s_waitcnt(0);
        unsigned nloc = b.st[0], nx = b.st[1];
        if (nloc == 0u) { xcd_barrier_complete(bar, bx_, nloc, nx); b.st[0] = nloc; b.st[1] = nx; }
        const unsigned old = xb_add(&bar[XB_XSUB(bx_)], 1u);
        const unsigned gen = old / nloc;
        if (old + 1u == (gen + 1u) * nloc) {
            __builtin_amdgcn_fence(__ATOMIC_RELEASE, "agent");
            asm volatile("s_waitcnt vmcnt(0)" ::: "memory");
            const unsigned og = xb_add(&bar[XB_TOP], 1u);
            const unsigned tg = og / nx;
            if (og + 1u == (tg + 1u) * nx) xb_add(&bar[XB_TOPGEN], 1u);
            else XB_SPIN(xb_ld(&bar[XB_TOPGEN]) == tg, bar);
            __builtin_amdgcn_fence(__ATOMIC_ACQUIRE, "agent");
            xb_add(&bar[XB_XGEN(bx_)], 1u);
            asm volatile("s_waitcnt vmcnt(0)" ::: "memory");
        } else {
            XB_SPIN(xb_ld(&bar[XB_XGEN(bx_)]) == gen, bar);
            __builtin_amdgcn_fence(__ATOMIC_ACQUIRE, "agent");
            asm volatile("s_waitcnt vmcnt(0)" ::: "memory");
        }
    }
    __syncthreads();
}

__device__ const float c_invf[32] = {
    1.000000000e+00f, 7.498942614e-01f, 5.623413324e-01f, 4.216965139e-01f, 3.162277639e-01f, 2.371373773e-01f, 1.778279394e-01f, 1.333521307e-01f,
    1.000000015e-01f, 7.498941571e-02f, 5.623413250e-02f, 4.216965288e-02f, 3.162277490e-02f, 2.371373773e-02f, 1.778279431e-02f, 1.333521493e-02f,
    9.999999776e-03f, 7.498941850e-03f, 5.623413250e-03f, 4.216964822e-03f, 3.162277630e-03f, 2.371373586e-03f, 1.778279431e-03f, 1.333521446e-03f,
    1.000000047e-03f, 7.498942432e-04f, 5.623413017e-04f, 4.216965172e-04f, 3.162277571e-04f, 2.371373703e-04f, 1.778279402e-04f, 1.333521504e-04f};

template <int KIND> __device__ __forceinline__ int srcmap(int n) {
    if constexpr (KIND == 0) return n;
    else if constexpr (KIND == 1) {
        if (n < 1024) return n;
        if (n < 1088) { const int jj = n - 1024; return 1024 + (jj >> 1) + 32 * (jj & 1); }
        if (n < 1280) return -1;
        if (n < 3328) return 1088 + (n - 1280);
        if (n < 5376) return 3136 + (n - 3328);
        if (n < 7424) return 7232 + (n - 5376);
        if (n < 9472) return 9280 + (n - 7424);
        if (n < 11520) return 11328 + (n - 9472);
        return 5184 + (n - 11520);
    } else if constexpr (KIND == 2) {
        if (n < 2048) return (n >> 7) * 192 + (n & 127);
        const int r = n - 2048, h = r >> 6, jj = r & 63; return h * 192 + 128 + (jj >> 1) + 32 * (jj & 1);
    } else if constexpr (KIND == 3) return (n >> 7) * 256 + (n & 127);
    else if constexpr (KIND == 4) return (n >> 7) * 256 + 128 + (n & 127);
    else { const int j = n >> 8, i = n & 255; return i < 128 ? 128 * j + i : DFF + 128 * j + (i - 128); }
}
template <int KIND> __device__ __forceinline__ void transpose_item(const float* W, int K, int Nsrc, bf16* WT, const float* scale, LAS float* scr, int kb, int nb, int lane) {
    const int k0 = 64 * kb, n0 = 32 * nb, sc = srcmap<KIND>(n0 + (lane & 31));
#pragma unroll 8
    for (int i = 0; i < 32; ++i) { const int kk = 2 * i + (lane >> 5); float v = 0.f;
        if (sc >= 0) { v = ((const GAS float*)W)[(size_t)(k0 + kk) * Nsrc + sc]; if (scale) v *= ((const GAS float*)scale)[k0 + kk]; }
        scr[kk * 33 + (lane & 31)] = v; }
    LDS_WAIT(); asm volatile("" ::: "memory");
    const int c = lane & 7;
#pragma unroll
    for (int j = 0; j < 4; ++j) { const int n = (lane >> 3) + 8 * j; const LAS float* s = scr + (8 * c) * 33 + n;
        v4u o; o.x = pk2(s[0 * 33], s[1 * 33]); o.y = pk2(s[2 * 33], s[3 * 33]); o.z = pk2(s[4 * 33], s[5 * 33]); o.w = pk2(s[6 * 33], s[7 * 33]);
        *(GAS v4u*)(WT + (size_t)(n0 + n) * K + k0 + 8 * c) = o; }
    LDS_WAIT(); asm volatile("" ::: "memory");
}
__device__ __forceinline__ void rms_row_to_bf16(const float* xrow, const float* gain, bf16* orow, float* xcopy, int lane) {
    const GAS f32x4* xr = (const GAS f32x4*)xrow + lane;
    f32x4 v[8]; float s = 0.f;
#pragma unroll
    for (int j = 0; j < 8; ++j) { v[j] = xr[64 * j]; s += (v[j].x * v[j].x + v[j].y * v[j].y) + (v[j].z * v[j].z + v[j].w * v[j].w); }
    const float rstd = 1.0f / sqrtf(wave_sum(s) * (1.f / DM) + EPS);
    if (xcopy) { GAS f32x4* xc = (GAS f32x4*)xcopy + lane;
#pragma unroll
        for (int j = 0; j < 8; ++j) xc[64 * j] = v[j]; }
    GAS v2u* o8 = (GAS v2u*)orow + lane;
#pragma unroll
    for (int j = 0; j < 8; ++j) { const f32x4 g = *((const GAS f32x4*)gain + lane + 64 * j);
        v2u w; w.x = pk2(v[j].x * rstd * g.x, v[j].y * rstd * g.y); w.y = pk2(v[j].z * rstd * g.z, v[j].w * rstd * g.w); o8[64 * j] = w; }
}
__device__ __forceinline__ void rms_row_f32(float* xrow, const float* gain, int lane) {
    GAS f32x4* xr = (GAS f32x4*)xrow + lane;
    f32x4 v[8]; float s = 0.f;
#pragma unroll
    for (int j = 0; j < 8; ++j) { v[j] = xr[64 * j]; s += (v[j].x * v[j].x + v[j].y * v[j].y) + (v[j].z * v[j].z + v[j].w * v[j].w); }
    const float rstd = 1.0f / sqrtf(wave_sum(s) * (1.f / DM) + EPS);
#pragma unroll
    for (int j = 0; j < 8; ++j) { const f32x4 g = *((const GAS f32x4*)gain + lane + 64 * j); xr[64 * j] = v[j] * rstd * g; }
}
__device__ __forceinline__ void sincos_f64(float angf, float& sn, float& cs) {
    const double a = (double)angf;
    const double n = __builtin_rint(a * 0.63661977236758134308);
    double r = __builtin_fma(-n, 1.57079632679489655800e+00, a); r = __builtin_fma(-n, 6.12323399573676603587e-17, r);
    const double r2 = r * r;
    double ps = -1.0 / 1307674368000.0; ps = ps * r2 + 1.0 / 6227020800.0; ps = ps * r2 - 1.0 / 39916800.0; ps = ps * r2 + 1.0 / 362880.0; ps = ps * r2 - 1.0 / 5040.0; ps = ps * r2 + 1.0 / 120.0; ps = ps * r2 - 1.0 / 6.0; ps = ps * r2 * r + r;
    double pc = 1.0 / 20922789888000.0; pc = pc * r2 - 1.0 / 87178291200.0; pc = pc * r2 + 1.0 / 479001600.0; pc = pc * r2 - 1.0 / 3628800.0; pc = pc * r2 + 1.0 / 40320.0; pc = pc * r2 - 1.0 / 720.0; pc = pc * r2 + 1.0 / 24.0; pc = pc * r2 - 0.5; pc = pc * r2 + 1.0;
    const int q = ((int)n) & 3;
    const double s_ = (q == 0) ? ps : (q == 1) ? pc : (q == 2) ? -ps : -pc;
    const double c_ = (q == 0) ? pc : (q == 1) ? -ps : (q == 2) ? -pc : ps;
    sn = (float)s_; cs = (float)c_;
}

__device__ __forceinline__ void latent_norm_row(bf16* row, int lane) {
    v4u a = *(const v4u*)(row + lane * 8), b = *(const v4u*)(row + 512 + lane * 8);
    float fa[8] = {bflo(a.x), bfhi(a.x), bflo(a.y), bfhi(a.y), bflo(a.z), bfhi(a.z), bflo(a.w), bfhi(a.w)};
    float fb[8] = {bflo(b.x), bfhi(b.x), bflo(b.y), bfhi(b.y), bflo(b.z), bfhi(b.z), bflo(b.w), bfhi(b.w)};
    float sa = 0.f, sb = 0.f;
#pragma unroll
    for (int i = 0; i < 8; ++i) { sa += fa[i] * fa[i]; sb += fb[i] * fb[i]; }
    const float ra = 1.0f / sqrtf(wave_sum(sa) * (1.f / 512.f) + EPS), rb = 1.0f / sqrtf(wave_sum(sb) * (1.f / 512.f) + EPS);
    a.x = pk2(fa[0] * ra, fa[1] * ra); a.y = pk2(fa[2] * ra, fa[3] * ra); a.z = pk2(fa[4] * ra, fa[5] * ra); a.w = pk2(fa[6] * ra, fa[7] * ra);
    b.x = pk2(fb[0] * rb, fb[1] * rb); b.y = pk2(fb[2] * rb, fb[3] * rb); b.z = pk2(fb[4] * rb, fb[5] * rb); b.w = pk2(fb[6] * rb, fb[7] * rb);
    *(v4u*)(row + lane * 8) = a; *(v4u*)(row + 512 + lane * 8) = b;
}

__device__ __forceinline__ void attn_naive(unsigned char* ws, LAS float* qs  , int gw, int ngw, int lane) {
    const bf16* QN = (const bf16*)(ws + WS_QN); const bf16* QR = (const bf16*)(ws + WS_QR); const bf16* KN = (const bf16*)(ws + WS_KN);
    const bf16* KPE = (const bf16*)(ws + WS_KPE); const bf16* VT = (const bf16*)(ws + WS_VT); bf16* ATT = (bf16*)(ws + WS_ATT);
    for (int item = gw; item < S_ * NH; item += ngw) {
        const int q = item >> 4, h = item & 15;
        if (lane < 24) { const v4u w = (lane < 16) ? *(const v4u*)(QN + (size_t)q * 2048 + h * 128 + lane * 8) : *(const v4u*)(QR + (size_t)q * 1024 + h * 64 + (lane - 16) * 8);
            LAS float* d = qs + lane * 8; d[0] = bflo(w.x); d[1] = bfhi(w.x); d[2] = bflo(w.y); d[3] = bfhi(w.y); d[4] = bflo(w.z); d[5] = bfhi(w.z); d[6] = bflo(w.w); d[7] = bfhi(w.w); }
        LDS_WAIT(); asm volatile("" ::: "memory");
        float m = -__builtin_inff(), l = 0.f, o0 = 0.f, o1 = 0.f;
        const bf16* v0p = VT + (size_t)(h * 128 + 2 * lane) * S_; const bf16* v1p = v0p + S_;
        for (int j0 = 0; j0 <= q; j0 += 64) {
            const int j = j0 + lane; const bool valid = j <= q; float s = 0.f;
            if (valid) {
                const bf16* kn = KN + (size_t)j * 2048 + h * 128; const bf16* kp = KPE + (size_t)j * 64;
#pragma unroll 4
                for (int c = 0; c < 24; ++c) { const v4u w = (c < 16) ? *(const v4u*)(kn + c * 8) : *(const v4u*)(kp + (c - 16) * 8); const LAS float* qq = qs + c * 8;
                    s += bflo(w.x) * qq[0] + bfhi(w.x) * qq[1] + bflo(w.y) * qq[2] + bfhi(w.y) * qq[3] + bflo(w.z) * qq[4] + bfhi(w.z) * qq[5] + bflo(w.w) * qq[6] + bfhi(w.w) * qq[7]; }
            } else s = -__builtin_inff();
            const float mn = fmaxf(m, wave_max(s)); const float alpha = __builtin_amdgcn_exp2f(m - mn); const float p = valid ? __builtin_amdgcn_exp2f(s - mn) : 0.f;
            l = l * alpha + wave_sum(p); m = mn; o0 *= alpha; o1 *= alpha;
#pragma unroll
            for (int c = 0; c < 8; ++c) { const v4u a = *(const v4u*)(v0p + j0 + c * 8), b = *(const v4u*)(v1p + j0 + c * 8);
                const float p0 = __builtin_bit_cast(float, __builtin_amdgcn_readlane(__builtin_bit_cast(int, p), c * 8 + 0)), p1 = __builtin_bit_cast(float, __builtin_amdgcn_readlane(__builtin_bit_cast(int, p), c * 8 + 1));
                const float p2 = __builtin_bit_cast(float, __builtin_amdgcn_readlane(__builtin_bit_cast(int, p), c * 8 + 2)), p3 = __builtin_bit_cast(float, __builtin_amdgcn_readlane(__builtin_bit_cast(int, p), c * 8 + 3));
                const float p4 = __builtin_bit_cast(float, __builtin_amdgcn_readlane(__builtin_bit_cast(int, p), c * 8 + 4)), p5 = __builtin_bit_cast(float, __builtin_amdgcn_readlane(__builtin_bit_cast(int, p), c * 8 + 5));
                const float p6 = __builtin_bit_cast(float, __builtin_amdgcn_readlane(__builtin_bit_cast(int, p), c * 8 + 6)), p7 = __builtin_bit_cast(float, __builtin_amdgcn_readlane(__builtin_bit_cast(int, p), c * 8 + 7));
                o0 += p0 * bflo(a.x) + p1 * bfhi(a.x) + p2 * bflo(a.y) + p3 * bfhi(a.y) + p4 * bflo(a.z) + p5 * bfhi(a.z) + p6 * bflo(a.w) + p7 * bfhi(a.w);
                o1 += p0 * bflo(b.x) + p1 * bfhi(b.x) + p2 * bflo(b.y) + p3 * bfhi(b.y) + p4 * bflo(b.z) + p5 * bfhi(b.z) + p6 * bflo(b.w) + p7 * bfhi(b.w); }
        }
        const float il = 1.f / l;
        *(unsigned*)(ATT + (size_t)q * 2048 + h * 128 + 2 * lane) = pk2(o0 * il, o1 * il);
        asm volatile("" ::: "memory");
    }
}
__device__ __forceinline__ void hgrn_naive(unsigned char* ws, int layer, int gw, int ngw, int lane) {
    const bf16* HQ = (const bf16*)(ws + WS_HQ); const float* HF = (const float*)(ws + WS_HF); const bf16* VTH = (const bf16*)(ws + WS_VTH);
    const float* LB = (const float*)(ws + WS_LB) + layer * 2048; float* RR = (float*)(ws + WS_RRAW);
    for (int item = gw; item < NH * 128; item += ngw) {
        const int h = item >> 7, e = item & 127, ch = h * 128 + 2 * lane;
        const float lb0 = LB[ch], lb1 = LB[ch + 1];
        float s0 = 0.f, s1 = 0.f;
        const bf16* vp = VTH + (size_t)(h * 128 + e) * S_;
        for (int t0 = 0; t0 < S_; t0 += 8) {
            const v4u vv = *(const v4u*)(vp + t0);
            const float vt[8] = {bflo(vv.x), bfhi(vv.x), bflo(vv.y), bfhi(vv.y), bflo(vv.z), bfhi(vv.z), bflo(vv.w), bfhi(vv.w)};
            float ov = 0.f;
#pragma unroll
            for (int i = 0; i < 8; ++i) { const size_t off = (size_t)(t0 + i) * 2048 + ch;
                const f32x2 z = *(const f32x2*)(HF + off); const unsigned qq = *(const unsigned*)(HQ + off);
                const float f0 = lb0 + (1.f - lb0) * sigm(z.x), f1 = lb1 + (1.f - lb1) * sigm(z.y);
                s0 = fmaxf(f0, 1e-30f) * s0 + (1.f - f0) * vt[i]; s1 = fmaxf(f1, 1e-30f) * s1 + (1.f - f1) * vt[i];
                const float o = wave_sum(bflo(qq) * s0 + bfhi(qq) * s1);
                ov = (lane == i) ? o : ov; }
            if (lane < 8) RR[(size_t)(t0 + lane) * 2048 + h * 128 + e] = ov;
        }
    }
}
__device__ __forceinline__ void hgrn_normgate(unsigned char* ws, const float* gain, int gw, int ngw, int lane) {
    const float* RR = (const float*)(ws + WS_RRAW); const bf16* HG = (const bf16*)(ws + WS_HG); bf16* REC = (bf16*)(ws + WS_REC);
    const f32x2 g = *(const GAS f32x2*)(gain + 2 * lane);
    for (int item = gw; item < S_ * NH; item += ngw) {
        const size_t off = (size_t)item * 128 + 2 * lane;
        const f32x2 v = *(const f32x2*)(RR + off); const unsigned hg = *(const unsigned*)(HG + off);
        const float rstd = 1.0f / sqrtf(wave_sum(v.x * v.x + v.y * v.y) * (1.f / 128.f) + EPS);
        *(unsigned*)(REC + off) = pk2(v.x * rstd * g.x * bflo(hg), v.y * rstd * g.y * bfhi(hg));
    }
}
__device__ __forceinline__ void conv_gate(unsigned char* ws, const float* cw, const float* cb, int gw, int ngw, int lane) {
    const bf16* U = (const bf16*)(ws + WS_U); bf16* ACT = (bf16*)(ws + WS_ACT);
    for (int item = gw; item < (S_ / 16) * 11; item += ngw) {
        const int tb = item / 11, cg = item % 11, c0 = cg * 512 + lane * 8;
        const int ucol = (c0 >> 7) * 256 + (c0 & 127), t0 = tb * 16;
        float wg[3][8], wu[3][8], bg[8], bu[8];
#pragma unroll
        for (int j = 0; j < 3; ++j)
#pragma unroll
            for (int i = 0; i < 8; ++i) { wg[j][i] = ((const GAS float*)cw)[(size_t)j * DFF2 + c0 + i]; wu[j][i] = ((const GAS float*)cw)[(size_t)j * DFF2 + DFF + c0 + i]; }
#pragma unroll
        for (int i = 0; i < 8; ++i) { bg[i] = ((const GAS float*)cb)[c0 + i]; bu[i] = ((const GAS float*)cb)[DFF + c0 + i]; }
        float g2[8], g1[8], u2[8], u1[8];
#pragma unroll
        for (int i = 0; i < 8; ++i) { g2[i] = 0.f; g1[i] = 0.f; u2[i] = 0.f; u1[i] = 0.f; }
        if (t0 > 0) {
            const v4u a = *(const v4u*)(U + (size_t)(t0 - 2) * DFF2 + ucol), b = *(const v4u*)(U + (size_t)(t0 - 2) * DFF2 + ucol + 128);
            const v4u c = *(const v4u*)(U + (size_t)(t0 - 1) * DFF2 + ucol), d = *(const v4u*)(U + (size_t)(t0 - 1) * DFF2 + ucol + 128);
            g2[0] = bflo(a.x); g2[1] = bfhi(a.x); g2[2] = bflo(a.y); g2[3] = bfhi(a.y); g2[4] = bflo(a.z); g2[5] = bfhi(a.z); g2[6] = bflo(a.w); g2[7] = bfhi(a.w);
            u2[0] = bflo(b.x); u2[1] = bfhi(b.x); u2[2] = bflo(b.y); u2[3] = bfhi(b.y); u2[4] = bflo(b.z); u2[5] = bfhi(b.z); u2[6] = bflo(b.w); u2[7] = bfhi(b.w);
            g1[0] = bflo(c.x); g1[1] = bfhi(c.x); g1[2] = bflo(c.y); g1[3] = bfhi(c.y); g1[4] = bflo(c.z); g1[5] = bfhi(c.z); g1[6] = bflo(c.w); g1[7] = bfhi(c.w);
            u1[0] = bflo(d.x); u1[1] = bfhi(d.x); u1[2] = bflo(d.y); u1[3] = bfhi(d.y); u1[4] = bflo(d.z); u1[5] = bfhi(d.z); u1[6] = bflo(d.w); u1[7] = bfhi(d.w);
        }
#pragma unroll 4
        for (int t = t0; t < t0 + 16; ++t) {
            const v4u a = *(const v4u*)(U + (size_t)t * DFF2 + ucol), b = *(const v4u*)(U + (size_t)t * DFF2 + ucol + 128);
            float g0[8], u0[8];
            g0[0] = bflo(a.x); g0[1] = bfhi(a.x); g0[2] = bflo(a.y); g0[3] = bfhi(a.y); g0[4] = bflo(a.z); g0[5] = bfhi(a.z); g0[6] = bflo(a.w); g0[7] = bfhi(a.w);
            u0[0] = bflo(b.x); u0[1] = bfhi(b.x); u0[2] = bflo(b.y); u0[3] = bfhi(b.y); u0[4] = bflo(b.z); u0[5] = bfhi(b.z); u0[6] = bflo(b.w); u0[7] = bfhi(b.w);
            float r[8];
#pragma unroll
            for (int i = 0; i < 8; ++i) { const float G = bg[i] + wg[0][i] * g2[i] + wg[1][i] * g1[i] + wg[2][i] * g0[i]; const float Uu = bu[i] + wu[0][i] * u2[i] + wu[1][i] * u1[i] + wu[2][i] * u0[i];
                r[i] = G * sigm(G) * Uu; g2[i] = g1[i]; g1[i] = g0[i]; u2[i] = u1[i]; u1[i] = u0[i]; }
            v4u o; o.x = pk2(r[0], r[1]); o.y = pk2(r[2], r[3]); o.z = pk2(r[4], r[5]); o.w = pk2(r[6], r[7]);
            *(v4u*)(ACT + (size_t)t * DFF + c0) = o;
        }
    }
}

#ifndef NAIVE_ATTN
#define NAIVE_ATTN 1
#endif
#ifndef NAIVE_HGRN
#define NAIVE_HGRN 1
#endif
struct Args { const float* in[19]; float* out; unsigned char* ws; };
enum { I_X = 0, I_POS, I_ANG, I_WIN, I_QNG, I_WUQ, I_KVNG, I_WUKV, I_LBL, I_HONG, I_WA, I_WB, I_WO, I_FNG, I_WUP, I_CW, I_CB, I_WDN, I_FING };

__global__ void __launch_bounds__(NTHR, 2) mk_fwd(Args args) {
    extern __shared__ __attribute__((aligned(16))) unsigned char lds_raw[];
    LAS unsigned char* lds = (LAS unsigned char*)lds_raw;
    const int tid = threadIdx.x, lane = tid & 63, wave = __builtin_amdgcn_readfirstlane(tid >> 6);
    const int G = gridDim.x, bx = blockIdx.x, vcu = (G % 8 == 0) ? (bx % 8) * (G / 8) + bx / 8 : bx;
    const int gw = vcu * NWAVES + wave, ngw = G * NWAVES;
    unsigned char* ws = args.ws;
    for (int u = tid; u < (LDS_BYTES - LDSCTL_OFF) / 4; u += NTHR) ((LAS unsigned*)(lds + LDSCTL_OFF))[u] = 0u;
    __syncthreads();
    XcdBarrier bar = xcd_barrier_post((unsigned*)(ws + WS_CTL) + CW_BAR, (volatile LAS unsigned*)(lds + MISC_OFF) + 8);
    float* X = args.out;
    if (tid < 19) ((LAS unsigned long long*)(lds + MISC_OFF + 128))[tid] = ((const __attribute__((address_space(4))) unsigned long long*)__builtin_amdgcn_kernarg_segment_ptr())[tid];
    __syncthreads();
#define INP(i) ((const float*)(((unsigned long long)(unsigned)__builtin_amdgcn_readfirstlane((int)(((LAS const unsigned long long*)(lds + MISC_OFF + 128))[i] >> 32)) << 32) | (unsigned long long)(unsigned)__builtin_amdgcn_readfirstlane((int)(unsigned)((LAS const unsigned long long*)(lds + MISC_OFF + 128))[i])))

    {
        LAS float* scr = (LAS float*)(lds + RING_OFF + wave * 16384);
        constexpr int I_IN = 32 * (WINR / 32), I_UQ = 8 * 96, I_K = 8 * 64, I_V = 8 * 64, I_SQ = 32 * 64, I_UP = 32 * 352, I_DN = 88 * 64;
        constexpr int PER_LAYER = I_IN + I_UQ + I_K + I_V + 3 * I_SQ + I_UP + I_DN;
        for (int it = gw; it < DEPTH * PER_LAYER; it += ngw) {
            const int l = it / PER_LAYER; int r = it % PER_LAYER;
            unsigned char* wl = ws + WS_W + (size_t)l * LW;
            if (r < I_IN) { transpose_item<1>(INP(I_WIN) + (size_t)l * DM * INW, DM, INW, (bf16*)(wl + LW_IN), nullptr, scr, r / (WINR / 32), r % (WINR / 32), lane); continue; } r -= I_IN;
            if (r < I_UQ) { transpose_item<2>(INP(I_WUQ) + (size_t)l * QL * 3072, QL, 3072, (bf16*)(wl + LW_UQ), INP(I_QNG) + l * QL, scr, r / 96, r % 96, lane); continue; } r -= I_UQ;
            if (r < I_K) { transpose_item<3>(INP(I_WUKV) + (size_t)l * KVL * 4096, KVL, 4096, (bf16*)(wl + LW_K), INP(I_KVNG) + l * KVL, scr, r / 64, r % 64, lane); continue; } r -= I_K;
            if (r < I_V) { transpose_item<4>(INP(I_WUKV) + (size_t)l * KVL * 4096, KVL, 4096, (bf16*)(wl + LW_V), INP(I_KVNG) + l * KVL, scr, r / 64, r % 64, lane); continue; } r -= I_V;
            if (r < I_SQ) { transpose_item<0>(INP(I_WA) + (size_t)l * DM * DM, DM, DM, (bf16*)(wl + LW_A), nullptr, scr, r / 64, r % 64, lane); continue; } r -= I_SQ;
            if (r < I_SQ) { transpose_item<0>(INP(I_WB) + (size_t)l * DM * DM, DM, DM, (bf16*)(wl + LW_B), nullptr, scr, r / 64, r % 64, lane); continue; } r -= I_SQ;
            if (r < I_SQ) { transpose_item<0>(INP(I_WO) + (size_t)l * DM * DM, DM, DM, (bf16*)(wl + LW_O), nullptr, scr, r / 64, r % 64, lane); continue; } r -= I_SQ;
            if (r < I_UP) { transpose_item<5>(INP(I_WUP) + (size_t)l * DM * DFF2, DM, DFF2, (bf16*)(wl + LW_UP), nullptr, scr, r / 352, r % 352, lane); continue; } r -= I_UP;
            transpose_item<0>(INP(I_WDN) + (size_t)l * DFF * DM, DFF, DM, (bf16*)(wl + LW_DN), nullptr, scr, r / 64, r % 64, lane);
        }
        { const GAS int* pos = (const GAS int*)INP(I_POS); float* COS = (float*)(ws + WS_COS); float* SIN = (float*)(ws + WS_SIN);
          for (int i = vcu * NTHR + tid; i < S_ * 32; i += G * NTHR) { const float ang = (float)pos[i >> 5] * c_invf[i & 31]; float sn, cs; sincos_f64(ang, sn, cs); COS[i] = cs; SIN[i] = sn; } }
        { const GAS float* lg = (const GAS float*)INP(I_LBL); float* LB = (float*)(ws + WS_LB);
          for (int c = vcu * NTHR + tid; c < 2048; c += G * NTHR) { const float a0 = lg[c], a1 = lg[2048 + c], a2 = lg[4096 + c], a3 = lg[6144 + c];
              const float mx = fmaxf(fmaxf(a0, a1), fmaxf(a2, a3)); const float e0 = expf(a0 - mx), e1 = expf(a1 - mx), e2 = expf(a2 - mx), e3 = expf(a3 - mx); const float inv = 1.f / (e0 + e1 + e2 + e3);
              LB[c] = 0.f; LB[2048 + c] = e1 * inv; LB[4096 + c] = (e1 + e2) * inv; LB[6144 + c] = (e1 + e2 + e3) * inv; } }
        for (int m = gw; m < S_; m += ngw) rms_row_to_bf16(INP(I_X) + (size_t)m * DM, INP(I_ANG), (bf16*)(ws + WS_XN) + (size_t)m * DM, X + (size_t)m * DM, lane);
    }
    xcd_barrier(bar);

    for (int l = 0; l < DEPTH; ++l) {
        unsigned char* wl = ws + WS_W + (size_t)l * LW;
        int lane_l = lane; asm volatile("" : "+v"(lane_l));
        { pg8::Gemm g{(const pg8::bf16_t*)(ws + WS_XN), (const pg8::bf16_t*)(wl + LW_IN), S_, NNAT, DM, DM, DM}; pg8::StaticOrder S; S.init(S_, NNAT, G, bx);
          pg8::EpiIn E{ws}; pg8::gemm_phase<pg8::EpiIn, pg8::StaticOrder, true, true>(lds + RING_OFF, g, S, E); }
        { pg8::Gemm g{(const pg8::bf16_t*)(wl + LW_IN) + (size_t)NNAT * DM, (const pg8::bf16_t*)(ws + WS_XN), 2048, S_, DM, DM, DM}; pg8::StaticOrder S; S.init(2048, S_, G, bx);
          pg8::EpiStore E{(pg8::bf16_t*)(ws + WS_VTH), S_}; pg8::gemm_phase<pg8::EpiStore, pg8::StaticOrder, true, true>(lds + RING_OFF, g, S, E); }
        xcd_barrier(bar);
        for (int m = gw; m < S_; m += ngw) latent_norm_row((bf16*)(ws + WS_CQKV) + (size_t)m * 1024, lane_l);
        xcd_barrier(bar);
        { pg8::Gemm g{(const pg8::bf16_t*)(ws + WS_CQKV), (const pg8::bf16_t*)(wl + LW_UQ), S_, 3072, QL, 1024, QL}; pg8::StaticOrder S; S.init(S_, 3072, G, bx);
          pg8::EpiQ E{ws}; pg8::gemm_phase<pg8::EpiQ, pg8::StaticOrder, true, true>(lds + RING_OFF, g, S, E); }
        { pg8::Gemm g{(const pg8::bf16_t*)(ws + WS_CQKV) + 512, (const pg8::bf16_t*)(wl + LW_K), S_, 2048, KVL, 1024, KVL}; pg8::StaticOrder S; S.init(S_, 2048, G, bx);
          pg8::EpiStore E{(pg8::bf16_t*)(ws + WS_KN), 2048}; pg8::gemm_phase<pg8::EpiStore, pg8::StaticOrder, true, true>(lds + RING_OFF, g, S, E); }
        { pg8::Gemm g{(const pg8::bf16_t*)(wl + LW_V), (const pg8::bf16_t*)(ws + WS_CQKV) + 512, 2048, S_, KVL, KVL, 1024}; pg8::StaticOrder S; S.init(2048, S_, G, bx);
          pg8::EpiStore E{(pg8::bf16_t*)(ws + WS_VT), S_}; pg8::gemm_phase<pg8::EpiStore, pg8::StaticOrder, true, true>(lds + RING_OFF, g, S, E); }
#if NAIVE_HGRN
        hgrn_naive(ws, l, gw, ngw, lane_l);
#endif
        xcd_barrier(bar);
#if NAIVE_ATTN
        attn_naive(ws, (LAS float*)(lds + RING_OFF) + wave * 192, gw, ngw, lane_l);
#endif
#if NAIVE_HGRN
        hgrn_normgate(ws, INP(I_HONG) + l * 128, gw, ngw, lane_l);
#endif
        xcd_barrier(bar);
        { pg8::Gemm g{(const pg8::bf16_t*)(ws + WS_ATT), (const pg8::bf16_t*)(wl + LW_A), S_, DM, DM, DM, DM}; pg8::StaticOrder S; S.init(S_, DM, G, bx);
          pg8::EpiGateA E{ws}; pg8::gemm_phase<pg8::EpiGateA, pg8::StaticOrder, true, true>(lds + RING_OFF, g, S, E); }
        { pg8::Gemm g{(const pg8::bf16_t*)(ws + WS_REC), (const pg8::bf16_t*)(wl + LW_B), S_, DM, DM, DM, DM}; pg8::StaticOrder S; S.init(S_, DM, G, bx);
          pg8::EpiGateB E{ws}; pg8::gemm_phase<pg8::EpiGateB, pg8::StaticOrder, true, true>(lds + RING_OFF, g, S, E); }
        xcd_barrier(bar);
        { pg8::Gemm g{(const pg8::bf16_t*)(ws + WS_MRG), (const pg8::bf16_t*)(wl + LW_O), S_, DM, DM, DM, DM}; pg8::StaticOrder S; S.init(S_, DM, G, bx);
          pg8::EpiRes E{X}; pg8::gemm_phase<pg8::EpiRes, pg8::StaticOrder, true, true>(lds + RING_OFF, g, S, E); }
        xcd_barrier(bar);
        for (int m = gw; m < S_; m += ngw) rms_row_to_bf16(X + (size_t)m * DM, INP(I_FNG) + l * DM, (bf16*)(ws + WS_XN) + (size_t)m * DM, nullptr, lane_l);
        xcd_barrier(bar);
        { pg8::Gemm g{(const pg8::bf16_t*)(ws + WS_XN), (const pg8::bf16_t*)(wl + LW_UP), S_, DFF2, DM, DM, DM}; pg8::StaticOrder S; S.init(S_, DFF2, G, bx);
          pg8::EpiStore E{(pg8::bf16_t*)(ws + WS_U), DFF2}; pg8::gemm_phase<pg8::EpiStore, pg8::StaticOrder, true, true>(lds + RING_OFF, g, S, E); }
        xcd_barrier(bar);
        conv_gate(ws, INP(I_CW) + (size_t)l * 3 * DFF2, INP(I_CB) + (size_t)l * DFF2, gw, ngw, lane_l);
        xcd_barrier(bar);
        { pg8::Gemm g{(const pg8::bf16_t*)(ws + WS_ACT), (const pg8::bf16_t*)(wl + LW_DN), S_, DM, DFF, DFF, DFF}; pg8::StaticOrder S; S.init(S_, DM, G, bx);
          pg8::EpiRes E{X}; pg8::gemm_phase<pg8::EpiRes, pg8::StaticOrder, true, true>(lds + RING_OFF, g, S, E); }
        xcd_barrier(bar);
        if (l + 1 < DEPTH) { for (int m = gw; m < S_; m += ngw) rms_row_to_bf16(X + (size_t)m * DM, INP(I_ANG) + (l + 1) * DM, (bf16*)(ws + WS_XN) + (size_t)m * DM, nullptr, lane_l);
            xcd_barrier(bar); }
        else { for (int m = gw; m < S_; m += ngw) rms_row_f32(X + (size_t)m * DM, INP(I_FING), lane_l); }
    }
}

extern "C" void kernel_launch(void* const* d_in, const int* in_sizes, int n_in, void* d_out, int out_size, void* d_ws, size_t ws_size, hipStream_t stream) {
    static int grid = 0;
    if (grid == 0) {
        if (n_in != 19 || in_sizes[0] != S_ * DM || out_size != S_ * DM || ws_size < WS_END) { fprintf(stderr, "kernel_launch: shape/workspace mismatch (n_in %d, in0 %d, out %d, ws %zu need %zu)\n", n_in, n_in > 0 ? in_sizes[0] : -1, out_size, ws_size, (size_t)WS_END); grid = -1; return; }
        int dev = 0, cus = 0, per_cu = 0;
        if (hipGetDevice(&dev) != hipSuccess || hipDeviceGetAttribute(&cus, hipDeviceAttributeMultiprocessorCount, dev) != hipSuccess) { grid = -1; return; }
        if (hipFuncSetAttribute((const void*)mk_fwd, hipFuncAttributeMaxDynamicSharedMemorySize, LDS_BYTES) != hipSuccess) { fprintf(stderr, "kernel_launch: hipFuncSetAttribute failed\n"); grid = -1; return; }
        if (hipOccupancyMaxActiveBlocksPerMultiprocessor(&per_cu, (const void*)mk_fwd, NTHR, LDS_BYTES) != hipSuccess || per_cu < 1) { fprintf(stderr, "kernel_launch: occupancy query reports %d blocks per CU\n", per_cu); }
        (void)hipGetLastError();
        grid = cus;
    }
    if (grid < 0) return;
    if (hipMemsetAsync((char*)d_ws + WS_CTL, 0, CTL_ZERO_BYTES, stream) != hipSuccess) return;
    Args a{};
    for (int i = 0; i < 19; ++i) a.in[i] = (const float*)d_in[i];
    a.out = (float*)d_out; a.ws = (unsigned char*)d_ws;
    hipLaunchKernelGGL(mk_fwd, dim3(grid), dim3(NTHR), LDS_BYTES, stream, a);
}
```

```cpp
#include <hip/hip_runtime.h>
#include <cstdio>
#include <cstdint>
namespace pg8 {
#define PG8_LAS __attribute__((address_space(3)))
typedef unsigned short bf16_t;
typedef short bf16x8 __attribute__((ext_vector_type(8)));
typedef float f32x4 __attribute__((ext_vector_type(4)));
typedef unsigned u32x4 __attribute__((ext_vector_type(4)));
constexpr int BM = 256, BK = 64, HALF = 128, HTB = HALF * BK * 2  , STAGE_BYTES = 8 * HTB, NXCD = 8, WGM = 8;

__host__ __device__ __forceinline__ int lds_byte(int r, int c) { const int st = (r >> 4) * 2 + (c >> 5), rr = r & 15, cc = c & 31, ob = rr * 64 + cc * 2; return st * 1024 + (ob ^ (((ob >> 9) & 1) << 5)); }
__host__ __device__ __forceinline__ void stage_rc(int b, int& R, int& C) { const int st = b / 1024, sb = b % 1024, swz = sb ^ (((sb >> 9) & 1) << 5); R = (st >> 1) * 16 + swz / 64; C = (st & 1) * 32 + (swz % 64) / 2; }
__host__ __device__ __forceinline__ int perm32(int rho) { const int n = rho >> 4, i = rho & 15; return 8 * (i >> 2) + 4 * n + (i & 3); }

struct Unit { int pm, pn; };
struct Gemm { const bf16_t* A; const bf16_t* Bt; int M, N, K, lda, ldb; };

struct StaticOrder {
    int nM, nN, nwg, G, c;
    __host__ __device__ void init(int M, int N, int G_, int c_) { nM = M / BM; nN = N / BM; nwg = nM * nN; G = G_; c = c_; }
    __host__ __device__ bool next(int i, Unit& u) const {
        const long L = (long)i * G + c; if (L >= nwg) return false;
        int wgid = (int)L; { const int q = nwg / NXCD, r = nwg % NXCD, xcd = wgid % NXCD, off = wgid / NXCD; wgid = (xcd < r ? xcd * (q + 1) : r * (q + 1) + (xcd - r) * q) + off; }
        const int nig = WGM * nN, gid = wgid / nig, fm = gid * WGM, gsz = (nM - fm) < WGM ? (nM - fm) : WGM;
        u.pm = fm + ((wgid % nig) % gsz); u.pn = (wgid % nig) / gsz; return true;
    }
    __device__ __forceinline__ void a_ready(const Unit&) const {}
    __device__ __forceinline__ void done(const Unit&) const {}
};

__device__ __forceinline__ unsigned cvt_pk_bf16(float lo, float hi) { unsigned r; asm volatile("v_cvt_pk_bf16_f32 %0, %1, %2" : "=v"(r) : "v"(lo), "v"(hi)); return r; }
template <class Epi, class Sched, bool ALIGN_EPI = false, bool SP2 = false>
__device__ __forceinline__ void gemm_phase(PG8_LAS unsigned char* lds, const Gemm g, const Sched& S, const Epi& E) {
    int tid = threadIdx.x; asm volatile("" : "+v"(tid));
    const int wid = __builtin_amdgcn_readfirstlane(tid >> 6), lane = tid & 63, wr = wid >> 2, wc = wid & 3, fr = lane & 15, fq = lane >> 4;
    const int K = g.K, nt = K / BK;
    unsigned voffA[2], voffB[2];
#pragma unroll
    for (int i = 0; i < 2; ++i) { int R, C; stage_rc(tid * 16 + i * 8192, R, C); const int Rb = Epi::PERM ? ((R & ~31) + perm32(R & 31)) : R;
        voffA[i] = (unsigned)(R * g.lda + C) * 2u; voffB[i] = (unsigned)(Rb * g.ldb + C) * 2u; }
    const size_t kstep = (size_t)(BK * 2);
    const size_t hstepA = (size_t)HALF * g.lda * 2, hstepB = (size_t)HALF * g.ldb * 2;
    const size_t tstepA = 2 * hstepA, tstepB = 2 * hstepB;
    const unsigned ldsw = (unsigned)wid * 1024u;
    const int aoff = lds_byte(wr * 64 + fr, fq * 8), boff = lds_byte(wc * 32 + fr, fq * 8);
#define PG8_SA(b, h) (((b) * 2 + (h)) * HTB)
#define PG8_SB(b, h) ((4 + (b) * 2 + (h)) * HTB)
#define PG8_STAGE(bufoff, gbase, voff) do { _Pragma("unroll") for (int _i = 0; _i < 2; ++_i) \
        __builtin_amdgcn_global_load_lds((const unsigned*)((const char*)(gbase) + (voff)[_i]), (PG8_LAS unsigned*)(lds + (bufoff) + ldsw + _i * 8192), 16, 0, 0); } while (0)
#define PG8_LDA(dst, b, h) do { _Pragma("unroll") for (int m = 0; m < 4; ++m) _Pragma("unroll") for (int k = 0; k < 2; ++k) dst[m][k] = *(const PG8_LAS bf16x8*)(lds + PG8_SA(b, h) + aoff + m * 2048 + k * 1024); } while (0)
#define PG8_LDB(dst, b, h) do { _Pragma("unroll") for (int n = 0; n < 2; ++n) _Pragma("unroll") for (int k = 0; k < 2; ++k) dst[n][k] = *(const PG8_LAS bf16x8*)(lds + PG8_SB(b, h) + boff + n * 2048 + k * 1024); } while (0)
#define PG8_MMA(ai, bj, At, Bt) do { __builtin_amdgcn_s_setprio(1); _Pragma("unroll") for (int m = 0; m < 4; ++m) _Pragma("unroll") for (int n = 0; n < 2; ++n) _Pragma("unroll") for (int k = 0; k < 2; ++k) \
        acc[ai][bj][m][n] = __builtin_amdgcn_mfma_f32_16x16x32_bf16(Bt[n][k], At[m][k], acc[ai][bj][m][n], 0, 0, 0); __builtin_amdgcn_s_setprio(0); } while (0)
#define PG8_WAIT_V(n) asm volatile("s_waitcnt vmcnt(" #n ")" ::: "memory")
#define PG8_WAIT_L(n) asm volatile("s_waitcnt lgkmcnt(" #n ")" ::: "memory")
#define PG8_BAR __builtin_amdgcn_s_barrier()
#define PG8_SCHED __builtin_amdgcn_sched_barrier(0)
    Unit cur, nxt; int ui = 0;
    if (!S.next(0, cur)) return;
    f32x4 acc[2][2][4][2];
#pragma unroll
    for (int a = 0; a < 2; ++a)
#pragma unroll
        for (int b = 0; b < 2; ++b)
#pragma unroll
            for (int m = 0; m < 4; ++m)
#pragma unroll
                for (int n = 0; n < 2; ++n) acc[a][b][m][n] = (f32x4){0.f, 0.f, 0.f, 0.f};
    bf16x8 At[4][2], B0[2][2], B1[2][2];
    const char* cA = (const char*)g.A + (size_t)cur.pm * tstepA; const char* cB = (const char*)g.Bt + (size_t)cur.pn * tstepB;
    S.a_ready(cur);
    if constexpr (SP2) {
        PG8_STAGE(PG8_SB(0, 0), cB, voffB); PG8_STAGE(PG8_SB(0, 1), cB + hstepB, voffB); PG8_STAGE(PG8_SA(0, 0), cA, voffA); PG8_STAGE(PG8_SA(0, 1), cA + hstepA, voffA);
        if (wr == 1) PG8_BAR;
        PG8_WAIT_V(2); PG8_BAR;
        PG8_STAGE(PG8_SB(1, 0), cB + kstep, voffB); PG8_STAGE(PG8_SA(1, 0), cA + kstep, voffA); PG8_STAGE(PG8_SB(1, 1), cB + hstepB + kstep, voffB);
        PG8_WAIT_V(6); PG8_BAR;
    } else {
        PG8_STAGE(PG8_SB(0, 0), cB, voffB); PG8_STAGE(PG8_SA(0, 0), cA, voffA); PG8_STAGE(PG8_SB(0, 1), cB + hstepB, voffB); PG8_STAGE(PG8_SA(0, 1), cA + hstepA, voffA);
        if (wr == 1) PG8_BAR;
        PG8_WAIT_V(4); PG8_BAR;
        PG8_STAGE(PG8_SB(1, 0), cB + kstep, voffB); PG8_STAGE(PG8_SA(1, 0), cA + kstep, voffA); PG8_STAGE(PG8_SB(1, 1), cB + hstepB + kstep, voffB);
        PG8_WAIT_V(6); PG8_BAR;
    }
    for (;;) {
        const bool has_next = S.next(ui + 1, nxt);
        const char* nA = has_next ? (const char*)g.A + (size_t)nxt.pm * tstepA : cA; const char* nB = has_next ? (const char*)g.Bt + (size_t)nxt.pn * tstepB : cB;
        for (int t = 0; t < nt; t += 2) {
            const bool last = (t == nt - 2);
            const char* a1 = cA + (size_t)(t + 1) * kstep;
            const char* a2 = last ? nA : cA + (size_t)(t + 2) * kstep; const char* b2 = last ? nB : cB + (size_t)(t + 2) * kstep;
            const char* a3 = a2 + kstep; const char* b3 = b2 + kstep;
            if (last && has_next) S.a_ready(nxt);
            if constexpr (SP2) {
            PG8_LDB(B0, 0, 0); PG8_LDB(B1, 0, 1); PG8_SCHED; PG8_LDA(At, 0, 0); PG8_STAGE(PG8_SA(1, 1), a1 + hstepA, voffA);
            PG8_WAIT_V(8); PG8_WAIT_L(0); PG8_BAR; PG8_MMA(0, 0, At, B0); PG8_MMA(0, 1, At, B1); PG8_BAR; PG8_SCHED;
            PG8_LDA(At, 0, 1); PG8_STAGE(PG8_SB(0, 0), b2, voffB); PG8_STAGE(PG8_SB(0, 1), b2 + hstepB, voffB); PG8_STAGE(PG8_SA(0, 0), a2, voffA);
            PG8_WAIT_V(8); PG8_WAIT_L(0); PG8_BAR; PG8_MMA(1, 0, At, B0); PG8_MMA(1, 1, At, B1); PG8_BAR; PG8_SCHED;
            PG8_LDB(B0, 1, 0); PG8_LDB(B1, 1, 1); PG8_SCHED; PG8_LDA(At, 1, 0); PG8_STAGE(PG8_SA(0, 1), a2 + hstepA, voffA);
            PG8_WAIT_V(8); PG8_WAIT_L(0); PG8_BAR; PG8_MMA(0, 0, At, B0); PG8_MMA(0, 1, At, B1); PG8_BAR; PG8_SCHED;
            PG8_LDA(At, 1, 1); PG8_STAGE(PG8_SB(1, 0), b3, voffB); PG8_STAGE(PG8_SB(1, 1), b3 + hstepB, voffB); PG8_STAGE(PG8_SA(1, 0), a3, voffA);
            PG8_WAIT_V(8); PG8_WAIT_L(0); PG8_BAR; PG8_MMA(1, 0, At, B0); PG8_MMA(1, 1, At, B1); PG8_BAR; PG8_SCHED;
            } else {
            PG8_LDB(B0, 0, 0); PG8_SCHED; PG8_LDA(At, 0, 0); PG8_STAGE(PG8_SA(1, 1), a1 + hstepA, voffA);
            PG8_WAIT_L(8); PG8_BAR; PG8_WAIT_L(0); PG8_MMA(0, 0, At, B0); PG8_BAR; PG8_SCHED;
            PG8_LDB(B1, 0, 1); PG8_STAGE(PG8_SB(0, 0), b2, voffB);
            PG8_BAR; PG8_WAIT_L(0); PG8_MMA(0, 1, At, B1); PG8_BAR;
            PG8_LDA(At, 0, 1); PG8_STAGE(PG8_SA(0, 0), a2, voffA);
            PG8_BAR; PG8_WAIT_L(0); PG8_MMA(1, 0, At, B0); PG8_BAR; PG8_SCHED;
            PG8_STAGE(PG8_SB(0, 1), b2 + hstepB, voffB);
            PG8_WAIT_V(6); PG8_BAR; PG8_MMA(1, 1, At, B1); PG8_BAR;
            PG8_LDB(B0, 1, 0); PG8_SCHED; PG8_LDA(At, 1, 0); PG8_STAGE(PG8_SA(0, 1), a2 + hstepA, voffA);
            PG8_WAIT_L(8); PG8_BAR; PG8_WAIT_L(0); PG8_MMA(0, 0, At, B0); PG8_BAR; PG8_SCHED;
            PG8_LDB(B1, 1, 1); PG8_STAGE(PG8_SB(1, 0), b3, voffB);
            PG8_BAR; PG8_WAIT_L(0); PG8_MMA(0, 1, At, B1); PG8_BAR;
            PG8_LDA(At, 1, 1); PG8_STAGE(PG8_SA(1, 0), a3, voffA);
            PG8_BAR; PG8_WAIT_L(0); PG8_MMA(1, 0, At, B0); PG8_BAR; PG8_SCHED;
            PG8_STAGE(PG8_SB(1, 1), b3 + hstepB, voffB);
            PG8_WAIT_V(6); PG8_BAR; PG8_MMA(1, 1, At, B1); PG8_BAR;
            }
        }
        if constexpr (ALIGN_EPI) { if (wr == 0) PG8_BAR; }
        if constexpr (!Epi::AFTER_DRAIN) { E(acc, cur, wr, wc, fr, fq); S.done(cur); }
        if (!has_next) break;
#pragma unroll
        for (int a = 0; a < 2; ++a)
#pragma unroll
            for (int b = 0; b < 2; ++b)
#pragma unroll
                for (int m = 0; m < 4; ++m)
#pragma unroll
                    for (int n = 0; n < 2; ++n) acc[a][b][m][n] = (f32x4){0.f, 0.f, 0.f, 0.f};
        cur = nxt; cA = nA; cB = nB; ++ui;
        if constexpr (ALIGN_EPI) { if (wr == 1) PG8_BAR; }
    }
    PG8_WAIT_V(0);
    if constexpr (!ALIGN_EPI) { if (wr == 0) PG8_BAR; }
    PG8_BAR;
    if constexpr (Epi::AFTER_DRAIN) { E.fused(acc, cur, wr, wc, fr, fq, lds, wid, lane); S.done(cur); }
#undef PG8_SA
#undef PG8_SB
#undef PG8_STAGE
#undef PG8_LDA
#undef PG8_LDB
#undef PG8_MMA
#undef PG8_WAIT_V
#undef PG8_WAIT_L
#undef PG8_BAR
#undef PG8_SCHED
}
}

constexpr int S_ = 8192, DM = 2048, DEPTH = 4, NH = 16;
constexpr int QL = 512, KVL = 512, ROPE = 64, NOPE = 128, VD = 128;
constexpr int INW = 13376;
constexpr int DFF = 5632, DFF2 = 11264;
constexpr int NNAT = 11520;
constexpr int WINR = NNAT + 2048;
constexpr float EPS = 1e-6f;
constexpr float LOG2E = 1.4426950408889634f;
constexpr float QSCALE = 0.07216878364870323f * 1.4426950408889634f;
constexpr int NWAVES = 8, NTHR = 512;

constexpr size_t MiB = 1u << 20;
constexpr size_t WS_CTL = 0, CTL_ZERO_BYTES = 1 * MiB;
constexpr size_t WS_COS = 1 * MiB, WS_SIN = 2 * MiB, WS_LB = 3 * MiB, WS_SSQ = 4 * MiB;
constexpr size_t WS_W = 5 * MiB;
constexpr size_t LW_IN = 0, LW_UQ = 53 * MiB, LW_K = 56 * MiB, LW_V = 58 * MiB, LW_A = 60 * MiB, LW_B = 68 * MiB, LW_O = 76 * MiB, LW_UP = 84 * MiB, LW_DN = 128 * MiB, LW = 150 * MiB;
constexpr size_t WS_XN = WS_W + 4 * LW;
constexpr size_t WS_MIX = WS_XN + 32 * MiB;
constexpr size_t WS_CQKV = WS_MIX;
constexpr size_t WS_KPE = WS_CQKV + 16 * MiB;
constexpr size_t WS_HQ = WS_KPE + 1 * MiB;
constexpr size_t GSTRIDE = 32 * MiB;
constexpr size_t WS_HG = WS_HQ + GSTRIDE, WS_GA = WS_HQ + 2 * GSTRIDE, WS_GB = WS_HQ + 3 * GSTRIDE;
constexpr size_t WS_HF = WS_HQ + 4 * GSTRIDE;
constexpr size_t WS_VTH = WS_HF + 64 * MiB;
constexpr size_t WS_QN = WS_VTH + 32 * MiB;
constexpr size_t WS_QR = WS_QN + 32 * MiB;
constexpr size_t WS_KN = WS_QR + 16 * MiB;
constexpr size_t WS_VT = WS_KN + 32 * MiB;
constexpr size_t WS_ATT = WS_VT + 32 * MiB;
constexpr size_t WS_REC = WS_ATT + 32 * MiB;
constexpr size_t WS_RRAW = WS_REC + 32 * MiB;
constexpr size_t WS_HU = WS_RRAW + 64 * MiB;
constexpr size_t WS_HS = WS_HU + 128 * MiB;
constexpr size_t WS_M1 = WS_HS + 64 * MiB;
constexpr size_t WS_MRG = WS_M1 + 64 * MiB;
constexpr size_t WS_MIX_END = WS_MRG + 32 * MiB;
constexpr size_t WS_U = WS_MIX;
constexpr size_t WS_ACT = WS_U + 176 * MiB;
static_assert(WS_ACT + 88 * MiB <= WS_MIX_END, "FFN overlay fits the mixer region");
constexpr size_t WS_END = WS_MIX_END;
constexpr int CW_BAR = 4096;

constexpr int RING_OFF = 0, RING_BYTES = 131072;
constexpr int LDSCTL_OFF = RING_BYTES, MISC_OFF = LDSCTL_OFF + 320;
constexpr int LDS_BYTES = 147456;

#define GAS __attribute__((address_space(1)))
#define LAS __attribute__((address_space(3)))
typedef unsigned short bf16;
typedef unsigned v4u __attribute__((ext_vector_type(4)));
typedef unsigned v2u __attribute__((ext_vector_type(2)));
typedef float f32x4 __attribute__((ext_vector_type(4)));
typedef float f32x2 __attribute__((ext_vector_type(2)));
typedef short bf16x8 __attribute__((ext_vector_type(8)));
typedef GAS unsigned gu32;
#define LDS_WAIT() asm volatile("s_waitcnt lgkmcnt(0)" ::: "memory")
#define VM_WAIT() asm volatile("s_waitcnt vmcnt(0)" ::: "memory")
__device__ __forceinline__ unsigned f2bf(float f) { unsigned u = __builtin_bit_cast(unsigned, f); return (u + 0x7fffu + ((u >> 16) & 1u)) >> 16; }
__device__ __forceinline__ unsigned pk2(float lo, float hi) { return f2bf(lo) | (f2bf(hi) << 16); }
__device__ __forceinline__ float bflo(unsigned u) { return __builtin_bit_cast(float, u << 16); }
__device__ __forceinline__ float bfhi(unsigned u) { return __builtin_bit_cast(float, u & 0xffff0000u); }
__device__ __forceinline__ float sigm(float x) { return __builtin_amdgcn_rcpf(1.f + __builtin_amdgcn_exp2f(-LOG2E * x)); }
__device__ __forceinline__ float wave_sum(float v) {
#pragma unroll
    for (int o = 1; o < 64; o <<= 1) v += __shfl_xor(v, o);
    return v;
}
__device__ __forceinline__ float wave_max(float v) {
#pragma unroll
    for (int o = 1; o < 64; o <<= 1) v = fmaxf(v, __shfl_xor(v, o));
    return v;
}

namespace pg8 {
__device__ __forceinline__ u32x4 pack8(f32x4 a, f32x4 b) { u32x4 w; w.x = cvt_pk_bf16(a[0], a[1]); w.y = cvt_pk_bf16(a[2], a[3]); w.z = cvt_pk_bf16(b[0], b[1]); w.w = cvt_pk_bf16(b[2], b[3]); return w; }
__device__ __forceinline__ f32x4 silu4(f32x4 v) { f32x4 r; r[0] = v[0] * sigm(v[0]); r[1] = v[1] * sigm(v[1]); r[2] = v[2] * sigm(v[2]); r[3] = v[3] * sigm(v[3]); return r; }
__device__ __forceinline__ f32x4 sigm4(f32x4 v) { f32x4 r; r[0] = sigm(v[0]); r[1] = sigm(v[1]); r[2] = sigm(v[2]); r[3] = sigm(v[3]); return r; }
__device__ __forceinline__ float sum8(const float* p) { const f32x4 a = *(const f32x4*)p, b = *(const f32x4*)(p + 4); return ((a[0] + a[1]) + (a[2] + a[3])) + ((b[0] + b[1]) + (b[2] + b[3])); }
__device__ __forceinline__ void rope8(f32x4& v0, f32x4& v1, const f32x4 cs, const f32x4 sn) {
    f32x4 a, b;
    a[0] = v0[0] * cs[0] - v0[1] * sn[0]; a[1] = v0[1] * cs[0] + v0[0] * sn[0];
    a[2] = v0[2] * cs[1] - v0[3] * sn[1]; a[3] = v0[3] * cs[1] + v0[2] * sn[1];
    b[0] = v1[0] * cs[2] - v1[1] * sn[2]; b[1] = v1[1] * cs[2] + v1[0] * sn[2];
    b[2] = v1[2] * cs[3] - v1[3] * sn[3]; b[3] = v1[3] * cs[3] + v1[2] * sn[3];
    v0 = a; v1 = b;
}

struct EpiIn {
    static constexpr bool PERM = true, AFTER_DRAIN = false;
    unsigned char* ws;
    __device__ __forceinline__ void operator()(const f32x4 (&acc)[2][2][4][2], const Unit& u, int wr, int wc, int fr, int fq) const {
        const int pn = u.pn, row0 = u.pm * BM + wr * 64 + fr, lc = wc * 32 + 8 * fq;
        if (pn == 4) {
            if (wc < 2) {
                const float* COS = (const float*)(ws + WS_COS); const float* SIN = (const float*)(ws + WS_SIN); bf16_t* KPE = (bf16_t*)(ws + WS_KPE);
#pragma unroll
                for (int ai = 0; ai < 2; ++ai)
#pragma unroll
                    for (int m = 0; m < 4; ++m) { const int row = row0 + ai * HALF + m * 16;
                        f32x4 v0 = acc[ai][0][m][0], v1 = acc[ai][0][m][1];
                        const f32x4 cs = *(const f32x4*)(COS + (size_t)row * 32 + wc * 16 + 4 * fq), sn = *(const f32x4*)(SIN + (size_t)row * 32 + wc * 16 + 4 * fq);
                        rope8(v0, v1, cs, sn);
                        *(u32x4*)(KPE + (size_t)row * 64 + lc) = pack8(v0, v1);
                        if (m & 1) asm volatile("" ::: "memory"); }
            }
        } else if (pn >= 13 && pn < 21) {
            float* HF = (float*)(ws + WS_HF);
#pragma unroll
            for (int ai = 0; ai < 2; ++ai)
#pragma unroll
                for (int m = 0; m < 4; ++m) { float* rp = HF + (size_t)(row0 + ai * HALF + m * 16) * 2048 + (pn - 13) * 256 + lc;
#pragma unroll
                    for (int bj = 0; bj < 2; ++bj) { *(f32x4*)(rp + bj * HALF) = acc[ai][bj][m][0]; *(f32x4*)(rp + bj * HALF + 4) = acc[ai][bj][m][1]; } }
        } else {
            bf16_t* base; int ldc, act;
            if (pn < 4) { base = (bf16_t*)(ws + WS_CQKV) + pn * 256; ldc = 1024; act = 0; }
            else { const int gi = (pn < 13) ? 0 : ((pn - 13) >> 3), ct = (pn < 13) ? (pn - 5) : ((pn - 13) & 7);
                   base = (bf16_t*)(ws + WS_HQ + (size_t)gi * GSTRIDE) + ct * 256; ldc = 2048; act = (gi <= 1) ? 1 : 2; }
#pragma unroll
            for (int ai = 0; ai < 2; ++ai)
#pragma unroll
                for (int m = 0; m < 4; ++m) { bf16_t* rp = base + (size_t)(row0 + ai * HALF + m * 16) * ldc + lc;
#pragma unroll
                    for (int bj = 0; bj < 2; ++bj) { f32x4 v0 = acc[ai][bj][m][0], v1 = acc[ai][bj][m][1];
                        if (act == 1) { v0 = silu4(v0); v1 = silu4(v1); }
                        else if (act == 2) { v0 = sigm4(v0); v1 = sigm4(v1); }
                        *(u32x4*)(rp + bj * HALF) = pack8(v0, v1); } }
        }
    }
};
struct EpiStore {
    static constexpr bool PERM = true, AFTER_DRAIN = false;
    bf16_t* O; int ldc;
    __device__ __forceinline__ void operator()(const f32x4 (&acc)[2][2][4][2], const Unit& u, int wr, int wc, int fr, int fq) const {
        const int row0 = u.pm * BM + wr * 64 + fr, col0 = u.pn * BM + wc * 32 + 8 * fq;
#pragma unroll
        for (int ai = 0; ai < 2; ++ai)
#pragma unroll
            for (int m = 0; m < 4; ++m) { bf16_t* rp = O + (size_t)(row0 + ai * HALF + m * 16) * ldc + col0;
#pragma unroll
                for (int bj = 0; bj < 2; ++bj) *(u32x4*)(rp + bj * HALF) = pack8(acc[ai][bj][m][0], acc[ai][bj][m][1]); }
    }
};
struct EpiQ {
    static constexpr bool PERM = true, AFTER_DRAIN = false;
    unsigned char* ws;
    __device__ __forceinline__ void operator()(const f32x4 (&acc)[2][2][4][2], const Unit& u, int wr, int wc, int fr, int fq) const {
        const int pn = u.pn, row0 = u.pm * BM + wr * 64 + fr, lc = wc * 32 + 8 * fq;
        if (pn < 8) {
            bf16_t* base = (bf16_t*)(ws + WS_QN) + pn * 256 + lc;
#pragma unroll
            for (int ai = 0; ai < 2; ++ai)
#pragma unroll
                for (int m = 0; m < 4; ++m)
#pragma unroll
                    for (int bj = 0; bj < 2; ++bj) *(u32x4*)(base + (size_t)(row0 + ai * HALF + m * 16) * 2048 + bj * HALF) = pack8(acc[ai][bj][m][0] * QSCALE, acc[ai][bj][m][1] * QSCALE);
        } else {
            const float* COS = (const float*)(ws + WS_COS); const float* SIN = (const float*)(ws + WS_SIN);
            bf16_t* base = (bf16_t*)(ws + WS_QR) + (pn - 8) * 256 + lc; const int p0 = (wc & 1) * 16 + 4 * fq;
#pragma unroll
            for (int ai = 0; ai < 2; ++ai)
#pragma unroll
                for (int m = 0; m < 4; ++m) { const int row = row0 + ai * HALF + m * 16;
                    const f32x4 cs = *(const f32x4*)(COS + (size_t)row * 32 + p0), sn = *(const f32x4*)(SIN + (size_t)row * 32 + p0);
#pragma unroll
                    for (int bj = 0; bj < 2; ++bj) { f32x4 v0 = acc[ai][bj][m][0] * QSCALE, v1 = acc[ai][bj][m][1] * QSCALE; rope8(v0, v1, cs, sn);
                        *(u32x4*)(base + (size_t)row * 1024 + bj * HALF) = pack8(v0, v1); }
                    if (m & 1) asm volatile("" ::: "memory"); }
        }
    }
};
struct EpiGateA {
    static constexpr bool PERM = true, AFTER_DRAIN = false;
    unsigned char* ws;
    __device__ __forceinline__ void operator()(const f32x4 (&acc)[2][2][4][2], const Unit& u, int wr, int wc, int fr, int fq) const {
        const int row0 = u.pm * BM + wr * 64 + fr, col0 = u.pn * BM + wc * 32 + 8 * fq;
        const bf16_t* G = (const bf16_t*)(ws + WS_GA); float* M1 = (float*)(ws + WS_M1);
#pragma unroll
        for (int ai = 0; ai < 2; ++ai)
#pragma unroll
            for (int m = 0; m < 4; ++m) { const size_t off = (size_t)(row0 + ai * HALF + m * 16) * 2048 + col0;
#pragma unroll
                for (int bj = 0; bj < 2; ++bj) { const u32x4 g = *(const u32x4*)(G + off + bj * HALF);
                    const f32x4 g0 = {bflo(g.x), bfhi(g.x), bflo(g.y), bfhi(g.y)}, g1 = {bflo(g.z), bfhi(g.z), bflo(g.w), bfhi(g.w)};
                    *(f32x4*)(M1 + off + bj * HALF) = acc[ai][bj][m][0] * g0; *(f32x4*)(M1 + off + bj * HALF + 4) = acc[ai][bj][m][1] * g1; }
                if (m & 1) asm volatile("" ::: "memory"); }
    }
};
struct EpiGateB {
    static constexpr bool PERM = true, AFTER_DRAIN = false;
    unsigned char* ws;
    __device__ __forceinline__ void operator()(const f32x4 (&acc)[2][2][4][2], const Unit& u, int wr, int wc, int fr, int fq) const {
        const int row0 = u.pm * BM + wr * 64 + fr, col0 = u.pn * BM + wc * 32 + 8 * fq;
        const bf16_t* G = (const bf16_t*)(ws + WS_GB); const float* M1 = (const float*)(ws + WS_M1); bf16_t* O = (bf16_t*)(ws + WS_MRG);
#pragma unroll
        for (int ai = 0; ai < 2; ++ai)
#pragma unroll
            for (int m = 0; m < 4; ++m) { const size_t off = (size_t)(row0 + ai * HALF + m * 16) * 2048 + col0;
#pragma unroll
                for (int bj = 0; bj < 2; ++bj) { const u32x4 g = *(const u32x4*)(G + off + bj * HALF);
                    const f32x4 g0 = {bflo(g.x), bfhi(g.x), bflo(g.y), bfhi(g.y)}, g1 = {bflo(g.z), bfhi(g.z), bflo(g.w), bfhi(g.w)};
                    const f32x4 m0 = *(const f32x4*)(M1 + off + bj * HALF), m1 = *(const f32x4*)(M1 + off + bj * HALF + 4);
                    *(u32x4*)(O + off + bj * HALF) = pack8(m0 + acc[ai][bj][m][0] * g0, m1 + acc[ai][bj][m][1] * g1); }
                if (m & 1) asm volatile("" ::: "memory"); }
    }
};
struct EpiRes {
    static constexpr bool PERM = true, AFTER_DRAIN = false;
    float* X;
    __device__ __forceinline__ void operator()(const f32x4 (&acc)[2][2][4][2], const Unit& u, int wr, int wc, int fr, int fq) const {
        const int row0 = u.pm * BM + wr * 64 + fr, col0 = u.pn * BM + wc * 32 + 8 * fq;
#pragma unroll
        for (int ai = 0; ai < 2; ++ai)
#pragma unroll
            for (int m = 0; m < 4; ++m) { float* rp = X + (size_t)(row0 + ai * HALF + m * 16) * 2048 + col0;
#pragma unroll
                for (int bj = 0; bj < 2; ++bj) { const f32x4 a = *(const f32x4*)(rp + bj * HALF), b = *(const f32x4*)(rp + bj * HALF + 4);
                    *(f32x4*)(rp + bj * HALF) = a + acc[ai][bj][m][0]; *(f32x4*)(rp + bj * HALF + 4) = b + acc[ai][bj][m][1]; }
                if (m & 1) asm volatile("" ::: "memory"); }
    }
};
}
#define XB_TMO      128
#define XB_XCNT(j)  (256  + 64 * (j))
#define XB_XSUB(j)  (1280 + 64 * (j))
#define XB_XGEN(j)  (2304 + 64 * (j))
#define XB_TOP      3328
#define XB_TOPGEN   3392
#define XCD_BAR_WORDS 3456
#define XB_SPIN_CAP (1u << 18)

__device__ __forceinline__ unsigned xb_ld(unsigned* p)              { return __hip_atomic_load(p, __ATOMIC_RELAXED, __HIP_MEMORY_SCOPE_AGENT); }
__device__ __forceinline__ unsigned xb_add(unsigned* p, unsigned v) { return __hip_atomic_fetch_add(p, v, __ATOMIC_RELAXED, __HIP_MEMORY_SCOPE_AGENT); }
__device__ __forceinline__ unsigned xb_xcc_id() { return (unsigned)__builtin_amdgcn_s_getreg((3 << 11) | 20) & 0xFu; }
#define XB_SPIN(cond, bar) do { unsigned _sp = 0; while (cond) { __builtin_amdgcn_s_sleep(1); \
    if ((++_sp & 255u) == 0u) { if (xb_ld(&(bar)[XB_TMO])) break; if (_sp > XB_SPIN_CAP) { atomicAdd(&(bar)[XB_TMO], 1u); break; } } } } while (0)

struct XcdBarrier {
    unsigned* bar; unsigned x;
    volatile LAS unsigned* st;
};

__device__ __forceinline__ XcdBarrier xcd_barrier_post(unsigned* bar, volatile LAS unsigned* st) {
    XcdBarrier b; b.bar = bar; b.x = xb_xcc_id(); b.st = st;
    if (threadIdx.x == 0) (void)xb_add(&bar[XB_XCNT(b.x)], 1u);
    return b;
}
__device__ __forceinline__ void xcd_barrier_complete(unsigned* bar, unsigned x, unsigned& nloc, unsigned& nx) {
    const unsigned G = gridDim.x * gridDim.y * gridDim.z;
    unsigned sum, cnt, mine, sp = 0u;
    for (;;) {
        sum = 0u; cnt = 0u; mine = 0u;
#pragma unroll
        for (unsigned j = 0; j < 16; ++j) { const unsigned c = xb_ld(&bar[XB_XCNT(j)]); sum += c; cnt += (c > 0u) ? 1u : 0u; mine = (j == x) ? c : mine; }
        if (sum == G) break;
        __builtin_amdgcn_s_sleep(1);
        if ((++sp & 255u) == 0u) { if (xb_ld(&bar[XB_TMO])) break; if (sp > XB_SPIN_CAP) { atomicAdd(&bar[XB_TMO], 1u); break; } }
    }
    nloc = mine > 0u ? mine : 1u; nx = cnt > 0u ? cnt : 1u;
}

__device__ __forceinline__ void xcd_barrier(const XcdBarrier& b) {
    asm volatile("s_waitcnt vmcnt(0)" ::: "memory");
    __syncthreads();
    if (threadIdx.x == 0) {
        GAS unsigned* gbar_ = (GAS unsigned*)b.bar; unsigned bx_ = b.x; asm volatile("" : "+s"(gbar_), "+s"(bx_)); unsigned* bar = (unsigned*)gbar_;
        __builtin_amdgcn_s_waitcnt(0);
        unsigned nloc = b.st[0], nx = b.st[1];
        if (nloc == 0u) { xcd_barrier_complete(bar, bx_, nloc, nx); b.st[0] = nloc; b.st[1] = nx; }
        const unsigned old = xb_add(&bar[XB_XSUB(bx_)], 1u);
        const unsigned gen = old / nloc;
        if (old + 1u == (gen + 1u) * nloc) {
            __builtin_amdgcn_fence(__ATOMIC_RELEASE, "agent");
            asm volatile("s_waitcnt vmcnt(0)" ::: "memory");
            const unsigned og = xb_add(&bar[XB_TOP], 1u);
            const unsigned tg = og / nx;
            if (og + 1u == (tg + 1u) * nx) xb_add(&bar[XB_TOPGEN], 1u);
            else XB_SPIN(xb_ld(&bar[XB_TOPGEN]) == tg, bar);
            __builtin_amdgcn_fence(__ATOMIC_ACQUIRE, "agent");
            xb_add(&bar[XB_XGEN(bx_)], 1u);
            asm volatile("s_waitcnt vmcnt(0)" ::: "memory");
        } else {
            XB_SPIN(xb_ld(&bar[XB_XGEN(bx_)]) == gen, bar);
            __builtin_amdgcn_fence(__ATOMIC_ACQUIRE, "agent");
            asm volatile("s_waitcnt vmcnt(0)" ::: "memory");
        }
    }
    __syncthreads();
}

__device__ const float c_invf[32] = {
    1.000000000e+00f, 7.498942614e-01f, 5.623413324e-01f, 4.216965139e-01f, 3.162277639e-01f, 2.371373773e-01f, 1.778279394e-01f, 1.333521307e-01f,
    1.000000015e-01f, 7.498941571e-02f, 5.623413250e-02f, 4.216965288e-02f, 3.162277490e-02f, 2.371373773e-02f, 1.778279431e-02f, 1.333521493e-02f,
    9.999999776e-03f, 7.498941850e-03f, 5.623413250e-03f, 4.216964822e-03f, 3.162277630e-03f, 2.371373586e-03f, 1.778279431e-03f, 1.333521446e-03f,
    1.000000047e-03f, 7.498942432e-04f, 5.623413017e-04f, 4.216965172e-04f, 3.162277571e-04f, 2.371373703e-04f, 1.778279402e-04f, 1.333521504e-04f};

template <int KIND> __device__ __forceinline__ int srcmap(int n) {
    if constexpr (KIND == 0) return n;
    else if constexpr (KIND == 1) {
        if (n < 1024) return n;
        if (n < 1088) { const int jj = n - 1024; return 1024 + (jj >> 1) + 32 * (jj & 1); }
        if (n < 1280) return -1;
        if (n < 3328) return 1088 + (n - 1280);
        if (n < 5376) return 3136 + (n - 3328);
        if (n < 7424) return 7232 + (n - 5376);
        if (n < 9472) return 9280 + (n - 7424);
        if (n < 11520) return 11328 + (n - 9472);
        return 5184 + (n - 11520);
    } else if constexpr (KIND == 2) {
        if (n < 2048) return (n >> 7) * 192 + (n & 127);
        const int r = n - 2048, h = r >> 6, jj = r & 63; return h * 192 + 128 + (jj >> 1) + 32 * (jj & 1);
    } else if constexpr (KIND == 3) return (n >> 7) * 256 + (n & 127);
    else if constexpr (KIND == 4) return (n >> 7) * 256 + 128 + (n & 127);
    else { const int j = n >> 8, i = n & 255; return i < 128 ? 128 * j + i : DFF + 128 * j + (i - 128); }
}
template <int KIND> __device__ __forceinline__ void transpose_item(const float* W, int K, int Nsrc, bf16* WT, const float* scale, LAS float* scr, int kb, int nb, int lane) {
    const int k0 = 64 * kb, n0 = 32 * nb, sc = srcmap<KIND>(n0 + (lane & 31));
#pragma unroll 8
    for (int i = 0; i < 32; ++i) { const int kk = 2 * i + (lane >> 5); float v = 0.f;
        if (sc >= 0) { v = ((const GAS float*)W)[(size_t)(k0 + kk) * Nsrc + sc]; if (scale) v *= ((const GAS float*)scale)[k0 + kk]; }
        scr[kk * 33 + (lane & 31)] = v; }
    LDS_WAIT(); asm volatile("" ::: "memory");
    const int c = lane & 7;
#pragma unroll
    for (int j = 0; j < 4; ++j) { const int n = (lane >> 3) + 8 * j; const LAS float* s = scr + (8 * c) * 33 + n;
        v4u o; o.x = pk2(s[0 * 33], s[1 * 33]); o.y = pk2(s[2 * 33], s[3 * 33]); o.z = pk2(s[4 * 33], s[5 * 33]); o.w = pk2(s[6 * 33], s[7 * 33]);
        *(GAS v4u*)(WT + (size_t)(n0 + n) * K + k0 + 8 * c) = o; }
    LDS_WAIT(); asm volatile("" ::: "memory");
}
__device__ __forceinline__ void rms_row_to_bf16(const float* xrow, const float* gain, bf16* orow, float* xcopy, int lane) {
    const GAS f32x4* xr = (const GAS f32x4*)xrow + lane;
    f32x4 v[8]; float s = 0.f;
#pragma unroll
    for (int j = 0; j < 8; ++j) { v[j] = xr[64 * j]; s += (v[j].x * v[j].x + v[j].y * v[j].y) + (v[j].z * v[j].z + v[j].w * v[j].w); }
    const float rstd = 1.0f / sqrtf(wave_sum(s) * (1.f / DM) + EPS);
    if (xcopy) { GAS f32x4* xc = (GAS f32x4*)xcopy + lane;
#pragma unroll
        for (int j = 0; j < 8; ++j) xc[64 * j] = v[j]; }
    GAS v2u* o8 = (GAS v2u*)orow + lane;
#pragma unroll
    for (int j = 0; j < 8; ++j) { const f32x4 g = *((const GAS f32x4*)gain + lane + 64 * j);
        v2u w; w.x = pk2(v[j].x * rstd * g.x, v[j].y * rstd * g.y); w.y = pk2(v[j].z * rstd * g.z, v[j].w * rstd * g.w); o8[64 * j] = w; }
}
__device__ __forceinline__ void rms_row_f32(float* xrow, const float* gain, int lane) {
    GAS f32x4* xr = (GAS f32x4*)xrow + lane;
    f32x4 v[8]; float s = 0.f;
#pragma unroll
    for (int j = 0; j < 8; ++j) { v[j] = xr[64 * j]; s += (v[j].x * v[j].x + v[j].y * v[j].y) + (v[j].z * v[j].z + v[j].w * v[j].w); }
    const float rstd = 1.0f / sqrtf(wave_sum(s) * (1.f / DM) + EPS);
#pragma unroll
    for (int j = 0; j < 8; ++j) { const f32x4 g = *((const GAS f32x4*)gain + lane + 64 * j); xr[64 * j] = v[j] * rstd * g; }
}
__device__ __forceinline__ void sincos_f64(float angf, float& sn, float& cs) {
    const double a = (double)angf;
    const double n = __builtin_rint(a * 0.63661977236758134308);
    double r = __builtin_fma(-n, 1.57079632679489655800e+00, a); r = __builtin_fma(-n, 6.12323399573676603587e-17, r);
    const double r2 = r * r;
    double ps = -1.0 / 1307674368000.0; ps = ps * r2 + 1.0 / 6227020800.0; ps = ps * r2 - 1.0 / 39916800.0; ps = ps * r2 + 1.0 / 362880.0; ps = ps * r2 - 1.0 / 5040.0; ps = ps * r2 + 1.0 / 120.0; ps = ps * r2 - 1.0 / 6.0; ps = ps * r2 * r + r;
    double pc = 1.0 / 20922789888000.0; pc = pc * r2 - 1.0 / 87178291200.0; pc = pc * r2 + 1.0 / 479001600.0; pc = pc * r2 - 1.0 / 3628800.0; pc = pc * r2 + 1.0 / 40320.0; pc = pc * r2 - 1.0 / 720.0; pc = pc * r2 + 1.0 / 24.0; pc = pc * r2 - 0.5; pc = pc * r2 + 1.0;
    const int q = ((int)n) & 3;
    const double s_ = (q == 0) ? ps : (q == 1) ? pc : (q == 2) ? -ps : -pc;
    const double c_ = (q == 0) ? pc : (q == 1) ? -ps : (q == 2) ? -pc : ps;
    sn = (float)s_; cs = (float)c_;
}

__device__ __forceinline__ void latent_norm_row(bf16* row, int lane) {
    v4u a = *(const v4u*)(row + lane * 8), b = *(const v4u*)(row + 512 + lane * 8);
    float fa[8] = {bflo(a.x), bfhi(a.x), bflo(a.y), bfhi(a.y), bflo(a.z), bfhi(a.z), bflo(a.w), bfhi(a.w)};
    float fb[8] = {bflo(b.x), bfhi(b.x), bflo(b.y), bfhi(b.y), bflo(b.z), bfhi(b.z), bflo(b.w), bfhi(b.w)};
    float sa = 0.f, sb = 0.f;
#pragma unroll
    for (int i = 0; i < 8; ++i) { sa += fa[i] * fa[i]; sb += fb[i] * fb[i]; }
    const float ra = 1.0f / sqrtf(wave_sum(sa) * (1.f / 512.f) + EPS), rb = 1.0f / sqrtf(wave_sum(sb) * (1.f / 512.f) + EPS);
    a.x = pk2(fa[0] * ra, fa[1] * ra); a.y = pk2(fa[2] * ra, fa[3] * ra); a.z = pk2(fa[4] * ra, fa[5] * ra); a.w = pk2(fa[6] * ra, fa[7] * ra);
    b.x = pk2(fb[0] * rb, fb[1] * rb); b.y = pk2(fb[2] * rb, fb[3] * rb); b.z = pk2(fb[4] * rb, fb[5] * rb); b.w = pk2(fb[6] * rb, fb[7] * rb);
    *(v4u*)(row + lane * 8) = a; *(v4u*)(row + 512 + lane * 8) = b;
}

__device__ __forceinline__ void attn_naive(unsigned char* ws, LAS float* qs  , int gw, int ngw, int lane) {
    const bf16* QN = (const bf16*)(ws + WS_QN); const bf16* QR = (const bf16*)(ws + WS_QR); const bf16* KN = (const bf16*)(ws + WS_KN);
    const bf16* KPE = (const bf16*)(ws + WS_KPE); const bf16* VT = (const bf16*)(ws + WS_VT); bf16* ATT = (bf16*)(ws + WS_ATT);
    for (int item = gw; item < S_ * NH; item += ngw) {
        const int q = item >> 4, h = item & 15;
        if (lane < 24) { const v4u w = (lane < 16) ? *(const v4u*)(QN + (size_t)q * 2048 + h * 128 + lane * 8) : *(const v4u*)(QR + (size_t)q * 1024 + h * 64 + (lane - 16) * 8);
            LAS float* d = qs + lane * 8; d[0] = bflo(w.x); d[1] = bfhi(w.x); d[2] = bflo(w.y); d[3] = bfhi(w.y); d[4] = bflo(w.z); d[5] = bfhi(w.z); d[6] = bflo(w.w); d[7] = bfhi(w.w); }
        LDS_WAIT(); asm volatile("" ::: "memory");
        float m = -__builtin_inff(), l = 0.f, o0 = 0.f, o1 = 0.f;
        const bf16* v0p = VT + (size_t)(h * 128 + 2 * lane) * S_; const bf16* v1p = v0p + S_;
        for (int j0 = 0; j0 <= q; j0 += 64) {
            const int j = j0 + lane; const bool valid = j <= q; float s = 0.f;
            if (valid) {
                const bf16* kn = KN + (size_t)j * 2048 + h * 128; const bf16* kp = KPE + (size_t)j * 64;
#pragma unroll 4
                for (int c = 0; c < 24; ++c) { const v4u w = (c < 16) ? *(const v4u*)(kn + c * 8) : *(const v4u*)(kp + (c - 16) * 8); const LAS float* qq = qs + c * 8;
                    s += bflo(w.x) * qq[0] + bfhi(w.x) * qq[1] + bflo(w.y) * qq[2] + bfhi(w.y) * qq[3] + bflo(w.z) * qq[4] + bfhi(w.z) * qq[5] + bflo(w.w) * qq[6] + bfhi(w.w) * qq[7]; }
            } else s = -__builtin_inff();
            const float mn = fmaxf(m, wave_max(s)); const float alpha = __builtin_amdgcn_exp2f(m - mn); const float p = valid ? __builtin_amdgcn_exp2f(s - mn) : 0.f;
            l = l * alpha + wave_sum(p); m = mn; o0 *= alpha; o1 *= alpha;
#pragma unroll
            for (int c = 0; c < 8; ++c) { const v4u a = *(const v4u*)(v0p + j0 + c * 8), b = *(const v4u*)(v1p + j0 + c * 8);
                const float p0 = __builtin_bit_cast(float, __builtin_amdgcn_readlane(__builtin_bit_cast(int, p), c * 8 + 0)), p1 = __builtin_bit_cast(float, __builtin_amdgcn_readlane(__builtin_bit_cast(int, p), c * 8 + 1));
                const float p2 = __builtin_bit_cast(float, __builtin_amdgcn_readlane(__builtin_bit_cast(int, p), c * 8 + 2)), p3 = __builtin_bit_cast(float, __builtin_amdgcn_readlane(__builtin_bit_cast(int, p), c * 8 + 3));
                const float p4 = __builtin_bit_cast(float, __builtin_amdgcn_readlane(__builtin_bit_cast(int, p), c * 8 + 4)), p5 = __builtin_bit_cast(float, __builtin_amdgcn_readlane(__builtin_bit_cast(int, p), c * 8 + 5));
                const float p6 = __builtin_bit_cast(float, __builtin_amdgcn_readlane(__builtin_bit_cast(int, p), c * 8 + 6)), p7 = __builtin_bit_cast(float, __builtin_amdgcn_readlane(__builtin_bit_cast(int, p), c * 8 + 7));
                o0 += p0 * bflo(a.x) + p1 * bfhi(a.x) + p2 * bflo(a.y) + p3 * bfhi(a.y) + p4 * bflo(a.z) + p5 * bfhi(a.z) + p6 * bflo(a.w) + p7 * bfhi(a.w);
                o1 += p0 * bflo(b.x) + p1 * bfhi(b.x) + p2 * bflo(b.y) + p3 * bfhi(b.y) + p4 * bflo(b.z) + p5 * bfhi(b.z) + p6 * bflo(b.w) + p7 * bfhi(b.w); }
        }
        const float il = 1.f / l;
        *(unsigned*)(ATT + (size_t)q * 2048 + h * 128 + 2 * lane) = pk2(o0 * il, o1 * il);
        asm volatile("" ::: "memory");
    }
}
__device__ __forceinline__ void hgrn_naive(unsigned char* ws, int layer, int gw, int ngw, int lane) {
    const bf16* HQ = (const bf16*)(ws + WS_HQ); const float* HF = (const float*)(ws + WS_HF); const bf16* VTH = (const bf16*)(ws + WS_VTH);
    const float* LB = (const float*)(ws + WS_LB) + layer * 2048; float* RR = (float*)(ws + WS_RRAW);
    for (int item = gw; item < NH * 128; item += ngw) {
        const int h = item >> 7, e = item & 127, ch = h * 128 + 2 * lane;
        const float lb0 = LB[ch], lb1 = LB[ch + 1];
        float s0 = 0.f, s1 = 0.f;
        const bf16* vp = VTH + (size_t)(h * 128 + e) * S_;
        for (int t0 = 0; t0 < S_; t0 += 8) {
            const v4u vv = *(const v4u*)(vp + t0);
            const float vt[8] = {bflo(vv.x), bfhi(vv.x), bflo(vv.y), bfhi(vv.y), bflo(vv.z), bfhi(vv.z), bflo(vv.w), bfhi(vv.w)};
            float ov = 0.f;
#pragma unroll
            for (int i = 0; i < 8; ++i) { const size_t off = (size_t)(t0 + i) * 2048 + ch;
                const f32x2 z = *(const f32x2*)(HF + off); const unsigned qq = *(const unsigned*)(HQ + off);
                const float f0 = lb0 + (1.f - lb0) * sigm(z.x), f1 = lb1 + (1.f - lb1) * sigm(z.y);
                s0 = fmaxf(f0, 1e-30f) * s0 + (1.f - f0) * vt[i]; s1 = fmaxf(f1, 1e-30f) * s1 + (1.f - f1) * vt[i];
                const float o = wave_sum(bflo(qq) * s0 + bfhi(qq) * s1);
                ov = (lane == i) ? o : ov; }
            if (lane < 8) RR[(size_t)(t0 + lane) * 2048 + h * 128 + e] = ov;
        }
    }
}
__device__ __forceinline__ void hgrn_normgate(unsigned char* ws, const float* gain, int gw, int ngw, int lane) {
    const float* RR = (const float*)(ws + WS_RRAW); const bf16* HG = (const bf16*)(ws + WS_HG); bf16* REC = (bf16*)(ws + WS_REC);
    const f32x2 g = *(const GAS f32x2*)(gain + 2 * lane);
    for (int item = gw; item < S_ * NH; item += ngw) {
        const size_t off = (size_t)item * 128 + 2 * lane;
        const f32x2 v = *(const f32x2*)(RR + off); const unsigned hg = *(const unsigned*)(HG + off);
        const float rstd = 1.0f / sqrtf(wave_sum(v.x * v.x + v.y * v.y) * (1.f / 128.f) + EPS);
        *(unsigned*)(REC + off) = pk2(v.x * rstd * g.x * bflo(hg), v.y * rstd * g.y * bfhi(hg));
    }
}
__device__ __forceinline__ void conv_gate(unsigned char* ws, const float* cw, const float* cb, int gw, int ngw, int lane) {
    const bf16* U = (const bf16*)(ws + WS_U); bf16* ACT = (bf16*)(ws + WS_ACT);
    for (int item = gw; item < (S_ / 16) * 11; item += ngw) {
        const int tb = item / 11, cg = item % 11, c0 = cg * 512 + lane * 8;
        const int ucol = (c0 >> 7) * 256 + (c0 & 127), t0 = tb * 16;
        float wg[3][8], wu[3][8], bg[8], bu[8];
#pragma unroll
        for (int j = 0; j < 3; ++j)
#pragma unroll
            for (int i = 0; i < 8; ++i) { wg[j][i] = ((const GAS float*)cw)[(size_t)j * DFF2 + c0 + i]; wu[j][i] = ((const GAS float*)cw)[(size_t)j * DFF2 + DFF + c0 + i]; }
#pragma unroll
        for (int i = 0; i < 8; ++i) { bg[i] = ((const GAS float*)cb)[c0 + i]; bu[i] = ((const GAS float*)cb)[DFF + c0 + i]; }
        float g2[8], g1[8], u2[8], u1[8];
#pragma unroll
        for (int i = 0; i < 8; ++i) { g2[i] = 0.f; g1[i] = 0.f; u2[i] = 0.f; u1[i] = 0.f; }
        if (t0 > 0) {
            const v4u a = *(const v4u*)(U + (size_t)(t0 - 2) * DFF2 + ucol), b = *(const v4u*)(U + (size_t)(t0 - 2) * DFF2 + ucol + 128);
            const v4u c = *(const v4u*)(U + (size_t)(t0 - 1) * DFF2 + ucol), d = *(const v4u*)(U + (size_t)(t0 - 1) * DFF2 + ucol + 128);
            g2[0] = bflo(a.x); g2[1] = bfhi(a.x); g2[2] = bflo(a.y); g2[3] = bfhi(a.y); g2[4] = bflo(a.z); g2[5] = bfhi(a.z); g2[6] = bflo(a.w); g2[7] = bfhi(a.w);
            u2[0] = bflo(b.x); u2[1] = bfhi(b.x); u2[2] = bflo(b.y); u2[3] = bfhi(b.y); u2[4] = bflo(b.z); u2[5] = bfhi(b.z); u2[6] = bflo(b.w); u2[7] = bfhi(b.w);
            g1[0] = bflo(c.x); g1[1] = bfhi(c.x); g1[2] = bflo(c.y); g1[3] = bfhi(c.y); g1[4] = bflo(c.z); g1[5] = bfhi(c.z); g1[6] = bflo(c.w); g1[7] = bfhi(c.w);
            u1[0] = bflo(d.x); u1[1] = bfhi(d.x); u1[2] = bflo(d.y); u1[3] = bfhi(d.y); u1[4] = bflo(d.z); u1[5] = bfhi(d.z); u1[6] = bflo(d.w); u1[7] = bfhi(d.w);
        }
#pragma unroll 4
        for (int t = t0; t < t0 + 16; ++t) {
            const v4u a = *(const v4u*)(U + (size_t)t * DFF2 + ucol), b = *(const v4u*)(U + (size_t)t * DFF2 + ucol + 128);
            float g0[8], u0[8];
            g0[0] = bflo(a.x); g0[1] = bfhi(a.x); g0[2] = bflo(a.y); g0[3] = bfhi(a.y); g0[4] = bflo(a.z); g0[5] = bfhi(a.z); g0[6] = bflo(a.w); g0[7] = bfhi(a.w);
            u0[0] = bflo(b.x); u0[1] = bfhi(b.x); u0[2] = bflo(b.y); u0[3] = bfhi(b.y); u0[4] = bflo(b.z); u0[5] = bfhi(b.z); u0[6] = bflo(b.w); u0[7] = bfhi(b.w);
            float r[8];
#pragma unroll
            for (int i = 0; i < 8; ++i) { const float G = bg[i] + wg[0][i] * g2[i] + wg[1][i] * g1[i] + wg[2][i] * g0[i]; const float Uu = bu[i] + wu[0][i] * u2[i] + wu[1][i] * u1[i] + wu[2][i] * u0[i];
                r[i] = G * sigm(G) * Uu; g2[i] = g1[i]; g1[i] = g0[i]; u2[i] = u1[i]; u1[i] = u0[i]; }
            v4u o; o.x = pk2(r[0], r[1]); o.y = pk2(r[2], r[3]); o.z = pk2(r[4], r[5]); o.w = pk2(r[6], r[7]);
            *(v4u*)(ACT + (size_t)t * DFF + c0) = o;
        }
    }
}

namespace fa {
typedef float f32x16 __attribute__((ext_vector_type(16)));
constexpr int KBUF = 24576, VBUF = 16384, STG = KBUF + VBUF;
constexpr float THR = 8.0f;
__device__ __forceinline__ float hmax(float a) { return fmaxf(a, __shfl_xor(a, 32)); }
__device__ __forceinline__ float hsum(float a) { return a + __shfl_xor(a, 32); }
__device__ __forceinline__ bf16x8 pk8(const f32x16& p, int b) {
    v4u w; w.x = pg8::cvt_pk_bf16(p[b], p[b + 1]); w.y = pg8::cvt_pk_bf16(p[b + 2], p[b + 3]); w.z = pg8::cvt_pk_bf16(p[b + 4], p[b + 5]); w.w = pg8::cvt_pk_bf16(p[b + 6], p[b + 7]);
    return __builtin_bit_cast(bf16x8, w);
}
__device__ __forceinline__ void attn_fast(unsigned char* ws, LAS unsigned char* lds, int vcu, int G) {
    int tid = threadIdx.x; asm volatile("" : "+v"(tid));
    const int lane = tid & 63, w = __builtin_amdgcn_readfirstlane(tid >> 6), r32 = lane & 31, hi = lane >> 5;
    const bf16* QN = (const bf16*)(ws + WS_QN); const bf16* QR = (const bf16*)(ws + WS_QR); const bf16* KN = (const bf16*)(ws + WS_KN);
    const bf16* KPE = (const bf16*)(ws + WS_KPE); const bf16* VT = (const bf16*)(ws + WS_VT); bf16* ATT = (bf16*)(ws + WS_ATT);
    const int pr = (r32 & 0x13) | ((r32 & 4) << 1) | ((r32 & 8) >> 1);
    const int kfo = hi * 1024 + pr * 16;
    const int fb = (r32 >> 1) & 7, va = (hi ^ (fb & 1)) << 4, vbb = fb >> 1;
    const int vfo = KBUF + r32 * 128 + va;
    const int vrow0 = 16 * w + (lane >> 3), vrow1 = vrow0 + 8;
    const int vsc0 = ((lane & 7) ^ ((vrow0 >> 1) & 7)) * 8, vsc1 = ((lane & 7) ^ ((vrow1 >> 1) & 7)) * 8;
    for (int item = vcu; item < 256; item += G) {
        const int h = item >> 4, sidx = item & 15;
        const bf16* kn_l = KN + (size_t)lane * 2048 + h * 128 + 8 * w;
        const bf16* kp_l = KPE + (size_t)lane * 64 + 8 * w;
        const bf16* v0_l = VT + (size_t)(h * 128 + vrow0) * S_ + vsc0; const bf16* v1_l = VT + (size_t)(h * 128 + vrow1) * S_ + vsc1;
#define FA_ISSUE(t, st) do { const size_t ko_ = (size_t)(t) * 64 * 2048, po_ = (size_t)(t) * 64 * 64; const int to_ = (t) * 64; LAS unsigned char* sb_ = lds + (st) * STG; \
        __builtin_amdgcn_global_load_lds((const unsigned*)(kn_l + ko_), (LAS unsigned*)(sb_ + w * 1024), 16, 0, 0); \
        __builtin_amdgcn_global_load_lds((const unsigned*)(kn_l + ko_ + 64), (LAS unsigned*)(sb_ + (w + 8) * 1024), 16, 0, 0); \
        __builtin_amdgcn_global_load_lds((const unsigned*)(kp_l + po_), (LAS unsigned*)(sb_ + (w + 16) * 1024), 16, 0, 0); \
        __builtin_amdgcn_global_load_lds((const unsigned*)(v0_l + to_), (LAS unsigned*)(sb_ + KBUF + (2 * w) * 1024), 16, 0, 0); \
        __builtin_amdgcn_global_load_lds((const unsigned*)(v1_l + to_), (LAS unsigned*)(sb_ + KBUF + (2 * w + 1) * 1024), 16, 0, 0); } while (0)
        for (int pass = 0; pass < 2; ++pass) {
            const int qb = pass ? sidx : 31 - sidx, q0 = qb * 256, NT = 4 * qb + 4, qw = q0 + 32 * w, q = qw + r32;
            FA_ISSUE(0, 0);
            bf16x8 qr[12];
#pragma unroll
            for (int d0 = 0; d0 < 8; ++d0) qr[d0] = *(const bf16x8*)(QN + (size_t)q * 2048 + h * 128 + d0 * 16 + hi * 8);
#pragma unroll
            for (int d0 = 0; d0 < 4; ++d0) qr[8 + d0] = *(const bf16x8*)(QR + (size_t)q * 1024 + h * 64 + d0 * 16 + hi * 8);
            f32x16 o[4];
#pragma unroll
            for (int e = 0; e < 4; ++e)
#pragma unroll
                for (int r = 0; r < 16; ++r) o[e][r] = 0.f;
            float m = -__builtin_inff(), l = 0.f;
            for (int t = 0; t < NT; ++t) {
                VM_WAIT(); __syncthreads();
                if (t + 1 < NT) FA_ISSUE(t + 1, (t + 1) & 1);
                {
                    const LAS unsigned char* sb = lds + (t & 1) * STG;
                    f32x16 p0, p1;
#pragma unroll
                    for (int r = 0; r < 16; ++r) { p0[r] = 0.f; p1[r] = 0.f; }
#pragma unroll
                    for (int d0 = 0; d0 < 12; ++d0) { const bf16x8 k0 = *(const LAS bf16x8*)(sb + kfo + d0 * 2048), k1 = *(const LAS bf16x8*)(sb + kfo + d0 * 2048 + 512);
                        p0 = __builtin_amdgcn_mfma_f32_32x32x16_bf16(k0, qr[d0], p0, 0, 0, 0); p1 = __builtin_amdgcn_mfma_f32_32x32x16_bf16(k1, qr[d0], p1, 0, 0, 0); }
                    if (64 * t + 63 > qw) {
                        const int kb = 64 * t + 8 * hi - q;
#pragma unroll
                        for (int r = 0; r < 16; ++r) { const int dk = kb + 16 * (r >> 3) + (r & 7); if (dk > 0) p0[r] = -__builtin_inff(); if (dk + 32 > 0) p1[r] = -__builtin_inff(); }
                    }
                    float mx = fmaxf(p0[0], p1[0]);
#pragma unroll
                    for (int r = 1; r < 16; ++r) mx = fmaxf(mx, fmaxf(p0[r], p1[r]));
                    mx = hmax(mx);
                    { const float mn = fmaxf(m, mx), alpha = __builtin_amdgcn_exp2f(m - mn); m = mn; l *= alpha;
#pragma unroll
                        for (int e = 0; e < 4; ++e)
#pragma unroll
                            for (int r = 0; r < 16; ++r) o[e][r] *= alpha; }
                    float ps = 0.f;
#pragma unroll
                    for (int r = 0; r < 16; ++r) { p0[r] = __builtin_amdgcn_exp2f(p0[r] - m); p1[r] = __builtin_amdgcn_exp2f(p1[r] - m); ps += p0[r] + p1[r]; }
                    l += ps;
                    const bf16x8 pf0 = pk8(p0, 0), pf1 = pk8(p0, 8), pf2 = pk8(p1, 0), pf3 = pk8(p1, 8);
                    const LAS unsigned char* vb0 = sb + vfo + ((0 ^ vbb) << 5); const LAS unsigned char* vb1 = sb + vfo + ((1 ^ vbb) << 5);
                    const LAS unsigned char* vb2 = sb + vfo + ((2 ^ vbb) << 5); const LAS unsigned char* vb3 = sb + vfo + ((3 ^ vbb) << 5);
#pragma unroll
                    for (int e = 0; e < 4; ++e) {
                        const bf16x8 a0 = *(const LAS bf16x8*)(vb0 + e * 4096), a1 = *(const LAS bf16x8*)(vb1 + e * 4096), a2 = *(const LAS bf16x8*)(vb2 + e * 4096), a3 = *(const LAS bf16x8*)(vb3 + e * 4096);
                        o[e] = __builtin_amdgcn_mfma_f32_32x32x16_bf16(a0, pf0, o[e], 0, 0, 0); o[e] = __builtin_amdgcn_mfma_f32_32x32x16_bf16(a1, pf1, o[e], 0, 0, 0);
                        o[e] = __builtin_amdgcn_mfma_f32_32x32x16_bf16(a2, pf2, o[e], 0, 0, 0); o[e] = __builtin_amdgcn_mfma_f32_32x32x16_bf16(a3, pf3, o[e], 0, 0, 0); }
                }
            }
            const float il = 1.0f / hsum(l);
            bf16* op = ATT + (size_t)q * 2048 + h * 128 + 4 * hi;
#pragma unroll
            for (int e = 0; e < 4; ++e)
#pragma unroll
                for (int g4 = 0; g4 < 4; ++g4) { v2u wv; wv.x = pg8::cvt_pk_bf16(o[e][4 * g4] * il, o[e][4 * g4 + 1] * il); wv.y = pg8::cvt_pk_bf16(o[e][4 * g4 + 2] * il, o[e][4 * g4 + 3] * il);
                    *(v2u*)(op + e * 32 + g4 * 8) = wv; }
            __syncthreads();
        }
#undef FA_ISSUE
    }
}
}

#ifndef NAIVE_ATTN
#define NAIVE_ATTN 0
#endif
#ifndef NAIVE_HGRN
#define NAIVE_HGRN 1
#endif
struct Args { const float* in[19]; float* out; unsigned char* ws; };
enum { I_X = 0, I_POS, I_ANG, I_WIN, I_QNG, I_WUQ, I_KVNG, I_WUKV, I_LBL, I_HONG, I_WA, I_WB, I_WO, I_FNG, I_WUP, I_CW, I_CB, I_WDN, I_FING };

__global__ void __launch_bounds__(NTHR, 2) mk_fwd(Args args) {
    extern __shared__ __attribute__((aligned(16))) unsigned char lds_raw[];
    LAS unsigned char* lds = (LAS unsigned char*)lds_raw;
    const int tid = threadIdx.x, lane = tid & 63, wave = __builtin_amdgcn_readfirstlane(tid >> 6);
    const int G = gridDim.x, bx = blockIdx.x, vcu = (G % 8 == 0) ? (bx % 8) * (G / 8) + bx / 8 : bx;
    const int gw = vcu * NWAVES + wave, ngw = G * NWAVES;
    unsigned char* ws = args.ws;
    for (int u = tid; u < (LDS_BYTES - LDSCTL_OFF) / 4; u += NTHR) ((LAS unsigned*)(lds + LDSCTL_OFF))[u] = 0u;
    __syncthreads();
    XcdBarrier bar = xcd_barrier_post((unsigned*)(ws + WS_CTL) + CW_BAR, (volatile LAS unsigned*)(lds + MISC_OFF) + 8);
    float* X = args.out;
    if (tid < 19) ((LAS unsigned long long*)(lds + MISC_OFF + 128))[tid] = ((const __attribute__((address_space(4))) unsigned long long*)__builtin_amdgcn_kernarg_segment_ptr())[tid];
    __syncthreads();
#define INP(i) ((const float*)(((unsigned long long)(unsigned)__builtin_amdgcn_readfirstlane((int)(((LAS const unsigned long long*)(lds + MISC_OFF + 128))[i] >> 32)) << 32) | (unsigned long long)(unsigned)__builtin_amdgcn_readfirstlane((int)(unsigned)((LAS const unsigned long long*)(lds + MISC_OFF + 128))[i])))

    {
        LAS float* scr = (LAS float*)(lds + RING_OFF + wave * 16384);
        constexpr int I_IN = 32 * (WINR / 32), I_UQ = 8 * 96, I_K = 8 * 64, I_V = 8 * 64, I_SQ = 32 * 64, I_UP = 32 * 352, I_DN = 88 * 64;
        constexpr int PER_LAYER = I_IN + I_UQ + I_K + I_V + 3 * I_SQ + I_UP + I_DN;
        for (int it = gw; it < DEPTH * PER_LAYER; it += ngw) {
            const int l = it / PER_LAYER; int r = it % PER_LAYER;
            unsigned char* wl = ws + WS_W + (size_t)l * LW;
            if (r < I_IN) { transpose_item<1>(INP(I_WIN) + (size_t)l * DM * INW, DM, INW, (bf16*)(wl + LW_IN), nullptr, scr, r / (WINR / 32), r % (WINR / 32), lane); continue; } r -= I_IN;
            if (r < I_UQ) { transpose_item<2>(INP(I_WUQ) + (size_t)l * QL * 3072, QL, 3072, (bf16*)(wl + LW_UQ), INP(I_QNG) + l * QL, scr, r / 96, r % 96, lane); continue; } r -= I_UQ;
            if (r < I_K) { transpose_item<3>(INP(I_WUKV) + (size_t)l * KVL * 4096, KVL, 4096, (bf16*)(wl + LW_K), INP(I_KVNG) + l * KVL, scr, r / 64, r % 64, lane); continue; } r -= I_K;
            if (r < I_V) { transpose_item<4>(INP(I_WUKV) + (size_t)l * KVL * 4096, KVL, 4096, (bf16*)(wl + LW_V), INP(I_KVNG) + l * KVL, scr, r / 64, r % 64, lane); continue; } r -= I_V;
            if (r < I_SQ) { transpose_item<0>(INP(I_WA) + (size_t)l * DM * DM, DM, DM, (bf16*)(wl + LW_A), nullptr, scr, r / 64, r % 64, lane); continue; } r -= I_SQ;
            if (r < I_SQ) { transpose_item<0>(INP(I_WB) + (size_t)l * DM * DM, DM, DM, (bf16*)(wl + LW_B), nullptr, scr, r / 64, r % 64, lane); continue; } r -= I_SQ;
            if (r < I_SQ) { transpose_item<0>(INP(I_WO) + (size_t)l * DM * DM, DM, DM, (bf16*)(wl + LW_O), nullptr, scr, r / 64, r % 64, lane); continue; } r -= I_SQ;
            if (r < I_UP) { transpose_item<5>(INP(I_WUP) + (size_t)l * DM * DFF2, DM, DFF2, (bf16*)(wl + LW_UP), nullptr, scr, r / 352, r % 352, lane); continue; } r -= I_UP;
            transpose_item<0>(INP(I_WDN) + (size_t)l * DFF * DM, DFF, DM, (bf16*)(wl + LW_DN), nullptr, scr, r / 64, r % 64, lane);
        }
        { const GAS int* pos = (const GAS int*)INP(I_POS); float* COS = (float*)(ws + WS_COS); float* SIN = (float*)(ws + WS_SIN);
          for (int i = vcu * NTHR + tid; i < S_ * 32; i += G * NTHR) { const float ang = (float)pos[i >> 5] * c_invf[i & 31]; float sn, cs; sincos_f64(ang, sn, cs); COS[i] = cs; SIN[i] = sn; } }
        { const GAS float* lg = (const GAS float*)INP(I_LBL); float* LB = (float*)(ws + WS_LB);
          for (int c = vcu * NTHR + tid; c < 2048; c += G * NTHR) { const float a0 = lg[c], a1 = lg[2048 + c], a2 = lg[4096 + c], a3 = lg[6144 + c];
              const float mx = fmaxf(fmaxf(a0, a1), fmaxf(a2, a3)); const float e0 = expf(a0 - mx), e1 = expf(a1 - mx), e2 = expf(a2 - mx), e3 = expf(a3 - mx); const float inv = 1.f / (e0 + e1 + e2 + e3);
              LB[c] = 0.f; LB[2048 + c] = e1 * inv; LB[4096 + c] = (e1 + e2) * inv; LB[6144 + c] = (e1 + e2 + e3) * inv; } }
        for (int m = gw; m < S_; m += ngw) rms_row_to_bf16(INP(I_X) + (size_t)m * DM, INP(I_ANG), (bf16*)(ws + WS_XN) + (size_t)m * DM, X + (size_t)m * DM, lane);
    }
    xcd_barrier(bar);

    for (int l = 0; l < DEPTH; ++l) {
        unsigned char* wl = ws + WS_W + (size_t)l * LW;
#define lane_l ({ int l_ = lane; asm volatile("" : "+v"(l_)); l_; })
        unsigned char* wsl = ws; int Gl = G, bxl = bx, gwl = gw, ngwl = ngw, vcul = vcu; float* Xl = X;
        asm volatile("" : "+s"(wsl), "+s"(Gl), "+s"(bxl), "+s"(gwl), "+s"(ngwl), "+s"(vcul), "+s"(Xl));
        { pg8::Gemm g{(const pg8::bf16_t*)(wsl + WS_XN), (const pg8::bf16_t*)(wl + LW_IN), S_, NNAT, DM, DM, DM}; pg8::StaticOrder S; S.init(S_, NNAT, Gl, bxl);
          pg8::EpiIn E{wsl}; pg8::gemm_phase<pg8::EpiIn, pg8::StaticOrder, true, true>(lds + RING_OFF, g, S, E); }
        { pg8::Gemm g{(const pg8::bf16_t*)(wl + LW_IN) + (size_t)NNAT * DM, (const pg8::bf16_t*)(wsl + WS_XN), 2048, S_, DM, DM, DM}; pg8::StaticOrder S; S.init(2048, S_, Gl, bxl);
          pg8::EpiStore E{(pg8::bf16_t*)(wsl + WS_VTH), S_}; pg8::gemm_phase<pg8::EpiStore, pg8::StaticOrder, true, true>(lds + RING_OFF, g, S, E); }
        xcd_barrier(bar);
        for (int m = gwl; m < S_; m += ngwl) latent_norm_row((bf16*)(wsl + WS_CQKV) + (size_t)m * 1024, lane_l);
        xcd_barrier(bar);
        { pg8::Gemm g{(const pg8::bf16_t*)(wsl + WS_CQKV), (const pg8::bf16_t*)(wl + LW_UQ), S_, 3072, QL, 1024, QL}; pg8::StaticOrder S; S.init(S_, 3072, Gl, bxl);
          pg8::EpiQ E{wsl}; pg8::gemm_phase<pg8::EpiQ, pg8::StaticOrder, true, true>(lds + RING_OFF, g, S, E); }
        { pg8::Gemm g{(const pg8::bf16_t*)(wsl + WS_CQKV) + 512, (const pg8::bf16_t*)(wl + LW_K), S_, 2048, KVL, 1024, KVL}; pg8::StaticOrder S; S.init(S_, 2048, Gl, bxl);
          pg8::EpiStore E{(pg8::bf16_t*)(wsl + WS_KN), 2048}; pg8::gemm_phase<pg8::EpiStore, pg8::StaticOrder, true, true>(lds + RING_OFF, g, S, E); }
        { pg8::Gemm g{(const pg8::bf16_t*)(wl + LW_V), (const pg8::bf16_t*)(wsl + WS_CQKV) + 512, 2048, S_, KVL, KVL, 1024}; pg8::StaticOrder S; S.init(2048, S_, Gl, bxl);
          pg8::EpiStore E{(pg8::bf16_t*)(wsl + WS_VT), S_}; pg8::gemm_phase<pg8::EpiStore, pg8::StaticOrder, true, true>(lds + RING_OFF, g, S, E); }
#if NAIVE_HGRN
        hgrn_naive(wsl, l, gwl, ngwl, lane_l);
#endif
        xcd_barrier(bar);
#if NAIVE_ATTN
        attn_naive(wsl, (LAS float*)(lds + RING_OFF) + wave * 192, gwl, ngwl, lane_l);
#else
        fa::attn_fast(wsl, lds + RING_OFF, vcul, Gl);
#endif
#if NAIVE_HGRN
        hgrn_normgate(wsl, INP(I_HONG) + l * 128, gwl, ngwl, lane_l);
#endif
        xcd_barrier(bar);
        { pg8::Gemm g{(const pg8::bf16_t*)(wsl + WS_ATT), (const pg8::bf16_t*)(wl + LW_A), S_, DM, DM, DM, DM}; pg8::StaticOrder S; S.init(S_, DM, Gl, bxl);
          pg8::EpiGateA E{wsl}; pg8::gemm_phase<pg8::EpiGateA, pg8::StaticOrder, true, true>(lds + RING_OFF, g, S, E); }
        { pg8::Gemm g{(const pg8::bf16_t*)(wsl + WS_REC), (const pg8::bf16_t*)(wl + LW_B), S_, DM, DM, DM, DM}; pg8::StaticOrder S; S.init(S_, DM, Gl, bxl);
          pg8::EpiGateB E{wsl}; pg8::gemm_phase<pg8::EpiGateB, pg8::StaticOrder, true, true>(lds + RING_OFF, g, S, E); }
        xcd_barrier(bar);
        { pg8::Gemm g{(const pg8::bf16_t*)(wsl + WS_MRG), (const pg8::bf16_t*)(wl + LW_O), S_, DM, DM, DM, DM}; pg8::StaticOrder S; S.init(S_, DM, Gl, bxl);
          pg8::EpiRes E{Xl}; pg8::gemm_phase<pg8::EpiRes, pg8::StaticOrder, true, true>(lds + RING_OFF, g, S, E); }
        xcd_barrier(bar);
        for (int m = gwl; m < S_; m += ngwl) rms_row_to_bf16(Xl + (size_t)m * DM, INP(I_FNG) + l * DM, (bf16*)(wsl + WS_XN) + (size_t)m * DM, nullptr, lane_l);
        xcd_barrier(bar);
        { pg8::Gemm g{(const pg8::bf16_t*)(wsl + WS_XN), (const pg8::bf16_t*)(wl + LW_UP), S_, DFF2, DM, DM, DM}; pg8::StaticOrder S; S.init(S_, DFF2, Gl, bxl);
          pg8::EpiStore E{(pg8::bf16_t*)(wsl + WS_U), DFF2}; pg8::gemm_phase<pg8::EpiStore, pg8::StaticOrder, true, true>(lds + RING_OFF, g, S, E); }
        xcd_barrier(bar);
        conv_gate(wsl, INP(I_CW) + (size_t)l * 3 * DFF2, INP(I_CB) + (size_t)l * DFF2, gwl, ngwl, lane_l);
        xcd_barrier(bar);
        { pg8::Gemm g{(const pg8::bf16_t*)(wsl + WS_ACT), (const pg8::bf16_t*)(wl + LW_DN), S_, DM, DFF, DFF, DFF}; pg8::StaticOrder S; S.init(S_, DM, Gl, bxl);
          pg8::EpiRes E{Xl}; pg8::gemm_phase<pg8::EpiRes, pg8::StaticOrder, true, true>(lds + RING_OFF, g, S, E); }
        xcd_barrier(bar);
        if (l + 1 < DEPTH) { for (int m = gwl; m < S_; m += ngwl) rms_row_to_bf16(Xl + (size_t)m * DM, INP(I_ANG) + (l + 1) * DM, (bf16*)(wsl + WS_XN) + (size_t)m * DM, nullptr, lane_l);
            xcd_barrier(bar); }
        else { for (int m = gwl; m < S_; m += ngwl) rms_row_f32(Xl + (size_t)m * DM, INP(I_FING), lane_l); }
    }
}

#undef lane_l
extern "C" void kernel_launch(void* const* d_in, const int* in_sizes, int n_in, void* d_out, int out_size, void* d_ws, size_t ws_size, hipStream_t stream) {
    static int grid = 0;
    if (grid == 0) {
        if (n_in != 19 || in_sizes[0] != S_ * DM || out_size != S_ * DM || ws_size < WS_END) { fprintf(stderr, "kernel_launch: shape/workspace mismatch (n_in %d, in0 %d, out %d, ws %zu need %zu)\n", n_in, n_in > 0 ? in_sizes[0] : -1, out_size, ws_size, (size_t)WS_END); grid = -1; return; }
        int dev = 0, cus = 0, per_cu = 0;
        if (hipGetDevice(&dev) != hipSuccess || hipDeviceGetAttribute(&cus, hipDeviceAttributeMultiprocessorCount, dev) != hipSuccess) { grid = -1; return; }
        if (hipFuncSetAttribute((const void*)mk_fwd, hipFuncAttributeMaxDynamicSharedMemorySize, LDS_BYTES) != hipSuccess) { fprintf(stderr, "kernel_launch: hipFuncSetAttribute failed\n"); grid = -1; return; }
        if (hipOccupancyMaxActiveBlocksPerMultiprocessor(&per_cu, (const void*)mk_fwd, NTHR, LDS_BYTES) != hipSuccess || per_cu < 1) { fprintf(stderr, "kernel_launch: occupancy query reports %d blocks per CU\n", per_cu); }
        (void)hipGetLastError();
        grid = cus;
    }
    if (grid < 0) return;
    if (hipMemsetAsync((char*)d_ws + WS_CTL, 0, CTL_ZERO_BYTES, stream) != hipSuccess) return;
    Args a{};
    for (int i = 0; i < 19; ++i) a.in[i] = (const float*)d_in[i];
    a.out = (float*)d_out; a.ws = (unsigned char*)d_ws;
    hipLaunchKernelGGL(mk_fwd, dim3(grid), dim3(NTHR), LDS_BYTES, stream, a);
}
```

```cpp
#include <hip/hip_runtime.h>
#include <cstdio>
#include <cstdint>
namespace pg8 {
#define PG8_LAS __attribute__((address_space(3)))
typedef unsigned short bf16_t;
typedef short bf16x8 __attribute__((ext_vector_type(8)));
typedef float f32x4 __attribute__((ext_vector_type(4)));
typedef unsigned u32x4 __attribute__((ext_vector_type(4)));
constexpr int BM = 256, BK = 64, HALF = 128, HTB = HALF * BK * 2  , STAGE_BYTES = 8 * HTB, NXCD = 8, WGM = 8;

__host__ __device__ __forceinline__ int lds_byte(int r, int c) { const int st = (r >> 4) * 2 + (c >> 5), rr = r & 15, cc = c & 31, ob = rr * 64 + cc * 2; return st * 1024 + (ob ^ (((ob >> 9) & 1) << 5)); }
__host__ __device__ __forceinline__ void stage_rc(int b, int& R, int& C) { const int st = b / 1024, sb = b % 1024, swz = sb ^ (((sb >> 9) & 1) << 5); R = (st >> 1) * 16 + swz / 64; C = (st & 1) * 32 + (swz % 64) / 2; }
__host__ __device__ __forceinline__ int perm32(int rho) { const int n = rho >> 4, i = rho & 15; return 8 * (i >> 2) + 4 * n + (i & 3); }

struct Unit { int pm, pn; };
struct Gemm { const bf16_t* A; const bf16_t* Bt; int M, N, K, lda, ldb; };

struct StaticOrder {
    int nM, nN, nwg, G, c;
    __host__ __device__ void init(int M, int N, int G_, int c_) { nM = M / BM; nN = N / BM; nwg = nM * nN; G = G_; c = c_; }
    __host__ __device__ bool next(int i, Unit& u) const {
        const long L = (long)i * G + c; if (L >= nwg) return false;
        int wgid = (int)L; { const int q = nwg / NXCD, r = nwg % NXCD, xcd = wgid % NXCD, off = wgid / NXCD; wgid = (xcd < r ? xcd * (q + 1) : r * (q + 1) + (xcd - r) * q) + off; }
        const int nig = WGM * nN, gid = wgid / nig, fm = gid * WGM, gsz = (nM - fm) < WGM ? (nM - fm) : WGM;
        u.pm = fm + ((wgid % nig) % gsz); u.pn = (wgid % nig) / gsz; return true;
    }
    __device__ __forceinline__ void a_ready(const Unit&) const {}
    __device__ __forceinline__ void done(const Unit&) const {}
};

__device__ __forceinline__ unsigned cvt_pk_bf16(float lo, float hi) { unsigned r; asm volatile("v_cvt_pk_bf16_f32 %0, %1, %2" : "=v"(r) : "v"(lo), "v"(hi)); return r; }
template <class Epi, class Sched, bool ALIGN_EPI = false, bool SP2 = false>
__device__ __forceinline__ void gemm_phase(PG8_LAS unsigned char* lds, const Gemm g, const Sched& S, const Epi& E) {
    int tid = threadIdx.x; asm volatile("" : "+v"(tid));
    const int wid = __builtin_amdgcn_readfirstlane(tid >> 6), lane = tid & 63, wr = wid >> 2, wc = wid & 3, fr = lane & 15, fq = lane >> 4;
    const int K = g.K, nt = K / BK;
    unsigned voffA[2], voffB[2];
#pragma unroll
    for (int i = 0; i < 2; ++i) { int R, C; stage_rc(tid * 16 + i * 8192, R, C); const int Rb = Epi::PERM ? ((R & ~31) + perm32(R & 31)) : R;
        voffA[i] = (unsigned)(R * g.lda + C) * 2u; voffB[i] = (unsigned)(Rb * g.ldb + C) * 2u; }
    const size_t kstep = (size_t)(BK * 2);
    const size_t hstepA = (size_t)HALF * g.lda * 2, hstepB = (size_t)HALF * g.ldb * 2;
    const size_t tstepA = 2 * hstepA, tstepB = 2 * hstepB;
    const unsigned ldsw = (unsigned)wid * 1024u;
    const int aoff = lds_byte(wr * 64 + fr, fq * 8), boff = lds_byte(wc * 32 + fr, fq * 8);
#define PG8_SA(b, h) (((b) * 2 + (h)) * HTB)
#define PG8_SB(b, h) ((4 + (b) * 2 + (h)) * HTB)
#define PG8_STAGE(bufoff, gbase, voff) do { _Pragma("unroll") for (int _i = 0; _i < 2; ++_i) \
        __builtin_amdgcn_global_load_lds((const unsigned*)((const char*)(gbase) + (voff)[_i]), (PG8_LAS unsigned*)(lds + (bufoff) + ldsw + _i * 8192), 16, 0, 0); } while (0)
#define PG8_LDA(dst, b, h) do { _Pragma("unroll") for (int m = 0; m < 4; ++m) _Pragma("unroll") for (int k = 0; k < 2; ++k) dst[m][k] = *(const PG8_LAS bf16x8*)(lds + PG8_SA(b, h) + aoff + m * 2048 + k * 1024); } while (0)
#define PG8_LDB(dst, b, h) do { _Pragma("unroll") for (int n = 0; n < 2; ++n) _Pragma("unroll") for (int k = 0; k < 2; ++k) dst[n][k] = *(const PG8_LAS bf16x8*)(lds + PG8_SB(b, h) + boff + n * 2048 + k * 1024); } while (0)
#define PG8_MMA(ai, bj, At, Bt) do { __builtin_amdgcn_s_setprio(1); _Pragma("unroll") for (int m = 0; m < 4; ++m) _Pragma("unroll") for (int n = 0; n < 2; ++n) _Pragma("unroll") for (int k = 0; k < 2; ++k) \
        acc[ai][bj][m][n] = __builtin_amdgcn_mfma_f32_16x16x32_bf16(Bt[n][k], At[m][k], acc[ai][bj][m][n], 0, 0, 0); __builtin_amdgcn_s_setprio(0); } while (0)
#define PG8_WAIT_V(n) asm volatile("s_waitcnt vmcnt(" #n ")" ::: "memory")
#define PG8_WAIT_L(n) asm volatile("s_waitcnt lgkmcnt(" #n ")" ::: "memory")
#define PG8_BAR __builtin_amdgcn_s_barrier()
#define PG8_SCHED __builtin_amdgcn_sched_barrier(0)
    Unit cur, nxt; int ui = 0;
    if (!S.next(0, cur)) return;
    f32x4 acc[2][2][4][2];
#pragma unroll
    for (int a = 0; a < 2; ++a)
#pragma unroll
        for (int b = 0; b < 2; ++b)
#pragma unroll
            for (int m = 0; m < 4; ++m)
#pragma unroll
                for (int n = 0; n < 2; ++n) acc[a][b][m][n] = (f32x4){0.f, 0.f, 0.f, 0.f};
    bf16x8 At[4][2], B0[2][2], B1[2][2];
    const char* cA = (const char*)g.A + (size_t)cur.pm * tstepA; const char* cB = (const char*)g.Bt + (size_t)cur.pn * tstepB;
    S.a_ready(cur);
    if constexpr (SP2) {
        PG8_STAGE(PG8_SB(0, 0), cB, voffB); PG8_STAGE(PG8_SB(0, 1), cB + hstepB, voffB); PG8_STAGE(PG8_SA(0, 0), cA, voffA); PG8_STAGE(PG8_SA(0, 1), cA + hstepA, voffA);
        if (wr == 1) PG8_BAR;
        PG8_WAIT_V(2); PG8_BAR;
        PG8_STAGE(PG8_SB(1, 0), cB + kstep, voffB); PG8_STAGE(PG8_SA(1, 0), cA + kstep, voffA); PG8_STAGE(PG8_SB(1, 1), cB + hstepB + kstep, voffB);
        PG8_WAIT_V(6); PG8_BAR;
    } else {
        PG8_STAGE(PG8_SB(0, 0), cB, voffB); PG8_STAGE(PG8_SA(0, 0), cA, voffA); PG8_STAGE(PG8_SB(0, 1), cB + hstepB, voffB); PG8_STAGE(PG8_SA(0, 1), cA + hstepA, voffA);
        if (wr == 1) PG8_BAR;
        PG8_WAIT_V(4); PG8_BAR;
        PG8_STAGE(PG8_SB(1, 0), cB + kstep, voffB); PG8_STAGE(PG8_SA(1, 0), cA + kstep, voffA); PG8_STAGE(PG8_SB(1, 1), cB + hstepB + kstep, voffB);
        PG8_WAIT_V(6); PG8_BAR;
    }
    for (;;) {
        const bool has_next = S.next(ui + 1, nxt);
        const char* nA = has_next ? (const char*)g.A + (size_t)nxt.pm * tstepA : cA; const char* nB = has_next ? (const char*)g.Bt + (size_t)nxt.pn * tstepB : cB;
        for (int t = 0; t < nt; t += 2) {
            const bool last = (t == nt - 2);
            const char* a1 = cA + (size_t)(t + 1) * kstep;
            const char* a2 = last ? nA : cA + (size_t)(t + 2) * kstep; const char* b2 = last ? nB : cB + (size_t)(t + 2) * kstep;
            const char* a3 = a2 + kstep; const char* b3 = b2 + kstep;
            if (last && has_next) S.a_ready(nxt);
            if constexpr (SP2) {
            PG8_LDB(B0, 0, 0); PG8_LDB(B1, 0, 1); PG8_SCHED; PG8_LDA(At, 0, 0); PG8_STAGE(PG8_SA(1, 1), a1 + hstepA, voffA);
            PG8_WAIT_V(8); PG8_WAIT_L(0); PG8_BAR; PG8_MMA(0, 0, At, B0); PG8_MMA(0, 1, At, B1); PG8_BAR; PG8_SCHED;
            PG8_LDA(At, 0, 1); PG8_STAGE(PG8_SB(0, 0), b2, voffB); PG8_STAGE(PG8_SB(0, 1), b2 + hstepB, voffB); PG8_STAGE(PG8_SA(0, 0), a2, voffA);
            PG8_WAIT_V(8); PG8_WAIT_L(0); PG8_BAR; PG8_MMA(1, 0, At, B0); PG8_MMA(1, 1, At, B1); PG8_BAR; PG8_SCHED;
            PG8_LDB(B0, 1, 0); PG8_LDB(B1, 1, 1); PG8_SCHED; PG8_LDA(At, 1, 0); PG8_STAGE(PG8_SA(0, 1), a2 + hstepA, voffA);
            PG8_WAIT_V(8); PG8_WAIT_L(0); PG8_BAR; PG8_MMA(0, 0, At, B0); PG8_MMA(0, 1, At, B1); PG8_BAR; PG8_SCHED;
            PG8_LDA(At, 1, 1); PG8_STAGE(PG8_SB(1, 0), b3, voffB); PG8_STAGE(PG8_SB(1, 1), b3 + hstepB, voffB); PG8_STAGE(PG8_SA(1, 0), a3, voffA);
            PG8_WAIT_V(8); PG8_WAIT_L(0); PG8_BAR; PG8_MMA(1, 0, At, B0); PG8_MMA(1, 1, At, B1); PG8_BAR; PG8_SCHED;
            } else {
            PG8_LDB(B0, 0, 0); PG8_SCHED; PG8_LDA(At, 0, 0); PG8_STAGE(PG8_SA(1, 1), a1 + hstepA, voffA);
            PG8_WAIT_L(8); PG8_BAR; PG8_WAIT_L(0); PG8_MMA(0, 0, At, B0); PG8_BAR; PG8_SCHED;
            PG8_LDB(B1, 0, 1); PG8_STAGE(PG8_SB(0, 0), b2, voffB);
            PG8_BAR; PG8_WAIT_L(0); PG8_MMA(0, 1, At, B1); PG8_BAR;
            PG8_LDA(At, 0, 1); PG8_STAGE(PG8_SA(0, 0), a2, voffA);
            PG8_BAR; PG8_WAIT_L(0); PG8_MMA(1, 0, At, B0); PG8_BAR; PG8_SCHED;
            PG8_STAGE(PG8_SB(0, 1), b2 + hstepB, voffB);
            PG8_WAIT_V(6); PG8_BAR; PG8_MMA(1, 1, At, B1); PG8_BAR;
            PG8_LDB(B0, 1, 0); PG8_SCHED; PG8_LDA(At, 1, 0); PG8_STAGE(PG8_SA(0, 1), a2 + hstepA, voffA);
            PG8_WAIT_L(8); PG8_BAR; PG8_WAIT_L(0); PG8_MMA(0, 0, At, B0); PG8_BAR; PG8_SCHED;
            PG8_LDB(B1, 1, 1); PG8_STAGE(PG8_SB(1, 0), b3, voffB);
            PG8_BAR; PG8_WAIT_L(0); PG8_MMA(0, 1, At, B1); PG8_BAR;
            PG8_LDA(At, 1, 1); PG8_STAGE(PG8_SA(1, 0), a3, voffA);
            PG8_BAR; PG8_WAIT_L(0); PG8_MMA(1, 0, At, B0); PG8_BAR; PG8_SCHED;
            PG8_STAGE(PG8_SB(1, 1), b3 + hstepB, voffB);
            PG8_WAIT_V(6); PG8_BAR; PG8_MMA(1, 1, At, B1); PG8_BAR;
            }
        }
        if constexpr (ALIGN_EPI) { if (wr == 0) PG8_BAR; }
        if constexpr (!Epi::AFTER_DRAIN) { E(acc, cur, wr, wc, fr, fq); S.done(cur); }
        if (!has_next) break;
#pragma unroll
        for (int a = 0; a < 2; ++a)
#pragma unroll
            for (int b = 0; b < 2; ++b)
#pragma unroll
                for (int m = 0; m < 4; ++m)
#pragma unroll
                    for (int n = 0; n < 2; ++n) acc[a][b][m][n] = (f32x4){0.f, 0.f, 0.f, 0.f};
        cur = nxt; cA = nA; cB = nB; ++ui;
        if constexpr (ALIGN_EPI) { if (wr == 1) PG8_BAR; }
    }
    PG8_WAIT_V(0);
    if constexpr (!ALIGN_EPI) { if (wr == 0) PG8_BAR; }
    PG8_BAR;
    if constexpr (Epi::AFTER_DRAIN) { E.fused(acc, cur, wr, wc, fr, fq, lds, wid, lane); S.done(cur); }
#undef PG8_SA
#undef PG8_SB
#undef PG8_STAGE
#undef PG8_LDA
#undef PG8_LDB
#undef PG8_MMA
#undef PG8_WAIT_V
#undef PG8_WAIT_L
#undef PG8_BAR
#undef PG8_SCHED
}
}

constexpr int S_ = 8192, DM = 2048, DEPTH = 4, NH = 16;
constexpr int QL = 512, KVL = 512, ROPE = 64, NOPE = 128, VD = 128;
constexpr int INW = 13376;
constexpr int DFF = 5632, DFF2 = 11264;
constexpr int NNAT = 11520;
constexpr int WINR = NNAT + 2048;
constexpr float EPS = 1e-6f;
constexpr float LOG2E = 1.4426950408889634f;
constexpr float QSCALE = 0.07216878364870323f * 1.4426950408889634f;
constexpr int NWAVES = 8, NTHR = 512;

constexpr size_t MiB = 1u << 20;
constexpr size_t WS_CTL = 0, CTL_ZERO_BYTES = 1 * MiB;
constexpr size_t WS_COS = 1 * MiB, WS_SIN = 2 * MiB, WS_LB = 3 * MiB, WS_SSQ = 4 * MiB;
constexpr size_t WS_W = 5 * MiB;
constexpr size_t LW_IN = 0, LW_UQ = 53 * MiB, LW_K = 56 * MiB, LW_V = 58 * MiB, LW_A = 60 * MiB, LW_B = 68 * MiB, LW_O = 76 * MiB, LW_UP = 84 * MiB, LW_DN = 128 * MiB, LW = 150 * MiB;
constexpr size_t WS_XN = WS_W + 4 * LW;
constexpr size_t WS_MIX = WS_XN + 32 * MiB;
constexpr size_t WS_CQKV = WS_MIX;
constexpr size_t WS_KPE = WS_CQKV + 16 * MiB;
constexpr size_t WS_HQ = WS_KPE + 1 * MiB;
constexpr size_t GSTRIDE = 32 * MiB;
constexpr size_t WS_HG = WS_HQ + GSTRIDE, WS_GA = WS_HQ + 2 * GSTRIDE, WS_GB = WS_HQ + 3 * GSTRIDE;
constexpr size_t WS_HF = WS_HQ + 4 * GSTRIDE;
constexpr size_t WS_VTH = WS_HF + 64 * MiB;
constexpr size_t WS_QN = WS_VTH + 32 * MiB;
constexpr size_t WS_QR = WS_QN + 32 * MiB;
constexpr size_t WS_KN = WS_QR + 16 * MiB;
constexpr size_t WS_VT = WS_KN + 32 * MiB;
constexpr size_t WS_ATT = WS_VT + 32 * MiB;
constexpr size_t WS_REC = WS_ATT + 32 * MiB;
constexpr size_t WS_RRAW = WS_REC + 32 * MiB;
constexpr size_t WS_HU = WS_RRAW + 64 * MiB;
constexpr size_t WS_HS = WS_HU + 128 * MiB;
constexpr size_t WS_M1 = WS_HS + 64 * MiB;
constexpr size_t WS_MRG = WS_M1 + 64 * MiB;
constexpr size_t WS_MIX_END = WS_MRG + 32 * MiB;
constexpr size_t WS_U = WS_MIX;
constexpr size_t WS_ACT = WS_U + 176 * MiB;
static_assert(WS_ACT + 88 * MiB <= WS_MIX_END, "FFN overlay fits the mixer region");
constexpr size_t WS_END = WS_MIX_END;
constexpr int CW_BAR = 4096;

constexpr int RING_OFF = 0, RING_BYTES = 131072;
constexpr int LDSCTL_OFF = RING_BYTES, MISC_OFF = LDSCTL_OFF + 320;
constexpr int LDS_BYTES = 147456;

#define GAS __attribute__((address_space(1)))
#define LAS __attribute__((address_space(3)))
typedef unsigned short bf16;
typedef unsigned v4u __attribute__((ext_vector_type(4)));
typedef unsigned v2u __attribute__((ext_vector_type(2)));
typedef float f32x4 __attribute__((ext_vector_type(4)));
typedef float f32x2 __attribute__((ext_vector_type(2)));
typedef short bf16x8 __attribute__((ext_vector_type(8)));
typedef GAS unsigned gu32;
#define LDS_WAIT() asm volatile("s_waitcnt lgkmcnt(0)" ::: "memory")
#define VM_WAIT() asm volatile("s_waitcnt vmcnt(0)" ::: "memory")
__device__ __forceinline__ unsigned f2bf(float f) { unsigned u = __builtin_bit_cast(unsigned, f); return (u + 0x7fffu + ((u >> 16) & 1u)) >> 16; }
__device__ __forceinline__ unsigned pk2(float lo, float hi) { return f2bf(lo) | (f2bf(hi) << 16); }
__device__ __forceinline__ float bflo(unsigned u) { return __builtin_bit_cast(float, u << 16); }
__device__ __forceinline__ float bfhi(unsigned u) { return __builtin_bit_cast(float, u & 0xffff0000u); }
__device__ __forceinline__ float sigm(float x) { return __builtin_amdgcn_rcpf(1.f + __builtin_amdgcn_exp2f(-LOG2E * x)); }
__device__ __forceinline__ float wave_sum(float v) {
#pragma unroll
    for (int o = 1; o < 64; o <<= 1) v += __shfl_xor(v, o);
    return v;
}
__device__ __forceinline__ float wave_max(float v) {
#pragma unroll
    for (int o = 1; o < 64; o <<= 1) v = fmaxf(v, __shfl_xor(v, o));
    return v;
}

namespace pg8 {
__device__ __forceinline__ u32x4 pack8(f32x4 a, f32x4 b) { u32x4 w; w.x = cvt_pk_bf16(a[0], a[1]); w.y = cvt_pk_bf16(a[2], a[3]); w.z = cvt_pk_bf16(b[0], b[1]); w.w = cvt_pk_bf16(b[2], b[3]); return w; }
__device__ __forceinline__ f32x4 silu4(f32x4 v) { f32x4 r; r[0] = v[0] * sigm(v[0]); r[1] = v[1] * sigm(v[1]); r[2] = v[2] * sigm(v[2]); r[3] = v[3] * sigm(v[3]); return r; }
__device__ __forceinline__ f32x4 sigm4(f32x4 v) { f32x4 r; r[0] = sigm(v[0]); r[1] = sigm(v[1]); r[2] = sigm(v[2]); r[3] = sigm(v[3]); return r; }
__device__ __forceinline__ float sum8(const float* p) { const f32x4 a = *(const f32x4*)p, b = *(const f32x4*)(p + 4); return ((a[0] + a[1]) + (a[2] + a[3])) + ((b[0] + b[1]) + (b[2] + b[3])); }
__device__ __forceinline__ void rope8(f32x4& v0, f32x4& v1, const f32x4 cs, const f32x4 sn) {
    f32x4 a, b;
    a[0] = v0[0] * cs[0] - v0[1] * sn[0]; a[1] = v0[1] * cs[0] + v0[0] * sn[0];
    a[2] = v0[2] * cs[1] - v0[3] * sn[1]; a[3] = v0[3] * cs[1] + v0[2] * sn[1];
    b[0] = v1[0] * cs[2] - v1[1] * sn[2]; b[1] = v1[1] * cs[2] + v1[0] * sn[2];
    b[2] = v1[2] * cs[3] - v1[3] * sn[3]; b[3] = v1[3] * cs[3] + v1[2] * sn[3];
    v0 = a; v1 = b;
}

struct EpiIn {
    static constexpr bool PERM = true, AFTER_DRAIN = false;
    unsigned char* ws;
    __device__ __forceinline__ void operator()(const f32x4 (&acc)[2][2][4][2], const Unit& u, int wr, int wc, int fr, int fq) const {
        const int pn = u.pn, row0 = u.pm * BM + wr * 64 + fr, lc = wc * 32 + 8 * fq;
        if (pn == 4) {
            if (wc < 2) {
                const float* COS = (const float*)(ws + WS_COS); const float* SIN = (const float*)(ws + WS_SIN); bf16_t* KPE = (bf16_t*)(ws + WS_KPE);
#pragma unroll
                for (int ai = 0; ai < 2; ++ai)
#pragma unroll
                    for (int m = 0; m < 4; ++m) { const int row = row0 + ai * HALF + m * 16;
                        f32x4 v0 = acc[ai][0][m][0], v1 = acc[ai][0][m][1];
                        const f32x4 cs = *(const f32x4*)(COS + (size_t)row * 32 + wc * 16 + 4 * fq), sn = *(const f32x4*)(SIN + (size_t)row * 32 + wc * 16 + 4 * fq);
                        rope8(v0, v1, cs, sn);
                        *(u32x4*)(KPE + (size_t)row * 64 + lc) = pack8(v0, v1);
                        if (m & 1) asm volatile("" ::: "memory"); }
            }
        } else if (pn >= 13 && pn < 21) {
            float* HF = (float*)(ws + WS_HF);
#pragma unroll
            for (int ai = 0; ai < 2; ++ai)
#pragma unroll
                for (int m = 0; m < 4; ++m) { float* rp = HF + (size_t)(row0 + ai * HALF + m * 16) * 2048 + (pn - 13) * 256 + lc;
#pragma unroll
                    for (int bj = 0; bj < 2; ++bj) { *(f32x4*)(rp + bj * HALF) = acc[ai][bj][m][0]; *(f32x4*)(rp + bj * HALF + 4) = acc[ai][bj][m][1]; } }
        } else {
            bf16_t* base; int ldc, act;
            if (pn < 4) { base = (bf16_t*)(ws + WS_CQKV) + pn * 256; ldc = 1024; act = 0; }
            else { const int gi = (pn < 13) ? 0 : ((pn - 13) >> 3), ct = (pn < 13) ? (pn - 5) : ((pn - 13) & 7);
                   base = (bf16_t*)(ws + WS_HQ + (size_t)gi * GSTRIDE) + ct * 256; ldc = 2048; act = (gi <= 1) ? 1 : 2; }
#pragma unroll
            for (int ai = 0; ai < 2; ++ai)
#pragma unroll
                for (int m = 0; m < 4; ++m) { bf16_t* rp = base + (size_t)(row0 + ai * HALF + m * 16) * ldc + lc;
#pragma unroll
                    for (int bj = 0; bj < 2; ++bj) { f32x4 v0 = acc[ai][bj][m][0], v1 = acc[ai][bj][m][1];
                        if (act == 1) { v0 = silu4(v0); v1 = silu4(v1); }
                        else if (act == 2) { v0 = sigm4(v0); v1 = sigm4(v1); }
                        *(u32x4*)(rp + bj * HALF) = pack8(v0, v1); } }
        }
    }
};
struct EpiStore {
    static constexpr bool PERM = true, AFTER_DRAIN = false;
    bf16_t* O; int ldc;
    __device__ __forceinline__ void operator()(const f32x4 (&acc)[2][2][4][2], const Unit& u, int wr, int wc, int fr, int fq) const {
        const int row0 = u.pm * BM + wr * 64 + fr, col0 = u.pn * BM + wc * 32 + 8 * fq;
#pragma unroll
        for (int ai = 0; ai < 2; ++ai)
#pragma unroll
            for (int m = 0; m < 4; ++m) { bf16_t* rp = O + (size_t)(row0 + ai * HALF + m * 16) * ldc + col0;
#pragma unroll
                for (int bj = 0; bj < 2; ++bj) *(u32x4*)(rp + bj * HALF) = pack8(acc[ai][bj][m][0], acc[ai][bj][m][1]); }
    }
};
struct EpiQ {
    static constexpr bool PERM = true, AFTER_DRAIN = false;
    unsigned char* ws;
    __device__ __forceinline__ void operator()(const f32x4 (&acc)[2][2][4][2], const Unit& u, int wr, int wc, int fr, int fq) const {
        const int pn = u.pn, row0 = u.pm * BM + wr * 64 + fr, lc = wc * 32 + 8 * fq;
        if (pn < 8) {
            bf16_t* base = (bf16_t*)(ws + WS_QN) + pn * 256 + lc;
#pragma unroll
            for (int ai = 0; ai < 2; ++ai)
#pragma unroll
                for (int m = 0; m < 4; ++m)
#pragma unroll
                    for (int bj = 0; bj < 2; ++bj) *(u32x4*)(base + (size_t)(row0 + ai * HALF + m * 16) * 2048 + bj * HALF) = pack8(acc[ai][bj][m][0] * QSCALE, acc[ai][bj][m][1] * QSCALE);
        } else {
            const float* COS = (const float*)(ws + WS_COS); const float* SIN = (const float*)(ws + WS_SIN);
            bf16_t* base = (bf16_t*)(ws + WS_QR) + (pn - 8) * 256 + lc; const int p0 = (wc & 1) * 16 + 4 * fq;
#pragma unroll
            for (int ai = 0; ai < 2; ++ai)
#pragma unroll
                for (int m = 0; m < 4; ++m) { const int row = row0 + ai * HALF + m * 16;
                    const f32x4 cs = *(const f32x4*)(COS + (size_t)row * 32 + p0), sn = *(const f32x4*)(SIN + (size_t)row * 32 + p0);
#pragma unroll
                    for (int bj = 0; bj < 2; ++bj) { f32x4 v0 = acc[ai][bj][m][0] * QSCALE, v1 = acc[ai][bj][m][1] * QSCALE; rope8(v0, v1, cs, sn);
                        *(u32x4*)(base + (size_t)row * 1024 + bj * HALF) = pack8(v0, v1); }
                    if (m & 1) asm volatile("" ::: "memory"); }
        }
    }
};
struct EpiGateA {
    static constexpr bool PERM = true, AFTER_DRAIN = false;
    unsigned char* ws;
    __device__ __forceinline__ void operator()(const f32x4 (&acc)[2][2][4][2], const Unit& u, int wr, int wc, int fr, int fq) const {
        const int row0 = u.pm * BM + wr * 64 + fr, col0 = u.pn * BM + wc * 32 + 8 * fq;
        const bf16_t* G = (const bf16_t*)(ws + WS_GA); float* M1 = (float*)(ws + WS_M1);
#pragma unroll
        for (int ai = 0; ai < 2; ++ai)
#pragma unroll
            for (int m = 0; m < 4; ++m) { const size_t off = (size_t)(row0 + ai * HALF + m * 16) * 2048 + col0;
#pragma unroll
                for (int bj = 0; bj < 2; ++bj) { const u32x4 g = *(const u32x4*)(G + off + bj * HALF);
                    const f32x4 g0 = {bflo(g.x), bfhi(g.x), bflo(g.y), bfhi(g.y)}, g1 = {bflo(g.z), bfhi(g.z), bflo(g.w), bfhi(g.w)};
                    *(f32x4*)(M1 + off + bj * HALF) = acc[ai][bj][m][0] * g0; *(f32x4*)(M1 + off + bj * HALF + 4) = acc[ai][bj][m][1] * g1; }
                if (m & 1) asm volatile("" ::: "memory"); }
    }
};
struct EpiGateB {
    static constexpr bool PERM = true, AFTER_DRAIN = false;
    unsigned char* ws;
    __device__ __forceinline__ void operator()(const f32x4 (&acc)[2][2][4][2], const Unit& u, int wr, int wc, int fr, int fq) const {
        const int row0 = u.pm * BM + wr * 64 + fr, col0 = u.pn * BM + wc * 32 + 8 * fq;
        const bf16_t* G = (const bf16_t*)(ws + WS_GB); const float* M1 = (const float*)(ws + WS_M1); bf16_t* O = (bf16_t*)(ws + WS_MRG);
#pragma unroll
        for (int ai = 0; ai < 2; ++ai)
#pragma unroll
            for (int m = 0; m < 4; ++m) { const size_t off = (size_t)(row0 + ai * HALF + m * 16) * 2048 + col0;
#pragma unroll
                for (int bj = 0; bj < 2; ++bj) { const u32x4 g = *(const u32x4*)(G + off + bj * HALF);
                    const f32x4 g0 = {bflo(g.x), bfhi(g.x), bflo(g.y), bfhi(g.y)}, g1 = {bflo(g.z), bfhi(g.z), bflo(g.w), bfhi(g.w)};
                    const f32x4 m0 = *(const f32x4*)(M1 + off + bj * HALF), m1 = *(const f32x4*)(M1 + off + bj * HALF + 4);
                    *(u32x4*)(O + off + bj * HALF) = pack8(m0 + acc[ai][bj][m][0] * g0, m1 + acc[ai][bj][m][1] * g1); }
                if (m & 1) asm volatile("" ::: "memory"); }
    }
};
struct EpiRes {
    static constexpr bool PERM = true, AFTER_DRAIN = false;
    float* X;
    __device__ __forceinline__ void operator()(const f32x4 (&acc)[2][2][4][2], const Unit& u, int wr, int wc, int fr, int fq) const {
        const int row0 = u.pm * BM + wr * 64 + fr, col0 = u.pn * BM + wc * 32 + 8 * fq;
#pragma unroll
        for (int ai = 0; ai < 2; ++ai)
#pragma unroll
            for (int m = 0; m < 4; ++m) { float* rp = X + (size_t)(row0 + ai * HALF + m * 16) * 2048 + col0;
#pragma unroll
                for (int bj = 0; bj < 2; ++bj) { const f32x4 a = *(const f32x4*)(rp + bj * HALF), b = *(const f32x4*)(rp + bj * HALF + 4);
                    *(f32x4*)(rp + bj * HALF) = a + acc[ai][bj][m][0]; *(f32x4*)(rp + bj * HALF + 4) = b + acc[ai][bj][m][1]; }
                if (m & 1) asm volatile("" ::: "memory"); }
    }
};
}
#define XB_TMO      128
#define XB_XCNT(j)  (256  + 64 * (j))
#define XB_XSUB(j)  (1280 + 64 * (j))
#define XB_XGEN(j)  (2304 + 64 * (j))
#define XB_TOP      3328
#define XB_TOPGEN   3392
#define XCD_BAR_WORDS 3456
#define XB_SPIN_CAP (1u << 18)

__device__ __forceinline__ unsigned xb_ld(unsigned* p)              { return __hip_atomic_load(p, __ATOMIC_RELAXED, __HIP_MEMORY_SCOPE_AGENT); }
__device__ __forceinline__ unsigned xb_add(unsigned* p, unsigned v) { return __hip_atomic_fetch_add(p, v, __ATOMIC_RELAXED, __HIP_MEMORY_SCOPE_AGENT); }
__device__ __forceinline__ unsigned xb_xcc_id() { return (unsigned)__builtin_amdgcn_s_getreg((3 << 11) | 20) & 0xFu; }
#define XB_SPIN(cond, bar) do { unsigned _sp = 0; while (cond) { __builtin_amdgcn_s_sleep(1); \
    if ((++_sp & 255u) == 0u) { if (xb_ld(&(bar)[XB_TMO])) break; if (_sp > XB_SPIN_CAP) { atomicAdd(&(bar)[XB_TMO], 1u); break; } } } } while (0)

struct XcdBarrier {
    unsigned* bar; unsigned x;
    volatile LAS unsigned* st;
};

__device__ __forceinline__ XcdBarrier xcd_barrier_post(unsigned* bar, volatile LAS unsigned* st) {
    XcdBarrier b; b.bar = bar; b.x = xb_xcc_id(); b.st = st;
    if (threadIdx.x == 0) (void)xb_add(&bar[XB_XCNT(b.x)], 1u);
    return b;
}
__device__ __forceinline__ void xcd_barrier_complete(unsigned* bar, unsigned x, unsigned& nloc, unsigned& nx) {
    const unsigned G = gridDim.x * gridDim.y * gridDim.z;
    unsigned sum, cnt, mine, sp = 0u;
    for (;;) {
        sum = 0u; cnt = 0u; mine = 0u;
#pragma unroll
        for (unsigned j = 0; j < 16; ++j) { const unsigned c = xb_ld(&bar[XB_XCNT(j)]); sum += c; cnt += (c > 0u) ? 1u : 0u; mine = (j == x) ? c : mine; }
        if (sum == G) break;
        __builtin_amdgcn_s_sleep(1);
        if ((++sp & 255u) == 0u) { if (xb_ld(&bar[XB_TMO])) break; if (sp > XB_SPIN_CAP) { atomicAdd(&bar[XB_TMO], 1u); break; } }
    }
    nloc = mine > 0u ? mine : 1u; nx = cnt > 0u ? cnt : 1u;
}

__device__ __forceinline__ void xcd_barrier(const XcdBarrier& b) {
    asm volatile("s_waitcnt vmcnt(0)" ::: "memory");
    __syncthreads();
    if (threadIdx.x == 0) {
        GAS unsigned* gbar_ = (GAS unsigned*)b.bar; unsigned bx_ = b.x; asm volatile("" : "+s"(gbar_), "+s"(bx_)); unsigned* bar = (unsigned*)gbar_;
        __builtin_amdgcn_s_waitcnt(0);
        unsigned nloc = b.st[0], nx = b.st[1];
        if (nloc == 0u) { xcd_barrier_complete(bar, bx_, nloc, nx); b.st[0] = nloc; b.st[1] = nx; }
        const unsigned old = xb_add(&bar[XB_XSUB(bx_)], 1u);
        const unsigned gen = old / nloc;
        if (old + 1u == (gen + 1u) * nloc) {
            __builtin_amdgcn_fence(__ATOMIC_RELEASE, "agent");
            asm volatile("s_waitcnt vmcnt(0)" ::: "memory");
            const unsigned og = xb_add(&bar[XB_TOP], 1u);
            const unsigned tg = og / nx;
            if (og + 1u == (tg + 1u) * nx) xb_add(&bar[XB_TOPGEN], 1u);
            else XB_SPIN(xb_ld(&bar[XB_TOPGEN]) == tg, bar);
            __builtin_amdgcn_fence(__ATOMIC_ACQUIRE, "agent");
            xb_add(&bar[XB_XGEN(bx_)], 1u);
            asm volatile("s_waitcnt vmcnt(0)" ::: "memory");
        } else {
            XB_SPIN(xb_ld(&bar[XB_XGEN(bx_)]) == gen, bar);
            __builtin_amdgcn_fence(__ATOMIC_ACQUIRE, "agent");
            asm volatile("s_waitcnt vmcnt(0)" ::: "memory");
        }
    }
    __syncthreads();
}

__device__ const float c_invf[32] = {
    1.000000000e+00f, 7.498942614e-01f, 5.623413324e-01f, 4.216965139e-01f, 3.162277639e-01f, 2.371373773e-01f, 1.778279394e-01f, 1.333521307e-01f,
    1.000000015e-01f, 7.498941571e-02f, 5.623413250e-02f, 4.216965288e-02f, 3.162277490e-02f, 2.371373773e-02f, 1.778279431e-02f, 1.333521493e-02f,
    9.999999776e-03f, 7.498941850e-03f, 5.623413250e-03f, 4.216964822e-03f, 3.162277630e-03f, 2.371373586e-03f, 1.778279431e-03f, 1.333521446e-03f,
    1.000000047e-03f, 7.498942432e-04f, 5.623413017e-04f, 4.216965172e-04f, 3.162277571e-04f, 2.371373703e-04f, 1.778279402e-04f, 1.333521504e-04f};

template <int KIND> __device__ __forceinline__ int srcmap(int n) {
    if constexpr (KIND == 0) return n;
    else if constexpr (KIND == 1) {
        if (n < 1024) return n;
        if (n < 1088) { const int jj = n - 1024; return 1024 + (jj >> 1) + 32 * (jj & 1); }
        if (n < 1280) return -1;
        if (n < 3328) return 1088 + (n - 1280);
        if (n < 5376) return 3136 + (n - 3328);
        if (n < 7424) return 7232 + (n - 5376);
        if (n < 9472) return 9280 + (n - 7424);
        if (n < 11520) return 11328 + (n - 9472);
        return 5184 + (n - 11520);
    } else if constexpr (KIND == 2) {
        if (n < 2048) return (n >> 7) * 192 + (n & 127);
        const int r = n - 2048, h = r >> 6, jj = r & 63; return h * 192 + 128 + (jj >> 1) + 32 * (jj & 1);
    } else if constexpr (KIND == 3) return (n >> 7) * 256 + (n & 127);
    else if constexpr (KIND == 4) return (n >> 7) * 256 + 128 + (n & 127);
    else { const int j = n >> 8, i = n & 255; return i < 128 ? 128 * j + i : DFF + 128 * j + (i - 128); }
}
template <int KIND> __device__ __forceinline__ void transpose_item(const float* W, int K, int Nsrc, bf16* WT, const float* scale, LAS float* scr, int kb, int nb, int lane) {
    const int k0 = 64 * kb, n0 = 32 * nb, sc = srcmap<KIND>(n0 + (lane & 31));
#pragma unroll 8
    for (int i = 0; i < 32; ++i) { const int kk = 2 * i + (lane >> 5); float v = 0.f;
        if (sc >= 0) { v = ((const GAS float*)W)[(size_t)(k0 + kk) * Nsrc + sc]; if (scale) v *= ((const GAS float*)scale)[k0 + kk]; }
        scr[kk * 33 + (lane & 31)] = v; }
    LDS_WAIT(); asm volatile("" ::: "memory");
    const int c = lane & 7;
#pragma unroll
    for (int j = 0; j < 4; ++j) { const int n = (lane >> 3) + 8 * j; const LAS float* s = scr + (8 * c) * 33 + n;
        v4u o; o.x = pk2(s[0 * 33], s[1 * 33]); o.y = pk2(s[2 * 33], s[3 * 33]); o.z = pk2(s[4 * 33], s[5 * 33]); o.w = pk2(s[6 * 33], s[7 * 33]);
        *(GAS v4u*)(WT + (size_t)(n0 + n) * K + k0 + 8 * c) = o; }
    LDS_WAIT(); asm volatile("" ::: "memory");
}
__device__ __forceinline__ void rms_row_to_bf16(const float* xrow, const float* gain, bf16* orow, float* xcopy, int lane) {
    const GAS f32x4* xr = (const GAS f32x4*)xrow + lane;
    f32x4 v[8]; float s = 0.f;
#pragma unroll
    for (int j = 0; j < 8; ++j) { v[j] = xr[64 * j]; s += (v[j].x * v[j].x + v[j].y * v[j].y) + (v[j].z * v[j].z + v[j].w * v[j].w); }
    const float rstd = 1.0f / sqrtf(wave_sum(s) * (1.f / DM) + EPS);
    if (xcopy) { GAS f32x4* xc = (GAS f32x4*)xcopy + lane;
#pragma unroll
        for (int j = 0; j < 8; ++j) xc[64 * j] = v[j]; }
    GAS v2u* o8 = (GAS v2u*)orow + lane;
#pragma unroll
    for (int j = 0; j < 8; ++j) { const f32x4 g = *((const GAS f32x4*)gain + lane + 64 * j);
        v2u w; w.x = pk2(v[j].x * rstd * g.x, v[j].y * rstd * g.y); w.y = pk2(v[j].z * rstd * g.z, v[j].w * rstd * g.w); o8[64 * j] = w; }
}
__device__ __forceinline__ void rms_row_f32(float* xrow, const float* gain, int lane) {
    GAS f32x4* xr = (GAS f32x4*)xrow + lane;
    f32x4 v[8]; float s = 0.f;
#pragma unroll
    for (int j = 0; j < 8; ++j) { v[j] = xr[64 * j]; s += (v[j].x * v[j].x + v[j].y * v[j].y) + (v[j].z * v[j].z + v[j].w * v[j].w); }
    const float rstd = 1.0f / sqrtf(wave_sum(s) * (1.f / DM) + EPS);
#pragma unroll
    for (int j = 0; j < 8; ++j) { const f32x4 g = *((const GAS f32x4*)gain + lane + 64 * j); xr[64 * j] = v[j] * rstd * g; }
}
__device__ __forceinline__ void sincos_f64(float angf, float& sn, float& cs) {
    const double a = (double)angf;
    const double n = __builtin_rint(a * 0.63661977236758134308);
    double r = __builtin_fma(-n, 1.57079632679489655800e+00, a); r = __builtin_fma(-n, 6.12323399573676603587e-17, r);
    const double r2 = r * r;
    double ps = -1.0 / 1307674368000.0; ps = ps * r2 + 1.0 / 6227020800.0; ps = ps * r2 - 1.0 / 39916800.0; ps = ps * r2 + 1.0 / 362880.0; ps = ps * r2 - 1.0 / 5040.0; ps = ps * r2 + 1.0 / 120.0; ps = ps * r2 - 1.0 / 6.0; ps = ps * r2 * r + r;
    double pc = 1.0 / 20922789888000.0; pc = pc * r2 - 1.0 / 87178291200.0; pc = pc * r2 + 1.0 / 479001600.0; pc = pc * r2 - 1.0 / 3628800.0; pc = pc * r2 + 1.0 / 40320.0; pc = pc * r2 - 1.0 / 720.0; pc = pc * r2 + 1.0 / 24.0; pc = pc * r2 - 0.5; pc = pc * r2 + 1.0;
    const int q = ((int)n) & 3;
    const double s_ = (q == 0) ? ps : (q == 1) ? pc : (q == 2) ? -ps : -pc;
    const double c_ = (q == 0) ? pc : (q == 1) ? -ps : (q == 2) ? -pc : ps;
    sn = (float)s_; cs = (float)c_;
}

__device__ __forceinline__ void latent_norm_row(bf16* row, int lane) {
    v4u a = *(const v4u*)(row + lane * 8), b = *(const v4u*)(row + 512 + lane * 8);
    float fa[8] = {bflo(a.x), bfhi(a.x), bflo(a.y), bfhi(a.y), bflo(a.z), bfhi(a.z), bflo(a.w), bfhi(a.w)};
    float fb[8] = {bflo(b.x), bfhi(b.x), bflo(b.y), bfhi(b.y), bflo(b.z), bfhi(b.z), bflo(b.w), bfhi(b.w)};
    float sa = 0.f, sb = 0.f;
#pragma unroll
    for (int i = 0; i < 8; ++i) { sa += fa[i] * fa[i]; sb += fb[i] * fb[i]; }
    const float ra = 1.0f / sqrtf(wave_sum(sa) * (1.f / 512.f) + EPS), rb = 1.0f / sqrtf(wave_sum(sb) * (1.f / 512.f) + EPS);
    a.x = pk2(fa[0] * ra, fa[1] * ra); a.y = pk2(fa[2] * ra, fa[3] * ra); a.z = pk2(fa[4] * ra, fa[5] * ra); a.w = pk2(fa[6] * ra, fa[7] * ra);
    b.x = pk2(fb[0] * rb, fb[1] * rb); b.y = pk2(fb[2] * rb, fb[3] * rb); b.z = pk2(fb[4] * rb, fb[5] * rb); b.w = pk2(fb[6] * rb, fb[7] * rb);
    *(v4u*)(row + lane * 8) = a; *(v4u*)(row + 512 + lane * 8) = b;
}

__device__ __forceinline__ void attn_naive(unsigned char* ws, LAS float* qs  , int gw, int ngw, int lane) {
    const bf16* QN = (const bf16*)(ws + WS_QN); const bf16* QR = (const bf16*)(ws + WS_QR); const bf16* KN = (const bf16*)(ws + WS_KN);
    const bf16* KPE = (const bf16*)(ws + WS_KPE); const bf16* VT = (const bf16*)(ws + WS_VT); bf16* ATT = (bf16*)(ws + WS_ATT);
    for (int item = gw; item < S_ * NH; item += ngw) {
        const int q = item >> 4, h = item & 15;
        if (lane < 24) { const v4u w = (lane < 16) ? *(const v4u*)(QN + (size_t)q * 2048 + h * 128 + lane * 8) : *(const v4u*)(QR + (size_t)q * 1024 + h * 64 + (lane - 16) * 8);
            LAS float* d = qs + lane * 8; d[0] = bflo(w.x); d[1] = bfhi(w.x); d[2] = bflo(w.y); d[3] = bfhi(w.y); d[4] = bflo(w.z); d[5] = bfhi(w.z); d[6] = bflo(w.w); d[7] = bfhi(w.w); }
        LDS_WAIT(); asm volatile("" ::: "memory");
        float m = -__builtin_inff(), l = 0.f, o0 = 0.f, o1 = 0.f;
        const bf16* v0p = VT + (size_t)(h * 128 + 2 * lane) * S_; const bf16* v1p = v0p + S_;
        for (int j0 = 0; j0 <= q; j0 += 64) {
            const int j = j0 + lane; const bool valid = j <= q; float s = 0.f;
            if (valid) {
                const bf16* kn = KN + (size_t)j * 2048 + h * 128; const bf16* kp = KPE + (size_t)j * 64;
#pragma unroll 4
                for (int c = 0; c < 24; ++c) { const v4u w = (c < 16) ? *(const v4u*)(kn + c * 8) : *(const v4u*)(kp + (c - 16) * 8); const LAS float* qq = qs + c * 8;
                    s += bflo(w.x) * qq[0] + bfhi(w.x) * qq[1] + bflo(w.y) * qq[2] + bfhi(w.y) * qq[3] + bflo(w.z) * qq[4] + bfhi(w.z) * qq[5] + bflo(w.w) * qq[6] + bfhi(w.w) * qq[7]; }
            } else s = -__builtin_inff();
            const float mn = fmaxf(m, wave_max(s)); const float alpha = __builtin_amdgcn_exp2f(m - mn); const float p = valid ? __builtin_amdgcn_exp2f(s - mn) : 0.f;
            l = l * alpha + wave_sum(p); m = mn; o0 *= alpha; o1 *= alpha;
#pragma unroll
            for (int c = 0; c < 8; ++c) { const v4u a = *(const v4u*)(v0p + j0 + c * 8), b = *(const v4u*)(v1p + j0 + c * 8);
                const float p0 = __builtin_bit_cast(float, __builtin_amdgcn_readlane(__builtin_bit_cast(int, p), c * 8 + 0)), p1 = __builtin_bit_cast(float, __builtin_amdgcn_readlane(__builtin_bit_cast(int, p), c * 8 + 1));
                const float p2 = __builtin_bit_cast(float, __builtin_amdgcn_readlane(__builtin_bit_cast(int, p), c * 8 + 2)), p3 = __builtin_bit_cast(float, __builtin_amdgcn_readlane(__builtin_bit_cast(int, p), c * 8 + 3));
                const float p4 = __builtin_bit_cast(float, __builtin_amdgcn_readlane(__builtin_bit_cast(int, p), c * 8 + 4)), p5 = __builtin_bit_cast(float, __builtin_amdgcn_readlane(__builtin_bit_cast(int, p), c * 8 + 5));
                const float p6 = __builtin_bit_cast(float, __builtin_amdgcn_readlane(__builtin_bit_cast(int, p), c * 8 + 6)), p7 = __builtin_bit_cast(float, __builtin_amdgcn_readlane(__builtin_bit_cast(int, p), c * 8 + 7));
                o0 += p0 * bflo(a.x) + p1 * bfhi(a.x) + p2 * bflo(a.y) + p3 * bfhi(a.y) + p4 * bflo(a.z) + p5 * bfhi(a.z) + p6 * bflo(a.w) + p7 * bfhi(a.w);
                o1 += p0 * bflo(b.x) + p1 * bfhi(b.x) + p2 * bflo(b.y) + p3 * bfhi(b.y) + p4 * bflo(b.z) + p5 * bfhi(b.z) + p6 * bflo(b.w) + p7 * bfhi(b.w); }
        }
        const float il = 1.f / l;
        *(unsigned*)(ATT + (size_t)q * 2048 + h * 128 + 2 * lane) = pk2(o0 * il, o1 * il);
        asm volatile("" ::: "memory");
    }
}
__device__ __forceinline__ void hgrn_naive(unsigned char* ws, int layer, int gw, int ngw, int lane) {
    const bf16* HQ = (const bf16*)(ws + WS_HQ); const float* HF = (const float*)(ws + WS_HF); const bf16* VTH = (const bf16*)(ws + WS_VTH);
    const float* LB = (const float*)(ws + WS_LB) + layer * 2048; float* RR = (float*)(ws + WS_RRAW);
    for (int item = gw; item < NH * 128; item += ngw) {
        const int h = item >> 7, e = item & 127, ch = h * 128 + 2 * lane;
        const float lb0 = LB[ch], lb1 = LB[ch + 1];
        float s0 = 0.f, s1 = 0.f;
        const bf16* vp = VTH + (size_t)(h * 128 + e) * S_;
        for (int t0 = 0; t0 < S_; t0 += 8) {
            const v4u vv = *(const v4u*)(vp + t0);
            const float vt[8] = {bflo(vv.x), bfhi(vv.x), bflo(vv.y), bfhi(vv.y), bflo(vv.z), bfhi(vv.z), bflo(vv.w), bfhi(vv.w)};
            float ov = 0.f;
#pragma unroll
            for (int i = 0; i < 8; ++i) { const size_t off = (size_t)(t0 + i) * 2048 + ch;
                const f32x2 z = *(const f32x2*)(HF + off); const unsigned qq = *(const unsigned*)(HQ + off);
                const float f0 = lb0 + (1.f - lb0) * sigm(z.x), f1 = lb1 + (1.f - lb1) * sigm(z.y);
                s0 = fmaxf(f0, 1e-30f) * s0 + (1.f - f0) * vt[i]; s1 = fmaxf(f1, 1e-30f) * s1 + (1.f - f1) * vt[i];
                const float o = wave_sum(bflo(qq) * s0 + bfhi(qq) * s1);
                ov = (lane == i) ? o : ov; }
            if (lane < 8) RR[(size_t)(t0 + lane) * 2048 + h * 128 + e] = ov;
        }
    }
}
__device__ __forceinline__ void hgrn_normgate(unsigned char* ws, const float* gain, int gw, int ngw, int lane) {
    const float* RR = (const float*)(ws + WS_RRAW); const bf16* HG = (const bf16*)(ws + WS_HG); bf16* REC = (bf16*)(ws + WS_REC);
    const f32x2 g = *(const GAS f32x2*)(gain + 2 * lane);
    for (int item = gw; item < S_ * NH; item += ngw) {
        const size_t off = (size_t)item * 128 + 2 * lane;
        const f32x2 v = *(const f32x2*)(RR + off); const unsigned hg = *(const unsigned*)(HG + off);
        const float rstd = 1.0f / sqrtf(wave_sum(v.x * v.x + v.y * v.y) * (1.f / 128.f) + EPS);
        *(unsigned*)(REC + off) = pk2(v.x * rstd * g.x * bflo(hg), v.y * rstd * g.y * bfhi(hg));
    }
}
__device__ __forceinline__ void conv_gate(unsigned char* ws, const float* cw, const float* cb, int gw, int ngw, int lane) {
    const bf16* U = (const bf16*)(ws + WS_U); bf16* ACT = (bf16*)(ws + WS_ACT);
    for (int item = gw; item < (S_ / 16) * 11; item += ngw) {
        const int tb = item / 11, cg = item % 11, c0 = cg * 512 + lane * 8;
        const int ucol = (c0 >> 7) * 256 + (c0 & 127), t0 = tb * 16;
        float wg[3][8], wu[3][8], bg[8], bu[8];
#pragma unroll
        for (int j = 0; j < 3; ++j)
#pragma unroll
            for (int i = 0; i < 8; ++i) { wg[j][i] = ((const GAS float*)cw)[(size_t)j * DFF2 + c0 + i]; wu[j][i] = ((const GAS float*)cw)[(size_t)j * DFF2 + DFF + c0 + i]; }
#pragma unroll
        for (int i = 0; i < 8; ++i) { bg[i] = ((const GAS float*)cb)[c0 + i]; bu[i] = ((const GAS float*)cb)[DFF + c0 + i]; }
        float g2[8], g1[8], u2[8], u1[8];
#pragma unroll
        for (int i = 0; i < 8; ++i) { g2[i] = 0.f; g1[i] = 0.f; u2[i] = 0.f; u1[i] = 0.f; }
        if (t0 > 0) {
            const v4u a = *(const v4u*)(U + (size_t)(t0 - 2) * DFF2 + ucol), b = *(const v4u*)(U + (size_t)(t0 - 2) * DFF2 + ucol + 128);
            const v4u c = *(const v4u*)(U + (size_t)(t0 - 1) * DFF2 + ucol), d = *(const v4u*)(U + (size_t)(t0 - 1) * DFF2 + ucol + 128);
            g2[0] = bflo(a.x); g2[1] = bfhi(a.x); g2[2] = bflo(a.y); g2[3] = bfhi(a.y); g2[4] = bflo(a.z); g2[5] = bfhi(a.z); g2[6] = bflo(a.w); g2[7] = bfhi(a.w);
            u2[0] = bflo(b.x); u2[1] = bfhi(b.x); u2[2] = bflo(b.y); u2[3] = bfhi(b.y); u2[4] = bflo(b.z); u2[5] = bfhi(b.z); u2[6] = bflo(b.w); u2[7] = bfhi(b.w);
            g1[0] = bflo(c.x); g1[1] = bfhi(c.x); g1[2] = bflo(c.y); g1[3] = bfhi(c.y); g1[4] = bflo(c.z); g1[5] = bfhi(c.z); g1[6] = bflo(c.w); g1[7] = bfhi(c.w);
            u1[0] = bflo(d.x); u1[1] = bfhi(d.x); u1[2] = bflo(d.y); u1[3] = bfhi(d.y); u1[4] = bflo(d.z); u1[5] = bfhi(d.z); u1[6] = bflo(d.w); u1[7] = bfhi(d.w);
        }
#pragma unroll 4
        for (int t = t0; t < t0 + 16; ++t) {
            const v4u a = *(const v4u*)(U + (size_t)t * DFF2 + ucol), b = *(const v4u*)(U + (size_t)t * DFF2 + ucol + 128);
            float g0[8], u0[8];
            g0[0] = bflo(a.x); g0[1] = bfhi(a.x); g0[2] = bflo(a.y); g0[3] = bfhi(a.y); g0[4] = bflo(a.z); g0[5] = bfhi(a.z); g0[6] = bflo(a.w); g0[7] = bfhi(a.w);
            u0[0] = bflo(b.x); u0[1] = bfhi(b.x); u0[2] = bflo(b.y); u0[3] = bfhi(b.y); u0[4] = bflo(b.z); u0[5] = bfhi(b.z); u0[6] = bflo(b.w); u0[7] = bfhi(b.w);
            float r[8];
#pragma unroll
            for (int i = 0; i < 8; ++i) { const float G = bg[i] + wg[0][i] * g2[i] + wg[1][i] * g1[i] + wg[2][i] * g0[i]; const float Uu = bu[i] + wu[0][i] * u2[i] + wu[1][i] * u1[i] + wu[2][i] * u0[i];
                r[i] = G * sigm(G) * Uu; g2[i] = g1[i]; g1[i] = g0[i]; u2[i] = u1[i]; u1[i] = u0[i]; }
            v4u o; o.x = pk2(r[0], r[1]); o.y = pk2(r[2], r[3]); o.z = pk2(r[4], r[5]); o.w = pk2(r[6], r[7]);
            *(v4u*)(ACT + (size_t)t * DFF + c0) = o;
        }
    }
}

namespace fa {
typedef float f32x16 __attribute__((ext_vector_type(16)));
constexpr int KBUF = 24576, VBUF = 16384, STG = KBUF + VBUF;
constexpr float THR = 8.0f;
__device__ __forceinline__ float hmax(float a) { return fmaxf(a, __shfl_xor(a, 32)); }
__device__ __forceinline__ float hsum(float a) { return a + __shfl_xor(a, 32); }
__device__ __forceinline__ bf16x8 pk8(const f32x16& p, int b) {
    v4u w; w.x = pg8::cvt_pk_bf16(p[b], p[b + 1]); w.y = pg8::cvt_pk_bf16(p[b + 2], p[b + 3]); w.z = pg8::cvt_pk_bf16(p[b + 4], p[b + 5]); w.w = pg8::cvt_pk_bf16(p[b + 6], p[b + 7]);
    return __builtin_bit_cast(bf16x8, w);
}
__device__ __forceinline__ void attn_fast(unsigned char* ws, LAS unsigned char* lds, int vcu, int G) {
    int tid = threadIdx.x; asm volatile("" : "+v"(tid));
    const int lane = tid & 63, w = __builtin_amdgcn_readfirstlane(tid >> 6), r32 = lane & 31, hi = lane >> 5;
    const bf16* QN = (const bf16*)(ws + WS_QN); const bf16* QR = (const bf16*)(ws + WS_QR); const bf16* KN = (const bf16*)(ws + WS_KN);
    const bf16* KPE = (const bf16*)(ws + WS_KPE); const bf16* VT = (const bf16*)(ws + WS_VT); bf16* ATT = (bf16*)(ws + WS_ATT);
    const int pr = (r32 & 0x13) | ((r32 & 4) << 1) | ((r32 & 8) >> 1);
    const int kfo = hi * 1024 + pr * 16;
    const int fb = (r32 >> 1) & 7, va = (hi ^ (fb & 1)) << 4, vbb = fb >> 1;
    const int vfo = KBUF + r32 * 128 + va;
    const int vrow0 = 16 * w + (lane >> 3), vrow1 = vrow0 + 8;
    const int vsc0 = ((lane & 7) ^ ((vrow0 >> 1) & 7)) * 8, vsc1 = ((lane & 7) ^ ((vrow1 >> 1) & 7)) * 8;
    for (int item = vcu; item < 256; item += G) {
        const int h = item >> 4, sidx = item & 15;
        const bf16* kn_l = KN + (size_t)lane * 2048 + h * 128 + 8 * w;
        const bf16* kp_l = KPE + (size_t)lane * 64 + 8 * w;
        const bf16* v0_l = VT + (size_t)(h * 128 + vrow0) * S_ + vsc0; const bf16* v1_l = VT + (size_t)(h * 128 + vrow1) * S_ + vsc1;
#define FA_ISSUE(t, st) do { const size_t ko_ = (size_t)(t) * 64 * 2048, po_ = (size_t)(t) * 64 * 64; const int to_ = (t) * 64; LAS unsigned char* sb_ = lds + (st) * STG; \
        __builtin_amdgcn_global_load_lds((const unsigned*)(kn_l + ko_), (LAS unsigned*)(sb_ + w * 1024), 16, 0, 0); \
        __builtin_amdgcn_global_load_lds((const unsigned*)(kn_l + ko_ + 64), (LAS unsigned*)(sb_ + (w + 8) * 1024), 16, 0, 0); \
        __builtin_amdgcn_global_load_lds((const unsigned*)(kp_l + po_), (LAS unsigned*)(sb_ + (w + 16) * 1024), 16, 0, 0); \
        __builtin_amdgcn_global_load_lds((const unsigned*)(v0_l + to_), (LAS unsigned*)(sb_ + KBUF + (2 * w) * 1024), 16, 0, 0); \
        __builtin_amdgcn_global_load_lds((const unsigned*)(v1_l + to_), (LAS unsigned*)(sb_ + KBUF + (2 * w + 1) * 1024), 16, 0, 0); } while (0)
        for (int pass = 0; pass < 2; ++pass) {
            const int qb = pass ? sidx : 31 - sidx, q0 = qb * 256, NT = 4 * qb + 4, qw = q0 + 32 * w, q = qw + r32;
            FA_ISSUE(0, 0);
            bf16x8 qr[12];
#pragma unroll
            for (int d0 = 0; d0 < 8; ++d0) qr[d0] = *(const bf16x8*)(QN + (size_t)q * 2048 + h * 128 + d0 * 16 + hi * 8);
#pragma unroll
            for (int d0 = 0; d0 < 4; ++d0) qr[8 + d0] = *(const bf16x8*)(QR + (size_t)q * 1024 + h * 64 + d0 * 16 + hi * 8);
            f32x16 o[4];
#pragma unroll
            for (int e = 0; e < 4; ++e)
#pragma unroll
                for (int r = 0; r < 16; ++r) o[e][r] = 0.f;
            float m = -__builtin_inff(), l = 0.f;
            for (int t = 0; t < NT; ++t) {
                VM_WAIT(); __syncthreads();
                if (t + 1 < NT) FA_ISSUE(t + 1, (t + 1) & 1);
                {
                    const LAS unsigned char* sb = lds + (t & 1) * STG;
                    f32x16 p0, p1;
#pragma unroll
                    for (int r = 0; r < 16; ++r) { p0[r] = 0.f; p1[r] = 0.f; }
#pragma unroll
                    for (int d0 = 0; d0 < 12; ++d0) { const bf16x8 k0 = *(const LAS bf16x8*)(sb + kfo + d0 * 2048), k1 = *(const LAS bf16x8*)(sb + kfo + d0 * 2048 + 512);
                        p0 = __builtin_amdgcn_mfma_f32_32x32x16_bf16(k0, qr[d0], p0, 0, 0, 0); p1 = __builtin_amdgcn_mfma_f32_32x32x16_bf16(k1, qr[d0], p1, 0, 0, 0); }
                    if (64 * t + 63 > qw) {
                        const int kb = 64 * t + 8 * hi - q;
#pragma unroll
                        for (int r = 0; r < 16; ++r) { const int dk = kb + 16 * (r >> 3) + (r & 7); if (dk > 0) p0[r] = -__builtin_inff(); if (dk + 32 > 0) p1[r] = -__builtin_inff(); }
                    }
                    float mx = fmaxf(p0[0], p1[0]);
#pragma unroll
                    for (int r = 1; r < 16; ++r) mx = fmaxf(mx, fmaxf(p0[r], p1[r]));
                    mx = hmax(mx);
                    { const float mn = fmaxf(m, mx), alpha = __builtin_amdgcn_exp2f(m - mn); m = mn; l *= alpha;
#pragma unroll
                        for (int e = 0; e < 4; ++e)
#pragma unroll
                            for (int r = 0; r < 16; ++r) o[e][r] *= alpha; }
                    float ps = 0.f;
#pragma unroll
                    for (int r = 0; r < 16; ++r) { p0[r] = __builtin_amdgcn_exp2f(p0[r] - m); p1[r] = __builtin_amdgcn_exp2f(p1[r] - m); ps += p0[r] + p1[r]; }
                    l += ps;
                    const bf16x8 pf0 = pk8(p0, 0), pf1 = pk8(p0, 8), pf2 = pk8(p1, 0), pf3 = pk8(p1, 8);
                    const LAS unsigned char* vb0 = sb + vfo + ((0 ^ vbb) << 5); const LAS unsigned char* vb1 = sb + vfo + ((1 ^ vbb) << 5);
                    const LAS unsigned char* vb2 = sb + vfo + ((2 ^ vbb) << 5); const LAS unsigned char* vb3 = sb + vfo + ((3 ^ vbb) << 5);
#pragma unroll
                    for (int e = 0; e < 4; ++e) {
                        const bf16x8 a0 = *(const LAS bf16x8*)(vb0 + e * 4096), a1 = *(const LAS bf16x8*)(vb1 + e * 4096), a2 = *(const LAS bf16x8*)(vb2 + e * 4096), a3 = *(const LAS bf16x8*)(vb3 + e * 4096);
                        o[e] = __builtin_amdgcn_mfma_f32_32x32x16_bf16(a0, pf0, o[e], 0, 0, 0); o[e] = __builtin_amdgcn_mfma_f32_32x32x16_bf16(a1, pf1, o[e], 0, 0, 0);
                        o[e] = __builtin_amdgcn_mfma_f32_32x32x16_bf16(a2, pf2, o[e], 0, 0, 0); o[e] = __builtin_amdgcn_mfma_f32_32x32x16_bf16(a3, pf3, o[e], 0, 0, 0); }
                }
            }
            const float il = 1.0f / hsum(l);
            bf16* op = ATT + (size_t)q * 2048 + h * 128 + 4 * hi;
#pragma unroll
            for (int e = 0; e < 4; ++e)
#pragma unroll
                for (int g4 = 0; g4 < 4; ++g4) { v2u wv; wv.x = pg8::cvt_pk_bf16(o[e][4 * g4] * il, o[e][4 * g4 + 1] * il); wv.y = pg8::cvt_pk_bf16(o[e][4 * g4 + 2] * il, o[e][4 * g4 + 3] * il);
                    *(v2u*)(op + e * 32 + g4 * 8) = wv; }
            __syncthreads();
        }
#undef FA_ISSUE
    }
}
}

namespace hg {
typedef float f32x16 __attribute__((ext_vector_type(16)));
constexpr int L_TOT = 0, L_KT = 4096;
constexpr int L_QA = 4096, L_QB = 20480, L_KA0 = 28672, L_KA1 = 36864, L_SSP = 53248;
__device__ __forceinline__ float log2_(float x) { return __builtin_amdgcn_logf(x); }
__device__ __forceinline__ float exp2_(float x) { return __builtin_amdgcn_exp2f(x); }
__device__ __forceinline__ bf16x8 pk8(const f32x16& p, int b) {
    v4u w; w.x = pg8::cvt_pk_bf16(p[b], p[b + 1]); w.y = pg8::cvt_pk_bf16(p[b + 2], p[b + 3]); w.z = pg8::cvt_pk_bf16(p[b + 4], p[b + 5]); w.w = pg8::cvt_pk_bf16(p[b + 6], p[b + 7]);
    return __builtin_bit_cast(bf16x8, w);
}
#define HG_GATES(HFp, lbv, t0, h) \
    float kk[16], bl[16]; { float run_ = 0.f; const float* zp_ = (HFp) + (size_t)((t0) + 16 * tg) * 2048 + (h) * 128 + d; \
      _Pragma("unroll") for (int i = 0; i < 16; ++i) { const float z_ = zp_[(size_t)i * 2048]; const float f_ = (lbv) + (1.f - (lbv)) * sigm(z_); kk[i] = 1.f - f_; run_ += log2_(fmaxf(f_, 1e-30f)); bl[i] = run_; } }

__device__ __forceinline__ void pass1(unsigned char* ws, LAS unsigned char* lds, int layer, int vcu, int G) {
    int tid = threadIdx.x; asm volatile("" : "+v"(tid));
    const int lane = tid & 63, w = __builtin_amdgcn_readfirstlane(tid >> 6), d = tid & 127, tg = tid >> 7, r32 = lane & 31, hi = lane >> 5;
    const float* HF = (const float*)(ws + WS_HF); const bf16* VTH = (const bf16*)(ws + WS_VTH); float* HU = (float*)(ws + WS_HU); float* GAM = (float*)(ws + WS_RRAW);
    const float* LB = (const float*)(ws + WS_LB) + layer * 2048;
    LAS float* tot = (LAS float*)(lds + L_TOT); LAS unsigned char* KT = lds + L_KT;
    const int fsw = (d >> 1) & 7, fsr = (r32 >> 1) & 7, et = w >> 1, dt0 = 2 * (w & 1);
    for (int unit = vcu; unit < NH * 128; unit += G) {
        const int h = unit >> 7, c = unit & 127, t0 = c * 64;
        const float lb = LB[h * 128 + d];
        HG_GATES(HF, lb, t0, h);
        tot[tg * 128 + d] = bl[15];
        __syncthreads();
        float pre = 0.f, all = 0.f;
#pragma unroll
        for (int j = 0; j < 4; ++j) { const float v = tot[j * 128 + d]; pre += (j < tg) ? v : 0.f; all += v; }
        { float kh[16];
#pragma unroll
          for (int i = 0; i < 16; ++i) kh[i] = kk[i] * exp2_(all - (pre + bl[i]));
          v4u c0, c1; c0.x = pk2(kh[0], kh[1]); c0.y = pk2(kh[2], kh[3]); c0.z = pk2(kh[4], kh[5]); c0.w = pk2(kh[6], kh[7]);
          c1.x = pk2(kh[8], kh[9]); c1.y = pk2(kh[10], kh[11]); c1.z = pk2(kh[12], kh[13]); c1.w = pk2(kh[14], kh[15]);
          *(LAS v4u*)(KT + d * 128 + (((2 * tg) ^ fsw) << 4)) = c0; *(LAS v4u*)(KT + d * 128 + (((2 * tg + 1) ^ fsw) << 4)) = c1; }
        if (tg == 0) GAM[(size_t)(h * 128 + c) * 128 + d] = exp2_(all);
        bf16x8 af[4];
#pragma unroll
        for (int ks = 0; ks < 4; ++ks) af[ks] = *(const bf16x8*)(VTH + (size_t)(h * 128 + 32 * et + r32) * S_ + t0 + 16 * ks + 8 * hi);
        __syncthreads();
#pragma unroll
        for (int dd = 0; dd < 2; ++dd) { const int dt = dt0 + dd; f32x16 acc;
#pragma unroll
            for (int r = 0; r < 16; ++r) acc[r] = 0.f;
#pragma unroll
            for (int ks = 0; ks < 4; ++ks) { const bf16x8 bq = *(const LAS bf16x8*)(KT + (32 * dt + r32) * 128 + (((2 * ks + hi) ^ fsr) << 4)); acc = __builtin_amdgcn_mfma_f32_32x32x16_bf16(af[ks], bq, acc, 0, 0, 0); }
            float* up = HU + ((size_t)(h * 128 + c) * 128 + 32 * et + 4 * hi) * 128 + 32 * dt + r32;
#pragma unroll
            for (int r = 0; r < 16; ++r) up[(size_t)((r & 3) + 8 * (r >> 2)) * 128] = acc[r]; }
        __syncthreads();
    }
}
__device__ __forceinline__ void scan(unsigned char* ws, int gtid, int nthr) {
    const float* HU = (const float*)(ws + WS_HU); const float* GAM = (const float*)(ws + WS_RRAW); bf16* HS = (bf16*)(ws + WS_HS);
    for (int idx = gtid; idx < NH * 128 * 64; idx += nthr) {
        const int h = idx >> 13, e = (idx >> 6) & 127, d = 2 * (idx & 63);
        float s0 = 0.f, s1 = 0.f;
#pragma unroll 8
        for (int c = 0; c < 128; ++c) { const size_t base = ((size_t)(h * 128 + c) * 128 + e) * 128 + d;
            *(unsigned*)(HS + base) = pk2(s0, s1);
            const f32x2 u = *(const f32x2*)(HU + base), gm = *(const f32x2*)(GAM + (size_t)(h * 128 + c) * 128 + d);
            s0 = gm.x * s0 + u.x; s1 = gm.y * s1 + u.y; }
    }
}
__device__ __forceinline__ void pass3(unsigned char* ws, LAS unsigned char* lds, const float* gain, int layer, int vcu, int G) {
    int tid = threadIdx.x; asm volatile("" : "+v"(tid));
    const int lane = tid & 63, w = __builtin_amdgcn_readfirstlane(tid >> 6), d = tid & 127, tg = tid >> 7, r32 = lane & 31, hi = lane >> 5;
    const float* HF = (const float*)(ws + WS_HF); const bf16* HQ = (const bf16*)(ws + WS_HQ); const bf16* HG = (const bf16*)(ws + WS_HG); const bf16* VTH = (const bf16*)(ws + WS_VTH);
    const bf16* HS = (const bf16*)(ws + WS_HS); bf16* REC = (bf16*)(ws + WS_REC); const float* LB = (const float*)(ws + WS_LB) + layer * 2048;
    LAS float* tot = (LAS float*)(lds + L_TOT); LAS float* SSP = (LAS float*)(lds + L_SSP);
    const int et = w & 3, tb = w >> 2, pr = (r32 & 0x13) | ((r32 & 4) << 1) | ((r32 & 8) >> 1);
    const int eo = (d >> 3) * 16, ei = (d & 7) * 2;
    for (int unit = vcu; unit < NH * 128; unit += G) {
        const int h = unit >> 7, c = unit & 127, t0 = c * 64;
        const float lb = LB[h * 128 + d];
        HG_GATES(HF, lb, t0, h);
        float qv[16];
        { const bf16* qp = HQ + (size_t)(t0 + 16 * tg) * 2048 + h * 128 + d;
#pragma unroll
          for (int i = 0; i < 16; ++i) qv[i] = __builtin_bit_cast(float, (unsigned)qp[(size_t)i * 2048] << 16); }
        tot[tg * 128 + d] = bl[15];
        __syncthreads();
        const float t_0 = tot[d], t_1 = tot[128 + d], t_2 = tot[256 + d];
        const float pre = (tg > 0 ? t_0 : 0.f) + (tg > 1 ? t_1 : 0.f) + (tg > 2 ? t_2 : 0.f), b31 = t_0 + t_1;
#pragma unroll
        for (int i = 0; i < 16; ++i) { const float b = pre + bl[i]; const int row = 16 * tg + i;
            *(LAS bf16*)(lds + L_QA + eo * 64 + row * 16 + ei) = (bf16)f2bf(qv[i] * exp2_(b));
            *(LAS bf16*)(lds + L_KA1 + eo * 64 + row * 16 + ei) = (bf16)f2bf(kk[i] * exp2_(b31 - b));
            if (tg < 2) *(LAS bf16*)(lds + L_KA0 + eo * 32 + row * 16 + ei) = (bf16)f2bf(kk[i] * exp2_(-b));
            else *(LAS bf16*)(lds + L_QB + eo * 32 + (row - 32) * 16 + ei) = (bf16)f2bf(qv[i] * exp2_(b - b31)); }
        __syncthreads();
        f32x16 o;
#pragma unroll
        for (int r = 0; r < 16; ++r) o[r] = 0.f;
        { const bf16* sp = HS + ((size_t)(h * 128 + c) * 128 + 32 * et + r32) * 128 + 8 * hi; const LAS unsigned char* qb_ = lds + L_QA + hi * 1024 + (32 * tb + r32) * 16;
#pragma unroll
          for (int kd = 0; kd < 8; ++kd) { const bf16x8 a = *(const bf16x8*)(sp + 16 * kd); const bf16x8 b = *(const LAS bf16x8*)(qb_ + kd * 2048); o = __builtin_amdgcn_mfma_f32_32x32x16_bf16(a, b, o, 0, 0, 0); } }
        const bf16* vp = VTH + (size_t)(h * 128 + 32 * et + r32) * S_ + t0 + 8 * hi;
        if (tb == 0) {
            f32x16 p;
#pragma unroll
            for (int r = 0; r < 16; ++r) p[r] = 0.f;
            const LAS unsigned char* ka = lds + L_KA0 + hi * 512 + pr * 16; const LAS unsigned char* qa = lds + L_QA + hi * 1024 + r32 * 16;
#pragma unroll
            for (int kd = 0; kd < 8; ++kd) p = __builtin_amdgcn_mfma_f32_32x32x16_bf16(*(const LAS bf16x8*)(ka + kd * 1024), *(const LAS bf16x8*)(qa + kd * 2048), p, 0, 0, 0);
#pragma unroll
            for (int r = 0; r < 16; ++r) if (16 * (r >> 3) + 8 * hi + (r & 7) > r32) p[r] = 0.f;
            o = __builtin_amdgcn_mfma_f32_32x32x16_bf16(*(const bf16x8*)(vp), pk8(p, 0), o, 0, 0, 0);
            o = __builtin_amdgcn_mfma_f32_32x32x16_bf16(*(const bf16x8*)(vp + 16), pk8(p, 8), o, 0, 0, 0);
        } else {
            f32x16 p0, p1;
#pragma unroll
            for (int r = 0; r < 16; ++r) { p0[r] = 0.f; p1[r] = 0.f; }
            const LAS unsigned char* ka = lds + L_KA1 + hi * 1024 + pr * 16; const LAS unsigned char* qa = lds + L_QB + hi * 512 + r32 * 16;
#pragma unroll
            for (int kd = 0; kd < 8; ++kd) { const bf16x8 qf = *(const LAS bf16x8*)(qa + kd * 1024);
                p0 = __builtin_amdgcn_mfma_f32_32x32x16_bf16(*(const LAS bf16x8*)(ka + kd * 2048), qf, p0, 0, 0, 0);
                p1 = __builtin_amdgcn_mfma_f32_32x32x16_bf16(*(const LAS bf16x8*)(ka + kd * 2048 + 512), qf, p1, 0, 0, 0); }
#pragma unroll
            for (int r = 0; r < 16; ++r) if (16 * (r >> 3) + 8 * hi + (r & 7) > r32) p1[r] = 0.f;
            o = __builtin_amdgcn_mfma_f32_32x32x16_bf16(*(const bf16x8*)(vp), pk8(p0, 0), o, 0, 0, 0);
            o = __builtin_amdgcn_mfma_f32_32x32x16_bf16(*(const bf16x8*)(vp + 16), pk8(p0, 8), o, 0, 0, 0);
            o = __builtin_amdgcn_mfma_f32_32x32x16_bf16(*(const bf16x8*)(vp + 32), pk8(p1, 0), o, 0, 0, 0);
            o = __builtin_amdgcn_mfma_f32_32x32x16_bf16(*(const bf16x8*)(vp + 48), pk8(p1, 8), o, 0, 0, 0);
        }
        float ss = 0.f;
#pragma unroll
        for (int r = 0; r < 16; ++r) ss += o[r] * o[r];
        ss += __shfl_xor(ss, 32);
        if (hi == 0) SSP[(tb * 4 + et) * 32 + r32] = ss;
        __syncthreads();
        const float rstd = 1.0f / sqrtf((SSP[(tb * 4 + 0) * 32 + r32] + SSP[(tb * 4 + 1) * 32 + r32] + SSP[(tb * 4 + 2) * 32 + r32] + SSP[(tb * 4 + 3) * 32 + r32]) * (1.f / 128.f) + EPS);
        { const size_t ro = (size_t)(t0 + 32 * tb + r32) * 2048 + h * 128 + 32 * et + 4 * hi;
#pragma unroll
          for (int g4 = 0; g4 < 4; ++g4) { const f32x4 gn = *(const GAS f32x4*)(gain + 32 * et + 4 * hi + 8 * g4); const v2u hv = *(const v2u*)(HG + ro + 8 * g4);
              v2u ov; ov.x = pk2(o[4 * g4] * rstd * gn.x * bflo(hv.x), o[4 * g4 + 1] * rstd * gn.y * bfhi(hv.x)); ov.y = pk2(o[4 * g4 + 2] * rstd * gn.z * bflo(hv.y), o[4 * g4 + 3] * rstd * gn.w * bfhi(hv.y));
              *(v2u*)(REC + ro + 8 * g4) = ov; } }
        __syncthreads();
    }
}
#undef HG_GATES
}

#ifndef NAIVE_ATTN
#define NAIVE_ATTN 0
#endif
#ifndef NAIVE_HGRN
#define NAIVE_HGRN 0
#endif
struct Args { const float* in[19]; float* out; unsigned char* ws; };
enum { I_X = 0, I_POS, I_ANG, I_WIN, I_QNG, I_WUQ, I_KVNG, I_WUKV, I_LBL, I_HONG, I_WA, I_WB, I_WO, I_FNG, I_WUP, I_CW, I_CB, I_WDN, I_FING };

__global__ void __launch_bounds__(NTHR, 2) mk_fwd(Args args) {
    extern __shared__ __attribute__((aligned(16))) unsigned char lds_raw[];
    LAS unsigned char* lds = (LAS unsigned char*)lds_raw;
    const int tid = threadIdx.x, lane = tid & 63, wave = __builtin_amdgcn_readfirstlane(tid >> 6);
    const int G = gridDim.x, bx = blockIdx.x, vcu = (G % 8 == 0) ? (bx % 8) * (G / 8) + bx / 8 : bx;
    const int gw = vcu * NWAVES + wave, ngw = G * NWAVES;
    unsigned char* ws = args.ws;
    for (int u = tid; u < (LDS_BYTES - LDSCTL_OFF) / 4; u += NTHR) ((LAS unsigned*)(lds + LDSCTL_OFF))[u] = 0u;
    __syncthreads();
    XcdBarrier bar = xcd_barrier_post((unsigned*)(ws + WS_CTL) + CW_BAR, (volatile LAS unsigned*)(lds + MISC_OFF) + 8);
    float* X = args.out;
    if (tid < 19) ((LAS unsigned long long*)(lds + MISC_OFF + 128))[tid] = ((const __attribute__((address_space(4))) unsigned long long*)__builtin_amdgcn_kernarg_segment_ptr())[tid];
    __syncthreads();
#define INP(i) ((const float*)(((unsigned long long)(unsigned)__builtin_amdgcn_readfirstlane((int)(((LAS const unsigned long long*)(lds + MISC_OFF + 128))[i] >> 32)) << 32) | (unsigned long long)(unsigned)__builtin_amdgcn_readfirstlane((int)(unsigned)((LAS const unsigned long long*)(lds + MISC_OFF + 128))[i])))

    {
        LAS float* scr = (LAS float*)(lds + RING_OFF + wave * 16384);
        constexpr int I_IN = 32 * (WINR / 32), I_UQ = 8 * 96, I_K = 8 * 64, I_V = 8 * 64, I_SQ = 32 * 64, I_UP = 32 * 352, I_DN = 88 * 64;
        constexpr int PER_LAYER = I_IN + I_UQ + I_K + I_V + 3 * I_SQ + I_UP + I_DN;
        for (int it = gw; it < DEPTH * PER_LAYER; it += ngw) {
            const int l = it / PER_LAYER; int r = it % PER_LAYER;
            unsigned char* wl = ws + WS_W + (size_t)l * LW;
            if (r < I_IN) { transpose_item<1>(INP(I_WIN) + (size_t)l * DM * INW, DM, INW, (bf16*)(wl + LW_IN), nullptr, scr, r / (WINR / 32), r % (WINR / 32), lane); continue; } r -= I_IN;
            if (r < I_UQ) { transpose_item<2>(INP(I_WUQ) + (size_t)l * QL * 3072, QL, 3072, (bf16*)(wl + LW_UQ), INP(I_QNG) + l * QL, scr, r / 96, r % 96, lane); continue; } r -= I_UQ;
            if (r < I_K) { transpose_item<3>(INP(I_WUKV) + (size_t)l * KVL * 4096, KVL, 4096, (bf16*)(wl + LW_K), INP(I_KVNG) + l * KVL, scr, r / 64, r % 64, lane); continue; } r -= I_K;
            if (r < I_V) { transpose_item<4>(INP(I_WUKV) + (size_t)l * KVL * 4096, KVL, 4096, (bf16*)(wl + LW_V), INP(I_KVNG) + l * KVL, scr, r / 64, r % 64, lane); continue; } r -= I_V;
            if (r < I_SQ) { transpose_item<0>(INP(I_WA) + (size_t)l * DM * DM, DM, DM, (bf16*)(wl + LW_A), nullptr, scr, r / 64, r % 64, lane); continue; } r -= I_SQ;
            if (r < I_SQ) { transpose_item<0>(INP(I_WB) + (size_t)l * DM * DM, DM, DM, (bf16*)(wl + LW_B), nullptr, scr, r / 64, r % 64, lane); continue; } r -= I_SQ;
            if (r < I_SQ) { transpose_item<0>(INP(I_WO) + (size_t)l * DM * DM, DM, DM, (bf16*)(wl + LW_O), nullptr, scr, r / 64, r % 64, lane); continue; } r -= I_SQ;
            if (r < I_UP) { transpose_item<5>(INP(I_WUP) + (size_t)l * DM * DFF2, DM, DFF2, (bf16*)(wl + LW_UP), nullptr, scr, r / 352, r % 352, lane); continue; } r -= I_UP;
            transpose_item<0>(INP(I_WDN) + (size_t)l * DFF * DM, DFF, DM, (bf16*)(wl + LW_DN), nullptr, scr, r / 64, r % 64, lane);
        }
        { const GAS int* pos = (const GAS int*)INP(I_POS); float* COS = (float*)(ws + WS_COS); float* SIN = (float*)(ws + WS_SIN);
          for (int i = vcu * NTHR + tid; i < S_ * 32; i += G * NTHR) { const float ang = (float)pos[i >> 5] * c_invf[i & 31]; float sn, cs; sincos_f64(ang, sn, cs); COS[i] = cs; SIN[i] = sn; } }
        { const GAS float* lg = (const GAS float*)INP(I_LBL); float* LB = (float*)(ws + WS_LB);
          for (int c = vcu * NTHR + tid; c < 2048; c += G * NTHR) { const float a0 = lg[c], a1 = lg[2048 + c], a2 = lg[4096 + c], a3 = lg[6144 + c];
              const float mx = fmaxf(fmaxf(a0, a1), fmaxf(a2, a3)); const float e0 = expf(a0 - mx), e1 = expf(a1 - mx), e2 = expf(a2 - mx), e3 = expf(a3 - mx); const float inv = 1.f / (e0 + e1 + e2 + e3);
              LB[c] = 0.f; LB[2048 + c] = e1 * inv; LB[4096 + c] = (e1 + e2) * inv; LB[6144 + c] = (e1 + e2 + e3) * inv; } }
        for (int m = gw; m < S_; m += ngw) rms_row_to_bf16(INP(I_X) + (size_t)m * DM, INP(I_ANG), (bf16*)(ws + WS_XN) + (size_t)m * DM, X + (size_t)m * DM, lane);
    }
    xcd_barrier(bar);

    for (int l = 0; l < DEPTH; ++l) {
        unsigned char* wl = ws + WS_W + (size_t)l * LW;
#define lane_l ({ int l_ = lane; asm volatile("" : "+v"(l_)); l_; })
        unsigned char* wsl = ws; int Gl = G, bxl = bx, gwl = gw, ngwl = ngw, vcul = vcu; float* Xl = X;
        asm volatile("" : "+s"(wsl), "+s"(Gl), "+s"(bxl), "+s"(gwl), "+s"(ngwl), "+s"(vcul), "+s"(Xl));
        { pg8::Gemm g{(const pg8::bf16_t*)(wsl + WS_XN), (const pg8::bf16_t*)(wl + LW_IN), S_, NNAT, DM, DM, DM}; pg8::StaticOrder S; S.init(S_, NNAT, Gl, bxl);
          pg8::EpiIn E{wsl}; pg8::gemm_phase<pg8::EpiIn, pg8::StaticOrder, true, true>(lds + RING_OFF, g, S, E); }
        { pg8::Gemm g{(const pg8::bf16_t*)(wl + LW_IN) + (size_t)NNAT * DM, (const pg8::bf16_t*)(wsl + WS_XN), 2048, S_, DM, DM, DM}; pg8::StaticOrder S; S.init(2048, S_, Gl, bxl);
          pg8::EpiStore E{(pg8::bf16_t*)(wsl + WS_VTH), S_}; pg8::gemm_phase<pg8::EpiStore, pg8::StaticOrder, true, true>(lds + RING_OFF, g, S, E); }
        xcd_barrier(bar);
        for (int m = gwl; m < S_; m += ngwl) latent_norm_row((bf16*)(wsl + WS_CQKV) + (size_t)m * 1024, lane_l);
        xcd_barrier(bar);
        { pg8::Gemm g{(const pg8::bf16_t*)(wsl + WS_CQKV), (const pg8::bf16_t*)(wl + LW_UQ), S_, 3072, QL, 1024, QL}; pg8::StaticOrder S; S.init(S_, 3072, Gl, bxl);
          pg8::EpiQ E{wsl}; pg8::gemm_phase<pg8::EpiQ, pg8::StaticOrder, true, true>(lds + RING_OFF, g, S, E); }
        { pg8::Gemm g{(const pg8::bf16_t*)(wsl + WS_CQKV) + 512, (const pg8::bf16_t*)(wl + LW_K), S_, 2048, KVL, 1024, KVL}; pg8::StaticOrder S; S.init(S_, 2048, Gl, bxl);
          pg8::EpiStore E{(pg8::bf16_t*)(wsl + WS_KN), 2048}; pg8::gemm_phase<pg8::EpiStore, pg8::StaticOrder, true, true>(lds + RING_OFF, g, S, E); }
        { pg8::Gemm g{(const pg8::bf16_t*)(wl + LW_V), (const pg8::bf16_t*)(wsl + WS_CQKV) + 512, 2048, S_, KVL, KVL, 1024}; pg8::StaticOrder S; S.init(2048, S_, Gl, bxl);
          pg8::EpiStore E{(pg8::bf16_t*)(wsl + WS_VT), S_}; pg8::gemm_phase<pg8::EpiStore, pg8::StaticOrder, true, true>(lds + RING_OFF, g, S, E); }
#if NAIVE_HGRN
        hgrn_naive(wsl, l, gwl, ngwl, lane_l);
        xcd_barrier(bar);
#else
        hg::pass1(wsl, lds + RING_OFF, l, vcul, Gl);
        xcd_barrier(bar);
        hg::scan(wsl, vcul * NTHR + (int)threadIdx.x, Gl * NTHR);
        xcd_barrier(bar);
#endif
#if NAIVE_ATTN
        attn_naive(wsl, (LAS float*)(lds + RING_OFF) + wave * 192, gwl, ngwl, lane_l);
#else
        fa::attn_fast(wsl, lds + RING_OFF, vcul, Gl);
#endif
#if NAIVE_HGRN
        hgrn_normgate(wsl, INP(I_HONG) + l * 128, gwl, ngwl, lane_l);
#else
        hg::pass3(wsl, lds + RING_OFF, INP(I_HONG) + l * 128, l, vcul, Gl);
#endif
        xcd_barrier(bar);
        { pg8::Gemm g{(const pg8::bf16_t*)(wsl + WS_ATT), (const pg8::bf16_t*)(wl + LW_A), S_, DM, DM, DM, DM}; pg8::StaticOrder S; S.init(S_, DM, Gl, bxl);
          pg8::EpiGateA E{wsl}; pg8::gemm_phase<pg8::EpiGateA, pg8::StaticOrder, true, true>(lds + RING_OFF, g, S, E); }
        { pg8::Gemm g{(const pg8::bf16_t*)(wsl + WS_REC), (const pg8::bf16_t*)(wl + LW_B), S_, DM, DM, DM, DM}; pg8::StaticOrder S; S.init(S_, DM, Gl, bxl);
          pg8::EpiGateB E{wsl}; pg8::gemm_phase<pg8::EpiGateB, pg8::StaticOrder, true, true>(lds + RING_OFF, g, S, E); }
        xcd_barrier(bar);
        { pg8::Gemm g{(const pg8::bf16_t*)(wsl + WS_MRG), (const pg8::bf16_t*)(wl + LW_O), S_, DM, DM, DM, DM}; pg8::StaticOrder S; S.init(S_, DM, Gl, bxl);
          pg8::EpiRes E{Xl}; pg8::gemm_phase<pg8::EpiRes, pg8::StaticOrder, true, true>(lds + RING_OFF, g, S, E); }
        xcd_barrier(bar);
        for (int m = gwl; m < S_; m += ngwl) rms_row_to_bf16(Xl + (size_t)m * DM, INP(I_FNG) + l * DM, (bf16*)(wsl + WS_XN) + (size_t)m * DM, nullptr, lane_l);
        xcd_barrier(bar);
        { pg8::Gemm g{(const pg8::bf16_t*)(wsl + WS_XN), (const pg8::bf16_t*)(wl + LW_UP), S_, DFF2, DM, DM, DM}; pg8::StaticOrder S; S.init(S_, DFF2, Gl, bxl);
          pg8::EpiStore E{(pg8::bf16_t*)(wsl + WS_U), DFF2}; pg8::gemm_phase<pg8::EpiStore, pg8::StaticOrder, true, true>(lds + RING_OFF, g, S, E); }
        xcd_barrier(bar);
        conv_gate(wsl, INP(I_CW) + (size_t)l * 3 * DFF2, INP(I_CB) + (size_t)l * DFF2, gwl, ngwl, lane_l);
        xcd_barrier(bar);
        { pg8::Gemm g{(const pg8::bf16_t*)(wsl + WS_ACT), (const pg8::bf16_t*)(wl + LW_DN), S_, DM, DFF, DFF, DFF}; pg8::StaticOrder S; S.init(S_, DM, Gl, bxl);
          pg8::EpiRes E{Xl}; pg8::gemm_phase<pg8::EpiRes, pg8::StaticOrder, true, true>(lds + RING_OFF, g, S, E); }
        xcd_barrier(bar);
        if (l + 1 < DEPTH) { for (int m = gwl; m < S_; m += ngwl) rms_row_to_bf16(Xl + (size_t)m * DM, INP(I_ANG) + (l + 1) * DM, (bf16*)(wsl + WS_XN) + (size_t)m * DM, nullptr, lane_l);
            xcd_barrier(bar); }
        else { for (int m = gwl; m < S_; m += ngwl) rms_row_f32(Xl + (size_t)m * DM, INP(I_FING), lane_l); }
    }
}

#undef lane_l
extern "C" void kernel_launch(void* const* d_in, const int* in_sizes, int n_in, void* d_out, int out_size, void* d_ws, size_t ws_size, hipStream_t stream) {
    static int grid = 0;
    if (grid == 0) {
        if (n_in != 19 || in_sizes[0] != S_ * DM || out_size != S_ * DM || ws_size < WS_END) { fprintf(stderr, "kernel_launch: shape/workspace mismatch (n_in %d, in0 %d, out %d, ws %zu need %zu)\n", n_in, n_in > 0 ? in_sizes[0] : -1, out_size, ws_size, (size_t)WS_END); grid = -1; return; }
        int dev = 0, cus = 0, per_cu = 0;
        if (hipGetDevice(&dev) != hipSuccess || hipDeviceGetAttribute(&cus, hipDeviceAttributeMultiprocessorCount, dev) != hipSuccess) { grid = -1; return; }
        if (hipFuncSetAttribute((const void*)mk_fwd, hipFuncAttributeMaxDynamicSharedMemorySize, LDS_BYTES) != hipSuccess) { fprintf(stderr, "kernel_launch: hipFuncSetAttribute failed\n"); grid = -1; return; }
        if (hipOccupancyMaxActiveBlocksPerMultiprocessor(&per_cu, (const void*)mk_fwd, NTHR, LDS_BYTES) != hipSuccess || per_cu < 1) { fprintf(stderr, "kernel_launch: occupancy query reports %d blocks per CU\n", per_cu); }
        (void)hipGetLastError();
        grid = cus;
    }
    if (grid < 0) return;
    if (hipMemsetAsync((char*)d_ws + WS_CTL, 0, CTL_ZERO_BYTES, stream) != hipSuccess) return;
    Args a{};
    for (int i = 0; i < 19; ++i) a.in[i] = (const float*)d_in[i];
    a.out = (float*)d_out; a.ws = (unsigned char*)d_ws;
    hipLaunchKernelGGL(mk_fwd, dim3(grid), dim3(NTHR), LDS_BYTES, stream, a);
}
```

```cpp
#include <hip/hip_runtime.h>
#include <cstdio>
#include <cstdint>
namespace pg8 {
#define PG8_LAS __attribute__((address_space(3)))
typedef unsigned short bf16_t;
typedef short bf16x8 __attribute__((ext_vector_type(8)));
typedef float f32x4 __attribute__((ext_vector_type(4)));
typedef unsigned u32x4 __attribute__((ext_vector_type(4)));
constexpr int BM = 256, BK = 64, HALF = 128, HTB = HALF * BK * 2  , STAGE_BYTES = 8 * HTB, NXCD = 8, WGM = 8;

__host__ __device__ __forceinline__ int lds_byte(int r, int c) { const int st = (r >> 4) * 2 + (c >> 5), rr = r & 15, cc = c & 31, ob = rr * 64 + cc * 2; return st * 1024 + (ob ^ (((ob >> 9) & 1) << 5)); }
__host__ __device__ __forceinline__ void stage_rc(int b, int& R, int& C) { const int st = b / 1024, sb = b % 1024, swz = sb ^ (((sb >> 9) & 1) << 5); R = (st >> 1) * 16 + swz / 64; C = (st & 1) * 32 + (swz % 64) / 2; }
__host__ __device__ __forceinline__ int perm32(int rho) { const int n = rho >> 4, i = rho & 15; return 8 * (i >> 2) + 4 * n + (i & 3); }

struct Unit { int pm, pn; };
struct Gemm { const bf16_t* A; const bf16_t* Bt; int M, N, K, lda, ldb; };

struct StaticOrder {
    int nM, nN, nwg, G, c;
    __host__ __device__ void init(int M, int N, int G_, int c_) { nM = M / BM; nN = N / BM; nwg = nM * nN; G = G_; c = c_; }
    __host__ __device__ bool next(int i, Unit& u) const {
        const long L = (long)i * G + c; if (L >= nwg) return false;
        int wgid = (int)L; { const int q = nwg / NXCD, r = nwg % NXCD, xcd = wgid % NXCD, off = wgid / NXCD; wgid = (xcd < r ? xcd * (q + 1) : r * (q + 1) + (xcd - r) * q) + off; }
        const int nig = WGM * nN, gid = wgid / nig, fm = gid * WGM, gsz = (nM - fm) < WGM ? (nM - fm) : WGM;
        u.pm = fm + ((wgid % nig) % gsz); u.pn = (wgid % nig) / gsz; return true;
    }
    __device__ __forceinline__ void a_ready(const Unit&) const {}
    __device__ __forceinline__ void done(const Unit&) const {}
};

__device__ __forceinline__ unsigned cvt_pk_bf16(float lo, float hi) { unsigned r; asm volatile("v_cvt_pk_bf16_f32 %0, %1, %2" : "=v"(r) : "v"(lo), "v"(hi)); return r; }
template <class Epi, class Sched, bool ALIGN_EPI = false, bool SP2 = false>
__device__ __forceinline__ void gemm_phase(PG8_LAS unsigned char* lds, const Gemm g, const Sched& S, const Epi& E) {
    int tid = threadIdx.x; asm volatile("" : "+v"(tid));
    const int wid = __builtin_amdgcn_readfirstlane(tid >> 6), lane = tid & 63, wr = wid >> 2, wc = wid & 3, fr = lane & 15, fq = lane >> 4;
    const int K = g.K, nt = K / BK;
    unsigned voffA[2], voffB[2];
#pragma unroll
    for (int i = 0; i < 2; ++i) { int R, C; stage_rc(tid * 16 + i * 8192, R, C); const int Rb = Epi::PERM ? ((R & ~31) + perm32(R & 31)) : R;
        voffA[i] = (unsigned)(R * g.lda + C) * 2u; voffB[i] = (unsigned)(Rb * g.ldb + C) * 2u; }
    const size_t kstep = (size_t)(BK * 2);
    const size_t hstepA = (size_t)HALF * g.lda * 2, hstepB = (size_t)HALF * g.ldb * 2;
    const size_t tstepA = 2 * hstepA, tstepB = 2 * hstepB;
    const unsigned ldsw = (unsigned)wid * 1024u;
    const int aoff = lds_byte(wr * 64 + fr, fq * 8), boff = lds_byte(wc * 32 + fr, fq * 8);
#define PG8_SA(b, h) (((b) * 2 + (h)) * HTB)
#define PG8_SB(b, h) ((4 + (b) * 2 + (h)) * HTB)
#define PG8_STAGE(bufoff, gbase, voff) do { _Pragma("unroll") for (int _i = 0; _i < 2; ++_i) \
        __builtin_amdgcn_global_load_lds((const unsigned*)((const char*)(gbase) + (voff)[_i]), (PG8_LAS unsigned*)(lds + (bufoff) + ldsw + _i * 8192), 16, 0, 0); } while (0)
#define PG8_LDA(dst, b, h) do { _Pragma("unroll") for (int m = 0; m < 4; ++m) _Pragma("unroll") for (int k = 0; k < 2; ++k) dst[m][k] = *(const PG8_LAS bf16x8*)(lds + PG8_SA(b, h) + aoff + m * 2048 + k * 1024); } while (0)
#define PG8_LDB(dst, b, h) do { _Pragma("unroll") for (int n = 0; n < 2; ++n) _Pragma("unroll") for (int k = 0; k < 2; ++k) dst[n][k] = *(const PG8_LAS bf16x8*)(lds + PG8_SB(b, h) + boff + n * 2048 + k * 1024); } while (0)
#define PG8_MMA(ai, bj, At, Bt) do { __builtin_amdgcn_s_setprio(1); _Pragma("unroll") for (int m = 0; m < 4; ++m) _Pragma("unroll") for (int n = 0; n < 2; ++n) _Pragma("unroll") for (int k = 0; k < 2; ++k) \
        acc[ai][bj][m][n] = __builtin_amdgcn_mfma_f32_16x16x32_bf16(Bt[n][k], At[m][k], acc[ai][bj][m][n], 0, 0, 0); __builtin_amdgcn_s_setprio(0); } while (0)
#define PG8_WAIT_V(n) asm volatile("s_waitcnt vmcnt(" #n ")" ::: "memory")
#define PG8_WAIT_L(n) asm volatile("s_waitcnt lgkmcnt(" #n ")" ::: "memory")
#define PG8_BAR __builtin_amdgcn_s_barrier()
#define PG8_SCHED __builtin_amdgcn_sched_barrier(0)
    Unit cur, nxt; int ui = 0;
    if (!S.next(0, cur)) return;
    f32x4 acc[2][2][4][2];
#pragma unroll
    for (int a = 0; a < 2; ++a)
#pragma unroll
        for (int b = 0; b < 2; ++b)
#pragma unroll
            for (int m = 0; m < 4; ++m)
#pragma unroll
                for (int n = 0; n < 2; ++n) acc[a][b][m][n] = (f32x4){0.f, 0.f, 0.f, 0.f};
    bf16x8 At[4][2], B0[2][2], B1[2][2];
    const char* cA = (const char*)g.A + (size_t)cur.pm * tstepA; const char* cB = (const char*)g.Bt + (size_t)cur.pn * tstepB;
    S.a_ready(cur);
    if constexpr (SP2) {
        PG8_STAGE(PG8_SB(0, 0), cB, voffB); PG8_STAGE(PG8_SB(0, 1), cB + hstepB, voffB); PG8_STAGE(PG8_SA(0, 0), cA, voffA); PG8_STAGE(PG8_SA(0, 1), cA + hstepA, voffA);
        if (wr == 1) PG8_BAR;
        PG8_WAIT_V(2); PG8_BAR;
        PG8_STAGE(PG8_SB(1, 0), cB + kstep, voffB); PG8_STAGE(PG8_SA(1, 0), cA + kstep, voffA); PG8_STAGE(PG8_SB(1, 1), cB + hstepB + kstep, voffB);
        PG8_WAIT_V(6); PG8_BAR;
    } else {
        PG8_STAGE(PG8_SB(0, 0), cB, voffB); PG8_STAGE(PG8_SA(0, 0), cA, voffA); PG8_STAGE(PG8_SB(0, 1), cB + hstepB, voffB); PG8_STAGE(PG8_SA(0, 1), cA + hstepA, voffA);
        if (wr == 1) PG8_BAR;
        PG8_WAIT_V(4); PG8_BAR;
        PG8_STAGE(PG8_SB(1, 0), cB + kstep, voffB); PG8_STAGE(PG8_SA(1, 0), cA + kstep, voffA); PG8_STAGE(PG8_SB(1, 1), cB + hstepB + kstep, voffB);
        PG8_WAIT_V(6); PG8_BAR;
    }
    for (;;) {
        const bool has_next = S.next(ui + 1, nxt);
        const char* nA = has_next ? (const char*)g.A + (size_t)nxt.pm * tstepA : cA; const char* nB = has_next ? (const char*)g.Bt + (size_t)nxt.pn * tstepB : cB;
        for (int t = 0; t < nt; t += 2) {
            const bool last = (t == nt - 2);
            const char* a1 = cA + (size_t)(t + 1) * kstep;
            const char* a2 = last ? nA : cA + (size_t)(t + 2) * kstep; const char* b2 = last ? nB : cB + (size_t)(t + 2) * kstep;
            const char* a3 = a2 + kstep; const char* b3 = b2 + kstep;
            if (last && has_next) S.a_ready(nxt);
            if constexpr (SP2) {
            PG8_LDB(B0, 0, 0); PG8_LDB(B1, 0, 1); PG8_SCHED; PG8_LDA(At, 0, 0); PG8_STAGE(PG8_SA(1, 1), a1 + hstepA, voffA);
            PG8_WAIT_V(8); PG8_WAIT_L(0); PG8_BAR; PG8_MMA(0, 0, At, B0); PG8_MMA(0, 1, At, B1); PG8_BAR; PG8_SCHED;
            PG8_LDA(At, 0, 1); PG8_STAGE(PG8_SB(0, 0), b2, voffB); PG8_STAGE(PG8_SB(0, 1), b2 + hstepB, voffB); PG8_STAGE(PG8_SA(0, 0), a2, voffA);
            PG8_WAIT_V(8); PG8_WAIT_L(0); PG8_BAR; PG8_MMA(1, 0, At, B0); PG8_MMA(1, 1, At, B1); PG8_BAR; PG8_SCHED;
            PG8_LDB(B0, 1, 0); PG8_LDB(B1, 1, 1); PG8_SCHED; PG8_LDA(At, 1, 0); PG8_STAGE(PG8_SA(0, 1), a2 + hstepA, voffA);
            PG8_WAIT_V(8); PG8_WAIT_L(0); PG8_BAR; PG8_MMA(0, 0, At, B0); PG8_MMA(0, 1, At, B1); PG8_BAR; PG8_SCHED;
            PG8_LDA(At, 1, 1); PG8_STAGE(PG8_SB(1, 0), b3, voffB); PG8_STAGE(PG8_SB(1, 1), b3 + hstepB, voffB); PG8_STAGE(PG8_SA(1, 0), a3, voffA);
            PG8_WAIT_V(8); PG8_WAIT_L(0); PG8_BAR; PG8_MMA(1, 0, At, B0); PG8_MMA(1, 1, At, B1); PG8_BAR; PG8_SCHED;
            } else {
            PG8_LDB(B0, 0, 0); PG8_SCHED; PG8_LDA(At, 0, 0); PG8_STAGE(PG8_SA(1, 1), a1 + hstepA, voffA);
            PG8_WAIT_L(8); PG8_BAR; PG8_WAIT_L(0); PG8_MMA(0, 0, At, B0); PG8_BAR; PG8_SCHED;
            PG8_LDB(B1, 0, 1); PG8_STAGE(PG8_SB(0, 0), b2, voffB);
            PG8_BAR; PG8_WAIT_L(0); PG8_MMA(0, 1, At, B1); PG8_BAR;
            PG8_LDA(At, 0, 1); PG8_STAGE(PG8_SA(0, 0), a2, voffA);
            PG8_BAR; PG8_WAIT_L(0); PG8_MMA(1, 0, At, B0); PG8_BAR; PG8_SCHED;
            PG8_STAGE(PG8_SB(0, 1), b2 + hstepB, voffB);
            PG8_WAIT_V(6); PG8_BAR; PG8_MMA(1, 1, At, B1); PG8_BAR;
            PG8_LDB(B0, 1, 0); PG8_SCHED; PG8_LDA(At, 1, 0); PG8_STAGE(PG8_SA(0, 1), a2 + hstepA, voffA);
            PG8_WAIT_L(8); PG8_BAR; PG8_WAIT_L(0); PG8_MMA(0, 0, At, B0); PG8_BAR; PG8_SCHED;
            PG8_LDB(B1, 1, 1); PG8_STAGE(PG8_SB(1, 0), b3, voffB);
            PG8_BAR; PG8_WAIT_L(0); PG8_MMA(0, 1, At, B1); PG8_BAR;
            PG8_LDA(At, 1, 1); PG8_STAGE(PG8_SA(1, 0), a3, voffA);
            PG8_BAR; PG8_WAIT_L(0); PG8_MMA(1, 0, At, B0); PG8_BAR; PG8_SCHED;
            PG8_STAGE(PG8_SB(1, 1), b3 + hstepB, voffB);
            PG8_WAIT_V(6); PG8_BAR; PG8_MMA(1, 1, At, B1); PG8_BAR;
            }
        }
        if constexpr (ALIGN_EPI) { if (wr == 0) PG8_BAR; }
        if constexpr (!Epi::AFTER_DRAIN) { E(acc, cur, wr, wc, fr, fq); S.done(cur); }
        if (!has_next) break;
#pragma unroll
        for (int a = 0; a < 2; ++a)
#pragma unroll
            for (int b = 0; b < 2; ++b)
#pragma unroll
                for (int m = 0; m < 4; ++m)
#pragma unroll
                    for (int n = 0; n < 2; ++n) acc[a][b][m][n] = (f32x4){0.f, 0.f, 0.f, 0.f};
        cur = nxt; cA = nA; cB = nB; ++ui;
        if constexpr (ALIGN_EPI) { if (wr == 1) PG8_BAR; }
    }
    PG8_WAIT_V(0);
    if constexpr (!ALIGN_EPI) { if (wr == 0) PG8_BAR; }
    PG8_BAR;
    if constexpr (Epi::AFTER_DRAIN) { E.fused(acc, cur, wr, wc, fr, fq, lds, wid, lane); S.done(cur); }
#undef PG8_SA
#undef PG8_SB
#undef PG8_STAGE
#undef PG8_LDA
#undef PG8_LDB
#undef PG8_MMA
#undef PG8_WAIT_V
#undef PG8_WAIT_L
#undef PG8_BAR
#undef PG8_SCHED
}
}

constexpr int S_ = 8192, DM = 2048, DEPTH = 4, NH = 16;
constexpr int QL = 512, KVL = 512, ROPE = 64, NOPE = 128, VD = 128;
constexpr int INW = 13376;
constexpr int DFF = 5632, DFF2 = 11264;
constexpr int NNAT = 11520;
constexpr int WINR = NNAT + 2048;
constexpr float EPS = 1e-6f;
constexpr float LOG2E = 1.4426950408889634f;
constexpr float QSCALE = 0.07216878364870323f * 1.4426950408889634f;
constexpr int NWAVES = 8, NTHR = 512;

constexpr size_t MiB = 1u << 20;
constexpr size_t WS_CTL = 0, CTL_ZERO_BYTES = 1 * MiB;
constexpr size_t WS_COS = 1 * MiB, WS_SIN = 2 * MiB, WS_LB = 3 * MiB, WS_SSQ = 4 * MiB;
constexpr size_t WS_W = 5 * MiB;
constexpr size_t LW_IN = 0, LW_UQ = 53 * MiB, LW_K = 56 * MiB, LW_V = 58 * MiB, LW_A = 60 * MiB, LW_B = 68 * MiB, LW_O = 76 * MiB, LW_UP = 84 * MiB, LW_DN = 128 * MiB, LW = 150 * MiB;
constexpr size_t WS_XN = WS_W + 4 * LW;
constexpr size_t WS_MIX = WS_XN + 32 * MiB;
constexpr size_t WS_CQKV = WS_MIX;
constexpr size_t WS_KPE = WS_CQKV + 16 * MiB;
constexpr size_t WS_HQ = WS_KPE + 1 * MiB;
constexpr size_t GSTRIDE = 32 * MiB;
constexpr size_t WS_HG = WS_HQ + GSTRIDE, WS_GA = WS_HQ + 2 * GSTRIDE, WS_GB = WS_HQ + 3 * GSTRIDE;
constexpr size_t WS_HF = WS_HQ + 4 * GSTRIDE;
constexpr size_t WS_VTH = WS_HF + 64 * MiB;
constexpr size_t WS_QN = WS_VTH + 32 * MiB;
constexpr size_t WS_QR = WS_QN + 32 * MiB;
constexpr size_t WS_KN = WS_QR + 16 * MiB;
constexpr size_t WS_VT = WS_KN + 32 * MiB;
constexpr size_t WS_ATT = WS_VT + 32 * MiB;
constexpr size_t WS_REC = WS_ATT + 32 * MiB;
constexpr size_t WS_RRAW = WS_REC + 32 * MiB;
constexpr size_t WS_HU = WS_RRAW + 64 * MiB;
constexpr size_t WS_HS = WS_HU + 128 * MiB;
constexpr size_t WS_M1 = WS_HS + 64 * MiB;
constexpr size_t WS_MRG = WS_M1 + 64 * MiB;
constexpr size_t WS_MIX_END = WS_MRG + 32 * MiB;
constexpr size_t WS_U = WS_MIX;
constexpr size_t WS_ACT = WS_U + 176 * MiB;
static_assert(WS_ACT + 88 * MiB <= WS_MIX_END, "FFN overlay fits the mixer region");
constexpr size_t WS_END = WS_MIX_END;
constexpr int CW_BAR = 4096;

constexpr int RING_OFF = 0, RING_BYTES = 131072;
constexpr int LDSCTL_OFF = RING_BYTES, MISC_OFF = LDSCTL_OFF + 320;
constexpr int LDS_BYTES = 147456;

#define GAS __attribute__((address_space(1)))
#define LAS __attribute__((address_space(3)))
typedef unsigned short bf16;
typedef unsigned v4u __attribute__((ext_vector_type(4)));
typedef unsigned v2u __attribute__((ext_vector_type(2)));
typedef float f32x4 __attribute__((ext_vector_type(4)));
typedef float f32x2 __attribute__((ext_vector_type(2)));
typedef short bf16x8 __attribute__((ext_vector_type(8)));
typedef GAS unsigned gu32;
#define LDS_WAIT() asm volatile("s_waitcnt lgkmcnt(0)" ::: "memory")
#define VM_WAIT() asm volatile("s_waitcnt vmcnt(0)" ::: "memory")
__device__ __forceinline__ unsigned f2bf(float f) { unsigned u = __builtin_bit_cast(unsigned, f); return (u + 0x7fffu + ((u >> 16) & 1u)) >> 16; }
__device__ __forceinline__ unsigned pk2(float lo, float hi) { return f2bf(lo) | (f2bf(hi) << 16); }
__device__ __forceinline__ float bflo(unsigned u) { return __builtin_bit_cast(float, u << 16); }
__device__ __forceinline__ float bfhi(unsigned u) { return __builtin_bit_cast(float, u & 0xffff0000u); }
__device__ __forceinline__ float sigm(float x) { return __builtin_amdgcn_rcpf(1.f + __builtin_amdgcn_exp2f(-LOG2E * x)); }
__device__ __forceinline__ float wave_sum(float v) {
#pragma unroll
    for (int o = 1; o < 64; o <<= 1) v += __shfl_xor(v, o);
    return v;
}
__device__ __forceinline__ float wave_max(float v) {
#pragma unroll
    for (int o = 1; o < 64; o <<= 1) v = fmaxf(v, __shfl_xor(v, o));
    return v;
}

namespace pg8 {
__device__ __forceinline__ u32x4 pack8(f32x4 a, f32x4 b) { u32x4 w; w.x = cvt_pk_bf16(a[0], a[1]); w.y = cvt_pk_bf16(a[2], a[3]); w.z = cvt_pk_bf16(b[0], b[1]); w.w = cvt_pk_bf16(b[2], b[3]); return w; }
__device__ __forceinline__ f32x4 silu4(f32x4 v) { f32x4 r; r[0] = v[0] * sigm(v[0]); r[1] = v[1] * sigm(v[1]); r[2] = v[2] * sigm(v[2]); r[3] = v[3] * sigm(v[3]); return r; }
__device__ __forceinline__ f32x4 sigm4(f32x4 v) { f32x4 r; r[0] = sigm(v[0]); r[1] = sigm(v[1]); r[2] = sigm(v[2]); r[3] = sigm(v[3]); return r; }
__device__ __forceinline__ float sum8(const float* p) { const f32x4 a = *(const f32x4*)p, b = *(const f32x4*)(p + 4); return ((a[0] + a[1]) + (a[2] + a[3])) + ((b[0] + b[1]) + (b[2] + b[3])); }
__device__ __forceinline__ void rope8(f32x4& v0, f32x4& v1, const f32x4 cs, const f32x4 sn) {
    f32x4 a, b;
    a[0] = v0[0] * cs[0] - v0[1] * sn[0]; a[1] = v0[1] * cs[0] + v0[0] * sn[0];
    a[2] = v0[2] * cs[1] - v0[3] * sn[1]; a[3] = v0[3] * cs[1] + v0[2] * sn[1];
    b[0] = v1[0] * cs[2] - v1[1] * sn[2]; b[1] = v1[1] * cs[2] + v1[0] * sn[2];
    b[2] = v1[2] * cs[3] - v1[3] * sn[3]; b[3] = v1[3] * cs[3] + v1[2] * sn[3];
    v0 = a; v1 = b;
}

struct EpiIn {
    static constexpr bool PERM = true, AFTER_DRAIN = false;
    unsigned char* ws;
    __device__ __forceinline__ void operator()(const f32x4 (&acc)[2][2][4][2], const Unit& u, int wr, int wc, int fr, int fq) const {
        const int pn = u.pn, row0 = u.pm * BM + wr * 64 + fr, lc = wc * 32 + 8 * fq;
        if (pn == 4) {
            if (wc < 2) {
                const float* COS = (const float*)(ws + WS_COS); const float* SIN = (const float*)(ws + WS_SIN); bf16_t* KPE = (bf16_t*)(ws + WS_KPE);
#pragma unroll
                for (int ai = 0; ai < 2; ++ai)
#pragma unroll
                    for (int m = 0; m < 4; ++m) { const int row = row0 + ai * HALF + m * 16;
                        f32x4 v0 = acc[ai][0][m][0], v1 = acc[ai][0][m][1];
                        const f32x4 cs = *(const f32x4*)(COS + (size_t)row * 32 + wc * 16 + 4 * fq), sn = *(const f32x4*)(SIN + (size_t)row * 32 + wc * 16 + 4 * fq);
                        rope8(v0, v1, cs, sn);
                        *(u32x4*)(KPE + (size_t)row * 64 + lc) = pack8(v0, v1);
                        if (m & 1) asm volatile("" ::: "memory"); }
            }
        } else if (pn >= 13 && pn < 21) {
            float* HF = (float*)(ws + WS_HF);
#pragma unroll
            for (int ai = 0; ai < 2; ++ai)
#pragma unroll
                for (int m = 0; m < 4; ++m) { float* rp = HF + (size_t)(row0 + ai * HALF + m * 16) * 2048 + (pn - 13) * 256 + lc;
#pragma unroll
                    for (int bj = 0; bj < 2; ++bj) { *(f32x4*)(rp + bj * HALF) = acc[ai][bj][m][0]; *(f32x4*)(rp + bj * HALF + 4) = acc[ai][bj][m][1]; } }
        } else {
            bf16_t* base; int ldc, act;
            if (pn < 4) { base = (bf16_t*)(ws + WS_CQKV) + pn * 256; ldc = 1024; act = 0; }
            else { const int gi = (pn < 13) ? 0 : ((pn - 13) >> 3), ct = (pn < 13) ? (pn - 5) : ((pn - 13) & 7);
                   base = (bf16_t*)(ws + WS_HQ + (size_t)gi * GSTRIDE) + ct * 256; ldc = 2048; act = (gi <= 1) ? 1 : 2; }
#pragma unroll
            for (int ai = 0; ai < 2; ++ai)
#pragma unroll
                for (int m = 0; m < 4; ++m) { bf16_t* rp = base + (size_t)(row0 + ai * HALF + m * 16) * ldc + lc;
#pragma unroll
                    for (int bj = 0; bj < 2; ++bj) { f32x4 v0 = acc[ai][bj][m][0], v1 = acc[ai][bj][m][1];
                        if (act == 1) { v0 = silu4(v0); v1 = silu4(v1); }
                        else if (act == 2) { v0 = sigm4(v0); v1 = sigm4(v1); }
                        *(u32x4*)(rp + bj * HALF) = pack8(v0, v1); } }
        }
    }
};
struct EpiStore {
    static constexpr bool PERM = true, AFTER_DRAIN = false;
    bf16_t* O; int ldc;
    __device__ __forceinline__ void operator()(const f32x4 (&acc)[2][2][4][2], const Unit& u, int wr, int wc, int fr, int fq) const {
        const int row0 = u.pm * BM + wr * 64 + fr, col0 = u.pn * BM + wc * 32 + 8 * fq;
#pragma unroll
        for (int ai = 0; ai < 2; ++ai)
#pragma unroll
            for (int m = 0; m < 4; ++m) { bf16_t* rp = O + (size_t)(row0 + ai * HALF + m * 16) * ldc + col0;
#pragma unroll
                for (int bj = 0; bj < 2; ++bj) *(u32x4*)(rp + bj * HALF) = pack8(acc[ai][bj][m][0], acc[ai][bj][m][1]); }
    }
};
struct EpiQ {
    static constexpr bool PERM = true, AFTER_DRAIN = false;
    unsigned char* ws;
    __device__ __forceinline__ void operator()(const f32x4 (&acc)[2][2][4][2], const Unit& u, int wr, int wc, int fr, int fq) const {
        const int pn = u.pn, row0 = u.pm * BM + wr * 64 + fr, lc = wc * 32 + 8 * fq;
        if (pn < 8) {
            bf16_t* base = (bf16_t*)(ws + WS_QN) + pn * 256 + lc;
#pragma unroll
            for (int ai = 0; ai < 2; ++ai)
#pragma unroll
                for (int m = 0; m < 4; ++m)
#pragma unroll
                    for (int bj = 0; bj < 2; ++bj) *(u32x4*)(base + (size_t)(row0 + ai * HALF + m * 16) * 2048 + bj * HALF) = pack8(acc[ai][bj][m][0] * QSCALE, acc[ai][bj][m][1] * QSCALE);
        } else {
            const float* COS = (const float*)(ws + WS_COS); const float* SIN = (const float*)(ws + WS_SIN);
            bf16_t* base = (bf16_t*)(ws + WS_QR) + (pn - 8) * 256 + lc; const int p0 = (wc & 1) * 16 + 4 * fq;
#pragma unroll
            for (int ai = 0; ai < 2; ++ai)
#pragma unroll
                for (int m = 0; m < 4; ++m) { const int row = row0 + ai * HALF + m * 16;
                    const f32x4 cs = *(const f32x4*)(COS + (size_t)row * 32 + p0), sn = *(const f32x4*)(SIN + (size_t)row * 32 + p0);
#pragma unroll
                    for (int bj = 0; bj < 2; ++bj) { f32x4 v0 = acc[ai][bj][m][0] * QSCALE, v1 = acc[ai][bj][m][1] * QSCALE; rope8(v0, v1, cs, sn);
                        *(u32x4*)(base + (size_t)row * 1024 + bj * HALF) = pack8(v0, v1); }
                    if (m & 1) asm volatile("" ::: "memory"); }
        }
    }
};
struct EpiGateA {
    static constexpr bool PERM = true, AFTER_DRAIN = false;
    unsigned char* ws;
    __device__ __forceinline__ void operator()(const f32x4 (&acc)[2][2][4][2], const Unit& u, int wr, int wc, int fr, int fq) const {
        const int row0 = u.pm * BM + wr * 64 + fr, col0 = u.pn * BM + wc * 32 + 8 * fq;
        const bf16_t* G = (const bf16_t*)(ws + WS_GA); float* M1 = (float*)(ws + WS_M1);
#pragma unroll
        for (int ai = 0; ai < 2; ++ai)
#pragma unroll
            for (int m = 0; m < 4; ++m) { const size_t off = (size_t)(row0 + ai * HALF + m * 16) * 2048 + col0;
#pragma unroll
                for (int bj = 0; bj < 2; ++bj) { const u32x4 g = *(const u32x4*)(G + off + bj * HALF);
                    const f32x4 g0 = {bflo(g.x), bfhi(g.x), bflo(g.y), bfhi(g.y)}, g1 = {bflo(g.z), bfhi(g.z), bflo(g.w), bfhi(g.w)};
                    *(f32x4*)(M1 + off + bj * HALF) = acc[ai][bj][m][0] * g0; *(f32x4*)(M1 + off + bj * HALF + 4) = acc[ai][bj][m][1] * g1; }
                if (m & 1) asm volatile("" ::: "memory"); }
    }
};
struct EpiGateB {
    static constexpr bool PERM = true, AFTER_DRAIN = false;
    unsigned char* ws;
    __device__ __forceinline__ void operator()(const f32x4 (&acc)[2][2][4][2], const Unit& u, int wr, int wc, int fr, int fq) const {
        const int row0 = u.pm * BM + wr * 64 + fr, col0 = u.pn * BM + wc * 32 + 8 * fq;
        const bf16_t* G = (const bf16_t*)(ws + WS_GB); const float* M1 = (const float*)(ws + WS_M1); bf16_t* O = (bf16_t*)(ws + WS_MRG);
#pragma unroll
        for (int ai = 0; ai < 2; ++ai)
#pragma unroll
            for (int m = 0; m < 4; ++m) { const size_t off = (size_t)(row0 + ai * HALF + m * 16) * 2048 + col0;
#pragma unroll
                for (int bj = 0; bj < 2; ++bj) { const u32x4 g = *(const u32x4*)(G + off + bj * HALF);
                    const f32x4 g0 = {bflo(g.x), bfhi(g.x), bflo(g.y), bfhi(g.y)}, g1 = {bflo(g.z), bfhi(g.z), bflo(g.w), bfhi(g.w)};
                    const f32x4 m0 = *(const f32x4*)(M1 + off + bj * HALF), m1 = *(const f32x4*)(M1 + off + bj * HALF + 4);
                    *(u32x4*)(O + off + bj * HALF) = pack8(m0 + acc[ai][bj][m][0] * g0, m1 + acc[ai][bj][m][1] * g1); }
                if (m & 1) asm volatile("" ::: "memory"); }
    }
};
struct EpiRes {
    static constexpr bool PERM = true, AFTER_DRAIN = false;
    float* X;
    __device__ __forceinline__ void operator()(const f32x4 (&acc)[2][2][4][2], const Unit& u, int wr, int wc, int fr, int fq) const {
        const int row0 = u.pm * BM + wr * 64 + fr, col0 = u.pn * BM + wc * 32 + 8 * fq;
#pragma unroll
        for (int ai = 0; ai < 2; ++ai)
#pragma unroll
            for (int m = 0; m < 4; ++m) { float* rp = X + (size_t)(row0 + ai * HALF + m * 16) * 2048 + col0;
#pragma unroll
                for (int bj = 0; bj < 2; ++bj) { const f32x4 a = *(const f32x4*)(rp + bj * HALF), b = *(const f32x4*)(rp + bj * HALF + 4);
                    *(f32x4*)(rp + bj * HALF) = a + acc[ai][bj][m][0]; *(f32x4*)(rp + bj * HALF + 4) = b + acc[ai][bj][m][1]; }
                if (m & 1) asm volatile("" ::: "memory"); }
    }
};
}
#define XB_TMO      128
#define XB_XCNT(j)  (256  + 64 * (j))
#define XB_XSUB(j)  (1280 + 64 * (j))
#define XB_XGEN(j)  (2304 + 64 * (j))
#define XB_TOP      3328
#define XB_TOPGEN   3392
#define XCD_BAR_WORDS 3456
#define XB_SPIN_CAP (1u << 18)

__device__ __forceinline__ unsigned xb_ld(unsigned* p)              { return __hip_atomic_load(p, __ATOMIC_RELAXED, __HIP_MEMORY_SCOPE_AGENT); }
__device__ __forceinline__ unsigned xb_add(unsigned* p, unsigned v) { return __hip_atomic_fetch_add(p, v, __ATOMIC_RELAXED, __HIP_MEMORY_SCOPE_AGENT); }
__device__ __forceinline__ unsigned xb_xcc_id() { return (unsigned)__builtin_amdgcn_s_getreg((3 << 11) | 20) & 0xFu; }
#define XB_SPIN(cond, bar) do { unsigned _sp = 0; while (cond) { __builtin_amdgcn_s_sleep(1); \
    if ((++_sp & 255u) == 0u) { if (xb_ld(&(bar)[XB_TMO])) break; if (_sp > XB_SPIN_CAP) { atomicAdd(&(bar)[XB_TMO], 1u); break; } } } } while (0)

struct XcdBarrier {
    unsigned* bar; unsigned x;
    volatile LAS unsigned* st;
};

__device__ __forceinline__ XcdBarrier xcd_barrier_post(unsigned* bar, volatile LAS unsigned* st) {
    XcdBarrier b; b.bar = bar; b.x = xb_xcc_id(); b.st = st;
    if (threadIdx.x == 0) (void)xb_add(&bar[XB_XCNT(b.x)], 1u);
    return b;
}
__device__ __forceinline__ void xcd_barrier_complete(unsigned* bar, unsigned x, unsigned& nloc, unsigned& nx) {
    const unsigned G = gridDim.x * gridDim.y * gridDim.z;
    unsigned sum, cnt, mine, sp = 0u;
    for (;;) {
        sum = 0u; cnt = 0u; mine = 0u;
#pragma unroll
        for (unsigned j = 0; j < 16; ++j) { const unsigned c = xb_ld(&bar[XB_XCNT(j)]); sum += c; cnt += (c > 0u) ? 1u : 0u; mine = (j == x) ? c : mine; }
        if (sum == G) break;
        __builtin_amdgcn_s_sleep(1);
        if ((++sp & 255u) == 0u) { if (xb_ld(&bar[XB_TMO])) break; if (sp > XB_SPIN_CAP) { atomicAdd(&bar[XB_TMO], 1u); break; } }
    }
    nloc = mine > 0u ? mine : 1u; nx = cnt > 0u ? cnt : 1u;
}

__device__ __forceinline__ void xcd_barrier(const XcdBarrier& b) {
    asm volatile("s_waitcnt vmcnt(0)" ::: "memory");
    __syncthreads();
    if (threadIdx.x == 0) {
        GAS unsigned* gbar_ = (GAS unsigned*)b.bar; unsigned bx_ = b.x; asm volatile("" : "+s"(gbar_), "+s"(bx_)); unsigned* bar = (unsigned*)gbar_;
        __builtin_amdgcn_s_waitcnt(0);
        unsigned nloc = b.st[0], nx = b.st[1];
        if (nloc == 0u) { xcd_barrier_complete(bar, bx_, nloc, nx); b.st[0] = nloc; b.st[1] = nx; }
        const unsigned old = xb_add(&bar[XB_XSUB(bx_)], 1u);
        const unsigned gen = old / nloc;
        if (old + 1u == (gen + 1u) * nloc) {
            __builtin_amdgcn_fence(__ATOMIC_RELEASE, "agent");
            asm volatile("s_waitcnt vmcnt(0)" ::: "memory");
            const unsigned og = xb_add(&bar[XB_TOP], 1u);
            const unsigned tg = og / nx;
            if (og + 1u == (tg + 1u) * nx) xb_add(&bar[XB_TOPGEN], 1u);
            else XB_SPIN(xb_ld(&bar[XB_TOPGEN]) == tg, bar);
            __builtin_amdgcn_fence(__ATOMIC_ACQUIRE, "agent");
            xb_add(&bar[XB_XGEN(bx_)], 1u);
            asm volatile("s_waitcnt vmcnt(0)" ::: "memory");
        } else {
            XB_SPIN(xb_ld(&bar[XB_XGEN(bx_)]) == gen, bar);
            __builtin_amdgcn_fence(__ATOMIC_ACQUIRE, "agent");
            asm volatile("s_waitcnt vmcnt(0)" ::: "memory");
        }
    }
    __syncthreads();
}

__device__ const float c_invf[32] = {
    1.000000000e+00f, 7.498942614e-01f, 5.623413324e-01f, 4.216965139e-01f, 3.162277639e-01f, 2.371373773e-01f, 1.778279394e-01f, 1.333521307e-01f,
    1.000000015e-01f, 7.498941571e-02f, 5.623413250e-02f, 4.216965288e-02f, 3.162277490e-02f, 2.371373773e-02f, 1.778279431e-02f, 1.333521493e-02f,
    9.999999776e-03f, 7.498941850e-03f, 5.623413250e-03f, 4.216964822e-03f, 3.162277630e-03f, 2.371373586e-03f, 1.778279431e-03f, 1.333521446e-03f,
    1.000000047e-03f, 7.498942432e-04f, 5.623413017e-04f, 4.216965172e-04f, 3.162277571e-04f, 2.371373703e-04f, 1.778279402e-04f, 1.333521504e-04f};

template <int KIND> __device__ __forceinline__ int srcmap(int n) {
    if constexpr (KIND == 0) return n;
    else if constexpr (KIND == 1) {
        if (n < 1024) return n;
        if (n < 1088) { const int jj = n - 1024; return 1024 + (jj >> 1) + 32 * (jj & 1); }
        if (n < 1280) return -1;
        if (n < 3328) return 1088 + (n - 1280);
        if (n < 5376) return 3136 + (n - 3328);
        if (n < 7424) return 7232 + (n - 5376);
        if (n < 9472) return 9280 + (n - 7424);
        if (n < 11520) return 11328 + (n - 9472);
        return 5184 + (n - 11520);
    } else if constexpr (KIND == 2) {
        if (n < 2048) return (n >> 7) * 192 + (n & 127);
        const int r = n - 2048, h = r >> 6, jj = r & 63; return h * 192 + 128 + (jj >> 1) + 32 * (jj & 1);
    } else if constexpr (KIND == 3) return (n >> 7) * 256 + (n & 127);
    else if constexpr (KIND == 4) return (n >> 7) * 256 + 128 + (n & 127);
    else { const int j = n >> 8, i = n & 255; return i < 128 ? 128 * j + i : DFF + 128 * j + (i - 128); }
}
template <int KIND> __device__ __forceinline__ void transpose_item(const float* W, int K, int Nsrc, bf16* WT, const float* scale, LAS float* scr, int kb, int nb, int lane) {
    const int k0 = 64 * kb, n0 = 32 * nb, sc = srcmap<KIND>(n0 + (lane & 31));
#pragma unroll 8
    for (int i = 0; i < 32; ++i) { const int kk = 2 * i + (lane >> 5); float v = 0.f;
        if (sc >= 0) { v = ((const GAS float*)W)[(size_t)(k0 + kk) * Nsrc + sc]; if (scale) v *= ((const GAS float*)scale)[k0 + kk]; }
        scr[kk * 33 + (lane & 31)] = v; }
    LDS_WAIT(); asm volatile("" ::: "memory");
    const int c = lane & 7;
#pragma unroll
    for (int j = 0; j < 4; ++j) { const int n = (lane >> 3) + 8 * j; const LAS float* s = scr + (8 * c) * 33 + n;
        v4u o; o.x = pk2(s[0 * 33], s[1 * 33]); o.y = pk2(s[2 * 33], s[3 * 33]); o.z = pk2(s[4 * 33], s[5 * 33]); o.w = pk2(s[6 * 33], s[7 * 33]);
        *(GAS v4u*)(WT + (size_t)(n0 + n) * K + k0 + 8 * c) = o; }
    LDS_WAIT(); asm volatile("" ::: "memory");
}

struct TItem { const float* src; const float* scale; bf16* dst; int K, Nsrc, k0, n0, sc; };
__device__ __forceinline__ int srcmap_rt(int kind, int n) {
    switch (kind) { case 1: return srcmap<1>(n); case 2: return srcmap<2>(n); case 3: return srcmap<3>(n); case 4: return srcmap<4>(n); case 5: return srcmap<5>(n); default: return n; }
}
__device__ __forceinline__ void rms_row_to_bf16(const float* xrow, const float* gain, bf16* orow, float* xcopy, int lane) {
    const GAS f32x4* xr = (const GAS f32x4*)xrow + lane;
    f32x4 v[8]; float s = 0.f;
#pragma unroll
    for (int j = 0; j < 8; ++j) { v[j] = xr[64 * j]; s += (v[j].x * v[j].x + v[j].y * v[j].y) + (v[j].z * v[j].z + v[j].w * v[j].w); }
    const float rstd = 1.0f / sqrtf(wave_sum(s) * (1.f / DM) + EPS);
    if (xcopy) { GAS f32x4* xc = (GAS f32x4*)xcopy + lane;
#pragma unroll
        for (int j = 0; j < 8; ++j) xc[64 * j] = v[j]; }
    GAS v2u* o8 = (GAS v2u*)orow + lane;
#pragma unroll
    for (int j = 0; j < 8; ++j) { const f32x4 g = *((const GAS f32x4*)gain + lane + 64 * j);
        v2u w; w.x = pk2(v[j].x * rstd * g.x, v[j].y * rstd * g.y); w.y = pk2(v[j].z * rstd * g.z, v[j].w * rstd * g.w); o8[64 * j] = w; }
}
__device__ __forceinline__ void rms_row_f32(float* xrow, const float* gain, int lane) {
    GAS f32x4* xr = (GAS f32x4*)xrow + lane;
    f32x4 v[8]; float s = 0.f;
#pragma unroll
    for (int j = 0; j < 8; ++j) { v[j] = xr[64 * j]; s += (v[j].x * v[j].x + v[j].y * v[j].y) + (v[j].z * v[j].z + v[j].w * v[j].w); }
    const float rstd = 1.0f / sqrtf(wave_sum(s) * (1.f / DM) + EPS);
#pragma unroll
    for (int j = 0; j < 8; ++j) { const f32x4 g = *((const GAS f32x4*)gain + lane + 64 * j); xr[64 * j] = v[j] * rstd * g; }
}
__device__ __forceinline__ void sincos_f64(float angf, float& sn, float& cs) {
    const double a = (double)angf;
    const double n = __builtin_rint(a * 0.63661977236758134308);
    double r = __builtin_fma(-n, 1.57079632679489655800e+00, a); r = __builtin_fma(-n, 6.12323399573676603587e-17, r);
    const double r2 = r * r;
    double ps = -1.0 / 1307674368000.0; ps = ps * r2 + 1.0 / 6227020800.0; ps = ps * r2 - 1.0 / 39916800.0; ps = ps * r2 + 1.0 / 362880.0; ps = ps * r2 - 1.0 / 5040.0; ps = ps * r2 + 1.0 / 120.0; ps = ps * r2 - 1.0 / 6.0; ps = ps * r2 * r + r;
    double pc = 1.0 / 20922789888000.0; pc = pc * r2 - 1.0 / 87178291200.0; pc = pc * r2 + 1.0 / 479001600.0; pc = pc * r2 - 1.0 / 3628800.0; pc = pc * r2 + 1.0 / 40320.0; pc = pc * r2 - 1.0 / 720.0; pc = pc * r2 + 1.0 / 24.0; pc = pc * r2 - 0.5; pc = pc * r2 + 1.0;
    const int q = ((int)n) & 3;
    const double s_ = (q == 0) ? ps : (q == 1) ? pc : (q == 2) ? -ps : -pc;
    const double c_ = (q == 0) ? pc : (q == 1) ? -ps : (q == 2) ? -pc : ps;
    sn = (float)s_; cs = (float)c_;
}

__device__ __forceinline__ void latent_norm_row(bf16* row, int lane) {
    v4u a = *(const v4u*)(row + lane * 8), b = *(const v4u*)(row + 512 + lane * 8);
    float fa[8] = {bflo(a.x), bfhi(a.x), bflo(a.y), bfhi(a.y), bflo(a.z), bfhi(a.z), bflo(a.w), bfhi(a.w)};
    float fb[8] = {bflo(b.x), bfhi(b.x), bflo(b.y), bfhi(b.y), bflo(b.z), bfhi(b.z), bflo(b.w), bfhi(b.w)};
    float sa = 0.f, sb = 0.f;
#pragma unroll
    for (int i = 0; i < 8; ++i) { sa += fa[i] * fa[i]; sb += fb[i] * fb[i]; }
    const float ra = 1.0f / sqrtf(wave_sum(sa) * (1.f / 512.f) + EPS), rb = 1.0f / sqrtf(wave_sum(sb) * (1.f / 512.f) + EPS);
    a.x = pk2(fa[0] * ra, fa[1] * ra); a.y = pk2(fa[2] * ra, fa[3] * ra); a.z = pk2(fa[4] * ra, fa[5] * ra); a.w = pk2(fa[6] * ra, fa[7] * ra);
    b.x = pk2(fb[0] * rb, fb[1] * rb); b.y = pk2(fb[2] * rb, fb[3] * rb); b.z = pk2(fb[4] * rb, fb[5] * rb); b.w = pk2(fb[6] * rb, fb[7] * rb);
    *(v4u*)(row + lane * 8) = a; *(v4u*)(row + 512 + lane * 8) = b;
}

__device__ __forceinline__ void attn_naive(unsigned char* ws, LAS float* qs  , int gw, int ngw, int lane) {
    const bf16* QN = (const bf16*)(ws + WS_QN); const bf16* QR = (const bf16*)(ws + WS_QR); const bf16* KN = (const bf16*)(ws + WS_KN);
    const bf16* KPE = (const bf16*)(ws + WS_KPE); const bf16* VT = (const bf16*)(ws + WS_VT); bf16* ATT = (bf16*)(ws + WS_ATT);
    for (int item = gw; item < S_ * NH; item += ngw) {
        const int q = item >> 4, h = item & 15;
        if (lane < 24) { const v4u w = (lane < 16) ? *(const v4u*)(QN + (size_t)q * 2048 + h * 128 + lane * 8) : *(const v4u*)(QR + (size_t)q * 1024 + h * 64 + (lane - 16) * 8);
            LAS float* d = qs + lane * 8; d[0] = bflo(w.x); d[1] = bfhi(w.x); d[2] = bflo(w.y); d[3] = bfhi(w.y); d[4] = bflo(w.z); d[5] = bfhi(w.z); d[6] = bflo(w.w); d[7] = bfhi(w.w); }
        LDS_WAIT(); asm volatile("" ::: "memory");
        float m = -__builtin_inff(), l = 0.f, o0 = 0.f, o1 = 0.f;
        const bf16* v0p = VT + (size_t)(h * 128 + 2 * lane) * S_; const bf16* v1p = v0p + S_;
        for (int j0 = 0; j0 <= q; j0 += 64) {
            const int j = j0 + lane; const bool valid = j <= q; float s = 0.f;
            if (valid) {
                const bf16* kn = KN + (size_t)j * 2048 + h * 128; const bf16* kp = KPE + (size_t)j * 64;
#pragma unroll 4
                for (int c = 0; c < 24; ++c) { const v4u w = (c < 16) ? *(const v4u*)(kn + c * 8) : *(const v4u*)(kp + (c - 16) * 8); const LAS float* qq = qs + c * 8;
                    s += bflo(w.x) * qq[0] + bfhi(w.x) * qq[1] + bflo(w.y) * qq[2] + bfhi(w.y) * qq[3] + bflo(w.z) * qq[4] + bfhi(w.z) * qq[5] + bflo(w.w) * qq[6] + bfhi(w.w) * qq[7]; }
            } else s = -__builtin_inff();
            const float mn = fmaxf(m, wave_max(s)); const float alpha = __builtin_amdgcn_exp2f(m - mn); const float p = valid ? __builtin_amdgcn_exp2f(s - mn) : 0.f;
            l = l * alpha + wave_sum(p); m = mn; o0 *= alpha; o1 *= alpha;
#pragma unroll
            for (int c = 0; c < 8; ++c) { const v4u a = *(const v4u*)(v0p + j0 + c * 8), b = *(const v4u*)(v1p + j0 + c * 8);
                const float p0 = __builtin_bit_cast(float, __builtin_amdgcn_readlane(__builtin_bit_cast(int, p), c * 8 + 0)), p1 = __builtin_bit_cast(float, __builtin_amdgcn_readlane(__builtin_bit_cast(int, p), c * 8 + 1));
                const float p2 = __builtin_bit_cast(float, __builtin_amdgcn_readlane(__builtin_bit_cast(int, p), c * 8 + 2)), p3 = __builtin_bit_cast(float, __builtin_amdgcn_readlane(__builtin_bit_cast(int, p), c * 8 + 3));
                const float p4 = __builtin_bit_cast(float, __builtin_amdgcn_readlane(__builtin_bit_cast(int, p), c * 8 + 4)), p5 = __builtin_bit_cast(float, __builtin_amdgcn_readlane(__builtin_bit_cast(int, p), c * 8 + 5));
                const float p6 = __builtin_bit_cast(float, __builtin_amdgcn_readlane(__builtin_bit_cast(int, p), c * 8 + 6)), p7 = __builtin_bit_cast(float, __builtin_amdgcn_readlane(__builtin_bit_cast(int, p), c * 8 + 7));
                o0 += p0 * bflo(a.x) + p1 * bfhi(a.x) + p2 * bflo(a.y) + p3 * bfhi(a.y) + p4 * bflo(a.z) + p5 * bfhi(a.z) + p6 * bflo(a.w) + p7 * bfhi(a.w);
                o1 += p0 * bflo(b.x) + p1 * bfhi(b.x) + p2 * bflo(b.y) + p3 * bfhi(b.y) + p4 * bflo(b.z) + p5 * bfhi(b.z) + p6 * bflo(b.w) + p7 * bfhi(b.w); }
        }
        const float il = 1.f / l;
        *(unsigned*)(ATT + (size_t)q * 2048 + h * 128 + 2 * lane) = pk2(o0 * il, o1 * il);
        asm volatile("" ::: "memory");
    }
}
__device__ __forceinline__ void hgrn_naive(unsigned char* ws, int layer, int gw, int ngw, int lane) {
    const bf16* HQ = (const bf16*)(ws + WS_HQ); const float* HF = (const float*)(ws + WS_HF); const bf16* VTH = (const bf16*)(ws + WS_VTH);
    const float* LB = (const float*)(ws + WS_LB) + layer * 2048; float* RR = (float*)(ws + WS_RRAW);
    for (int item = gw; item < NH * 128; item += ngw) {
        const int h = item >> 7, e = item & 127, ch = h * 128 + 2 * lane;
        const float lb0 = LB[ch], lb1 = LB[ch + 1];
        float s0 = 0.f, s1 = 0.f;
        const bf16* vp = VTH + (size_t)(h * 128 + e) * S_;
        for (int t0 = 0; t0 < S_; t0 += 8) {
            const v4u vv = *(const v4u*)(vp + t0);
            const float vt[8] = {bflo(vv.x), bfhi(vv.x), bflo(vv.y), bfhi(vv.y), bflo(vv.z), bfhi(vv.z), bflo(vv.w), bfhi(vv.w)};
            float ov = 0.f;
#pragma unroll
            for (int i = 0; i < 8; ++i) { const size_t off = (size_t)(t0 + i) * 2048 + ch;
                const f32x2 z = *(const f32x2*)(HF + off); const unsigned qq = *(const unsigned*)(HQ + off);
                const float f0 = lb0 + (1.f - lb0) * sigm(z.x), f1 = lb1 + (1.f - lb1) * sigm(z.y);
                s0 = fmaxf(f0, 1e-30f) * s0 + (1.f - f0) * vt[i]; s1 = fmaxf(f1, 1e-30f) * s1 + (1.f - f1) * vt[i];
                const float o = wave_sum(bflo(qq) * s0 + bfhi(qq) * s1);
                ov = (lane == i) ? o : ov; }
            if (lane < 8) RR[(size_t)(t0 + lane) * 2048 + h * 128 + e] = ov;
        }
    }
}
__device__ __forceinline__ void hgrn_normgate(unsigned char* ws, const float* gain, int gw, int ngw, int lane) {
    const float* RR = (const float*)(ws + WS_RRAW); const bf16* HG = (const bf16*)(ws + WS_HG); bf16* REC = (bf16*)(ws + WS_REC);
    const f32x2 g = *(const GAS f32x2*)(gain + 2 * lane);
    for (int item = gw; item < S_ * NH; item += ngw) {
        const size_t off = (size_t)item * 128 + 2 * lane;
        const f32x2 v = *(const f32x2*)(RR + off); const unsigned hg = *(const unsigned*)(HG + off);
        const float rstd = 1.0f / sqrtf(wave_sum(v.x * v.x + v.y * v.y) * (1.f / 128.f) + EPS);
        *(unsigned*)(REC + off) = pk2(v.x * rstd * g.x * bflo(hg), v.y * rstd * g.y * bfhi(hg));
    }
}
__device__ __forceinline__ void conv_gate(unsigned char* ws, const float* cw, const float* cb, int gw, int ngw, int lane) {
    const bf16* U = (const bf16*)(ws + WS_U); bf16* ACT = (bf16*)(ws + WS_ACT);
    for (int item = gw; item < (S_ / 16) * 11; item += ngw) {
        const int tb = item / 11, cg = item % 11, c0 = cg * 512 + lane * 8;
        const int ucol = (c0 >> 7) * 256 + (c0 & 127), t0 = tb * 16;
        float wg[3][8], wu[3][8], bg[8], bu[8];
#pragma unroll
        for (int j = 0; j < 3; ++j)
#pragma unroll
            for (int i = 0; i < 8; ++i) { wg[j][i] = ((const GAS float*)cw)[(size_t)j * DFF2 + c0 + i]; wu[j][i] = ((const GAS float*)cw)[(size_t)j * DFF2 + DFF + c0 + i]; }
#pragma unroll
        for (int i = 0; i < 8; ++i) { bg[i] = ((const GAS float*)cb)[c0 + i]; bu[i] = ((const GAS float*)cb)[DFF + c0 + i]; }
        float g2[8], g1[8], u2[8], u1[8];
#pragma unroll
        for (int i = 0; i < 8; ++i) { g2[i] = 0.f; g1[i] = 0.f; u2[i] = 0.f; u1[i] = 0.f; }
        if (t0 > 0) {
            const v4u a = *(const v4u*)(U + (size_t)(t0 - 2) * DFF2 + ucol), b = *(const v4u*)(U + (size_t)(t0 - 2) * DFF2 + ucol + 128);
            const v4u c = *(const v4u*)(U + (size_t)(t0 - 1) * DFF2 + ucol), d = *(const v4u*)(U + (size_t)(t0 - 1) * DFF2 + ucol + 128);
            g2[0] = bflo(a.x); g2[1] = bfhi(a.x); g2[2] = bflo(a.y); g2[3] = bfhi(a.y); g2[4] = bflo(a.z); g2[5] = bfhi(a.z); g2[6] = bflo(a.w); g2[7] = bfhi(a.w);
            u2[0] = bflo(b.x); u2[1] = bfhi(b.x); u2[2] = bflo(b.y); u2[3] = bfhi(b.y); u2[4] = bflo(b.z); u2[5] = bfhi(b.z); u2[6] = bflo(b.w); u2[7] = bfhi(b.w);
            g1[0] = bflo(c.x); g1[1] = bfhi(c.x); g1[2] = bflo(c.y); g1[3] = bfhi(c.y); g1[4] = bflo(c.z); g1[5] = bfhi(c.z); g1[6] = bflo(c.w); g1[7] = bfhi(c.w);
            u1[0] = bflo(d.x); u1[1] = bfhi(d.x); u1[2] = bflo(d.y); u1[3] = bfhi(d.y); u1[4] = bflo(d.z); u1[5] = bfhi(d.z); u1[6] = bflo(d.w); u1[7] = bfhi(d.w);
        }
#pragma unroll 4
        for (int t = t0; t < t0 + 16; ++t) {
            const v4u a = *(const v4u*)(U + (size_t)t * DFF2 + ucol), b = *(const v4u*)(U + (size_t)t * DFF2 + ucol + 128);
            float g0[8], u0[8];
            g0[0] = bflo(a.x); g0[1] = bfhi(a.x); g0[2] = bflo(a.y); g0[3] = bfhi(a.y); g0[4] = bflo(a.z); g0[5] = bfhi(a.z); g0[6] = bflo(a.w); g0[7] = bfhi(a.w);
            u0[0] = bflo(b.x); u0[1] = bfhi(b.x); u0[2] = bflo(b.y); u0[3] = bfhi(b.y); u0[4] = bflo(b.z); u0[5] = bfhi(b.z); u0[6] = bflo(b.w); u0[7] = bfhi(b.w);
            float r[8];
#pragma unroll
            for (int i = 0; i < 8; ++i) { const float G = bg[i] + wg[0][i] * g2[i] + wg[1][i] * g1[i] + wg[2][i] * g0[i]; const float Uu = bu[i] + wu[0][i] * u2[i] + wu[1][i] * u1[i] + wu[2][i] * u0[i];
                r[i] = G * sigm(G) * Uu; g2[i] = g1[i]; g1[i] = g0[i]; u2[i] = u1[i]; u1[i] = u0[i]; }
            v4u o; o.x = pk2(r[0], r[1]); o.y = pk2(r[2], r[3]); o.z = pk2(r[4], r[5]); o.w = pk2(r[6], r[7]);
            *(v4u*)(ACT + (size_t)t * DFF + c0) = o;
        }
    }
}

namespace fa {
typedef float f32x16 __attribute__((ext_vector_type(16)));
constexpr int KBUF = 24576, VBUF = 16384, STG = KBUF + VBUF;
constexpr float THR = 8.0f;
__device__ __forceinline__ float hmax(float a) { return fmaxf(a, __shfl_xor(a, 32)); }
__device__ __forceinline__ float hsum(float a) { return a + __shfl_xor(a, 32); }
__device__ __forceinline__ bf16x8 pk8(const f32x16& p, int b) {
    v4u w; w.x = pg8::cvt_pk_bf16(p[b], p[b + 1]); w.y = pg8::cvt_pk_bf16(p[b + 2], p[b + 3]); w.z = pg8::cvt_pk_bf16(p[b + 4], p[b + 5]); w.w = pg8::cvt_pk_bf16(p[b + 6], p[b + 7]);
    return __builtin_bit_cast(bf16x8, w);
}
__device__ __forceinline__ void attn_fast(unsigned char* ws, LAS unsigned char* lds, int vcu, int G) {
    int tid = threadIdx.x; asm volatile("" : "+v"(tid));
    const int lane = tid & 63, w = __builtin_amdgcn_readfirstlane(tid >> 6), r32 = lane & 31, hi = lane >> 5;
    const bf16* QN = (const bf16*)(ws + WS_QN); const bf16* QR = (const bf16*)(ws + WS_QR); const bf16* KN = (const bf16*)(ws + WS_KN);
    const bf16* KPE = (const bf16*)(ws + WS_KPE); const bf16* VT = (const bf16*)(ws + WS_VT); bf16* ATT = (bf16*)(ws + WS_ATT);
    const int pr = (r32 & 0x13) | ((r32 & 4) << 1) | ((r32 & 8) >> 1);
    const int kfo = hi * 1024 + pr * 16;
    const int fb = (r32 >> 1) & 7, va = (hi ^ (fb & 1)) << 4, vbb = fb >> 1;
    const int vfo = KBUF + r32 * 128 + va;
    const int vrow0 = 16 * w + (lane >> 3), vrow1 = vrow0 + 8;
    const int vsc0 = ((lane & 7) ^ ((vrow0 >> 1) & 7)) * 8, vsc1 = ((lane & 7) ^ ((vrow1 >> 1) & 7)) * 8;
    for (int item = vcu; item < 256; item += G) {
        const int h = item >> 4, sidx = item & 15;
        const bf16* kn_l = KN + (size_t)lane * 2048 + h * 128 + 8 * w;
        const bf16* kp_l = KPE + (size_t)lane * 64 + 8 * w;
        const bf16* v0_l = VT + (size_t)(h * 128 + vrow0) * S_ + vsc0; const bf16* v1_l = VT + (size_t)(h * 128 + vrow1) * S_ + vsc1;
#define FA_ISSUE(t, st) do { const size_t ko_ = (size_t)(t) * 64 * 2048, po_ = (size_t)(t) * 64 * 64; const int to_ = (t) * 64; LAS unsigned char* sb_ = lds + (st) * STG; \
        __builtin_amdgcn_global_load_lds((const unsigned*)(kn_l + ko_), (LAS unsigned*)(sb_ + w * 1024), 16, 0, 0); \
        __builtin_amdgcn_global_load_lds((const unsigned*)(kn_l + ko_ + 64), (LAS unsigned*)(sb_ + (w + 8) * 1024), 16, 0, 0); \
        __builtin_amdgcn_global_load_lds((const unsigned*)(kp_l + po_), (LAS unsigned*)(sb_ + (w + 16) * 1024), 16, 0, 0); \
        __builtin_amdgcn_global_load_lds((const unsigned*)(v0_l + to_), (LAS unsigned*)(sb_ + KBUF + (2 * w) * 1024), 16, 0, 0); \
        __builtin_amdgcn_global_load_lds((const unsigned*)(v1_l + to_), (LAS unsigned*)(sb_ + KBUF + (2 * w + 1) * 1024), 16, 0, 0); } while (0)
        for (int pass = 0; pass < 2; ++pass) {
            const int qb = pass ? sidx : 31 - sidx, q0 = qb * 256, NT = 4 * qb + 4, qw = q0 + 32 * w, q = qw + r32;
            FA_ISSUE(0, 0);
            bf16x8 qr[12];
#pragma unroll
            for (int d0 = 0; d0 < 8; ++d0) qr[d0] = *(const bf16x8*)(QN + (size_t)q * 2048 + h * 128 + d0 * 16 + hi * 8);
#pragma unroll
            for (int d0 = 0; d0 < 4; ++d0) qr[8 + d0] = *(const bf16x8*)(QR + (size_t)q * 1024 + h * 64 + d0 * 16 + hi * 8);
            f32x16 o[4];
#pragma unroll
            for (int e = 0; e < 4; ++e)
#pragma unroll
                for (int r = 0; r < 16; ++r) o[e][r] = 0.f;
            float m = -__builtin_inff(), l = 0.f;
            for (int t = 0; t < NT; ++t) {
                VM_WAIT(); __syncthreads();
                if (t + 1 < NT) FA_ISSUE(t + 1, (t + 1) & 1);
                {
                    const LAS unsigned char* sb = lds + (t & 1) * STG;
                    f32x16 p0, p1;
#pragma unroll
                    for (int r = 0; r < 16; ++r) { p0[r] = 0.f; p1[r] = 0.f; }
                    {
#define FA_KLD(g, A0, A1, B0, B1) do { A0 = *(const LAS bf16x8*)(sb + kfo + (2 * (g)) * 2048); A1 = *(const LAS bf16x8*)(sb + kfo + (2 * (g)) * 2048 + 512); \
                                       B0 = *(const LAS bf16x8*)(sb + kfo + (2 * (g) + 1) * 2048); B1 = *(const LAS bf16x8*)(sb + kfo + (2 * (g) + 1) * 2048 + 512); } while (0)
#define FA_KMM(g, A0, A1, B0, B1) do { p0 = __builtin_amdgcn_mfma_f32_32x32x16_bf16(A0, qr[2 * (g)], p0, 0, 0, 0); p1 = __builtin_amdgcn_mfma_f32_32x32x16_bf16(A1, qr[2 * (g)], p1, 0, 0, 0); \
                                       p0 = __builtin_amdgcn_mfma_f32_32x32x16_bf16(B0, qr[2 * (g) + 1], p0, 0, 0, 0); p1 = __builtin_amdgcn_mfma_f32_32x32x16_bf16(B1, qr[2 * (g) + 1], p1, 0, 0, 0); } while (0)
                        bf16x8 xa0, xa1, xb0, xb1, ya0, ya1, yb0, yb1;
                        FA_KLD(0, xa0, xa1, xb0, xb1); __builtin_amdgcn_sched_barrier(0);
                        FA_KLD(1, ya0, ya1, yb0, yb1); __builtin_amdgcn_sched_barrier(0); FA_KMM(0, xa0, xa1, xb0, xb1); __builtin_amdgcn_sched_barrier(0);
                        FA_KLD(2, xa0, xa1, xb0, xb1); __builtin_amdgcn_sched_barrier(0); FA_KMM(1, ya0, ya1, yb0, yb1); __builtin_amdgcn_sched_barrier(0);
                        FA_KLD(3, ya0, ya1, yb0, yb1); __builtin_amdgcn_sched_barrier(0); FA_KMM(2, xa0, xa1, xb0, xb1); __builtin_amdgcn_sched_barrier(0);
                        FA_KLD(4, xa0, xa1, xb0, xb1); __builtin_amdgcn_sched_barrier(0); FA_KMM(3, ya0, ya1, yb0, yb1); __builtin_amdgcn_sched_barrier(0);
                        FA_KLD(5, ya0, ya1, yb0, yb1); __builtin_amdgcn_sched_barrier(0); FA_KMM(4, xa0, xa1, xb0, xb1); __builtin_amdgcn_sched_barrier(0);
                        FA_KMM(5, ya0, ya1, yb0, yb1);
#undef FA_KLD
#undef FA_KMM
                    }
                    if (64 * t + 63 > qw) {
                        const int kb = 64 * t + 8 * hi - q;
#pragma unroll
                        for (int r = 0; r < 16; ++r) { const int dk = kb + 16 * (r >> 3) + (r & 7); if (dk > 0) p0[r] = -__builtin_inff(); if (dk + 32 > 0) p1[r] = -__builtin_inff(); }
                    }
                    float mx = fmaxf(p0[0], p1[0]);
#pragma unroll
                    for (int r = 1; r < 16; ++r) mx = fmaxf(mx, fmaxf(p0[r], p1[r]));
                    mx = hmax(mx);
                    { const float mn = fmaxf(m, mx), alpha = __builtin_amdgcn_exp2f(m - mn); m = mn; l *= alpha;
#pragma unroll
                        for (int e = 0; e < 4; ++e)
#pragma unroll
                            for (int r = 0; r < 16; ++r) o[e][r] *= alpha; }
                    float ps = 0.f;
#pragma unroll
                    for (int r = 0; r < 16; ++r) { p0[r] = __builtin_amdgcn_exp2f(p0[r] - m); p1[r] = __builtin_amdgcn_exp2f(p1[r] - m); ps += p0[r] + p1[r]; }
                    l += ps;
                    const bf16x8 pf0 = pk8(p0, 0), pf1 = pk8(p0, 8), pf2 = pk8(p1, 0), pf3 = pk8(p1, 8);
                    const LAS unsigned char* vb0 = sb + vfo + ((0 ^ vbb) << 5); const LAS unsigned char* vb1 = sb + vfo + ((1 ^ vbb) << 5);
                    const LAS unsigned char* vb2 = sb + vfo + ((2 ^ vbb) << 5); const LAS unsigned char* vb3 = sb + vfo + ((3 ^ vbb) << 5);
#pragma unroll
                    for (int e = 0; e < 4; ++e) {
                        const bf16x8 a0 = *(const LAS bf16x8*)(vb0 + e * 4096), a1 = *(const LAS bf16x8*)(vb1 + e * 4096), a2 = *(const LAS bf16x8*)(vb2 + e * 4096), a3 = *(const LAS bf16x8*)(vb3 + e * 4096);
                        o[e] = __builtin_amdgcn_mfma_f32_32x32x16_bf16(a0, pf0, o[e], 0, 0, 0); o[e] = __builtin_amdgcn_mfma_f32_32x32x16_bf16(a1, pf1, o[e], 0, 0, 0);
                        o[e] = __builtin_amdgcn_mfma_f32_32x32x16_bf16(a2, pf2, o[e], 0, 0, 0); o[e] = __builtin_amdgcn_mfma_f32_32x32x16_bf16(a3, pf3, o[e], 0, 0, 0); }
                }
            }
            const float il = 1.0f / hsum(l);
            bf16* op = ATT + (size_t)q * 2048 + h * 128 + 4 * hi;
#pragma unroll
            for (int e = 0; e < 4; ++e)
#pragma unroll
                for (int g4 = 0; g4 < 4; ++g4) { v2u wv; wv.x = pg8::cvt_pk_bf16(o[e][4 * g4] * il, o[e][4 * g4 + 1] * il); wv.y = pg8::cvt_pk_bf16(o[e][4 * g4 + 2] * il, o[e][4 * g4 + 3] * il);
                    *(v2u*)(op + e * 32 + g4 * 8) = wv; }
            __syncthreads();
        }
#undef FA_ISSUE
    }
}
}

namespace hg {
typedef float f32x16 __attribute__((ext_vector_type(16)));
constexpr int L_TOT = 0, L_KT = 4096;
constexpr int L_QA = 4096, L_QB = 20480, L_KA0 = 28672, L_KA1 = 36864, L_SSP = 53248;
__device__ __forceinline__ float log2_(float x) { return __builtin_amdgcn_logf(x); }
__device__ __forceinline__ float exp2_(float x) { return __builtin_amdgcn_exp2f(x); }
__device__ __forceinline__ bf16x8 pk8(const f32x16& p, int b) {
    v4u w; w.x = pg8::cvt_pk_bf16(p[b], p[b + 1]); w.y = pg8::cvt_pk_bf16(p[b + 2], p[b + 3]); w.z = pg8::cvt_pk_bf16(p[b + 4], p[b + 5]); w.w = pg8::cvt_pk_bf16(p[b + 6], p[b + 7]);
    return __builtin_bit_cast(bf16x8, w);
}
#define HG_GATES(HFp, lbv, t0, h) \
    float kk[16], bl[16]; { float run_ = 0.f; const float* zp_ = (HFp) + (size_t)((t0) + 16 * tg) * 2048 + (h) * 128 + d; \
      _Pragma("unroll") for (int i = 0; i < 16; ++i) { const float z_ = zp_[(size_t)i * 2048]; const float f_ = (lbv) + (1.f - (lbv)) * sigm(z_); kk[i] = 1.f - f_; run_ += log2_(fmaxf(f_, 1e-30f)); bl[i] = run_; } }

__device__ __forceinline__ void pass1(unsigned char* ws, LAS unsigned char* lds, int layer, int vcu, int G) {
    int tid = threadIdx.x; asm volatile("" : "+v"(tid));
    const int lane = tid & 63, w = __builtin_amdgcn_readfirstlane(tid >> 6), d = tid & 127, tg = tid >> 7, r32 = lane & 31, hi = lane >> 5;
    const float* HF = (const float*)(ws + WS_HF); const bf16* VTH = (const bf16*)(ws + WS_VTH); bf16* HU = (bf16*)(ws + WS_HU); float* GAM = (float*)(ws + WS_RRAW);
    const float* LB = (const float*)(ws + WS_LB) + layer * 2048;
    LAS float* tot = (LAS float*)(lds + L_TOT); LAS unsigned char* KT = lds + L_KT;
    const int fsw = (d >> 1) & 7, fsr = (r32 >> 1) & 7, et = w >> 1, dt0 = 2 * (w & 1);
    for (int unit = vcu; unit < NH * 128; unit += G) {
        const int h = unit >> 7, c = unit & 127, t0 = c * 64;
        const float lb = LB[h * 128 + d];
        HG_GATES(HF, lb, t0, h);
        tot[tg * 128 + d] = bl[15];
        __syncthreads();
        float pre = 0.f, all = 0.f;
#pragma unroll
        for (int j = 0; j < 4; ++j) { const float v = tot[j * 128 + d]; pre += (j < tg) ? v : 0.f; all += v; }
        { float kh[16];
#pragma unroll
          for (int i = 0; i < 16; ++i) kh[i] = kk[i] * exp2_(all - (pre + bl[i]));
          v4u c0, c1; c0.x = pk2(kh[0], kh[1]); c0.y = pk2(kh[2], kh[3]); c0.z = pk2(kh[4], kh[5]); c0.w = pk2(kh[6], kh[7]);
          c1.x = pk2(kh[8], kh[9]); c1.y = pk2(kh[10], kh[11]); c1.z = pk2(kh[12], kh[13]); c1.w = pk2(kh[14], kh[15]);
          *(LAS v4u*)(KT + d * 128 + (((2 * tg) ^ fsw) << 4)) = c0; *(LAS v4u*)(KT + d * 128 + (((2 * tg + 1) ^ fsw) << 4)) = c1; }
        if (tg == 0) GAM[(size_t)(h * 128 + c) * 128 + d] = exp2_(all);
        bf16x8 af[4];
#pragma unroll
        for (int ks = 0; ks < 4; ++ks) af[ks] = *(const bf16x8*)(VTH + (size_t)(h * 128 + 32 * et + r32) * S_ + t0 + 16 * ks + 8 * hi);
        __syncthreads();
#pragma unroll
        for (int dd = 0; dd < 2; ++dd) { const int dt = dt0 + dd; f32x16 acc;
#pragma unroll
            for (int r = 0; r < 16; ++r) acc[r] = 0.f;
#pragma unroll
            for (int ks = 0; ks < 4; ++ks) { const bf16x8 bq = *(const LAS bf16x8*)(KT + (32 * dt + r32) * 128 + (((2 * ks + hi) ^ fsr) << 4)); acc = __builtin_amdgcn_mfma_f32_32x32x16_bf16(af[ks], bq, acc, 0, 0, 0); }
            bf16* up = HU + ((size_t)(h * 128 + c) * 128 + 32 * et + 4 * hi) * 128 + 32 * dt + r32;
#pragma unroll
            for (int r = 0; r < 16; ++r) up[(size_t)((r & 3) + 8 * (r >> 2)) * 128] = (bf16)f2bf(acc[r]); }
        __syncthreads();
    }
}
__device__ __forceinline__ void scan(unsigned char* ws, int gtid, int nthr) {
    const bf16* HU = (const bf16*)(ws + WS_HU); const float* GAM = (const float*)(ws + WS_RRAW); bf16* HS = (bf16*)(ws + WS_HS);
    for (int idx = gtid; idx < NH * 128 * 64; idx += nthr) {
        const int h = idx >> 13, e = (idx >> 6) & 127, d = 2 * (idx & 63);
        float s0 = 0.f, s1 = 0.f;
#pragma unroll 8
        for (int c = 0; c < 128; ++c) { const size_t base = ((size_t)(h * 128 + c) * 128 + e) * 128 + d;
            *(unsigned*)(HS + base) = pk2(s0, s1);
            const unsigned u = *(const unsigned*)(HU + base); const f32x2 gm = *(const f32x2*)(GAM + (size_t)(h * 128 + c) * 128 + d);
            s0 = gm.x * s0 + bflo(u); s1 = gm.y * s1 + bfhi(u); }
    }
}
__device__ __forceinline__ void pass3(unsigned char* ws, LAS unsigned char* lds, const float* gain, int layer, int vcu, int G) {
    int tid = threadIdx.x; asm volatile("" : "+v"(tid));
    const int lane = tid & 63, w = __builtin_amdgcn_readfirstlane(tid >> 6), d = tid & 127, tg = tid >> 7, r32 = lane & 31, hi = lane >> 5;
    const float* HF = (const float*)(ws + WS_HF); const bf16* HQ = (const bf16*)(ws + WS_HQ); const bf16* HG = (const bf16*)(ws + WS_HG); const bf16* VTH = (const bf16*)(ws + WS_VTH);
    const bf16* HS = (const bf16*)(ws + WS_HS); bf16* REC = (bf16*)(ws + WS_REC); const float* LB = (const float*)(ws + WS_LB) + layer * 2048;
    LAS float* tot = (LAS float*)(lds + L_TOT); LAS float* SSP = (LAS float*)(lds + L_SSP);
    const int et = w & 3, tb = w >> 2, pr = (r32 & 0x13) | ((r32 & 4) << 1) | ((r32 & 8) >> 1);
    const int eo = (d >> 3) * 16, ei = (d & 7) * 2;
    for (int unit = vcu; unit < NH * 128; unit += G) {
        const int h = unit >> 7, c = unit & 127, t0 = c * 64;
        const float lb = LB[h * 128 + d];
        HG_GATES(HF, lb, t0, h);
        float qv[16];
        { const bf16* qp = HQ + (size_t)(t0 + 16 * tg) * 2048 + h * 128 + d;
#pragma unroll
          for (int i = 0; i < 16; ++i) qv[i] = __builtin_bit_cast(float, (unsigned)qp[(size_t)i * 2048] << 16); }
        tot[tg * 128 + d] = bl[15];
        __syncthreads();
        const float t_0 = tot[d], t_1 = tot[128 + d], t_2 = tot[256 + d];
        const float pre = (tg > 0 ? t_0 : 0.f) + (tg > 1 ? t_1 : 0.f) + (tg > 2 ? t_2 : 0.f), b31 = t_0 + t_1;
#pragma unroll
        for (int i = 0; i < 16; ++i) { const float b = pre + bl[i]; const int row = 16 * tg + i;
            *(LAS bf16*)(lds + L_QA + eo * 64 + row * 16 + ei) = (bf16)f2bf(qv[i] * exp2_(b));
            *(LAS bf16*)(lds + L_KA1 + eo * 64 + row * 16 + ei) = (bf16)f2bf(kk[i] * exp2_(b31 - b));
            if (tg < 2) *(LAS bf16*)(lds + L_KA0 + eo * 32 + row * 16 + ei) = (bf16)f2bf(kk[i] * exp2_(-b));
            else *(LAS bf16*)(lds + L_QB + eo * 32 + (row - 32) * 16 + ei) = (bf16)f2bf(qv[i] * exp2_(b - b31)); }
        __syncthreads();
        f32x16 o;
#pragma unroll
        for (int r = 0; r < 16; ++r) o[r] = 0.f;
        { const bf16* sp = HS + ((size_t)(h * 128 + c) * 128 + 32 * et + r32) * 128 + 8 * hi; const LAS unsigned char* qb_ = lds + L_QA + hi * 1024 + (32 * tb + r32) * 16;
#pragma unroll
          for (int kd = 0; kd < 8; ++kd) { const bf16x8 a = *(const bf16x8*)(sp + 16 * kd); const bf16x8 b = *(const LAS bf16x8*)(qb_ + kd * 2048); o = __builtin_amdgcn_mfma_f32_32x32x16_bf16(a, b, o, 0, 0, 0); } }
        const bf16* vp = VTH + (size_t)(h * 128 + 32 * et + r32) * S_ + t0 + 8 * hi;
        if (tb == 0) {
            f32x16 p;
#pragma unroll
            for (int r = 0; r < 16; ++r) p[r] = 0.f;
            const LAS unsigned char* ka = lds + L_KA0 + hi * 512 + pr * 16; const LAS unsigned char* qa = lds + L_QA + hi * 1024 + r32 * 16;
#pragma unroll
            for (int kd = 0; kd < 8; ++kd) p = __builtin_amdgcn_mfma_f32_32x32x16_bf16(*(const LAS bf16x8*)(ka + kd * 1024), *(const LAS bf16x8*)(qa + kd * 2048), p, 0, 0, 0);
#pragma unroll
            for (int r = 0; r < 16; ++r) if (16 * (r >> 3) + 8 * hi + (r & 7) > r32) p[r] = 0.f;
            o = __builtin_amdgcn_mfma_f32_32x32x16_bf16(*(const bf16x8*)(vp), pk8(p, 0), o, 0, 0, 0);
            o = __builtin_amdgcn_mfma_f32_32x32x16_bf16(*(const bf16x8*)(vp + 16), pk8(p, 8), o, 0, 0, 0);
        } else {
            f32x16 p0, p1;
#pragma unroll
            for (int r = 0; r < 16; ++r) { p0[r] = 0.f; p1[r] = 0.f; }
            const LAS unsigned char* ka = lds + L_KA1 + hi * 1024 + pr * 16; const LAS unsigned char* qa = lds + L_QB + hi * 512 + r32 * 16;
#pragma unroll
            for (int kd = 0; kd < 8; ++kd) { const bf16x8 qf = *(const LAS bf16x8*)(qa + kd * 1024);
                p0 = __builtin_amdgcn_mfma_f32_32x32x16_bf16(*(const LAS bf16x8*)(ka + kd * 2048), qf, p0, 0, 0, 0);
                p1 = __builtin_amdgcn_mfma_f32_32x32x16_bf16(*(const LAS bf16x8*)(ka + kd * 2048 + 512), qf, p1, 0, 0, 0); }
#pragma unroll
            for (int r = 0; r < 16; ++r) if (16 * (r >> 3) + 8 * hi + (r & 7) > r32) p1[r] = 0.f;
            o = __builtin_amdgcn_mfma_f32_32x32x16_bf16(*(const bf16x8*)(vp), pk8(p0, 0), o, 0, 0, 0);
            o = __builtin_amdgcn_mfma_f32_32x32x16_bf16(*(const bf16x8*)(vp + 16), pk8(p0, 8), o, 0, 0, 0);
            o = __builtin_amdgcn_mfma_f32_32x32x16_bf16(*(const bf16x8*)(vp + 32), pk8(p1, 0), o, 0, 0, 0);
            o = __builtin_amdgcn_mfma_f32_32x32x16_bf16(*(const bf16x8*)(vp + 48), pk8(p1, 8), o, 0, 0, 0);
        }
        float ss = 0.f;
#pragma unroll
        for (int r = 0; r < 16; ++r) ss += o[r] * o[r];
        ss += __shfl_xor(ss, 32);
        if (hi == 0) SSP[(tb * 4 + et) * 32 + r32] = ss;
        __syncthreads();
        const float rstd = 1.0f / sqrtf((SSP[(tb * 4 + 0) * 32 + r32] + SSP[(tb * 4 + 1) * 32 + r32] + SSP[(tb * 4 + 2) * 32 + r32] + SSP[(tb * 4 + 3) * 32 + r32]) * (1.f / 128.f) + EPS);
        { const size_t ro = (size_t)(t0 + 32 * tb + r32) * 2048 + h * 128 + 32 * et + 4 * hi;
#pragma unroll
          for (int g4 = 0; g4 < 4; ++g4) { const f32x4 gn = *(const GAS f32x4*)(gain + 32 * et + 4 * hi + 8 * g4); const v2u hv = *(const v2u*)(HG + ro + 8 * g4);
              v2u ov; ov.x = pk2(o[4 * g4] * rstd * gn.x * bflo(hv.x), o[4 * g4 + 1] * rstd * gn.y * bfhi(hv.x)); ov.y = pk2(o[4 * g4 + 2] * rstd * gn.z * bflo(hv.y), o[4 * g4 + 3] * rstd * gn.w * bfhi(hv.y));
              *(v2u*)(REC + ro + 8 * g4) = ov; } }
        __syncthreads();
    }
}
#undef HG_GATES
}

#ifndef PROBE
#define PROBE 0
#endif
#define REPS(k) (((PROBE >> (k)) & 1) + 1)
#define XBAR(b) do { for (int rb_ = 0; rb_ < REPS(8); ++rb_) xcd_barrier(b); } while (0)
#ifndef NAIVE_ATTN
#define NAIVE_ATTN 0
#endif
#ifndef NAIVE_HGRN
#define NAIVE_HGRN 0
#endif
struct Args { const float* in[19]; float* out; unsigned char* ws; };
enum { I_X = 0, I_POS, I_ANG, I_WIN, I_QNG, I_WUQ, I_KVNG, I_WUKV, I_LBL, I_HONG, I_WA, I_WB, I_WO, I_FNG, I_WUP, I_CW, I_CB, I_WDN, I_FING };

__global__ void __launch_bounds__(NTHR, 2) mk_fwd(Args args) {
    extern __shared__ __attribute__((aligned(16))) unsigned char lds_raw[];
    LAS unsigned char* lds = (LAS unsigned char*)lds_raw;
    const int tid = threadIdx.x, lane = tid & 63, wave = __builtin_amdgcn_readfirstlane(tid >> 6);
    const int G = gridDim.x, bx = blockIdx.x, vcu = (G % 8 == 0) ? (bx % 8) * (G / 8) + bx / 8 : bx;
    const int gw = vcu * NWAVES + wave, ngw = G * NWAVES;
    unsigned char* ws = args.ws;
    for (int u = tid; u < (LDS_BYTES - LDSCTL_OFF) / 4; u += NTHR) ((LAS unsigned*)(lds + LDSCTL_OFF))[u] = 0u;
    __syncthreads();
    XcdBarrier bar = xcd_barrier_post((unsigned*)(ws + WS_CTL) + CW_BAR, (volatile LAS unsigned*)(lds + MISC_OFF) + 8);
    float* X = args.out;
    if (tid < 19) ((LAS unsigned long long*)(lds + MISC_OFF + 128))[tid] = ((const __attribute__((address_space(4))) unsigned long long*)__builtin_amdgcn_kernarg_segment_ptr())[tid];
    __syncthreads();
#define INP(i) ((const float*)(((unsigned long long)(unsigned)__builtin_amdgcn_readfirstlane((int)(((LAS const unsigned long long*)(lds + MISC_OFF + 128))[i] >> 32)) << 32) | (unsigned long long)(unsigned)__builtin_amdgcn_readfirstlane((int)(unsigned)((LAS const unsigned long long*)(lds + MISC_OFF + 128))[i])))

    for (int rep = 0; rep < REPS(4); ++rep) {
        LAS float* scr = (LAS float*)(lds + RING_OFF + wave * 16384);
        constexpr int I_IN = 32 * (WINR / 32), I_UQ = 8 * 96, I_K = 8 * 64, I_V = 8 * 64, I_SQ = 32 * 64, I_UP = 32 * 352, I_DN = 88 * 64;
        constexpr int PER_LAYER = I_IN + I_UQ + I_K + I_V + 3 * I_SQ + I_UP + I_DN;
        const float* p_win = INP(I_WIN); const float* p_wuq = INP(I_WUQ); const float* p_wukv = INP(I_WUKV); const float* p_wa = INP(I_WA); const float* p_wb = INP(I_WB);
        const float* p_wo = INP(I_WO); const float* p_wup = INP(I_WUP); const float* p_wdn = INP(I_WDN); const float* p_qg = INP(I_QNG); const float* p_kvg = INP(I_KVNG);
#define T_DECODE(it, T) do { const int l_ = (it) / PER_LAYER; int r_ = (it) % PER_LAYER; unsigned char* wl_ = ws + WS_W + (size_t)l_ * LW; int kind_, nblk_; (T).scale = nullptr; \
        if (r_ < I_IN) { kind_ = 1; nblk_ = WINR / 32; (T).src = p_win + (size_t)l_ * DM * INW; (T).K = DM; (T).Nsrc = INW; (T).dst = (bf16*)(wl_ + LW_IN); } \
        else if ((r_ -= I_IN) < I_UQ) { kind_ = 2; nblk_ = 96; (T).src = p_wuq + (size_t)l_ * QL * 3072; (T).K = QL; (T).Nsrc = 3072; (T).dst = (bf16*)(wl_ + LW_UQ); (T).scale = p_qg + l_ * QL; } \
        else if ((r_ -= I_UQ) < I_K) { kind_ = 3; nblk_ = 64; (T).src = p_wukv + (size_t)l_ * KVL * 4096; (T).K = KVL; (T).Nsrc = 4096; (T).dst = (bf16*)(wl_ + LW_K); (T).scale = p_kvg + l_ * KVL; } \
        else if ((r_ -= I_K) < I_V) { kind_ = 4; nblk_ = 64; (T).src = p_wukv + (size_t)l_ * KVL * 4096; (T).K = KVL; (T).Nsrc = 4096; (T).dst = (bf16*)(wl_ + LW_V); (T).scale = p_kvg + l_ * KVL; } \
        else if ((r_ -= I_V) < I_SQ) { kind_ = 0; nblk_ = 64; (T).src = p_wa + (size_t)l_ * DM * DM; (T).K = DM; (T).Nsrc = DM; (T).dst = (bf16*)(wl_ + LW_A); } \
        else if ((r_ -= I_SQ) < I_SQ) { kind_ = 0; nblk_ = 64; (T).src = p_wb + (size_t)l_ * DM * DM; (T).K = DM; (T).Nsrc = DM; (T).dst = (bf16*)(wl_ + LW_B); } \
        else if ((r_ -= I_SQ) < I_SQ) { kind_ = 0; nblk_ = 64; (T).src = p_wo + (size_t)l_ * DM * DM; (T).K = DM; (T).Nsrc = DM; (T).dst = (bf16*)(wl_ + LW_O); } \
        else if ((r_ -= I_SQ) < I_UP) { kind_ = 5; nblk_ = 352; (T).src = p_wup + (size_t)l_ * DM * DFF2; (T).K = DM; (T).Nsrc = DFF2; (T).dst = (bf16*)(wl_ + LW_UP); } \
        else { r_ -= I_UP; kind_ = 0; nblk_ = 64; (T).src = p_wdn + (size_t)l_ * DFF * DM; (T).K = DFF; (T).Nsrc = DM; (T).dst = (bf16*)(wl_ + LW_DN); } \
        (T).k0 = 64 * (r_ / nblk_); (T).n0 = 32 * (r_ % nblk_); (T).sc = srcmap_rt(kind_, (T).n0 + (lane & 31)); } while (0)
#define T_LOAD(T, V) do { const GAS float* sp_ = (const GAS float*)(T).src + (size_t)((T).k0 + (lane >> 5)) * (T).Nsrc + ((T).sc >= 0 ? (T).sc : 0); \
        _Pragma("unroll") for (int i = 0; i < 32; ++i) (V)[i] = sp_[(size_t)(2 * i) * (T).Nsrc]; } while (0)
#define T_PROC(T, V) do { const bool z_ = (T).sc < 0; \
        if ((T).scale) { const GAS float* gp_ = (const GAS float*)(T).scale + (T).k0 + (lane >> 5); _Pragma("unroll") for (int i = 0; i < 32; ++i) (V)[i] *= gp_[2 * i]; } \
        _Pragma("unroll") for (int i = 0; i < 32; ++i) scr[(2 * i + (lane >> 5)) * 33 + (lane & 31)] = z_ ? 0.f : (V)[i]; \
        LDS_WAIT(); asm volatile("" ::: "memory"); \
        { const int c_ = lane & 7; _Pragma("unroll") for (int j = 0; j < 4; ++j) { const int n_ = (lane >> 3) + 8 * j; const LAS float* s_ = scr + (8 * c_) * 33 + n_; \
            v4u o_; o_.x = pk2(s_[0 * 33], s_[1 * 33]); o_.y = pk2(s_[2 * 33], s_[3 * 33]); o_.z = pk2(s_[4 * 33], s_[5 * 33]); o_.w = pk2(s_[6 * 33], s_[7 * 33]); \
            *(GAS v4u*)((T).dst + (size_t)((T).n0 + n_) * (T).K + (T).k0 + 8 * c_) = o_; } } \
        LDS_WAIT(); asm volatile("" ::: "memory"); } while (0)
        { TItem ta, tb; float va[32], vb[32]; int it = gw; const int NIT = DEPTH * PER_LAYER;
          if (it < NIT) { T_DECODE(it, ta); T_LOAD(ta, va); }
          while (it < NIT) {
              const int it1 = it + ngw; if (it1 < NIT) { T_DECODE(it1, tb); T_LOAD(tb, vb); }
              T_PROC(ta, va);
              if (it1 >= NIT) break;
              const int it2 = it1 + ngw; if (it2 < NIT) { T_DECODE(it2, ta); T_LOAD(ta, va); }
              T_PROC(tb, vb);
              it = it2; } }
#undef T_DECODE
#undef T_LOAD
#undef T_PROC
        { const GAS int* pos = (const GAS int*)INP(I_POS); float* COS = (float*)(ws + WS_COS); float* SIN = (float*)(ws + WS_SIN);
          for (int i = vcu * NTHR + tid; i < S_ * 32; i += G * NTHR) { const float ang = (float)pos[i >> 5] * c_invf[i & 31]; float sn, cs; sincos_f64(ang, sn, cs); COS[i] = cs; SIN[i] = sn; } }
        { const GAS float* lg = (const GAS float*)INP(I_LBL); float* LB = (float*)(ws + WS_LB);
          for (int c = vcu * NTHR + tid; c < 2048; c += G * NTHR) { const float a0 = lg[c], a1 = lg[2048 + c], a2 = lg[4096 + c], a3 = lg[6144 + c];
              const float mx = fmaxf(fmaxf(a0, a1), fmaxf(a2, a3)); const float e0 = expf(a0 - mx), e1 = expf(a1 - mx), e2 = expf(a2 - mx), e3 = expf(a3 - mx); const float inv = 1.f / (e0 + e1 + e2 + e3);
              LB[c] = 0.f; LB[2048 + c] = e1 * inv; LB[4096 + c] = (e1 + e2) * inv; LB[6144 + c] = (e1 + e2 + e3) * inv; } }
        for (int m = gw; m < S_; m += ngw) rms_row_to_bf16(INP(I_X) + (size_t)m * DM, INP(I_ANG), (bf16*)(ws + WS_XN) + (size_t)m * DM, X + (size_t)m * DM, lane);
    }
    XBAR(bar);

    for (int l = 0; l < DEPTH; ++l) {
        unsigned char* wl = ws + WS_W + (size_t)l * LW;
#define lane_l ({ int l_ = lane; asm volatile("" : "+v"(l_)); l_; })
        GAS unsigned char* wsg_ = (GAS unsigned char*)ws; GAS float* xg_ = (GAS float*)X; int Gl = G, bxl = bx, gwl = gw, ngwl = ngw, vcul = vcu;
        asm volatile("" : "+s"(wsg_), "+s"(Gl), "+s"(bxl), "+s"(gwl), "+s"(ngwl), "+s"(vcul), "+s"(xg_));
        unsigned char* wsl = (unsigned char*)wsg_; float* Xl = (float*)xg_;
        for (int rep = 0; rep < REPS(1); ++rep)
        { pg8::Gemm g{(const pg8::bf16_t*)(wsl + WS_XN), (const pg8::bf16_t*)(wl + LW_IN), S_, NNAT, DM, DM, DM}; pg8::StaticOrder S; S.init(S_, NNAT, Gl, bxl);
          pg8::EpiIn E{wsl}; pg8::gemm_phase<pg8::EpiIn, pg8::StaticOrder, true, true>(lds + RING_OFF, g, S, E); }
        { pg8::Gemm g{(const pg8::bf16_t*)(wl + LW_IN) + (size_t)NNAT * DM, (const pg8::bf16_t*)(wsl + WS_XN), 2048, S_, DM, DM, DM}; pg8::StaticOrder S; S.init(2048, S_, Gl, bxl);
          pg8::EpiStore E{(pg8::bf16_t*)(wsl + WS_VTH), S_}; pg8::gemm_phase<pg8::EpiStore, pg8::StaticOrder, true, true>(lds + RING_OFF, g, S, E); }
        XBAR(bar);
        for (int rep = 0; rep < REPS(3); ++rep) for (int m = gwl; m < S_; m += ngwl) latent_norm_row((bf16*)(wsl + WS_CQKV) + (size_t)m * 1024, lane_l);
        XBAR(bar);
        for (int rep = 0; rep < REPS(6); ++rep) {
        { pg8::Gemm g{(const pg8::bf16_t*)(wsl + WS_CQKV), (const pg8::bf16_t*)(wl + LW_UQ), S_, 3072, QL, 1024, QL}; pg8::StaticOrder S; S.init(S_, 3072, Gl, bxl);
          pg8::EpiQ E{wsl}; pg8::gemm_phase<pg8::EpiQ, pg8::StaticOrder, true, true>(lds + RING_OFF, g, S, E); }
        { pg8::Gemm g{(const pg8::bf16_t*)(wsl + WS_CQKV) + 512, (const pg8::bf16_t*)(wl + LW_K), S_, 2048, KVL, 1024, KVL}; pg8::StaticOrder S; S.init(S_, 2048, Gl, bxl);
          pg8::EpiStore E{(pg8::bf16_t*)(wsl + WS_KN), 2048}; pg8::gemm_phase<pg8::EpiStore, pg8::StaticOrder, true, true>(lds + RING_OFF, g, S, E); }
        { pg8::Gemm g{(const pg8::bf16_t*)(wl + LW_V), (const pg8::bf16_t*)(wsl + WS_CQKV) + 512, 2048, S_, KVL, KVL, 1024}; pg8::StaticOrder S; S.init(2048, S_, Gl, bxl);
          pg8::EpiStore E{(pg8::bf16_t*)(wsl + WS_VT), S_}; pg8::gemm_phase<pg8::EpiStore, pg8::StaticOrder, true, true>(lds + RING_OFF, g, S, E); }
        }
#if NAIVE_HGRN
        hgrn_naive(wsl, l, gwl, ngwl, lane_l);
        XBAR(bar);
#else
        for (int rep = 0; rep < REPS(2); ++rep) hg::pass1(wsl, lds + RING_OFF, l, vcul, Gl);
        XBAR(bar);
        for (int rep = 0; rep < REPS(2); ++rep) hg::scan(wsl, vcul * NTHR + (int)threadIdx.x, Gl * NTHR);
        XBAR(bar);
#endif
#if NAIVE_ATTN
        attn_naive(wsl, (LAS float*)(lds + RING_OFF) + wave * 192, gwl, ngwl, lane_l);
#else
        for (int rep = 0; rep < REPS(0); ++rep) fa::attn_fast(wsl, lds + RING_OFF, vcul, Gl);
#endif
#if NAIVE_HGRN
        hgrn_normgate(wsl, INP(I_HONG) + l * 128, gwl, ngwl, lane_l);
#else
        for (int rep = 0; rep < REPS(2); ++rep) hg::pass3(wsl, lds + RING_OFF, INP(I_HONG) + l * 128, l, vcul, Gl);
#endif
        XBAR(bar);
        for (int rep = 0; rep < REPS(7); ++rep) {
        { pg8::Gemm g{(const pg8::bf16_t*)(wsl + WS_ATT), (const pg8::bf16_t*)(wl + LW_A), S_, DM, DM, DM, DM}; pg8::StaticOrder S; S.init(S_, DM, Gl, bxl);
          pg8::EpiGateA E{wsl}; pg8::gemm_phase<pg8::EpiGateA, pg8::StaticOrder, true, true>(lds + RING_OFF, g, S, E); }
        { pg8::Gemm g{(const pg8::bf16_t*)(wsl + WS_REC), (const pg8::bf16_t*)(wl + LW_B), S_, DM, DM, DM, DM}; pg8::StaticOrder S; S.init(S_, DM, Gl, bxl);
          pg8::EpiGateB E{wsl}; pg8::gemm_phase<pg8::EpiGateB, pg8::StaticOrder, true, true>(lds + RING_OFF, g, S, E); }
        }
        XBAR(bar);
        { pg8::Gemm g{(const pg8::bf16_t*)(wsl + WS_MRG), (const pg8::bf16_t*)(wl + LW_O), S_, DM, DM, DM, DM}; pg8::StaticOrder S; S.init(S_, DM, Gl, bxl);
          pg8::EpiRes E{Xl}; pg8::gemm_phase<pg8::EpiRes, pg8::StaticOrder, true, true>(lds + RING_OFF, g, S, E); }
        XBAR(bar);
        for (int rep = 0; rep < REPS(3); ++rep) for (int m = gwl; m < S_; m += ngwl) rms_row_to_bf16(Xl + (size_t)m * DM, INP(I_FNG) + l * DM, (bf16*)(wsl + WS_XN) + (size_t)m * DM, nullptr, lane_l);
        XBAR(bar);
        for (int rep = 0; rep < REPS(5); ++rep)
        { pg8::Gemm g{(const pg8::bf16_t*)(wsl + WS_XN), (const pg8::bf16_t*)(wl + LW_UP), S_, DFF2, DM, DM, DM}; pg8::StaticOrder S; S.init(S_, DFF2, Gl, bxl);
          pg8::EpiStore E{(pg8::bf16_t*)(wsl + WS_U), DFF2}; pg8::gemm_phase<pg8::EpiStore, pg8::StaticOrder, true, true>(lds + RING_OFF, g, S, E); }
        XBAR(bar);
        for (int rep = 0; rep < REPS(3); ++rep) conv_gate(wsl, INP(I_CW) + (size_t)l * 3 * DFF2, INP(I_CB) + (size_t)l * DFF2, gwl, ngwl, lane_l);
        XBAR(bar);
        { pg8::Gemm g{(const pg8::bf16_t*)(wsl + WS_ACT), (const pg8::bf16_t*)(wl + LW_DN), S_, DM, DFF, DFF, DFF}; pg8::StaticOrder S; S.init(S_, DM, Gl, bxl);
          pg8::EpiRes E{Xl}; pg8::gemm_phase<pg8::EpiRes, pg8::StaticOrder, true, true>(lds + RING_OFF, g, S, E); }
        XBAR(bar);
        if (l + 1 < DEPTH) { for (int rep = 0; rep < REPS(3); ++rep) for (int m = gwl; m < S_; m += ngwl) rms_row_to_bf16(Xl + (size_t)m * DM, INP(I_ANG) + (l + 1) * DM, (bf16*)(wsl + WS_XN) + (size_t)m * DM, nullptr, lane_l);
            XBAR(bar); }
        else { for (int m = gwl; m < S_; m += ngwl) rms_row_f32(Xl + (size_t)m * DM, INP(I_FING), lane_l); }
    }
}

#undef lane_l
extern "C" void kernel_launch(void* const* d_in, const int* in_sizes, int n_in, void* d_out, int out_size, void* d_ws, size_t ws_size, hipStream_t stream) {
    static int grid = 0;
    if (grid == 0) {
        if (n_in != 19 || in_sizes[0] != S_ * DM || out_size != S_ * DM || ws_size < WS_END) { fprintf(stderr, "kernel_launch: shape/workspace mismatch (n_in %d, in0 %d, out %d, ws %zu need %zu)\n", n_in, n_in > 0 ? in_sizes[0] : -1, out_size, ws_size, (size_t)WS_END); grid = -1; return; }
        int dev = 0, cus = 0, per_cu = 0;
        if (hipGetDevice(&dev) != hipSuccess || hipDeviceGetAttribute(&cus, hipDeviceAttributeMultiprocessorCount, dev) != hipSuccess) { grid = -1; return; }
        if (hipFuncSetAttribute((const void*)mk_fwd, hipFuncAttributeMaxDynamicSharedMemorySize, LDS_BYTES) != hipSuccess) { fprintf(stderr, "kernel_launch: hipFuncSetAttribute failed\n"); grid = -1; return; }
        if (hipOccupancyMaxActiveBlocksPerMultiprocessor(&per_cu, (const void*)mk_fwd, NTHR, LDS_BYTES) != hipSuccess || per_cu < 1) { fprintf(stderr, "kernel_launch: occupancy query reports %d blocks per CU\n", per_cu); }
        (void)hipGetLastError();
        grid = cus;
    }
    if (grid < 0) return;
    if (hipMemsetAsync((char*)d_ws + WS_CTL, 0, CTL_ZERO_BYTES, stream) != hipSuccess) return;
    Args a{};
    for (int i = 0; i < 19; ++i) a.in[i] = (const float*)d_in[i];
    a.out = (float*)d_out; a.ws = (unsigned char*)d_ws;
    hipLaunchKernelGGL(mk_fwd, dim3(grid), dim3(NTHR), LDS_BYTES, stream, a);
}
```

```cpp
#include <hip/hip_runtime.h>
#include <cstdio>
#include <cstdint>
namespace pg8 {
#define PG8_LAS __attribute__((address_space(3)))
typedef unsigned short bf16_t;
typedef short bf16x8 __attribute__((ext_vector_type(8)));
typedef float f32x4 __attribute__((ext_vector_type(4)));
typedef unsigned u32x4 __attribute__((ext_vector_type(4)));
constexpr int BM = 256, BK = 64, HALF = 128, HTB = HALF * BK * 2  , STAGE_BYTES = 8 * HTB, NXCD = 8, WGM = 8;

__host__ __device__ __forceinline__ int lds_byte(int r, int c) { const int st = (r >> 4) * 2 + (c >> 5), rr = r & 15, cc = c & 31, ob = rr * 64 + cc * 2; return st * 1024 + (ob ^ (((ob >> 9) & 1) << 5)); }
__host__ __device__ __forceinline__ void stage_rc(int b, int& R, int& C) { const int st = b / 1024, sb = b % 1024, swz = sb ^ (((sb >> 9) & 1) << 5); R = (st >> 1) * 16 + swz / 64; C = (st & 1) * 32 + (swz % 64) / 2; }
__host__ __device__ __forceinline__ int perm32(int rho) { const int n = rho >> 4, i = rho & 15; return 8 * (i >> 2) + 4 * n + (i & 3); }

struct Unit { int pm, pn; };
struct Gemm { const bf16_t* A; const bf16_t* Bt; int M, N, K, lda, ldb; int mstep = BM; };

struct StaticOrder {
    int nM, nN, nwg, G, c;
    __host__ __device__ void init(int M, int N, int G_, int c_) { nM = M / BM; nN = N / BM; nwg = nM * nN; G = G_; c = c_; }
    __host__ __device__ bool next(int i, Unit& u) const {
        const long L = (long)i * G + c; if (L >= nwg) return false;
        int wgid = (int)L; { const int q = nwg / NXCD, r = nwg % NXCD, xcd = wgid % NXCD, off = wgid / NXCD; wgid = (xcd < r ? xcd * (q + 1) : r * (q + 1) + (xcd - r) * q) + off; }
        const int nig = WGM * nN, gid = wgid / nig, fm = gid * WGM, gsz = (nM - fm) < WGM ? (nM - fm) : WGM;
        u.pm = fm + ((wgid % nig) % gsz); u.pn = (wgid % nig) / gsz; return true;
    }
    __device__ __forceinline__ void a_ready(const Unit&) const {}
    __device__ __forceinline__ void done(const Unit&) const {}
};

__device__ __forceinline__ unsigned cvt_pk_bf16(float lo, float hi) { unsigned r; asm volatile("v_cvt_pk_bf16_f32 %0, %1, %2" : "=v"(r) : "v"(lo), "v"(hi)); return r; }
template <class Epi, class Sched, bool ALIGN_EPI = false, bool SP2 = false>
__device__ __forceinline__ void gemm_phase(PG8_LAS unsigned char* lds, const Gemm g, const Sched& S, const Epi& E) {
    int tid = threadIdx.x; asm volatile("" : "+v"(tid));
    const int wid = __builtin_amdgcn_readfirstlane(tid >> 6), lane = tid & 63, wr = wid >> 2, wc = wid & 3, fr = lane & 15, fq = lane >> 4;
    const int K = g.K, nt = K / BK;
    unsigned voffA[2], voffB[2];
#pragma unroll
    for (int i = 0; i < 2; ++i) { int R, C; stage_rc(tid * 16 + i * 8192, R, C); const int Rb = Epi::PERM ? ((R & ~31) + perm32(R & 31)) : R;
        voffA[i] = (unsigned)(R * g.lda + C) * 2u; voffB[i] = (unsigned)(Rb * g.ldb + C) * 2u; }
    const size_t kstep = (size_t)(BK * 2);
    const size_t hstepA = (size_t)HALF * g.lda * 2, hstepB = (size_t)HALF * g.ldb * 2;
    const size_t tstepA = (size_t)g.mstep * g.lda * 2, tstepB = 2 * hstepB;
    const unsigned ldsw = (unsigned)wid * 1024u;
    const int aoff = lds_byte(wr * 64 + fr, fq * 8), boff = lds_byte(wc * 32 + fr, fq * 8);
#define PG8_SA(b, h) (((b) * 2 + (h)) * HTB)
#define PG8_SB(b, h) ((4 + (b) * 2 + (h)) * HTB)
#define PG8_STAGE(bufoff, gbase, voff) do { _Pragma("unroll") for (int _i = 0; _i < 2; ++_i) \
        __builtin_amdgcn_global_load_lds((const unsigned*)((const char*)(gbase) + (voff)[_i]), (PG8_LAS unsigned*)(lds + (bufoff) + ldsw + _i * 8192), 16, 0, 0); } while (0)
#define PG8_LDA(dst, b, h) do { _Pragma("unroll") for (int m = 0; m < 4; ++m) _Pragma("unroll") for (int k = 0; k < 2; ++k) dst[m][k] = *(const PG8_LAS bf16x8*)(lds + PG8_SA(b, h) + aoff + m * 2048 + k * 1024); } while (0)
#define PG8_LDB(dst, b, h) do { _Pragma("unroll") for (int n = 0; n < 2; ++n) _Pragma("unroll") for (int k = 0; k < 2; ++k) dst[n][k] = *(const PG8_LAS bf16x8*)(lds + PG8_SB(b, h) + boff + n * 2048 + k * 1024); } while (0)
#define PG8_MMA(ai, bj, At, Bt) do { __builtin_amdgcn_s_setprio(1); _Pragma("unroll") for (int m = 0; m < 4; ++m) _Pragma("unroll") for (int n = 0; n < 2; ++n) _Pragma("unroll") for (int k = 0; k < 2; ++k) \
        acc[ai][bj][m][n] = __builtin_amdgcn_mfma_f32_16x16x32_bf16(Bt[n][k], At[m][k], acc[ai][bj][m][n], 0, 0, 0); __builtin_amdgcn_s_setprio(0); } while (0)
#define PG8_WAIT_V(n) asm volatile("s_waitcnt vmcnt(" #n ")" ::: "memory")
#define PG8_WAIT_L(n) asm volatile("s_waitcnt lgkmcnt(" #n ")" ::: "memory")
#define PG8_BAR __builtin_amdgcn_s_barrier()
#define PG8_SCHED __builtin_amdgcn_sched_barrier(0)
    Unit cur, nxt; int ui = 0;
    if (!S.next(0, cur)) return;
    f32x4 acc[2][2][4][2];
#pragma unroll
    for (int a = 0; a < 2; ++a)
#pragma unroll
        for (int b = 0; b < 2; ++b)
#pragma unroll
            for (int m = 0; m < 4; ++m)
#pragma unroll
                for (int n = 0; n < 2; ++n) acc[a][b][m][n] = (f32x4){0.f, 0.f, 0.f, 0.f};
    bf16x8 At[4][2], B0[2][2], B1[2][2];
    const char* cA = (const char*)g.A + (size_t)cur.pm * tstepA; const char* cB = (const char*)g.Bt + (size_t)cur.pn * tstepB;
    S.a_ready(cur);
    if constexpr (SP2) {
        PG8_STAGE(PG8_SB(0, 0), cB, voffB); PG8_STAGE(PG8_SB(0, 1), cB + hstepB, voffB); PG8_STAGE(PG8_SA(0, 0), cA, voffA); PG8_STAGE(PG8_SA(0, 1), cA + hstepA, voffA);
        if (wr == 1) PG8_BAR;
        PG8_WAIT_V(2); PG8_BAR;
        PG8_STAGE(PG8_SB(1, 0), cB + kstep, voffB); PG8_STAGE(PG8_SA(1, 0), cA + kstep, voffA); PG8_STAGE(PG8_SB(1, 1), cB + hstepB + kstep, voffB);
        PG8_WAIT_V(6); PG8_BAR;
    } else {
        PG8_STAGE(PG8_SB(0, 0), cB, voffB); PG8_STAGE(PG8_SA(0, 0), cA, voffA); PG8_STAGE(PG8_SB(0, 1), cB + hstepB, voffB); PG8_STAGE(PG8_SA(0, 1), cA + hstepA, voffA);
        if (wr == 1) PG8_BAR;
        PG8_WAIT_V(4); PG8_BAR;
        PG8_STAGE(PG8_SB(1, 0), cB + kstep, voffB); PG8_STAGE(PG8_SA(1, 0), cA + kstep, voffA); PG8_STAGE(PG8_SB(1, 1), cB + hstepB + kstep, voffB);
        PG8_WAIT_V(6); PG8_BAR;
    }
    for (;;) {
        const bool has_next = S.next(ui + 1, nxt);
        const char* nA = has_next ? (const char*)g.A + (size_t)nxt.pm * tstepA : cA; const char* nB = has_next ? (const char*)g.Bt + (size_t)nxt.pn * tstepB : cB;
        for (int t = 0; t < nt; t += 2) {
            const bool last = (t == nt - 2);
            const char* a1 = cA + (size_t)(t + 1) * kstep;
            const char* a2 = last ? nA : cA + (size_t)(t + 2) * kstep; const char* b2 = last ? nB : cB + (size_t)(t + 2) * kstep;
            const char* a3 = a2 + kstep; const char* b3 = b2 + kstep;
            if (last && has_next) S.a_ready(nxt);
            if constexpr (SP2) {
            PG8_LDB(B0, 0, 0); PG8_LDB(B1, 0, 1); PG8_SCHED; PG8_LDA(At, 0, 0); PG8_STAGE(PG8_SA(1, 1), a1 + hstepA, voffA);
            PG8_WAIT_V(8); PG8_WAIT_L(0); PG8_BAR; PG8_MMA(0, 0, At, B0); PG8_MMA(0, 1, At, B1); PG8_BAR; PG8_SCHED;
            PG8_LDA(At, 0, 1); PG8_STAGE(PG8_SB(0, 0), b2, voffB); PG8_STAGE(PG8_SB(0, 1), b2 + hstepB, voffB); PG8_STAGE(PG8_SA(0, 0), a2, voffA);
            PG8_WAIT_V(8); PG8_WAIT_L(0); PG8_BAR; PG8_MMA(1, 0, At, B0); PG8_MMA(1, 1, At, B1); PG8_BAR; PG8_SCHED;
            PG8_LDB(B0, 1, 0); PG8_LDB(B1, 1, 1); PG8_SCHED; PG8_LDA(At, 1, 0); PG8_STAGE(PG8_SA(0, 1), a2 + hstepA, voffA);
            PG8_WAIT_V(8); PG8_WAIT_L(0); PG8_BAR; PG8_MMA(0, 0, At, B0); PG8_MMA(0, 1, At, B1); PG8_BAR; PG8_SCHED;
            PG8_LDA(At, 1, 1); PG8_STAGE(PG8_SB(1, 0), b3, voffB); PG8_STAGE(PG8_SB(1, 1), b3 + hstepB, voffB); PG8_STAGE(PG8_SA(1, 0), a3, voffA);
            PG8_WAIT_V(8); PG8_WAIT_L(0); PG8_BAR; PG8_MMA(1, 0, At, B0); PG8_MMA(1, 1, At, B1); PG8_BAR; PG8_SCHED;
            } else {
            PG8_LDB(B0, 0, 0); PG8_SCHED; PG8_LDA(At, 0, 0); PG8_STAGE(PG8_SA(1, 1), a1 + hstepA, voffA);
            PG8_WAIT_L(8); PG8_BAR; PG8_WAIT_L(0); PG8_MMA(0, 0, At, B0); PG8_BAR; PG8_SCHED;
            PG8_LDB(B1, 0, 1); PG8_STAGE(PG8_SB(0, 0), b2, voffB);
            PG8_BAR; PG8_WAIT_L(0); PG8_MMA(0, 1, At, B1); PG8_BAR;
            PG8_LDA(At, 0, 1); PG8_STAGE(PG8_SA(0, 0), a2, voffA);
            PG8_BAR; PG8_WAIT_L(0); PG8_MMA(1, 0, At, B0); PG8_BAR; PG8_SCHED;
            PG8_STAGE(PG8_SB(0, 1), b2 + hstepB, voffB);
            PG8_WAIT_V(6); PG8_BAR; PG8_MMA(1, 1, At, B1); PG8_BAR;
            PG8_LDB(B0, 1, 0); PG8_SCHED; PG8_LDA(At, 1, 0); PG8_STAGE(PG8_SA(0, 1), a2 + hstepA, voffA);
            PG8_WAIT_L(8); PG8_BAR; PG8_WAIT_L(0); PG8_MMA(0, 0, At, B0); PG8_BAR; PG8_SCHED;
            PG8_LDB(B1, 1, 1); PG8_STAGE(PG8_SB(1, 0), b3, voffB);
            PG8_BAR; PG8_WAIT_L(0); PG8_MMA(0, 1, At, B1); PG8_BAR;
            PG8_LDA(At, 1, 1); PG8_STAGE(PG8_SA(1, 0), a3, voffA);
            PG8_BAR; PG8_WAIT_L(0); PG8_MMA(1, 0, At, B0); PG8_BAR; PG8_SCHED;
            PG8_STAGE(PG8_SB(1, 1), b3 + hstepB, voffB);
            PG8_WAIT_V(6); PG8_BAR; PG8_MMA(1, 1, At, B1); PG8_BAR;
            }
        }
        if constexpr (ALIGN_EPI) { if (wr == 0) PG8_BAR; }
        if constexpr (!Epi::AFTER_DRAIN) { E(acc, cur, wr, wc, fr, fq); S.done(cur); }
        if (!has_next) break;
#pragma unroll
        for (int a = 0; a < 2; ++a)
#pragma unroll
            for (int b = 0; b < 2; ++b)
#pragma unroll
                for (int m = 0; m < 4; ++m)
#pragma unroll
                    for (int n = 0; n < 2; ++n) acc[a][b][m][n] = (f32x4){0.f, 0.f, 0.f, 0.f};
        cur = nxt; cA = nA; cB = nB; ++ui;
        if constexpr (ALIGN_EPI) { if (wr == 1) PG8_BAR; }
    }
    PG8_WAIT_V(0);
    if constexpr (!ALIGN_EPI) { if (wr == 0) PG8_BAR; }
    PG8_BAR;
    if constexpr (Epi::AFTER_DRAIN) { E.fused(acc, cur, wr, wc, fr, fq, lds, wid, lane); S.done(cur); }
#undef PG8_SA
#undef PG8_SB
#undef PG8_STAGE
#undef PG8_LDA
#undef PG8_LDB
#undef PG8_MMA
#undef PG8_WAIT_V
#undef PG8_WAIT_L
#undef PG8_BAR
#undef PG8_SCHED
}
}

constexpr int S_ = 8192, DM = 2048, DEPTH = 4, NH = 16;
constexpr int QL = 512, KVL = 512, ROPE = 64, NOPE = 128, VD = 128;
constexpr int INW = 13376;
constexpr int DFF = 5632, DFF2 = 11264;
constexpr int NNAT = 11520;
constexpr int WINR = NNAT + 2048;
constexpr float EPS = 1e-6f;
constexpr float LOG2E = 1.4426950408889634f;
constexpr float QSCALE = 0.07216878364870323f * 1.4426950408889634f;
constexpr int NWAVES = 8, NTHR = 512;

constexpr size_t MiB = 1u << 20;
constexpr size_t WS_CTL = 0, CTL_ZERO_BYTES = 1 * MiB;
constexpr size_t WS_COS = 1 * MiB, WS_SIN = 2 * MiB, WS_LB = 3 * MiB, WS_SSQ = 4 * MiB;
constexpr size_t WS_W = 5 * MiB;
constexpr size_t LW_IN = 0, LW_UQ = 53 * MiB, LW_K = 56 * MiB, LW_V = 58 * MiB, LW_A = 60 * MiB, LW_B = 68 * MiB, LW_O = 76 * MiB, LW_UP = 84 * MiB, LW_DN = 128 * MiB, LW = 150 * MiB;
constexpr size_t WS_XN = WS_W + 4 * LW + 1 * MiB;
constexpr size_t WS_MIX = WS_XN + 32 * MiB;
constexpr size_t WS_CQKV = WS_MIX;
constexpr size_t WS_KPE = WS_CQKV + 16 * MiB;
constexpr size_t WS_HQ = WS_KPE + 1 * MiB;
constexpr size_t GSTRIDE = 32 * MiB;
constexpr size_t WS_HG = WS_HQ + GSTRIDE, WS_GA = WS_HQ + 2 * GSTRIDE, WS_GB = WS_HQ + 3 * GSTRIDE;
constexpr size_t WS_HF = WS_HQ + 4 * GSTRIDE;
constexpr size_t WS_VTH = WS_HF + 64 * MiB;
constexpr size_t WS_QN = WS_VTH + 32 * MiB;
constexpr size_t WS_QR = WS_QN + 32 * MiB;
constexpr size_t WS_KN = WS_QR + 16 * MiB;
constexpr size_t WS_VT = WS_KN + 32 * MiB;
constexpr size_t WS_ATT = WS_VT + 32 * MiB;
constexpr size_t WS_REC = WS_ATT + 32 * MiB;
constexpr size_t WS_RRAW = WS_REC + 32 * MiB;
constexpr size_t WS_HU = WS_RRAW + 64 * MiB;
constexpr size_t WS_HS = WS_HU + 128 * MiB;
constexpr size_t WS_M1 = WS_HS + 64 * MiB;
constexpr size_t WS_MRG = WS_M1 + 64 * MiB;
constexpr size_t WS_MIX_END = WS_MRG + 32 * MiB;
constexpr size_t WS_U = WS_MIX;
constexpr size_t WS_ACT = WS_U + 176 * MiB;
static_assert(WS_ACT + 88 * MiB <= WS_MIX_END, "FFN overlay fits the mixer region");
constexpr size_t WS_END = WS_MIX_END;
constexpr int CW_BAR = 4096;

constexpr int RING_OFF = 0, RING_BYTES = 131072;
constexpr int LDSCTL_OFF = RING_BYTES, MISC_OFF = LDSCTL_OFF + 320;
constexpr int LDS_BYTES = 147456;

#define GAS __attribute__((address_space(1)))
#define LAS __attribute__((address_space(3)))
typedef unsigned short bf16;
typedef unsigned v4u __attribute__((ext_vector_type(4)));
typedef unsigned v2u __attribute__((ext_vector_type(2)));
typedef float f32x4 __attribute__((ext_vector_type(4)));
typedef float f32x2 __attribute__((ext_vector_type(2)));
typedef short bf16x8 __attribute__((ext_vector_type(8)));
typedef GAS unsigned gu32;
#define LDS_WAIT() asm volatile("s_waitcnt lgkmcnt(0)" ::: "memory")
#define VM_WAIT() asm volatile("s_waitcnt vmcnt(0)" ::: "memory")
__device__ __forceinline__ unsigned f2bf(float f) { unsigned u = __builtin_bit_cast(unsigned, f); return (u + 0x7fffu + ((u >> 16) & 1u)) >> 16; }
__device__ __forceinline__ unsigned pk2(float lo, float hi) { return f2bf(lo) | (f2bf(hi) << 16); }
__device__ __forceinline__ float bflo(unsigned u) { return __builtin_bit_cast(float, u << 16); }
__device__ __forceinline__ float bfhi(unsigned u) { return __builtin_bit_cast(float, u & 0xffff0000u); }
__device__ __forceinline__ float sigm(float x) { return __builtin_amdgcn_rcpf(1.f + __builtin_amdgcn_exp2f(-LOG2E * x)); }
__device__ __forceinline__ float wave_sum(float v) {
#pragma unroll
    for (int o = 1; o < 64; o <<= 1) v += __shfl_xor(v, o);
    return v;
}
__device__ __forceinline__ float wave_max(float v) {
#pragma unroll
    for (int o = 1; o < 64; o <<= 1) v = fmaxf(v, __shfl_xor(v, o));
    return v;
}

namespace pg8 {
typedef unsigned v2u_t __attribute__((ext_vector_type(2)));
__device__ __forceinline__ u32x4 pack8(f32x4 a, f32x4 b) { u32x4 w; w.x = cvt_pk_bf16(a[0], a[1]); w.y = cvt_pk_bf16(a[2], a[3]); w.z = cvt_pk_bf16(b[0], b[1]); w.w = cvt_pk_bf16(b[2], b[3]); return w; }
__device__ __forceinline__ f32x4 silu4(f32x4 v) { f32x4 r; r[0] = v[0] * sigm(v[0]); r[1] = v[1] * sigm(v[1]); r[2] = v[2] * sigm(v[2]); r[3] = v[3] * sigm(v[3]); return r; }
__device__ __forceinline__ f32x4 sigm4(f32x4 v) { f32x4 r; r[0] = sigm(v[0]); r[1] = sigm(v[1]); r[2] = sigm(v[2]); r[3] = sigm(v[3]); return r; }
__device__ __forceinline__ float sum8(const float* p) { const f32x4 a = *(const f32x4*)p, b = *(const f32x4*)(p + 4); return ((a[0] + a[1]) + (a[2] + a[3])) + ((b[0] + b[1]) + (b[2] + b[3])); }
__device__ __forceinline__ void rope8(f32x4& v0, f32x4& v1, const f32x4 cs, const f32x4 sn) {
    f32x4 a, b;
    a[0] = v0[0] * cs[0] - v0[1] * sn[0]; a[1] = v0[1] * cs[0] + v0[0] * sn[0];
    a[2] = v0[2] * cs[1] - v0[3] * sn[1]; a[3] = v0[3] * cs[1] + v0[2] * sn[1];
    b[0] = v1[0] * cs[2] - v1[1] * sn[2]; b[1] = v1[1] * cs[2] + v1[0] * sn[2];
    b[2] = v1[2] * cs[3] - v1[3] * sn[3]; b[3] = v1[3] * cs[3] + v1[2] * sn[3];
    v0 = a; v1 = b;
}

struct EpiIn {
    static constexpr bool PERM = true, AFTER_DRAIN = false;
    unsigned char* ws;
    __device__ __forceinline__ void operator()(const f32x4 (&acc)[2][2][4][2], const Unit& u, int wr, int wc, int fr, int fq) const {
        const int pn = u.pn, row0 = u.pm * BM + wr * 64 + fr, lc = wc * 32 + 8 * fq;
        if (pn == 4) {
            if (wc < 2) {
                const float* COS = (const float*)(ws + WS_COS); const float* SIN = (const float*)(ws + WS_SIN); bf16_t* KPE = (bf16_t*)(ws + WS_KPE);
#pragma unroll
                for (int ai = 0; ai < 2; ++ai)
#pragma unroll
                    for (int m = 0; m < 4; ++m) { const int row = row0 + ai * HALF + m * 16;
                        f32x4 v0 = acc[ai][0][m][0], v1 = acc[ai][0][m][1];
                        const f32x4 cs = *(const f32x4*)(COS + (size_t)row * 32 + wc * 16 + 4 * fq), sn = *(const f32x4*)(SIN + (size_t)row * 32 + wc * 16 + 4 * fq);
                        rope8(v0, v1, cs, sn);
                        *(u32x4*)(KPE + (size_t)row * 64 + lc) = pack8(v0, v1);
                        if (m & 1) asm volatile("" ::: "memory"); }
            }
        } else if (pn >= 13 && pn < 21) {
            float* HF = (float*)(ws + WS_HF);
#pragma unroll
            for (int ai = 0; ai < 2; ++ai)
#pragma unroll
                for (int m = 0; m < 4; ++m) { float* rp = HF + (size_t)(row0 + ai * HALF + m * 16) * 2048 + (pn - 13) * 256 + lc;
#pragma unroll
                    for (int bj = 0; bj < 2; ++bj) { *(f32x4*)(rp + bj * HALF) = acc[ai][bj][m][0]; *(f32x4*)(rp + bj * HALF + 4) = acc[ai][bj][m][1]; } }
        } else {
            bf16_t* base; int ldc, act;
            if (pn < 4) { base = (bf16_t*)(ws + WS_CQKV) + pn * 256; ldc = 1024; act = 0; }
            else { const int gi = (pn < 13) ? 0 : ((pn - 13) >> 3), ct = (pn < 13) ? (pn - 5) : ((pn - 13) & 7);
                   base = (bf16_t*)(ws + WS_HQ + (size_t)gi * GSTRIDE) + ct * 256; ldc = 2048; act = (gi <= 1) ? 1 : 2; }
#pragma unroll
            for (int ai = 0; ai < 2; ++ai)
#pragma unroll
                for (int m = 0; m < 4; ++m) { bf16_t* rp = base + (size_t)(row0 + ai * HALF + m * 16) * ldc + lc;
#pragma unroll
                    for (int bj = 0; bj < 2; ++bj) { f32x4 v0 = acc[ai][bj][m][0], v1 = acc[ai][bj][m][1];
                        if (act == 1) { v0 = silu4(v0); v1 = silu4(v1); }
                        else if (act == 2) { v0 = sigm4(v0); v1 = sigm4(v1); }
                        *(u32x4*)(rp + bj * HALF) = pack8(v0, v1); } }
        }
    }
};
struct EpiStore {
    static constexpr bool PERM = true, AFTER_DRAIN = false;
    bf16_t* O; int ldc;
    __device__ __forceinline__ void operator()(const f32x4 (&acc)[2][2][4][2], const Unit& u, int wr, int wc, int fr, int fq) const {
        const int row0 = u.pm * BM + wr * 64 + fr, col0 = u.pn * BM + wc * 32 + 8 * fq;
#pragma unroll
        for (int ai = 0; ai < 2; ++ai)
#pragma unroll
            for (int m = 0; m < 4; ++m) { bf16_t* rp = O + (size_t)(row0 + ai * HALF + m * 16) * ldc + col0;
#pragma unroll
                for (int bj = 0; bj < 2; ++bj) *(u32x4*)(rp + bj * HALF) = pack8(acc[ai][bj][m][0], acc[ai][bj][m][1]); }
    }
};
struct EpiQ {
    static constexpr bool PERM = true, AFTER_DRAIN = false;
    unsigned char* ws;
    __device__ __forceinline__ void operator()(const f32x4 (&acc)[2][2][4][2], const Unit& u, int wr, int wc, int fr, int fq) const {
        const int pn = u.pn, row0 = u.pm * BM + wr * 64 + fr, lc = wc * 32 + 8 * fq;
        if (pn < 8) {
            bf16_t* base = (bf16_t*)(ws + WS_QN) + pn * 256 + lc;
#pragma unroll
            for (int ai = 0; ai < 2; ++ai)
#pragma unroll
                for (int m = 0; m < 4; ++m)
#pragma unroll
                    for (int bj = 0; bj < 2; ++bj) *(u32x4*)(base + (size_t)(row0 + ai * HALF + m * 16) * 2048 + bj * HALF) = pack8(acc[ai][bj][m][0] * QSCALE, acc[ai][bj][m][1] * QSCALE);
        } else {
            const float* COS = (const float*)(ws + WS_COS); const float* SIN = (const float*)(ws + WS_SIN);
            bf16_t* base = (bf16_t*)(ws + WS_QR) + (pn - 8) * 256 + lc; const int p0 = (wc & 1) * 16 + 4 * fq;
#pragma unroll
            for (int ai = 0; ai < 2; ++ai)
#pragma unroll
                for (int m = 0; m < 4; ++m) { const int row = row0 + ai * HALF + m * 16;
                    const f32x4 cs = *(const f32x4*)(COS + (size_t)row * 32 + p0), sn = *(const f32x4*)(SIN + (size_t)row * 32 + p0);
#pragma unroll
                    for (int bj = 0; bj < 2; ++bj) { f32x4 v0 = acc[ai][bj][m][0] * QSCALE, v1 = acc[ai][bj][m][1] * QSCALE; rope8(v0, v1, cs, sn);
                        *(u32x4*)(base + (size_t)row * 1024 + bj * HALF) = pack8(v0, v1); }
                    if (m & 1) asm volatile("" ::: "memory"); }
        }
    }
};
struct EpiGateA {
    static constexpr bool PERM = true, AFTER_DRAIN = false;
    unsigned char* ws;
    __device__ __forceinline__ void operator()(const f32x4 (&acc)[2][2][4][2], const Unit& u, int wr, int wc, int fr, int fq) const {
        const int row0 = u.pm * BM + wr * 64 + fr, col0 = u.pn * BM + wc * 32 + 8 * fq;
        const bf16_t* G = (const bf16_t*)(ws + WS_GA); float* M1 = (float*)(ws + WS_M1);
#pragma unroll
        for (int ai = 0; ai < 2; ++ai)
#pragma unroll
            for (int m = 0; m < 4; ++m) { const size_t off = (size_t)(row0 + ai * HALF + m * 16) * 2048 + col0;
#pragma unroll
                for (int bj = 0; bj < 2; ++bj) { const u32x4 g = *(const u32x4*)(G + off + bj * HALF);
                    const f32x4 g0 = {bflo(g.x), bfhi(g.x), bflo(g.y), bfhi(g.y)}, g1 = {bflo(g.z), bfhi(g.z), bflo(g.w), bfhi(g.w)};
                    *(f32x4*)(M1 + off + bj * HALF) = acc[ai][bj][m][0] * g0; *(f32x4*)(M1 + off + bj * HALF + 4) = acc[ai][bj][m][1] * g1; }
                if (m & 1) asm volatile("" ::: "memory"); }
    }
};
struct EpiGateB {
    static constexpr bool PERM = true, AFTER_DRAIN = false;
    unsigned char* ws;
    __device__ __forceinline__ void operator()(const f32x4 (&acc)[2][2][4][2], const Unit& u, int wr, int wc, int fr, int fq) const {
        const int row0 = u.pm * BM + wr * 64 + fr, col0 = u.pn * BM + wc * 32 + 8 * fq;
        const bf16_t* G = (const bf16_t*)(ws + WS_GB); const float* M1 = (const float*)(ws + WS_M1); bf16_t* O = (bf16_t*)(ws + WS_MRG);
#pragma unroll
        for (int ai = 0; ai < 2; ++ai)
#pragma unroll
            for (int m = 0; m < 4; ++m) { const size_t off = (size_t)(row0 + ai * HALF + m * 16) * 2048 + col0;
#pragma unroll
                for (int bj = 0; bj < 2; ++bj) { const u32x4 g = *(const u32x4*)(G + off + bj * HALF);
                    const f32x4 g0 = {bflo(g.x), bfhi(g.x), bflo(g.y), bfhi(g.y)}, g1 = {bflo(g.z), bfhi(g.z), bflo(g.w), bfhi(g.w)};
                    const f32x4 m0 = *(const f32x4*)(M1 + off + bj * HALF), m1 = *(const f32x4*)(M1 + off + bj * HALF + 4);
                    *(u32x4*)(O + off + bj * HALF) = pack8(m0 + acc[ai][bj][m][0] * g0, m1 + acc[ai][bj][m][1] * g1); }
                if (m & 1) asm volatile("" ::: "memory"); }
    }
};
struct EpiRes {
    static constexpr bool PERM = true, AFTER_DRAIN = false;
    float* X;
    __device__ __forceinline__ void operator()(const f32x4 (&acc)[2][2][4][2], const Unit& u, int wr, int wc, int fr, int fq) const {
        const int row0 = u.pm * BM + wr * 64 + fr, col0 = u.pn * BM + wc * 32 + 8 * fq;
#pragma unroll
        for (int ai = 0; ai < 2; ++ai)
#pragma unroll
            for (int m = 0; m < 4; ++m) { float* rp = X + (size_t)(row0 + ai * HALF + m * 16) * 2048 + col0;
#pragma unroll
                for (int bj = 0; bj < 2; ++bj) { const f32x4 a = *(const f32x4*)(rp + bj * HALF), b = *(const f32x4*)(rp + bj * HALF + 4);
                    *(f32x4*)(rp + bj * HALF) = a + acc[ai][bj][m][0]; *(f32x4*)(rp + bj * HALF + 4) = b + acc[ai][bj][m][1]; }
                if (m & 1) asm volatile("" ::: "memory"); }
    }
};

__device__ __forceinline__ float dpp_shr1(float fill, float v) { return __builtin_bit_cast(float, __builtin_amdgcn_update_dpp(__builtin_bit_cast(int, fill), __builtin_bit_cast(int, v), 0x111, 0xf, 0xf, false)); }
__device__ __forceinline__ float dpp_shr2(float fill, float v) { return __builtin_bit_cast(float, __builtin_amdgcn_update_dpp(__builtin_bit_cast(int, fill), __builtin_bit_cast(int, v), 0x112, 0xf, 0xf, false)); }
__device__ __forceinline__ float dpp_ror1(float v) { return __builtin_bit_cast(float, __builtin_amdgcn_update_dpp(0, __builtin_bit_cast(int, v), 0x121, 0xf, 0xf, false)); }
__device__ __forceinline__ float dpp_ror2(float v) { return __builtin_bit_cast(float, __builtin_amdgcn_update_dpp(0, __builtin_bit_cast(int, v), 0x122, 0xf, 0xf, false)); }
struct EpiConv {
    static constexpr bool PERM = true, AFTER_DRAIN = false;
    bf16_t* ACT; const float* cw; const float* cb; PG8_LAS float* EX;
    __device__ __forceinline__ void operator()(const f32x4 (&acc)[2][2][4][2], const Unit& u, int wr, int wc, int fr, int fq) const {
        const int lc = wc * 32 + 8 * fq;
        if (fr >= 14) {
#pragma unroll
            for (int ai = 0; ai < 2; ++ai)
#pragma unroll
                for (int bj = 0; bj < 2; ++bj)
#pragma unroll
                    for (int n = 0; n < 2; ++n) *(PG8_LAS f32x4*)(EX + ((2 * ai + wr) * 2 + (fr - 14)) * 256 + bj * HALF + lc + 4 * n) = acc[ai][bj][3][n];
        }
        asm volatile("s_waitcnt lgkmcnt(0)" ::: "memory"); __builtin_amdgcn_s_barrier(); asm volatile("" ::: "memory");
        const int ch0 = u.pn * HALF + lc;
        const int trow0 = u.pm * 254 - 2 + wr * 64 + fr;
#pragma unroll
        for (int n = 0; n < 2; ++n) {
            const int ch = ch0 + 4 * n;
            const f32x4 g0 = *(const f32x4*)(cw + ch), g1 = *(const f32x4*)(cw + DFF2 + ch), g2 = *(const f32x4*)(cw + 2 * DFF2 + ch), gb = *(const f32x4*)(cb + ch);
            const f32x4 u0 = *(const f32x4*)(cw + DFF + ch), u1 = *(const f32x4*)(cw + DFF2 + DFF + ch), u2 = *(const f32x4*)(cw + 2 * DFF2 + DFF + ch), ub = *(const f32x4*)(cb + DFF + ch);
#pragma unroll
            for (int ai = 0; ai < 2; ++ai) {
                const int b = 2 * ai + wr;
                f32x4 f1g = {0.f, 0.f, 0.f, 0.f}, f2g = f1g, f1u = f1g, f2u = f1g;
                if (b > 0) { const PG8_LAS float* e63 = EX + ((b - 1) * 2 + 1) * 256 + lc + 4 * n; const PG8_LAS float* e2 = EX + ((b - 1) * 2 + (fr == 0 ? 0 : 1)) * 256 + lc + 4 * n;
                    f1g = *(const PG8_LAS f32x4*)e63; f2g = *(const PG8_LAS f32x4*)e2; f1u = *(const PG8_LAS f32x4*)(e63 + HALF); f2u = *(const PG8_LAS f32x4*)(e2 + HALF); }
#pragma unroll
                for (int m = 0; m < 4; ++m) {
                    const f32x4 cg = acc[ai][0][m][n], cu = acc[ai][1][m][n];
                    if (m > 0) { const f32x4 pg = acc[ai][0][m - 1][n], pu = acc[ai][1][m - 1][n];
#pragma unroll
                        for (int i = 0; i < 4; ++i) { f1g[i] = dpp_ror1(pg[i]); f2g[i] = dpp_ror2(pg[i]); f1u[i] = dpp_ror1(pu[i]); f2u[i] = dpp_ror2(pu[i]); } }
                    f32x4 r;
#pragma unroll
                    for (int i = 0; i < 4; ++i) { const float G = gb[i] + g0[i] * dpp_shr2(f2g[i], cg[i]) + g1[i] * dpp_shr1(f1g[i], cg[i]) + g2[i] * cg[i];
                                                  const float U = ub[i] + u0[i] * dpp_shr2(f2u[i], cu[i]) + u1[i] * dpp_shr1(f1u[i], cu[i]) + u2[i] * cu[i];
                                                  r[i] = G * sigm(G) * U; }
                    const int t = trow0 + ai * HALF + m * 16;
                    if (t >= u.pm * 254 && t < S_) { v2u_t w; w.x = cvt_pk_bf16(r[0], r[1]); w.y = cvt_pk_bf16(r[2], r[3]); *(v2u_t*)(ACT + (size_t)t * DFF + ch) = w; }
                }
            }
        }
    }
};
}
#define XB_TMO      128
#define XB_XCNT(j)  (256  + 64 * (j))
#define XB_XSUB(j)  (1280 + 64 * (j))
#define XB_XGEN(j)  (2304 + 64 * (j))
#define XB_TOP      3328
#define XB_TOPGEN   3392
#define XCD_BAR_WORDS 3456
#define XB_SPIN_CAP (1u << 18)

__device__ __forceinline__ unsigned xb_ld(unsigned* p)              { return __hip_atomic_load(p, __ATOMIC_RELAXED, __HIP_MEMORY_SCOPE_AGENT); }
__device__ __forceinline__ unsigned xb_add(unsigned* p, unsigned v) { return __hip_atomic_fetch_add(p, v, __ATOMIC_RELAXED, __HIP_MEMORY_SCOPE_AGENT); }
__device__ __forceinline__ unsigned xb_xcc_id() { return (unsigned)__builtin_amdgcn_s_getreg((3 << 11) | 20) & 0xFu; }
#define XB_SPIN(cond, bar) do { unsigned _sp = 0; while (cond) { __builtin_amdgcn_s_sleep(1); \
    if ((++_sp & 255u) == 0u) { if (xb_ld(&(bar)[XB_TMO])) break; if (_sp > XB_SPIN_CAP) { atomicAdd(&(bar)[XB_TMO], 1u); break; } } } } while (0)

struct XcdBarrier {
    unsigned* bar; unsigned x;
    volatile LAS unsigned* st;
};

__device__ __forceinline__ XcdBarrier xcd_barrier_post(unsigned* bar, volatile LAS unsigned* st) {
    XcdBarrier b; b.bar = bar; b.x = xb_xcc_id(); b.st = st;
    if (threadIdx.x == 0) (void)xb_add(&bar[XB_XCNT(b.x)], 1u);
    return b;
}
__device__ __forceinline__ void xcd_barrier_complete(unsigned* bar, unsigned x, unsigned& nloc, unsigned& nx) {
    const unsigned G = gridDim.x * gridDim.y * gridDim.z;
    unsigned sum, cnt, mine, sp = 0u;
    for (;;) {
        sum = 0u; cnt = 0u; mine = 0u;
#pragma unroll
        for (unsigned j = 0; j < 16; ++j) { const unsigned c = xb_ld(&bar[XB_XCNT(j)]); sum += c; cnt += (c > 0u) ? 1u : 0u; mine = (j == x) ? c : mine; }
        if (sum == G) break;
        __builtin_amdgcn_s_sleep(1);
        if ((++sp & 255u) == 0u) { if (xb_ld(&bar[XB_TMO])) break; if (sp > XB_SPIN_CAP) { atomicAdd(&bar[XB_TMO], 1u); break; } }
    }
    nloc = mine > 0u ? mine : 1u; nx = cnt > 0u ? cnt : 1u;
}

__device__ __forceinline__ void xcd_barrier(const XcdBarrier& b) {
    asm volatile("s_waitcnt vmcnt(0)" ::: "memory");
    __syncthreads();
    if (threadIdx.x == 0) {
        GAS unsigned* gbar_ = (GAS unsigned*)b.bar; unsigned bx_ = b.x; asm volatile("" : "+s"(gbar_), "+s"(bx_)); unsigned* bar = (unsigned*)gbar_;
        __builtin_amdgcn_s_waitcnt(0);
        unsigned nloc = b.st[0], nx = b.st[1];
        if (nloc == 0u) { xcd_barrier_complete(bar, bx_, nloc, nx); b.st[0] = nloc; b.st[1] = nx; }
        const unsigned old = xb_add(&bar[XB_XSUB(bx_)], 1u);
        const unsigned gen = old / nloc;
        if (old + 1u == (gen + 1u) * nloc) {
            __builtin_amdgcn_fence(__ATOMIC_RELEASE, "agent");
            asm volatile("s_waitcnt vmcnt(0)" ::: "memory");
            const unsigned og = xb_add(&bar[XB_TOP], 1u);
            const unsigned tg = og / nx;
            if (og + 1u == (tg + 1u) * nx) xb_add(&bar[XB_TOPGEN], 1u);
            else XB_SPIN(xb_ld(&bar[XB_TOPGEN]) == tg, bar);
            __builtin_amdgcn_fence(__ATOMIC_ACQUIRE, "agent");
            xb_add(&bar[XB_XGEN(bx_)], 1u);
            asm volatile("s_waitcnt vmcnt(0)" ::: "memory");
        } else {
            XB_SPIN(xb_ld(&bar[XB_XGEN(bx_)]) == gen, bar);
            __builtin_amdgcn_fence(__ATOMIC_ACQUIRE, "agent");
            asm volatile("s_waitcnt vmcnt(0)" ::: "memory");
        }
    }
    __syncthreads();
}

__device__ const float c_invf[32] = {
    1.000000000e+00f, 7.498942614e-01f, 5.623413324e-01f, 4.216965139e-01f, 3.162277639e-01f, 2.371373773e-01f, 1.778279394e-01f, 1.333521307e-01f,
    1.000000015e-01f, 7.498941571e-02f, 5.623413250e-02f, 4.216965288e-02f, 3.162277490e-02f, 2.371373773e-02f, 1.778279431e-02f, 1.333521493e-02f,
    9.999999776e-03f, 7.498941850e-03f, 5.623413250e-03f, 4.216964822e-03f, 3.162277630e-03f, 2.371373586e-03f, 1.778279431e-03f, 1.333521446e-03f,
    1.000000047e-03f, 7.498942432e-04f, 5.623413017e-04f, 4.216965172e-04f, 3.162277571e-04f, 2.371373703e-04f, 1.778279402e-04f, 1.333521504e-04f};

template <int KIND> __device__ __forceinline__ int srcmap(int n) {
    if constexpr (KIND == 0) return n;
    else if constexpr (KIND == 1) {
        if (n < 1024) return n;
        if (n < 1088) { const int jj = n - 1024; return 1024 + (jj >> 1) + 32 * (jj & 1); }
        if (n < 1280) return -1;
        if (n < 3328) return 1088 + (n - 1280);
        if (n < 5376) return 3136 + (n - 3328);
        if (n < 7424) return 7232 + (n - 5376);
        if (n < 9472) return 9280 + (n - 7424);
        if (n < 11520) return 11328 + (n - 9472);
        return 5184 + (n - 11520);
    } else if constexpr (KIND == 2) {
        if (n < 2048) return (n >> 7) * 192 + (n & 127);
        const int r = n - 2048, h = r >> 6, jj = r & 63; return h * 192 + 128 + (jj >> 1) + 32 * (jj & 1);
    } else if constexpr (KIND == 3) return (n >> 7) * 256 + (n & 127);
    else if constexpr (KIND == 4) return (n >> 7) * 256 + 128 + (n & 127);
    else { const int j = n >> 8, i = n & 255; return i < 128 ? 128 * j + i : DFF + 128 * j + (i - 128); }
}
template <int KIND> __device__ __forceinline__ void transpose_item(const float* W, int K, int Nsrc, bf16* WT, const float* scale, LAS float* scr, int kb, int nb, int lane) {
    const int k0 = 64 * kb, n0 = 32 * nb, sc = srcmap<KIND>(n0 + (lane & 31));
#pragma unroll 8
    for (int i = 0; i < 32; ++i) { const int kk = 2 * i + (lane >> 5); float v = 0.f;
        if (sc >= 0) { v = ((const GAS float*)W)[(size_t)(k0 + kk) * Nsrc + sc]; if (scale) v *= ((const GAS float*)scale)[k0 + kk]; }
        scr[kk * 33 + (lane & 31)] = v; }
    LDS_WAIT(); asm volatile("" ::: "memory");
    const int c = lane & 7;
#pragma unroll
    for (int j = 0; j < 4; ++j) { const int n = (lane >> 3) + 8 * j; const LAS float* s = scr + (8 * c) * 33 + n;
        v4u o; o.x = pk2(s[0 * 33], s[1 * 33]); o.y = pk2(s[2 * 33], s[3 * 33]); o.z = pk2(s[4 * 33], s[5 * 33]); o.w = pk2(s[6 * 33], s[7 * 33]);
        *(GAS v4u*)(WT + (size_t)(n0 + n) * K + k0 + 8 * c) = o; }
    LDS_WAIT(); asm volatile("" ::: "memory");
}

struct TItem { const float* src; const float* scale; bf16* dst; int K, Nsrc, k0, n0, sc; };
__device__ __forceinline__ int srcmap_rt(int kind, int n) {
    switch (kind) { case 1: return srcmap<1>(n); case 2: return srcmap<2>(n); case 3: return srcmap<3>(n); case 4: return srcmap<4>(n); case 5: return srcmap<5>(n); default: return n; }
}
__device__ __forceinline__ void rms_row_to_bf16(const float* xrow, const float* gain, bf16* orow, float* xcopy, int lane) {
    const GAS f32x4* xr = (const GAS f32x4*)xrow + lane;
    f32x4 v[8]; float s = 0.f;
#pragma unroll
    for (int j = 0; j < 8; ++j) { v[j] = xr[64 * j]; s += (v[j].x * v[j].x + v[j].y * v[j].y) + (v[j].z * v[j].z + v[j].w * v[j].w); }
    const float rstd = 1.0f / sqrtf(wave_sum(s) * (1.f / DM) + EPS);
    if (xcopy) { GAS f32x4* xc = (GAS f32x4*)xcopy + lane;
#pragma unroll
        for (int j = 0; j < 8; ++j) xc[64 * j] = v[j]; }
    GAS v2u* o8 = (GAS v2u*)orow + lane;
#pragma unroll
    for (int j = 0; j < 8; ++j) { const f32x4 g = *((const GAS f32x4*)gain + lane + 64 * j);
        v2u w; w.x = pk2(v[j].x * rstd * g.x, v[j].y * rstd * g.y); w.y = pk2(v[j].z * rstd * g.z, v[j].w * rstd * g.w); o8[64 * j] = w; }
}
__device__ __forceinline__ void rms_row_f32(float* xrow, const float* gain, int lane) {
    GAS f32x4* xr = (GAS f32x4*)xrow + lane;
    f32x4 v[8]; float s = 0.f;
#pragma unroll
    for (int j = 0; j < 8; ++j) { v[j] = xr[64 * j]; s += (v[j].x * v[j].x + v[j].y * v[j].y) + (v[j].z * v[j].z + v[j].w * v[j].w); }
    const float rstd = 1.0f / sqrtf(wave_sum(s) * (1.f / DM) + EPS);
#pragma unroll
    for (int j = 0; j < 8; ++j) { const f32x4 g = *((const GAS f32x4*)gain + lane + 64 * j); xr[64 * j] = v[j] * rstd * g; }
}
__device__ __forceinline__ void sincos_f64(float angf, float& sn, float& cs) {
    const double a = (double)angf;
    const double n = __builtin_rint(a * 0.63661977236758134308);
    double r = __builtin_fma(-n, 1.57079632679489655800e+00, a); r = __builtin_fma(-n, 6.12323399573676603587e-17, r);
    const double r2 = r * r;
    double ps = -1.0 / 1307674368000.0; ps = ps * r2 + 1.0 / 6227020800.0; ps = ps * r2 - 1.0 / 39916800.0; ps = ps * r2 + 1.0 / 362880.0; ps = ps * r2 - 1.0 / 5040.0; ps = ps * r2 + 1.0 / 120.0; ps = ps * r2 - 1.0 / 6.0; ps = ps * r2 * r + r;
    double pc = 1.0 / 20922789888000.0; pc = pc * r2 - 1.0 / 87178291200.0; pc = pc * r2 + 1.0 / 479001600.0; pc = pc * r2 - 1.0 / 3628800.0; pc = pc * r2 + 1.0 / 40320.0; pc = pc * r2 - 1.0 / 720.0; pc = pc * r2 + 1.0 / 24.0; pc = pc * r2 - 0.5; pc = pc * r2 + 1.0;
    const int q = ((int)n) & 3;
    const double s_ = (q == 0) ? ps : (q == 1) ? pc : (q == 2) ? -ps : -pc;
    const double c_ = (q == 0) ? pc : (q == 1) ? -ps : (q == 2) ? -pc : ps;
    sn = (float)s_; cs = (float)c_;
}

__device__ __forceinline__ void latent_norm_row(bf16* row, int lane) {
    v4u a = *(const v4u*)(row + lane * 8), b = *(const v4u*)(row + 512 + lane * 8);
    float fa[8] = {bflo(a.x), bfhi(a.x), bflo(a.y), bfhi(a.y), bflo(a.z), bfhi(a.z), bflo(a.w), bfhi(a.w)};
    float fb[8] = {bflo(b.x), bfhi(b.x), bflo(b.y), bfhi(b.y), bflo(b.z), bfhi(b.z), bflo(b.w), bfhi(b.w)};
    float sa = 0.f, sb = 0.f;
#pragma unroll
    for (int i = 0; i < 8; ++i) { sa += fa[i] * fa[i]; sb += fb[i] * fb[i]; }
    const float ra = 1.0f / sqrtf(wave_sum(sa) * (1.f / 512.f) + EPS), rb = 1.0f / sqrtf(wave_sum(sb) * (1.f / 512.f) + EPS);
    a.x = pk2(fa[0] * ra, fa[1] * ra); a.y = pk2(fa[2] * ra, fa[3] * ra); a.z = pk2(fa[4] * ra, fa[5] * ra); a.w = pk2(fa[6] * ra, fa[7] * ra);
    b.x = pk2(fb[0] * rb, fb[1] * rb); b.y = pk2(fb[2] * rb, fb[3] * rb); b.z = pk2(fb[4] * rb, fb[5] * rb); b.w = pk2(fb[6] * rb, fb[7] * rb);
    *(v4u*)(row + lane * 8) = a; *(v4u*)(row + 512 + lane * 8) = b;
}

__device__ __forceinline__ void attn_naive(unsigned char* ws, LAS float* qs  , int gw, int ngw, int lane) {
    const bf16* QN = (const bf16*)(ws + WS_QN); const bf16* QR = (const bf16*)(ws + WS_QR); const bf16* KN = (const bf16*)(ws + WS_KN);
    const bf16* KPE = (const bf16*)(ws + WS_KPE); const bf16* VT = (const bf16*)(ws + WS_VT); bf16* ATT = (bf16*)(ws + WS_ATT);
    for (int item = gw; item < S_ * NH; item += ngw) {
        const int q = item >> 4, h = item & 15;
        if (lane < 24) { const v4u w = (lane < 16) ? *(const v4u*)(QN + (size_t)q * 2048 + h * 128 + lane * 8) : *(const v4u*)(QR + (size_t)q * 1024 + h * 64 + (lane - 16) * 8);
            LAS float* d = qs + lane * 8; d[0] = bflo(w.x); d[1] = bfhi(w.x); d[2] = bflo(w.y); d[3] = bfhi(w.y); d[4] = bflo(w.z); d[5] = bfhi(w.z); d[6] = bflo(w.w); d[7] = bfhi(w.w); }
        LDS_WAIT(); asm volatile("" ::: "memory");
        float m = -__builtin_inff(), l = 0.f, o0 = 0.f, o1 = 0.f;
        const bf16* v0p = VT + (size_t)(h * 128 + 2 * lane) * S_; const bf16* v1p = v0p + S_;
        for (int j0 = 0; j0 <= q; j0 += 64) {
            const int j = j0 + lane; const bool valid = j <= q; float s = 0.f;
            if (valid) {
                const bf16* kn = KN + (size_t)j * 2048 + h * 128; const bf16* kp = KPE + (size_t)j * 64;
#pragma unroll 4
                for (int c = 0; c < 24; ++c) { const v4u w = (c < 16) ? *(const v4u*)(kn + c * 8) : *(const v4u*)(kp + (c - 16) * 8); const LAS float* qq = qs + c * 8;
                    s += bflo(w.x) * qq[0] + bfhi(w.x) * qq[1] + bflo(w.y) * qq[2] + bfhi(w.y) * qq[3] + bflo(w.z) * qq[4] + bfhi(w.z) * qq[5] + bflo(w.w) * qq[6] + bfhi(w.w) * qq[7]; }
            } else s = -__builtin_inff();
            const float mn = fmaxf(m, wave_max(s)); const float alpha = __builtin_amdgcn_exp2f(m - mn); const float p = valid ? __builtin_amdgcn_exp2f(s - mn) : 0.f;
            l = l * alpha + wave_sum(p); m = mn; o0 *= alpha; o1 *= alpha;
#pragma unroll
            for (int c = 0; c < 8; ++c) { const v4u a = *(const v4u*)(v0p + j0 + c * 8), b = *(const v4u*)(v1p + j0 + c * 8);
                const float p0 = __builtin_bit_cast(float, __builtin_amdgcn_readlane(__builtin_bit_cast(int, p), c * 8 + 0)), p1 = __builtin_bit_cast(float, __builtin_amdgcn_readlane(__builtin_bit_cast(int, p), c * 8 + 1));
                const float p2 = __builtin_bit_cast(float, __builtin_amdgcn_readlane(__builtin_bit_cast(int, p), c * 8 + 2)), p3 = __builtin_bit_cast(float, __builtin_amdgcn_readlane(__builtin_bit_cast(int, p), c * 8 + 3));
                const float p4 = __builtin_bit_cast(float, __builtin_amdgcn_readlane(__builtin_bit_cast(int, p), c * 8 + 4)), p5 = __builtin_bit_cast(float, __builtin_amdgcn_readlane(__builtin_bit_cast(int, p), c * 8 + 5));
                const float p6 = __builtin_bit_cast(float, __builtin_amdgcn_readlane(__builtin_bit_cast(int, p), c * 8 + 6)), p7 = __builtin_bit_cast(float, __builtin_amdgcn_readlane(__builtin_bit_cast(int, p), c * 8 + 7));
                o0 += p0 * bflo(a.x) + p1 * bfhi(a.x) + p2 * bflo(a.y) + p3 * bfhi(a.y) + p4 * bflo(a.z) + p5 * bfhi(a.z) + p6 * bflo(a.w) + p7 * bfhi(a.w);
                o1 += p0 * bflo(b.x) + p1 * bfhi(b.x) + p2 * bflo(b.y) + p3 * bfhi(b.y) + p4 * bflo(b.z) + p5 * bfhi(b.z) + p6 * bflo(b.w) + p7 * bfhi(b.w); }
        }
        const float il = 1.f / l;
        *(unsigned*)(ATT + (size_t)q * 2048 + h * 128 + 2 * lane) = pk2(o0 * il, o1 * il);
        asm volatile("" ::: "memory");
    }
}
__device__ __forceinline__ void hgrn_naive(unsigned char* ws, int layer, int gw, int ngw, int lane) {
    const bf16* HQ = (const bf16*)(ws + WS_HQ); const float* HF = (const float*)(ws + WS_HF); const bf16* VTH = (const bf16*)(ws + WS_VTH);
    const float* LB = (const float*)(ws + WS_LB) + layer * 2048; float* RR = (float*)(ws + WS_RRAW);
    for (int item = gw; item < NH * 128; item += ngw) {
        const int h = item >> 7, e = item & 127, ch = h * 128 + 2 * lane;
        const float lb0 = LB[ch], lb1 = LB[ch + 1];
        float s0 = 0.f, s1 = 0.f;
        const bf16* vp = VTH + (size_t)(h * 128 + e) * S_;
        for (int t0 = 0; t0 < S_; t0 += 8) {
            const v4u vv = *(const v4u*)(vp + t0);
            const float vt[8] = {bflo(vv.x), bfhi(vv.x), bflo(vv.y), bfhi(vv.y), bflo(vv.z), bfhi(vv.z), bflo(vv.w), bfhi(vv.w)};
            float ov = 0.f;
#pragma unroll
            for (int i = 0; i < 8; ++i) { const size_t off = (size_t)(t0 + i) * 2048 + ch;
                const f32x2 z = *(const f32x2*)(HF + off); const unsigned qq = *(const unsigned*)(HQ + off);
                const float f0 = lb0 + (1.f - lb0) * sigm(z.x), f1 = lb1 + (1.f - lb1) * sigm(z.y);
                s0 = fmaxf(f0, 1e-30f) * s0 + (1.f - f0) * vt[i]; s1 = fmaxf(f1, 1e-30f) * s1 + (1.f - f1) * vt[i];
                const float o = wave_sum(bflo(qq) * s0 + bfhi(qq) * s1);
                ov = (lane == i) ? o : ov; }
            if (lane < 8) RR[(size_t)(t0 + lane) * 2048 + h * 128 + e] = ov;
        }
    }
}
__device__ __forceinline__ void hgrn_normgate(unsigned char* ws, const float* gain, int gw, int ngw, int lane) {
    const float* RR = (const float*)(ws + WS_RRAW); const bf16* HG = (const bf16*)(ws + WS_HG); bf16* REC = (bf16*)(ws + WS_REC);
    const f32x2 g = *(const GAS f32x2*)(gain + 2 * lane);
    for (int item = gw; item < S_ * NH; item += ngw) {
        const size_t off = (size_t)item * 128 + 2 * lane;
        const f32x2 v = *(const f32x2*)(RR + off); const unsigned hg = *(const unsigned*)(HG + off);
        const float rstd = 1.0f / sqrtf(wave_sum(v.x * v.x + v.y * v.y) * (1.f / 128.f) + EPS);
        *(unsigned*)(REC + off) = pk2(v.x * rstd * g.x * bflo(hg), v.y * rstd * g.y * bfhi(hg));
    }
}
__device__ __forceinline__ void conv_gate(unsigned char* ws, const float* cw, const float* cb, int gw, int ngw, int lane) {
    const bf16* U = (const bf16*)(ws + WS_U); bf16* ACT = (bf16*)(ws + WS_ACT);
    for (int item = gw; item < (S_ / 16) * 11; item += ngw) {
        const int tb = item / 11, cg = item % 11, c0 = cg * 512 + lane * 8;
        const int ucol = (c0 >> 7) * 256 + (c0 & 127), t0 = tb * 16;
        float wg[3][8], wu[3][8], bg[8], bu[8];
#pragma unroll
        for (int j = 0; j < 3; ++j)
#pragma unroll
            for (int i = 0; i < 8; ++i) { wg[j][i] = ((const GAS float*)cw)[(size_t)j * DFF2 + c0 + i]; wu[j][i] = ((const GAS float*)cw)[(size_t)j * DFF2 + DFF + c0 + i]; }
#pragma unroll
        for (int i = 0; i < 8; ++i) { bg[i] = ((const GAS float*)cb)[c0 + i]; bu[i] = ((const GAS float*)cb)[DFF + c0 + i]; }
        float g2[8], g1[8], u2[8], u1[8];
#pragma unroll
        for (int i = 0; i < 8; ++i) { g2[i] = 0.f; g1[i] = 0.f; u2[i] = 0.f; u1[i] = 0.f; }
        if (t0 > 0) {
            const v4u a = *(const v4u*)(U + (size_t)(t0 - 2) * DFF2 + ucol), b = *(const v4u*)(U + (size_t)(t0 - 2) * DFF2 + ucol + 128);
            const v4u c = *(const v4u*)(U + (size_t)(t0 - 1) * DFF2 + ucol), d = *(const v4u*)(U + (size_t)(t0 - 1) * DFF2 + ucol + 128);
            g2[0] = bflo(a.x); g2[1] = bfhi(a.x); g2[2] = bflo(a.y); g2[3] = bfhi(a.y); g2[4] = bflo(a.z); g2[5] = bfhi(a.z); g2[6] = bflo(a.w); g2[7] = bfhi(a.w);
            u2[0] = bflo(b.x); u2[1] = bfhi(b.x); u2[2] = bflo(b.y); u2[3] = bfhi(b.y); u2[4] = bflo(b.z); u2[5] = bfhi(b.z); u2[6] = bflo(b.w); u2[7] = bfhi(b.w);
            g1[0] = bflo(c.x); g1[1] = bfhi(c.x); g1[2] = bflo(c.y); g1[3] = bfhi(c.y); g1[4] = bflo(c.z); g1[5] = bfhi(c.z); g1[6] = bflo(c.w); g1[7] = bfhi(c.w);
            u1[0] = bflo(d.x); u1[1] = bfhi(d.x); u1[2] = bflo(d.y); u1[3] = bfhi(d.y); u1[4] = bflo(d.z); u1[5] = bfhi(d.z); u1[6] = bflo(d.w); u1[7] = bfhi(d.w);
        }
#pragma unroll 4
        for (int t = t0; t < t0 + 16; ++t) {
            const v4u a = *(const v4u*)(U + (size_t)t * DFF2 + ucol), b = *(const v4u*)(U + (size_t)t * DFF2 + ucol + 128);
            float g0[8], u0[8];
            g0[0] = bflo(a.x); g0[1] = bfhi(a.x); g0[2] = bflo(a.y); g0[3] = bfhi(a.y); g0[4] = bflo(a.z); g0[5] = bfhi(a.z); g0[6] = bflo(a.w); g0[7] = bfhi(a.w);
            u0[0] = bflo(b.x); u0[1] = bfhi(b.x); u0[2] = bflo(b.y); u0[3] = bfhi(b.y); u0[4] = bflo(b.z); u0[5] = bfhi(b.z); u0[6] = bflo(b.w); u0[7] = bfhi(b.w);
            float r[8];
#pragma unroll
            for (int i = 0; i < 8; ++i) { const float G = bg[i] + wg[0][i] * g2[i] + wg[1][i] * g1[i] + wg[2][i] * g0[i]; const float Uu = bu[i] + wu[0][i] * u2[i] + wu[1][i] * u1[i] + wu[2][i] * u0[i];
                r[i] = G * sigm(G) * Uu; g2[i] = g1[i]; g1[i] = g0[i]; u2[i] = u1[i]; u1[i] = u0[i]; }
            v4u o; o.x = pk2(r[0], r[1]); o.y = pk2(r[2], r[3]); o.z = pk2(r[4], r[5]); o.w = pk2(r[6], r[7]);
            *(v4u*)(ACT + (size_t)t * DFF + c0) = o;
        }
    }
}

namespace fa {
typedef float f32x16 __attribute__((ext_vector_type(16)));
constexpr int KBUF = 24576, VBUF = 16384, STG = KBUF + VBUF;
constexpr float THR = 8.0f;
__device__ __forceinline__ float hmax(float a) { return fmaxf(a, __shfl_xor(a, 32)); }
__device__ __forceinline__ float hsum(float a) { return a + __shfl_xor(a, 32); }
__device__ __forceinline__ bf16x8 pk8(const f32x16& p, int b) {
    v4u w; w.x = pg8::cvt_pk_bf16(p[b], p[b + 1]); w.y = pg8::cvt_pk_bf16(p[b + 2], p[b + 3]); w.z = pg8::cvt_pk_bf16(p[b + 4], p[b + 5]); w.w = pg8::cvt_pk_bf16(p[b + 6], p[b + 7]);
    return __builtin_bit_cast(bf16x8, w);
}
__device__ __forceinline__ void attn_fast(unsigned char* ws, LAS unsigned char* lds, int vcu, int G) {
    int tid = threadIdx.x; asm volatile("" : "+v"(tid));
    const int lane = tid & 63, w = __builtin_amdgcn_readfirstlane(tid >> 6), r32 = lane & 31, hi = lane >> 5;
    const bf16* QN = (const bf16*)(ws + WS_QN); const bf16* QR = (const bf16*)(ws + WS_QR); const bf16* KN = (const bf16*)(ws + WS_KN);
    const bf16* KPE = (const bf16*)(ws + WS_KPE); const bf16* VT = (const bf16*)(ws + WS_VT); bf16* ATT = (bf16*)(ws + WS_ATT);
    const int pr = (r32 & 0x13) | ((r32 & 4) << 1) | ((r32 & 8) >> 1);
    const int kfo = hi * 1024 + pr * 16;
    const int fb = (r32 >> 1) & 7, va = (hi ^ (fb & 1)) << 4, vbb = fb >> 1;
    const int vfo = KBUF + r32 * 128 + va;
    const int vrow0 = 16 * w + (lane >> 3), vrow1 = vrow0 + 8;
    const int vsc0 = ((lane & 7) ^ ((vrow0 >> 1) & 7)) * 8, vsc1 = ((lane & 7) ^ ((vrow1 >> 1) & 7)) * 8;
    for (int item = vcu; item < 256; item += G) {
        const int h = item >> 4, sidx = item & 15;
        const bf16* kn_l = KN + (size_t)lane * 2048 + h * 128 + 8 * w;
        const bf16* kp_l = KPE + (size_t)lane * 64 + 8 * w;
        const bf16* v0_l = VT + (size_t)(h * 128 + vrow0) * S_ + vsc0; const bf16* v1_l = VT + (size_t)(h * 128 + vrow1) * S_ + vsc1;
#define FA_ISSUE(t, st) do { const size_t ko_ = (size_t)(t) * 64 * 2048, po_ = (size_t)(t) * 64 * 64; const int to_ = (t) * 64; LAS unsigned char* sb_ = lds + (st) * STG; \
        __builtin_amdgcn_global_load_lds((const unsigned*)(kn_l + ko_), (LAS unsigned*)(sb_ + w * 1024), 16, 0, 0); \
        __builtin_amdgcn_global_load_lds((const unsigned*)(kn_l + ko_ + 64), (LAS unsigned*)(sb_ + (w + 8) * 1024), 16, 0, 0); \
        __builtin_amdgcn_global_load_lds((const unsigned*)(kp_l + po_), (LAS unsigned*)(sb_ + (w + 16) * 1024), 16, 0, 0); \
        __builtin_amdgcn_global_load_lds((const unsigned*)(v0_l + to_), (LAS unsigned*)(sb_ + KBUF + (2 * w) * 1024), 16, 0, 0); \
        __builtin_amdgcn_global_load_lds((const unsigned*)(v1_l + to_), (LAS unsigned*)(sb_ + KBUF + (2 * w + 1) * 1024), 16, 0, 0); } while (0)
        for (int pass = 0; pass < 2; ++pass) {
            const int qb = pass ? sidx : 31 - sidx, q0 = qb * 256, NT = 4 * qb + 4, qw = q0 + 32 * w, q = qw + r32;
            FA_ISSUE(0, 0);
            bf16x8 qr[12];
#pragma unroll
            for (int d0 = 0; d0 < 8; ++d0) qr[d0] = *(const bf16x8*)(QN + (size_t)q * 2048 + h * 128 + d0 * 16 + hi * 8);
#pragma unroll
            for (int d0 = 0; d0 < 4; ++d0) qr[8 + d0] = *(const bf16x8*)(QR + (size_t)q * 1024 + h * 64 + d0 * 16 + hi * 8);
            f32x16 o[4];
#pragma unroll
            for (int e = 0; e < 4; ++e)
#pragma unroll
                for (int r = 0; r < 16; ++r) o[e][r] = 0.f;
            float m = -__builtin_inff(), l = 0.f;
            for (int t = 0; t < NT; ++t) {
                VM_WAIT(); __syncthreads();
                if (t + 1 < NT) FA_ISSUE(t + 1, (t + 1) & 1);
                {
                    const LAS unsigned char* sb = lds + (t & 1) * STG;
                    f32x16 p0, p1;
#pragma unroll
                    for (int r = 0; r < 16; ++r) { p0[r] = 0.f; p1[r] = 0.f; }
                    {
#define FA_KLD(g, A0, A1, B0, B1) do { A0 = *(const LAS bf16x8*)(sb + kfo + (2 * (g)) * 2048); A1 = *(const LAS bf16x8*)(sb + kfo + (2 * (g)) * 2048 + 512); \
                                       B0 = *(const LAS bf16x8*)(sb + kfo + (2 * (g) + 1) * 2048); B1 = *(const LAS bf16x8*)(sb + kfo + (2 * (g) + 1) * 2048 + 512); } while (0)
#define FA_KMM(g, A0, A1, B0, B1) do { p0 = __builtin_amdgcn_mfma_f32_32x32x16_bf16(A0, qr[2 * (g)], p0, 0, 0, 0); p1 = __builtin_amdgcn_mfma_f32_32x32x16_bf16(A1, qr[2 * (g)], p1, 0, 0, 0); \
                                       p0 = __builtin_amdgcn_mfma_f32_32x32x16_bf16(B0, qr[2 * (g) + 1], p0, 0, 0, 0); p1 = __builtin_amdgcn_mfma_f32_32x32x16_bf16(B1, qr[2 * (g) + 1], p1, 0, 0, 0); } while (0)
                        bf16x8 xa0, xa1, xb0, xb1, ya0, ya1, yb0, yb1;
                        FA_KLD(0, xa0, xa1, xb0, xb1); __builtin_amdgcn_sched_barrier(0);
                        FA_KLD(1, ya0, ya1, yb0, yb1); __builtin_amdgcn_sched_barrier(0); FA_KMM(0, xa0, xa1, xb0, xb1); __builtin_amdgcn_sched_barrier(0);
                        FA_KLD(2, xa0, xa1, xb0, xb1); __builtin_amdgcn_sched_barrier(0); FA_KMM(1, ya0, ya1, yb0, yb1); __builtin_amdgcn_sched_barrier(0);
                        FA_KLD(3, ya0, ya1, yb0, yb1); __builtin_amdgcn_sched_barrier(0); FA_KMM(2, xa0, xa1, xb0, xb1); __builtin_amdgcn_sched_barrier(0);
                        FA_KLD(4, xa0, xa1, xb0, xb1); __builtin_amdgcn_sched_barrier(0); FA_KMM(3, ya0, ya1, yb0, yb1); __builtin_amdgcn_sched_barrier(0);
                        FA_KLD(5, ya0, ya1, yb0, yb1); __builtin_amdgcn_sched_barrier(0); FA_KMM(4, xa0, xa1, xb0, xb1); __builtin_amdgcn_sched_barrier(0);
                        FA_KMM(5, ya0, ya1, yb0, yb1);
#undef FA_KLD
#undef FA_KMM
                    }
                    if (64 * t + 63 > qw) {
                        const int kb = 64 * t + 8 * hi - q;
#pragma unroll
                        for (int r = 0; r < 16; ++r) { const int dk = kb + 16 * (r >> 3) + (r & 7); if (dk > 0) p0[r] = -__builtin_inff(); if (dk + 32 > 0) p1[r] = -__builtin_inff(); }
                    }
                    float mx = fmaxf(p0[0], p1[0]);
#pragma unroll
                    for (int r = 1; r < 16; ++r) mx = fmaxf(mx, fmaxf(p0[r], p1[r]));
                    mx = hmax(mx);
                    { const float mn = fmaxf(m, mx), alpha = __builtin_amdgcn_exp2f(m - mn); m = mn; l *= alpha;
#pragma unroll
                        for (int e = 0; e < 4; ++e)
#pragma unroll
                            for (int r = 0; r < 16; ++r) o[e][r] *= alpha; }
                    float ps = 0.f;
#pragma unroll
                    for (int r = 0; r < 16; ++r) { p0[r] = __builtin_amdgcn_exp2f(p0[r] - m); p1[r] = __builtin_amdgcn_exp2f(p1[r] - m); ps += p0[r] + p1[r]; }
                    l += ps;
                    const bf16x8 pf0 = pk8(p0, 0), pf1 = pk8(p0, 8), pf2 = pk8(p1, 0), pf3 = pk8(p1, 8);
                    const LAS unsigned char* vb0 = sb + vfo + ((0 ^ vbb) << 5); const LAS unsigned char* vb1 = sb + vfo + ((1 ^ vbb) << 5);
                    const LAS unsigned char* vb2 = sb + vfo + ((2 ^ vbb) << 5); const LAS unsigned char* vb3 = sb + vfo + ((3 ^ vbb) << 5);
#pragma unroll
                    for (int e = 0; e < 4; ++e) {
                        const bf16x8 a0 = *(const LAS bf16x8*)(vb0 + e * 4096), a1 = *(const LAS bf16x8*)(vb1 + e * 4096), a2 = *(const LAS bf16x8*)(vb2 + e * 4096), a3 = *(const LAS bf16x8*)(vb3 + e * 4096);
                        o[e] = __builtin_amdgcn_mfma_f32_32x32x16_bf16(a0, pf0, o[e], 0, 0, 0); o[e] = __builtin_amdgcn_mfma_f32_32x32x16_bf16(a1, pf1, o[e], 0, 0, 0);
                        o[e] = __builtin_amdgcn_mfma_f32_32x32x16_bf16(a2, pf2, o[e], 0, 0, 0); o[e] = __builtin_amdgcn_mfma_f32_32x32x16_bf16(a3, pf3, o[e], 0, 0, 0); }
                }
            }
            const float il = 1.0f / hsum(l);
            bf16* op = ATT + (size_t)q * 2048 + h * 128 + 4 * hi;
#pragma unroll
            for (int e = 0; e < 4; ++e)
#pragma unroll
                for (int g4 = 0; g4 < 4; ++g4) { v2u wv; wv.x = pg8::cvt_pk_bf16(o[e][4 * g4] * il, o[e][4 * g4 + 1] * il); wv.y = pg8::cvt_pk_bf16(o[e][4 * g4 + 2] * il, o[e][4 * g4 + 3] * il);
                    *(v2u*)(op + e * 32 + g4 * 8) = wv; }
            __syncthreads();
        }
#undef FA_ISSUE
    }
}
}

namespace hg {
typedef float f32x16 __attribute__((ext_vector_type(16)));
constexpr int L_TOT = 0, L_KT = 4096;
constexpr int L_QA = 4096, L_QB = 20480, L_KA0 = 28672, L_KA1 = 36864, L_SSP = 53248;
__device__ __forceinline__ float log2_(float x) { return __builtin_amdgcn_logf(x); }
__device__ __forceinline__ float exp2_(float x) { return __builtin_amdgcn_exp2f(x); }
__device__ __forceinline__ bf16x8 pk8(const f32x16& p, int b) {
    v4u w; w.x = pg8::cvt_pk_bf16(p[b], p[b + 1]); w.y = pg8::cvt_pk_bf16(p[b + 2], p[b + 3]); w.z = pg8::cvt_pk_bf16(p[b + 4], p[b + 5]); w.w = pg8::cvt_pk_bf16(p[b + 6], p[b + 7]);
    return __builtin_bit_cast(bf16x8, w);
}
#define HG_GATES(HFp, lbv, t0, h) \
    float kk[16], bl[16]; { float run_ = 0.f; const float* zp_ = (HFp) + (size_t)((t0) + 16 * tg) * 2048 + (h) * 128 + d; \
      _Pragma("unroll") for (int i = 0; i < 16; ++i) { const float z_ = zp_[(size_t)i * 2048]; const float f_ = (lbv) + (1.f - (lbv)) * sigm(z_); kk[i] = 1.f - f_; run_ += log2_(fmaxf(f_, 1e-30f)); bl[i] = run_; } }

__device__ __forceinline__ void pass1(unsigned char* ws, LAS unsigned char* lds, int layer, int vcu, int G) {
    int tid = threadIdx.x; asm volatile("" : "+v"(tid));
    const int lane = tid & 63, w = __builtin_amdgcn_readfirstlane(tid >> 6), d = tid & 127, tg = tid >> 7, r32 = lane & 31, hi = lane >> 5;
    const float* HF = (const float*)(ws + WS_HF); const bf16* VTH = (const bf16*)(ws + WS_VTH); bf16* HU = (bf16*)(ws + WS_HU); float* GAM = (float*)(ws + WS_RRAW);
    const float* LB = (const float*)(ws + WS_LB) + layer * 2048;
    LAS float* tot = (LAS float*)(lds + L_TOT); LAS unsigned char* KT = lds + L_KT;
    const int fsw = (d >> 1) & 7, fsr = (r32 >> 1) & 7, et = w >> 1, dt0 = 2 * (w & 1);
    for (int unit = vcu; unit < NH * 128; unit += G) {
        const int h = unit >> 7, c = unit & 127, t0 = c * 64;
        const float lb = LB[h * 128 + d];
        HG_GATES(HF, lb, t0, h);
        tot[tg * 128 + d] = bl[15];
        __syncthreads();
        float pre = 0.f, all = 0.f;
#pragma unroll
        for (int j = 0; j < 4; ++j) { const float v = tot[j * 128 + d]; pre += (j < tg) ? v : 0.f; all += v; }
        { float kh[16];
#pragma unroll
          for (int i = 0; i < 16; ++i) kh[i] = kk[i] * exp2_(all - (pre + bl[i]));
          v4u c0, c1; c0.x = pk2(kh[0], kh[1]); c0.y = pk2(kh[2], kh[3]); c0.z = pk2(kh[4], kh[5]); c0.w = pk2(kh[6], kh[7]);
          c1.x = pk2(kh[8], kh[9]); c1.y = pk2(kh[10], kh[11]); c1.z = pk2(kh[12], kh[13]); c1.w = pk2(kh[14], kh[15]);
          *(LAS v4u*)(KT + d * 128 + (((2 * tg) ^ fsw) << 4)) = c0; *(LAS v4u*)(KT + d * 128 + (((2 * tg + 1) ^ fsw) << 4)) = c1; }
        if (tg == 0) GAM[(size_t)(h * 128 + c) * 128 + d] = exp2_(all);
        bf16x8 af[4];
#pragma unroll
        for (int ks = 0; ks < 4; ++ks) af[ks] = *(const bf16x8*)(VTH + (size_t)(h * 128 + 32 * et + r32) * S_ + t0 + 16 * ks + 8 * hi);
        __syncthreads();
#pragma unroll
        for (int dd = 0; dd < 2; ++dd) { const int dt = dt0 + dd; f32x16 acc;
#pragma unroll
            for (int r = 0; r < 16; ++r) acc[r] = 0.f;
#pragma unroll
            for (int ks = 0; ks < 4; ++ks) { const bf16x8 bq = *(const LAS bf16x8*)(KT + (32 * dt + r32) * 128 + (((2 * ks + hi) ^ fsr) << 4)); acc = __builtin_amdgcn_mfma_f32_32x32x16_bf16(af[ks], bq, acc, 0, 0, 0); }
            bf16* up = HU + ((size_t)(h * 128 + c) * 128 + 32 * et + 4 * hi) * 128 + 32 * dt + r32;
#pragma unroll
            for (int r = 0; r < 16; ++r) up[(size_t)((r & 3) + 8 * (r >> 2)) * 128] = (bf16)f2bf(acc[r]); }
        __syncthreads();
    }
}
__device__ __forceinline__ void scan(unsigned char* ws, int gtid, int nthr) {
    const bf16* HU = (const bf16*)(ws + WS_HU); const float* GAM = (const float*)(ws + WS_RRAW); bf16* HS = (bf16*)(ws + WS_HS);
    for (int idx = gtid; idx < NH * 128 * 64; idx += nthr) {
        const int h = idx >> 13, e = (idx >> 6) & 127, d = 2 * (idx & 63);
        float s0 = 0.f, s1 = 0.f;
#pragma unroll 8
        for (int c = 0; c < 128; ++c) { const size_t base = ((size_t)(h * 128 + c) * 128 + e) * 128 + d;
            *(unsigned*)(HS + base) = pk2(s0, s1);
            const unsigned u = *(const unsigned*)(HU + base); const f32x2 gm = *(const f32x2*)(GAM + (size_t)(h * 128 + c) * 128 + d);
            s0 = gm.x * s0 + bflo(u); s1 = gm.y * s1 + bfhi(u); }
    }
}
__device__ __forceinline__ void pass3(unsigned char* ws, LAS unsigned char* lds, const float* gain, int layer, int vcu, int G) {
    int tid = threadIdx.x; asm volatile("" : "+v"(tid));
    const int lane = tid & 63, w = __builtin_amdgcn_readfirstlane(tid >> 6), d = tid & 127, tg = tid >> 7, r32 = lane & 31, hi = lane >> 5;
    const float* HF = (const float*)(ws + WS_HF); const bf16* HQ = (const bf16*)(ws + WS_HQ); const bf16* HG = (const bf16*)(ws + WS_HG); const bf16* VTH = (const bf16*)(ws + WS_VTH);
    const bf16* HS = (const bf16*)(ws + WS_HS); bf16* REC = (bf16*)(ws + WS_REC); const float* LB = (const float*)(ws + WS_LB) + layer * 2048;
    LAS float* tot = (LAS float*)(lds + L_TOT); LAS float* SSP = (LAS float*)(lds + L_SSP);
    const int et = w & 3, tb = w >> 2, pr = (r32 & 0x13) | ((r32 & 4) << 1) | ((r32 & 8) >> 1);
    const int eo = (d >> 3) * 16, ei = (d & 7) * 2;
    for (int unit = vcu; unit < NH * 128; unit += G) {
        const int h = unit >> 7, c = unit & 127, t0 = c * 64;
        const float lb = LB[h * 128 + d];
        HG_GATES(HF, lb, t0, h);
        float qv[16];
        { const bf16* qp = HQ + (size_t)(t0 + 16 * tg) * 2048 + h * 128 + d;
#pragma unroll
          for (int i = 0; i < 16; ++i) qv[i] = __builtin_bit_cast(float, (unsigned)qp[(size_t)i * 2048] << 16); }
        tot[tg * 128 + d] = bl[15];
        __syncthreads();
        const float t_0 = tot[d], t_1 = tot[128 + d], t_2 = tot[256 + d];
        const float pre = (tg > 0 ? t_0 : 0.f) + (tg > 1 ? t_1 : 0.f) + (tg > 2 ? t_2 : 0.f), b31 = t_0 + t_1;
#pragma unroll
        for (int i = 0; i < 16; ++i) { const float b = pre + bl[i]; const int row = 16 * tg + i;
            *(LAS bf16*)(lds + L_QA + eo * 64 + row * 16 + ei) = (bf16)f2bf(qv[i] * exp2_(b));
            *(LAS bf16*)(lds + L_KA1 + eo * 64 + row * 16 + ei) = (bf16)f2bf(kk[i] * exp2_(b31 - b));
            if (tg < 2) *(LAS bf16*)(lds + L_KA0 + eo * 32 + row * 16 + ei) = (bf16)f2bf(kk[i] * exp2_(-b));
            else *(LAS bf16*)(lds + L_QB + eo * 32 + (row - 32) * 16 + ei) = (bf16)f2bf(qv[i] * exp2_(b - b31)); }
        __syncthreads();
        f32x16 o;
#pragma unroll
        for (int r = 0; r < 16; ++r) o[r] = 0.f;
        { const bf16* sp = HS + ((size_t)(h * 128 + c) * 128 + 32 * et + r32) * 128 + 8 * hi; const LAS unsigned char* qb_ = lds + L_QA + hi * 1024 + (32 * tb + r32) * 16;
#pragma unroll
          for (int kd = 0; kd < 8; ++kd) { const bf16x8 a = *(const bf16x8*)(sp + 16 * kd); const bf16x8 b = *(const LAS bf16x8*)(qb_ + kd * 2048); o = __builtin_amdgcn_mfma_f32_32x32x16_bf16(a, b, o, 0, 0, 0); } }
        const bf16* vp = VTH + (size_t)(h * 128 + 32 * et + r32) * S_ + t0 + 8 * hi;
        if (tb == 0) {
            f32x16 p;
#pragma unroll
            for (int r = 0; r < 16; ++r) p[r] = 0.f;
            const LAS unsigned char* ka = lds + L_KA0 + hi * 512 + pr * 16; const LAS unsigned char* qa = lds + L_QA + hi * 1024 + r32 * 16;
#pragma unroll
            for (int kd = 0; kd < 8; ++kd) p = __builtin_amdgcn_mfma_f32_32x32x16_bf16(*(const LAS bf16x8*)(ka + kd * 1024), *(const LAS bf16x8*)(qa + kd * 2048), p, 0, 0, 0);
#pragma unroll
            for (int r = 0; r < 16; ++r) if (16 * (r >> 3) + 8 * hi + (r & 7) > r32) p[r] = 0.f;
            o = __builtin_amdgcn_mfma_f32_32x32x16_bf16(*(const bf16x8*)(vp), pk8(p, 0), o, 0, 0, 0);
            o = __builtin_amdgcn_mfma_f32_32x32x16_bf16(*(const bf16x8*)(vp + 16), pk8(p, 8), o, 0, 0, 0);
        } else {
            f32x16 p0, p1;
#pragma unroll
            for (int r = 0; r < 16; ++r) { p0[r] = 0.f; p1[r] = 0.f; }
            const LAS unsigned char* ka = lds + L_KA1 + hi * 1024 + pr * 16; const LAS unsigned char* qa = lds + L_QB + hi * 512 + r32 * 16;
#pragma unroll
            for (int kd = 0; kd < 8; ++kd) { const bf16x8 qf = *(const LAS bf16x8*)(qa + kd * 1024);
                p0 = __builtin_amdgcn_mfma_f32_32x32x16_bf16(*(const LAS bf16x8*)(ka + kd * 2048), qf, p0, 0, 0, 0);
                p1 = __builtin_amdgcn_mfma_f32_32x32x16_bf16(*(const LAS bf16x8*)(ka + kd * 2048 + 512), qf, p1, 0, 0, 0); }
#pragma unroll
            for (int r = 0; r < 16; ++r) if (16 * (r >> 3) + 8 * hi + (r & 7) > r32) p1[r] = 0.f;
            o = __builtin_amdgcn_mfma_f32_32x32x16_bf16(*(const bf16x8*)(vp), pk8(p0, 0), o, 0, 0, 0);
            o = __builtin_amdgcn_mfma_f32_32x32x16_bf16(*(const bf16x8*)(vp + 16), pk8(p0, 8), o, 0, 0, 0);
            o = __builtin_amdgcn_mfma_f32_32x32x16_bf16(*(const bf16x8*)(vp + 32), pk8(p1, 0), o, 0, 0, 0);
            o = __builtin_amdgcn_mfma_f32_32x32x16_bf16(*(const bf16x8*)(vp + 48), pk8(p1, 8), o, 0, 0, 0);
        }
        float ss = 0.f;
#pragma unroll
        for (int r = 0; r < 16; ++r) ss += o[r] * o[r];
        ss += __shfl_xor(ss, 32);
        if (hi == 0) SSP[(tb * 4 + et) * 32 + r32] = ss;
        __syncthreads();
        const float rstd = 1.0f / sqrtf((SSP[(tb * 4 + 0) * 32 + r32] + SSP[(tb * 4 + 1) * 32 + r32] + SSP[(tb * 4 + 2) * 32 + r32] + SSP[(tb * 4 + 3) * 32 + r32]) * (1.f / 128.f) + EPS);
        { const size_t ro = (size_t)(t0 + 32 * tb + r32) * 2048 + h * 128 + 32 * et + 4 * hi;
#pragma unroll
          for (int g4 = 0; g4 < 4; ++g4) { const f32x4 gn = *(const GAS f32x4*)(gain + 32 * et + 4 * hi + 8 * g4); const v2u hv = *(const v2u*)(HG + ro + 8 * g4);
              v2u ov; ov.x = pk2(o[4 * g4] * rstd * gn.x * bflo(hv.x), o[4 * g4 + 1] * rstd * gn.y * bfhi(hv.x)); ov.y = pk2(o[4 * g4 + 2] * rstd * gn.z * bflo(hv.y), o[4 * g4 + 3] * rstd * gn.w * bfhi(hv.y));
              *(v2u*)(REC + ro + 8 * g4) = ov; } }
        __syncthreads();
    }
}
#undef HG_GATES
}

#ifndef PROBE
#define PROBE 0
#endif
#define REPS(k) (((PROBE >> (k)) & 1) + 1)
#define XBAR(b) do { for (int rb_ = 0; rb_ < REPS(8); ++rb_) xcd_barrier(b); } while (0)
#ifndef NAIVE_ATTN
#define NAIVE_ATTN 0
#endif
#ifndef NAIVE_HGRN
#define NAIVE_HGRN 0
#endif
struct Args { const float* in[19]; float* out; unsigned char* ws; };
enum { I_X = 0, I_POS, I_ANG, I_WIN, I_QNG, I_WUQ, I_KVNG, I_WUKV, I_LBL, I_HONG, I_WA, I_WB, I_WO, I_FNG, I_WUP, I_CW, I_CB, I_WDN, I_FING };

__global__ void __launch_bounds__(NTHR, 2) mk_fwd(Args args) {
    extern __shared__ __attribute__((aligned(16))) unsigned char lds_raw[];
    LAS unsigned char* lds = (LAS unsigned char*)lds_raw;
    const int tid = threadIdx.x, lane = tid & 63, wave = __builtin_amdgcn_readfirstlane(tid >> 6);
    const int G = gridDim.x, bx = blockIdx.x, vcu = (G % 8 == 0) ? (bx % 8) * (G / 8) + bx / 8 : bx;
    const int gw = vcu * NWAVES + wave, ngw = G * NWAVES;
    unsigned char* ws = args.ws;
    for (int u = tid; u < (LDS_BYTES - LDSCTL_OFF) / 4; u += NTHR) ((LAS unsigned*)(lds + LDSCTL_OFF))[u] = 0u;
    __syncthreads();
    XcdBarrier bar = xcd_barrier_post((unsigned*)(ws + WS_CTL) + CW_BAR, (volatile LAS unsigned*)(lds + MISC_OFF) + 8);
    float* X = args.out;
    if (tid < 19) ((LAS unsigned long long*)(lds + MISC_OFF + 128))[tid] = ((const __attribute__((address_space(4))) unsigned long long*)__builtin_amdgcn_kernarg_segment_ptr())[tid];
    __syncthreads();
#define INP(i) ((const float*)(((unsigned long long)(unsigned)__builtin_amdgcn_readfirstlane((int)(((LAS const unsigned long long*)(lds + MISC_OFF + 128))[i] >> 32)) << 32) | (unsigned long long)(unsigned)__builtin_amdgcn_readfirstlane((int)(unsigned)((LAS const unsigned long long*)(lds + MISC_OFF + 128))[i])))

    for (int rep = 0; rep < REPS(4); ++rep) {
        LAS float* scr = (LAS float*)(lds + RING_OFF + wave * 16384);
        constexpr int I_IN = 32 * (WINR / 32), I_UQ = 8 * 96, I_K = 8 * 64, I_V = 8 * 64, I_SQ = 32 * 64, I_UP = 32 * 352, I_DN = 88 * 64;
        constexpr int PER_LAYER = I_IN + I_UQ + I_K + I_V + 3 * I_SQ + I_UP + I_DN;
        const float* p_win = INP(I_WIN); const float* p_wuq = INP(I_WUQ); const float* p_wukv = INP(I_WUKV); const float* p_wa = INP(I_WA); const float* p_wb = INP(I_WB);
        const float* p_wo = INP(I_WO); const float* p_wup = INP(I_WUP); const float* p_wdn = INP(I_WDN); const float* p_qg = INP(I_QNG); const float* p_kvg = INP(I_KVNG);
#define T_DECODE(it, T) do { const int l_ = (it) / PER_LAYER; int r_ = (it) % PER_LAYER; unsigned char* wl_ = ws + WS_W + (size_t)l_ * LW; int kind_, nblk_; (T).scale = nullptr; \
        if (r_ < I_IN) { kind_ = 1; nblk_ = WINR / 32; (T).src = p_win + (size_t)l_ * DM * INW; (T).K = DM; (T).Nsrc = INW; (T).dst = (bf16*)(wl_ + LW_IN); } \
        else if ((r_ -= I_IN) < I_UQ) { kind_ = 2; nblk_ = 96; (T).src = p_wuq + (size_t)l_ * QL * 3072; (T).K = QL; (T).Nsrc = 3072; (T).dst = (bf16*)(wl_ + LW_UQ); (T).scale = p_qg + l_ * QL; } \
        else if ((r_ -= I_UQ) < I_K) { kind_ = 3; nblk_ = 64; (T).src = p_wukv + (size_t)l_ * KVL * 4096; (T).K = KVL; (T).Nsrc = 4096; (T).dst = (bf16*)(wl_ + LW_K); (T).scale = p_kvg + l_ * KVL; } \
        else if ((r_ -= I_K) < I_V) { kind_ = 4; nblk_ = 64; (T).src = p_wukv + (size_t)l_ * KVL * 4096; (T).K = KVL; (T).Nsrc = 4096; (T).dst = (bf16*)(wl_ + LW_V); (T).scale = p_kvg + l_ * KVL; } \
        else if ((r_ -= I_V) < I_SQ) { kind_ = 0; nblk_ = 64; (T).src = p_wa + (size_t)l_ * DM * DM; (T).K = DM; (T).Nsrc = DM; (T).dst = (bf16*)(wl_ + LW_A); } \
        else if ((r_ -= I_SQ) < I_SQ) { kind_ = 0; nblk_ = 64; (T).src = p_wb + (size_t)l_ * DM * DM; (T).K = DM; (T).Nsrc = DM; (T).dst = (bf16*)(wl_ + LW_B); } \
        else if ((r_ -= I_SQ) < I_SQ) { kind_ = 0; nblk_ = 64; (T).src = p_wo + (size_t)l_ * DM * DM; (T).K = DM; (T).Nsrc = DM; (T).dst = (bf16*)(wl_ + LW_O); } \
        else if ((r_ -= I_SQ) < I_UP) { kind_ = 5; nblk_ = 352; (T).src = p_wup + (size_t)l_ * DM * DFF2; (T).K = DM; (T).Nsrc = DFF2; (T).dst = (bf16*)(wl_ + LW_UP); } \
        else { r_ -= I_UP; kind_ = 0; nblk_ = 64; (T).src = p_wdn + (size_t)l_ * DFF * DM; (T).K = DFF; (T).Nsrc = DM; (T).dst = (bf16*)(wl_ + LW_DN); } \
        (T).k0 = 64 * (r_ / nblk_); (T).n0 = 32 * (r_ % nblk_); (T).sc = srcmap_rt(kind_, (T).n0 + (lane & 31)); } while (0)
#define T_LOAD(T, V) do { const GAS float* sp_ = (const GAS float*)(T).src + (size_t)((T).k0 + (lane >> 5)) * (T).Nsrc + ((T).sc >= 0 ? (T).sc : 0); \
        _Pragma("unroll") for (int i = 0; i < 32; ++i) (V)[i] = sp_[(size_t)(2 * i) * (T).Nsrc]; } while (0)
#define T_PROC(T, V) do { const bool z_ = (T).sc < 0; \
        if ((T).scale) { const GAS float* gp_ = (const GAS float*)(T).scale + (T).k0 + (lane >> 5); _Pragma("unroll") for (int i = 0; i < 32; ++i) (V)[i] *= gp_[2 * i]; } \
        _Pragma("unroll") for (int i = 0; i < 32; ++i) scr[(2 * i + (lane >> 5)) * 33 + (lane & 31)] = z_ ? 0.f : (V)[i]; \
        LDS_WAIT(); asm volatile("" ::: "memory"); \
        { const int c_ = lane & 7; _Pragma("unroll") for (int j = 0; j < 4; ++j) { const int n_ = (lane >> 3) + 8 * j; const LAS float* s_ = scr + (8 * c_) * 33 + n_; \
            v4u o_; o_.x = pk2(s_[0 * 33], s_[1 * 33]); o_.y = pk2(s_[2 * 33], s_[3 * 33]); o_.z = pk2(s_[4 * 33], s_[5 * 33]); o_.w = pk2(s_[6 * 33], s_[7 * 33]); \
            *(GAS v4u*)((T).dst + (size_t)((T).n0 + n_) * (T).K + (T).k0 + 8 * c_) = o_; } } \
        LDS_WAIT(); asm volatile("" ::: "memory"); } while (0)
        { TItem ta, tb; float va[32], vb[32]; int it = gw; const int NIT = DEPTH * PER_LAYER;
          if (it < NIT) { T_DECODE(it, ta); T_LOAD(ta, va); }
          while (it < NIT) {
              const int it1 = it + ngw; if (it1 < NIT) { T_DECODE(it1, tb); T_LOAD(tb, vb); }
              T_PROC(ta, va);
              if (it1 >= NIT) break;
              const int it2 = it1 + ngw; if (it2 < NIT) { T_DECODE(it2, ta); T_LOAD(ta, va); }
              T_PROC(tb, vb);
              it = it2; } }
#undef T_DECODE
#undef T_LOAD
#undef T_PROC
        { const GAS int* pos = (const GAS int*)INP(I_POS); float* COS = (float*)(ws + WS_COS); float* SIN = (float*)(ws + WS_SIN);
          for (int i = vcu * NTHR + tid; i < S_ * 32; i += G * NTHR) { const float ang = (float)pos[i >> 5] * c_invf[i & 31]; float sn, cs; sincos_f64(ang, sn, cs); COS[i] = cs; SIN[i] = sn; } }
        { const GAS float* lg = (const GAS float*)INP(I_LBL); float* LB = (float*)(ws + WS_LB);
          for (int c = vcu * NTHR + tid; c < 2048; c += G * NTHR) { const float a0 = lg[c], a1 = lg[2048 + c], a2 = lg[4096 + c], a3 = lg[6144 + c];
              const float mx = fmaxf(fmaxf(a0, a1), fmaxf(a2, a3)); const float e0 = expf(a0 - mx), e1 = expf(a1 - mx), e2 = expf(a2 - mx), e3 = expf(a3 - mx); const float inv = 1.f / (e0 + e1 + e2 + e3);
              LB[c] = 0.f; LB[2048 + c] = e1 * inv; LB[4096 + c] = (e1 + e2) * inv; LB[6144 + c] = (e1 + e2 + e3) * inv; } }
        for (int i = vcu * NTHR + tid; i < 2 * DM / 8; i += G * NTHR) *(GAS v4u*)(ws + WS_XN - 2 * DM * 2 + (size_t)i * 16) = (v4u){0u, 0u, 0u, 0u};
        for (int m = gw; m < S_; m += ngw) rms_row_to_bf16(INP(I_X) + (size_t)m * DM, INP(I_ANG), (bf16*)(ws + WS_XN) + (size_t)m * DM, X + (size_t)m * DM, lane);
    }
    XBAR(bar);

    for (int l = 0; l < DEPTH; ++l) {
        unsigned char* wl = ws + WS_W + (size_t)l * LW;
#define lane_l ({ int l_ = lane; asm volatile("" : "+v"(l_)); l_; })
        GAS unsigned char* wsg_ = (GAS unsigned char*)ws; GAS float* xg_ = (GAS float*)X; int Gl = G, bxl = bx, gwl = gw, ngwl = ngw, vcul = vcu;
        asm volatile("" : "+s"(wsg_), "+s"(Gl), "+s"(bxl), "+s"(gwl), "+s"(ngwl), "+s"(vcul), "+s"(xg_));
        unsigned char* wsl = (unsigned char*)wsg_; float* Xl = (float*)xg_;
        for (int rep = 0; rep < REPS(1); ++rep)
        { pg8::Gemm g{(const pg8::bf16_t*)(wsl + WS_XN), (const pg8::bf16_t*)(wl + LW_IN), S_, NNAT, DM, DM, DM}; pg8::StaticOrder S; S.init(S_, NNAT, Gl, bxl);
          pg8::EpiIn E{wsl}; pg8::gemm_phase<pg8::EpiIn, pg8::StaticOrder, true, true>(lds + RING_OFF, g, S, E); }
        { pg8::Gemm g{(const pg8::bf16_t*)(wl + LW_IN) + (size_t)NNAT * DM, (const pg8::bf16_t*)(wsl + WS_XN), 2048, S_, DM, DM, DM}; pg8::StaticOrder S; S.init(2048, S_, Gl, bxl);
          pg8::EpiStore E{(pg8::bf16_t*)(wsl + WS_VTH), S_}; pg8::gemm_phase<pg8::EpiStore, pg8::StaticOrder, true, true>(lds + RING_OFF, g, S, E); }
        XBAR(bar);
        for (int rep = 0; rep < REPS(3); ++rep) for (int m = gwl; m < S_; m += ngwl) latent_norm_row((bf16*)(wsl + WS_CQKV) + (size_t)m * 1024, lane_l);
        XBAR(bar);
        for (int rep = 0; rep < REPS(6); ++rep) {
        { pg8::Gemm g{(const pg8::bf16_t*)(wsl + WS_CQKV), (const pg8::bf16_t*)(wl + LW_UQ), S_, 3072, QL, 1024, QL}; pg8::StaticOrder S; S.init(S_, 3072, Gl, bxl);
          pg8::EpiQ E{wsl}; pg8::gemm_phase<pg8::EpiQ, pg8::StaticOrder, true, true>(lds + RING_OFF, g, S, E); }
        { pg8::Gemm g{(const pg8::bf16_t*)(wsl + WS_CQKV) + 512, (const pg8::bf16_t*)(wl + LW_K), S_, 2048, KVL, 1024, KVL}; pg8::StaticOrder S; S.init(S_, 2048, Gl, bxl);
          pg8::EpiStore E{(pg8::bf16_t*)(wsl + WS_KN), 2048}; pg8::gemm_phase<pg8::EpiStore, pg8::StaticOrder, true, true>(lds + RING_OFF, g, S, E); }
        { pg8::Gemm g{(const pg8::bf16_t*)(wl + LW_V), (const pg8::bf16_t*)(wsl + WS_CQKV) + 512, 2048, S_, KVL, KVL, 1024}; pg8::StaticOrder S; S.init(2048, S_, Gl, bxl);
          pg8::EpiStore E{(pg8::bf16_t*)(wsl + WS_VT), S_}; pg8::gemm_phase<pg8::EpiStore, pg8::StaticOrder, true, true>(lds + RING_OFF, g, S, E); }
        }
#if NAIVE_HGRN
        hgrn_naive(wsl, l, gwl, ngwl, lane_l);
        XBAR(bar);
#else
        for (int rep = 0; rep < REPS(2); ++rep) hg::pass1(wsl, lds + RING_OFF, l, vcul, Gl);
        XBAR(bar);
        for (int rep = 0; rep < REPS(2); ++rep) hg::scan(wsl, vcul * NTHR + (int)threadIdx.x, Gl * NTHR);
        XBAR(bar);
#endif
#if NAIVE_ATTN
        attn_naive(wsl, (LAS float*)(lds + RING_OFF) + wave * 192, gwl, ngwl, lane_l);
#else
        for (int rep = 0; rep < REPS(0); ++rep) fa::attn_fast(wsl, lds + RING_OFF, vcul, Gl);
#endif
#if NAIVE_HGRN
        hgrn_normgate(wsl, INP(I_HONG) + l * 128, gwl, ngwl, lane_l);
#else
        for (int rep = 0; rep < REPS(2); ++rep) hg::pass3(wsl, lds + RING_OFF, INP(I_HONG) + l * 128, l, vcul, Gl);
#endif
        XBAR(bar);
        for (int rep = 0; rep < REPS(7); ++rep) {
        { pg8::Gemm g{(const pg8::bf16_t*)(wsl + WS_ATT), (const pg8::bf16_t*)(wl + LW_A), S_, DM, DM, DM, DM}; pg8::StaticOrder S; S.init(S_, DM, Gl, bxl);
          pg8::EpiGateA E{wsl}; pg8::gemm_phase<pg8::EpiGateA, pg8::StaticOrder, true, true>(lds + RING_OFF, g, S, E); }
        { pg8::Gemm g{(const pg8::bf16_t*)(wsl + WS_REC), (const pg8::bf16_t*)(wl + LW_B), S_, DM, DM, DM, DM}; pg8::StaticOrder S; S.init(S_, DM, Gl, bxl);
          pg8::EpiGateB E{wsl}; pg8::gemm_phase<pg8::EpiGateB, pg8::StaticOrder, true, true>(lds + RING_OFF, g, S, E); }
        }
        XBAR(bar);
        { pg8::Gemm g{(const pg8::bf16_t*)(wsl + WS_MRG), (const pg8::bf16_t*)(wl + LW_O), S_, DM, DM, DM, DM}; pg8::StaticOrder S; S.init(S_, DM, Gl, bxl);
          pg8::EpiRes E{Xl}; pg8::gemm_phase<pg8::EpiRes, pg8::StaticOrder, true, true>(lds + RING_OFF, g, S, E); }
        XBAR(bar);
        for (int rep = 0; rep < REPS(3); ++rep) for (int m = gwl; m < S_; m += ngwl) rms_row_to_bf16(Xl + (size_t)m * DM, INP(I_FNG) + l * DM, (bf16*)(wsl + WS_XN) + (size_t)m * DM, nullptr, lane_l);
        XBAR(bar);
        for (int rep = 0; rep < REPS(5); ++rep)
        { pg8::Gemm g{(const pg8::bf16_t*)(wsl + WS_XN) - 2 * DM, (const pg8::bf16_t*)(wl + LW_UP), 33 * 256, DFF2, DM, DM, DM, 254}; pg8::StaticOrder S; S.init(33 * 256, DFF2, Gl, bxl);
          pg8::EpiConv E{(pg8::bf16_t*)(wsl + WS_ACT), INP(I_CW) + (size_t)l * 3 * DFF2, INP(I_CB) + (size_t)l * DFF2, (PG8_LAS float*)(lds + LDSCTL_OFF + 1024)};
          pg8::gemm_phase<pg8::EpiConv, pg8::StaticOrder, true, true>(lds + RING_OFF, g, S, E); }
        xcd_barrier(bar);
        { pg8::Gemm g{(const pg8::bf16_t*)(wsl + WS_ACT), (const pg8::bf16_t*)(wl + LW_DN), S_, DM, DFF, DFF, DFF}; pg8::StaticOrder S; S.init(S_, DM, Gl, bxl);
          pg8::EpiRes E{Xl}; pg8::gemm_phase<pg8::EpiRes, pg8::StaticOrder, true, true>(lds + RING_OFF, g, S, E); }
        XBAR(bar);
        if (l + 1 < DEPTH) { for (int rep = 0; rep < REPS(3); ++rep) for (int m = gwl; m < S_; m += ngwl) rms_row_to_bf16(Xl + (size_t)m * DM, INP(I_ANG) + (l + 1) * DM, (bf16*)(wsl + WS_XN) + (size_t)m * DM, nullptr, lane_l);
            XBAR(bar); }
        else { for (int m = gwl; m < S_; m += ngwl) rms_row_f32(Xl + (size_t)m * DM, INP(I_FING), lane_l); }
    }
}

#undef lane_l
extern "C" void kernel_launch(void* const* d_in, const int* in_sizes, int n_in, void* d_out, int out_size, void* d_ws, size_t ws_size, hipStream_t stream) {
    static int grid = 0;
    if (grid == 0) {
        if (n_in != 19 || in_sizes[0] != S_ * DM || out_size != S_ * DM || ws_size < WS_END) { fprintf(stderr, "kernel_launch: shape/workspace mismatch (n_in %d, in0 %d, out %d, ws %zu need %zu)\n", n_in, n_in > 0 ? in_sizes[0] : -1, out_size, ws_size, (size_t)WS_END); grid = -1; return; }
        int dev = 0, cus = 0, per_cu = 0;
        if (hipGetDevice(&dev) != hipSuccess || hipDeviceGetAttribute(&cus, hipDeviceAttributeMultiprocessorCount, dev) != hipSuccess) { grid = -1; return; }
        if (hipFuncSetAttribute((const void*)mk_fwd, hipFuncAttributeMaxDynamicSharedMemorySize, LDS_BYTES) != hipSuccess) { fprintf(stderr, "kernel_launch: hipFuncSetAttribute failed\n"); grid = -1; return; }
        if (hipOccupancyMaxActiveBlocksPerMultiprocessor(&per_cu, (const void*)mk_fwd, NTHR, LDS_BYTES) != hipSuccess || per_cu < 1) { fprintf(stderr, "kernel_launch: occupancy query reports %d blocks per CU\n", per_cu); }
        (void)hipGetLastError();
        grid = cus;
    }
    if (grid < 0) return;
    if (hipMemsetAsync((char*)d_ws + WS_CTL, 0, CTL_ZERO_BYTES, stream) != hipSuccess) return;
    Args a{};
    for (int i = 0; i < 19; ++i) a.in[i] = (const float*)d_in[i];
    a.out = (float*)d_out; a.ws = (unsigned char*)d_ws;
    hipLaunchKernelGGL(mk_fwd, dim3(grid), dim3(NTHR), LDS_BYTES, stream, a);
}
```

```cpp
#include <hip/hip_runtime.h>
#include <cstdio>
#include <cstdint>
namespace pg8 {
#define PG8_LAS __attribute__((address_space(3)))
typedef unsigned short bf16_t;
typedef short bf16x8 __attribute__((ext_vector_type(8)));
typedef float f32x4 __attribute__((ext_vector_type(4)));
typedef unsigned u32x4 __attribute__((ext_vector_type(4)));
constexpr int BM = 256, BK = 64, HALF = 128, HTB = HALF * BK * 2  , STAGE_BYTES = 8 * HTB, NXCD = 8, WGM = 8;

__host__ __device__ __forceinline__ int lds_byte(int r, int c) { const int st = (r >> 4) * 2 + (c >> 5), rr = r & 15, cc = c & 31, ob = rr * 64 + cc * 2; return st * 1024 + (ob ^ (((ob >> 9) & 1) << 5)); }
__host__ __device__ __forceinline__ void stage_rc(int b, int& R, int& C) { const int st = b / 1024, sb = b % 1024, swz = sb ^ (((sb >> 9) & 1) << 5); R = (st >> 1) * 16 + swz / 64; C = (st & 1) * 32 + (swz % 64) / 2; }
__host__ __device__ __forceinline__ int perm32(int rho) { const int n = rho >> 4, i = rho & 15; return 8 * (i >> 2) + 4 * n + (i & 3); }

struct Unit { int pm, pn; };
struct Gemm { const bf16_t* A; const bf16_t* Bt; int M, N, K, lda, ldb; int mstep = BM; };

struct StaticOrder {
    int nM, nN, nwg, G, c;
    __host__ __device__ void init(int M, int N, int G_, int c_) { nM = M / BM; nN = N / BM; nwg = nM * nN; G = G_; c = c_; }
    __host__ __device__ bool next(int i, Unit& u) const {
        const long L = (long)i * G + c; if (L >= nwg) return false;
        int wgid = (int)L; { const int q = nwg / NXCD, r = nwg % NXCD, xcd = wgid % NXCD, off = wgid / NXCD; wgid = (xcd < r ? xcd * (q + 1) : r * (q + 1) + (xcd - r) * q) + off; }
        const int nig = WGM * nN, gid = wgid / nig, fm = gid * WGM, gsz = (nM - fm) < WGM ? (nM - fm) : WGM;
        u.pm = fm + ((wgid % nig) % gsz); u.pn = (wgid % nig) / gsz; return true;
    }
    __device__ __forceinline__ void a_ready(const Unit&) const {}
    __device__ __forceinline__ void done(const Unit&) const {}
};

__device__ __forceinline__ unsigned cvt_pk_bf16(float lo, float hi) { unsigned r; asm volatile("v_cvt_pk_bf16_f32 %0, %1, %2" : "=v"(r) : "v"(lo), "v"(hi)); return r; }
template <class Epi, class Sched, bool ALIGN_EPI = false, bool SP2 = false>
__device__ __forceinline__ void gemm_phase(PG8_LAS unsigned char* lds, const Gemm g, const Sched& S, const Epi& E) {
    int tid = threadIdx.x; asm volatile("" : "+v"(tid));
    const int wid = __builtin_amdgcn_readfirstlane(tid >> 6), lane = tid & 63, wr = wid >> 2, wc = wid & 3, fr = lane & 15, fq = lane >> 4;
    const int K = g.K, nt = K / BK;
    unsigned voffA[2], voffB[2];
#pragma unroll
    for (int i = 0; i < 2; ++i) { int R, C; stage_rc(tid * 16 + i * 8192, R, C); const int Rb = Epi::PERM ? ((R & ~31) + perm32(R & 31)) : R;
        voffA[i] = (unsigned)(R * g.lda + C) * 2u; voffB[i] = (unsigned)(Rb * g.ldb + C) * 2u; }
    const size_t kstep = (size_t)(BK * 2);
    const size_t hstepA = (size_t)HALF * g.lda * 2, hstepB = (size_t)HALF * g.ldb * 2;
    const size_t tstepA = (size_t)g.mstep * g.lda * 2, tstepB = 2 * hstepB;
    const unsigned ldsw = (unsigned)wid * 1024u;
    const int aoff = lds_byte(wr * 64 + fr, fq * 8), boff = lds_byte(wc * 32 + fr, fq * 8);
#define PG8_SA(b, h) (((b) * 2 + (h)) * HTB)
#define PG8_SB(b, h) ((4 + (b) * 2 + (h)) * HTB)
#define PG8_STAGE(bufoff, gbase, voff) do { _Pragma("unroll") for (int _i = 0; _i < 2; ++_i) \
        __builtin_amdgcn_global_load_lds((const unsigned*)((const char*)(gbase) + (voff)[_i]), (PG8_LAS unsigned*)(lds + (bufoff) + ldsw + _i * 8192), 16, 0, 0); } while (0)
#define PG8_LDA(dst, b, h) do { _Pragma("unroll") for (int m = 0; m < 4; ++m) _Pragma("unroll") for (int k = 0; k < 2; ++k) dst[m][k] = *(const PG8_LAS bf16x8*)(lds + PG8_SA(b, h) + aoff + m * 2048 + k * 1024); } while (0)
#define PG8_LDB(dst, b, h) do { _Pragma("unroll") for (int n = 0; n < 2; ++n) _Pragma("unroll") for (int k = 0; k < 2; ++k) dst[n][k] = *(const PG8_LAS bf16x8*)(lds + PG8_SB(b, h) + boff + n * 2048 + k * 1024); } while (0)
#define PG8_MMA(ai, bj, At, Bt) do { __builtin_amdgcn_s_setprio(1); _Pragma("unroll") for (int m = 0; m < 4; ++m) _Pragma("unroll") for (int n = 0; n < 2; ++n) _Pragma("unroll") for (int k = 0; k < 2; ++k) \
        acc[ai][bj][m][n] = __builtin_amdgcn_mfma_f32_16x16x32_bf16(Bt[n][k], At[m][k], acc[ai][bj][m][n], 0, 0, 0); __builtin_amdgcn_s_setprio(0); } while (0)
#define PG8_WAIT_V(n) asm volatile("s_waitcnt vmcnt(" #n ")" ::: "memory")
#define PG8_WAIT_L(n) asm volatile("s_waitcnt lgkmcnt(" #n ")" ::: "memory")
#define PG8_BAR __builtin_amdgcn_s_barrier()
#define PG8_SCHED __builtin_amdgcn_sched_barrier(0)
    Unit cur, nxt; int ui = 0;
    if (!S.next(0, cur)) return;
    f32x4 acc[2][2][4][2];
#pragma unroll
    for (int a = 0; a < 2; ++a)
#pragma unroll
        for (int b = 0; b < 2; ++b)
#pragma unroll
            for (int m = 0; m < 4; ++m)
#pragma unroll
                for (int n = 0; n < 2; ++n) acc[a][b][m][n] = (f32x4){0.f, 0.f, 0.f, 0.f};
    bf16x8 At[4][2], B0[2][2], B1[2][2];
    const char* cA = (const char*)g.A + (size_t)cur.pm * tstepA; const char* cB = (const char*)g.Bt + (size_t)cur.pn * tstepB;
    S.a_ready(cur);
    if constexpr (SP2) {
        PG8_STAGE(PG8_SB(0, 0), cB, voffB); PG8_STAGE(PG8_SB(0, 1), cB + hstepB, voffB); PG8_STAGE(PG8_SA(0, 0), cA, voffA); PG8_STAGE(PG8_SA(0, 1), cA + hstepA, voffA);
        if (wr == 1) PG8_BAR;
        PG8_WAIT_V(2); PG8_BAR;
        PG8_STAGE(PG8_SB(1, 0), cB + kstep, voffB); PG8_STAGE(PG8_SA(1, 0), cA + kstep, voffA); PG8_STAGE(PG8_SB(1, 1), cB + hstepB + kstep, voffB);
        PG8_WAIT_V(6); PG8_BAR;
    } else {
        PG8_STAGE(PG8_SB(0, 0), cB, voffB); PG8_STAGE(PG8_SA(0, 0), cA, voffA); PG8_STAGE(PG8_SB(0, 1), cB + hstepB, voffB); PG8_STAGE(PG8_SA(0, 1), cA + hstepA, voffA);
        if (wr == 1) PG8_BAR;
        PG8_WAIT_V(4); PG8_BAR;
        PG8_STAGE(PG8_SB(1, 0), cB + kstep, voffB); PG8_STAGE(PG8_SA(1, 0), cA + kstep, voffA); PG8_STAGE(PG8_SB(1, 1), cB + hstepB + kstep, voffB);
        PG8_WAIT_V(6); PG8_BAR;
    }
    for (;;) {
        const bool has_next = S.next(ui + 1, nxt);
        const char* nA = has_next ? (const char*)g.A + (size_t)nxt.pm * tstepA : cA; const char* nB = has_next ? (const char*)g.Bt + (size_t)nxt.pn * tstepB : cB;
        for (int t = 0; t < nt; t += 2) {
            const bool last = (t == nt - 2);
            const char* a1 = cA + (size_t)(t + 1) * kstep;
            const char* a2 = last ? nA : cA + (size_t)(t + 2) * kstep; const char* b2 = last ? nB : cB + (size_t)(t + 2) * kstep;
            const char* a3 = a2 + kstep; const char* b3 = b2 + kstep;
            if (last && has_next) S.a_ready(nxt);
            if constexpr (SP2) {
            PG8_LDB(B0, 0, 0); PG8_LDB(B1, 0, 1); PG8_SCHED; PG8_LDA(At, 0, 0); PG8_STAGE(PG8_SA(1, 1), a1 + hstepA, voffA);
            PG8_WAIT_V(8); PG8_WAIT_L(0); PG8_BAR; PG8_MMA(0, 0, At, B0); PG8_MMA(0, 1, At, B1); PG8_BAR; PG8_SCHED;
            PG8_LDA(At, 0, 1); PG8_STAGE(PG8_SB(0, 0), b2, voffB); PG8_STAGE(PG8_SB(0, 1), b2 + hstepB, voffB); PG8_STAGE(PG8_SA(0, 0), a2, voffA);
            PG8_WAIT_V(8); PG8_WAIT_L(0); PG8_BAR; PG8_MMA(1, 0, At, B0); PG8_MMA(1, 1, At, B1); PG8_BAR; PG8_SCHED;
            PG8_LDB(B0, 1, 0); PG8_LDB(B1, 1, 1); PG8_SCHED; PG8_LDA(At, 1, 0); PG8_STAGE(PG8_SA(0, 1), a2 + hstepA, voffA);
            PG8_WAIT_V(8); PG8_WAIT_L(0); PG8_BAR; PG8_MMA(0, 0, At, B0); PG8_MMA(0, 1, At, B1); PG8_BAR; PG8_SCHED;
            PG8_LDA(At, 1, 1); PG8_STAGE(PG8_SB(1, 0), b3, voffB); PG8_STAGE(PG8_SB(1, 1), b3 + hstepB, voffB); PG8_STAGE(PG8_SA(1, 0), a3, voffA);
            PG8_WAIT_V(8); PG8_WAIT_L(0); PG8_BAR; PG8_MMA(1, 0, At, B0); PG8_MMA(1, 1, At, B1); PG8_BAR; PG8_SCHED;
            } else {
            PG8_LDB(B0, 0, 0); PG8_SCHED; PG8_LDA(At, 0, 0); PG8_STAGE(PG8_SA(1, 1), a1 + hstepA, voffA);
            PG8_WAIT_L(8); PG8_BAR; PG8_WAIT_L(0); PG8_MMA(0, 0, At, B0); PG8_BAR; PG8_SCHED;
            PG8_LDB(B1, 0, 1); PG8_STAGE(PG8_SB(0, 0), b2, voffB);
            PG8_BAR; PG8_WAIT_L(0); PG8_MMA(0, 1, At, B1); PG8_BAR;
            PG8_LDA(At, 0, 1); PG8_STAGE(PG8_SA(0, 0), a2, voffA);
            PG8_BAR; PG8_WAIT_L(0); PG8_MMA(1, 0, At, B0); PG8_BAR; PG8_SCHED;
            PG8_STAGE(PG8_SB(0, 1), b2 + hstepB, voffB);
            PG8_WAIT_V(6); PG8_BAR; PG8_MMA(1, 1, At, B1); PG8_BAR;
            PG8_LDB(B0, 1, 0); PG8_SCHED; PG8_LDA(At, 1, 0); PG8_STAGE(PG8_SA(0, 1), a2 + hstepA, voffA);
            PG8_WAIT_L(8); PG8_BAR; PG8_WAIT_L(0); PG8_MMA(0, 0, At, B0); PG8_BAR; PG8_SCHED;
            PG8_LDB(B1, 1, 1); PG8_STAGE(PG8_SB(1, 0), b3, voffB);
            PG8_BAR; PG8_WAIT_L(0); PG8_MMA(0, 1, At, B1); PG8_BAR;
            PG8_LDA(At, 1, 1); PG8_STAGE(PG8_SA(1, 0), a3, voffA);
            PG8_BAR; PG8_WAIT_L(0); PG8_MMA(1, 0, At, B0); PG8_BAR; PG8_SCHED;
            PG8_STAGE(PG8_SB(1, 1), b3 + hstepB, voffB);
            PG8_WAIT_V(6); PG8_BAR; PG8_MMA(1, 1, At, B1); PG8_BAR;
            }
        }
        if constexpr (ALIGN_EPI) { if (wr == 0) PG8_BAR; }
        if constexpr (!Epi::AFTER_DRAIN) { E(acc, cur, wr, wc, fr, fq); S.done(cur); }
        if (!has_next) break;
#pragma unroll
        for (int a = 0; a < 2; ++a)
#pragma unroll
            for (int b = 0; b < 2; ++b)
#pragma unroll
                for (int m = 0; m < 4; ++m)
#pragma unroll
                    for (int n = 0; n < 2; ++n) acc[a][b][m][n] = (f32x4){0.f, 0.f, 0.f, 0.f};
        cur = nxt; cA = nA; cB = nB; ++ui;
        if constexpr (ALIGN_EPI) { if (wr == 1) PG8_BAR; }
    }
    PG8_WAIT_V(0);
    if constexpr (!ALIGN_EPI) { if (wr == 0) PG8_BAR; }
    PG8_BAR;
    if constexpr (Epi::AFTER_DRAIN) { E.fused(acc, cur, wr, wc, fr, fq, lds, wid, lane); S.done(cur); }
#undef PG8_SA
#undef PG8_SB
#undef PG8_STAGE
#undef PG8_LDA
#undef PG8_LDB
#undef PG8_MMA
#undef PG8_WAIT_V
#undef PG8_WAIT_L
#undef PG8_BAR
#undef PG8_SCHED
}
}

constexpr int S_ = 8192, DM = 2048, DEPTH = 4, NH = 16;
constexpr int QL = 512, KVL = 512, ROPE = 64, NOPE = 128, VD = 128;
constexpr int INW = 13376;
constexpr int DFF = 5632, DFF2 = 11264;
constexpr int NNAT = 11520;
constexpr int WINR = NNAT + 2048;
constexpr float EPS = 1e-6f;
constexpr float LOG2E = 1.4426950408889634f;
constexpr float QSCALE = 0.07216878364870323f * 1.4426950408889634f;
constexpr int NWAVES = 8, NTHR = 512;

constexpr size_t MiB = 1u << 20;
constexpr size_t WS_CTL = 0, CTL_ZERO_BYTES = 1 * MiB;
constexpr size_t WS_COS = 1 * MiB, WS_SIN = 2 * MiB, WS_LB = 3 * MiB, WS_SSQ = 4 * MiB;
constexpr size_t WS_W = 5 * MiB;
constexpr size_t LW_IN = 0, LW_UQ = 53 * MiB, LW_K = 56 * MiB, LW_V = 58 * MiB, LW_A = 60 * MiB, LW_B = 68 * MiB, LW_O = 76 * MiB, LW_UP = 84 * MiB, LW_DN = 128 * MiB, LW = 150 * MiB;
constexpr size_t WS_XN = WS_W + 4 * LW + 1 * MiB;
constexpr size_t WS_MIX = WS_XN + 32 * MiB;
constexpr size_t WS_CQKV = WS_MIX;
constexpr size_t WS_KPE = WS_CQKV + 16 * MiB;
constexpr size_t WS_HQ = WS_KPE + 1 * MiB;
constexpr size_t GSTRIDE = 32 * MiB;
constexpr size_t WS_HG = WS_HQ + GSTRIDE, WS_GA = WS_HQ + 2 * GSTRIDE, WS_GB = WS_HQ + 3 * GSTRIDE;
constexpr size_t WS_HF = WS_HQ + 4 * GSTRIDE;
constexpr size_t WS_VTH = WS_HF + 64 * MiB;
constexpr size_t WS_QN = WS_VTH + 32 * MiB;
constexpr size_t WS_QR = WS_QN + 32 * MiB;
constexpr size_t WS_KN = WS_QR + 16 * MiB;
constexpr size_t WS_VT = WS_KN + 32 * MiB;
constexpr size_t WS_ATT = WS_VT + 32 * MiB;
constexpr size_t WS_REC = WS_ATT + 32 * MiB;
constexpr size_t WS_RRAW = WS_REC + 32 * MiB;
constexpr size_t WS_HU = WS_RRAW + 64 * MiB;
constexpr size_t WS_HS = WS_HU + 128 * MiB;
constexpr size_t WS_M1 = WS_HS + 64 * MiB;
constexpr size_t WS_MRG = WS_M1 + 64 * MiB;
constexpr size_t WS_MIX_END = WS_MRG + 32 * MiB;
constexpr size_t WS_U = WS_MIX;
constexpr size_t WS_ACT = WS_U + 176 * MiB;
static_assert(WS_ACT + 88 * MiB <= WS_MIX_END, "FFN overlay fits the mixer region");
constexpr size_t WS_END = WS_MIX_END;
constexpr int CW_BAR = 4096;

constexpr int RING_OFF = 0, RING_BYTES = 131072;
constexpr int LDSCTL_OFF = RING_BYTES, MISC_OFF = LDSCTL_OFF + 320;
constexpr int LDS_BYTES = 147456;

#define GAS __attribute__((address_space(1)))
#define LAS __attribute__((address_space(3)))
typedef unsigned short bf16;
typedef unsigned v4u __attribute__((ext_vector_type(4)));
typedef unsigned v2u __attribute__((ext_vector_type(2)));
typedef float f32x4 __attribute__((ext_vector_type(4)));
typedef float f32x2 __attribute__((ext_vector_type(2)));
typedef short bf16x8 __attribute__((ext_vector_type(8)));
typedef GAS unsigned gu32;
#define LDS_WAIT() asm volatile("s_waitcnt lgkmcnt(0)" ::: "memory")
#define VM_WAIT() asm volatile("s_waitcnt vmcnt(0)" ::: "memory")
__device__ __forceinline__ unsigned f2bf(float f) { unsigned u = __builtin_bit_cast(unsigned, f); return (u + 0x7fffu + ((u >> 16) & 1u)) >> 16; }
__device__ __forceinline__ unsigned pk2(float lo, float hi) { return f2bf(lo) | (f2bf(hi) << 16); }
__device__ __forceinline__ float bflo(unsigned u) { return __builtin_bit_cast(float, u << 16); }
__device__ __forceinline__ float bfhi(unsigned u) { return __builtin_bit_cast(float, u & 0xffff0000u); }
__device__ __forceinline__ float sigm(float x) { return __builtin_amdgcn_rcpf(1.f + __builtin_amdgcn_exp2f(-LOG2E * x)); }
__device__ __forceinline__ float wave_sum(float v) {
#pragma unroll
    for (int o = 1; o < 64; o <<= 1) v += __shfl_xor(v, o);
    return v;
}
__device__ __forceinline__ float wave_max(float v) {
#pragma unroll
    for (int o = 1; o < 64; o <<= 1) v = fmaxf(v, __shfl_xor(v, o));
    return v;
}

namespace pg8 {
typedef unsigned v2u_t __attribute__((ext_vector_type(2)));
__device__ __forceinline__ u32x4 pack8(f32x4 a, f32x4 b) { u32x4 w; w.x = cvt_pk_bf16(a[0], a[1]); w.y = cvt_pk_bf16(a[2], a[3]); w.z = cvt_pk_bf16(b[0], b[1]); w.w = cvt_pk_bf16(b[2], b[3]); return w; }
__device__ __forceinline__ f32x4 silu4(f32x4 v) { f32x4 r; r[0] = v[0] * sigm(v[0]); r[1] = v[1] * sigm(v[1]); r[2] = v[2] * sigm(v[2]); r[3] = v[3] * sigm(v[3]); return r; }
__device__ __forceinline__ f32x4 sigm4(f32x4 v) { f32x4 r; r[0] = sigm(v[0]); r[1] = sigm(v[1]); r[2] = sigm(v[2]); r[3] = sigm(v[3]); return r; }
__device__ __forceinline__ float sum8(const float* p) { const f32x4 a = *(const f32x4*)p, b = *(const f32x4*)(p + 4); return ((a[0] + a[1]) + (a[2] + a[3])) + ((b[0] + b[1]) + (b[2] + b[3])); }
__device__ __forceinline__ void rope8(f32x4& v0, f32x4& v1, const f32x4 cs, const f32x4 sn) {
    f32x4 a, b;
    a[0] = v0[0] * cs[0] - v0[1] * sn[0]; a[1] = v0[1] * cs[0] + v0[0] * sn[0];
    a[2] = v0[2] * cs[1] - v0[3] * sn[1]; a[3] = v0[3] * cs[1] + v0[2] * sn[1];
    b[0] = v1[0] * cs[2] - v1[1] * sn[2]; b[1] = v1[1] * cs[2] + v1[0] * sn[2];
    b[2] = v1[2] * cs[3] - v1[3] * sn[3]; b[3] = v1[3] * cs[3] + v1[2] * sn[3];
    v0 = a; v1 = b;
}

struct EpiIn {
    static constexpr bool PERM = true, AFTER_DRAIN = false;
    unsigned char* ws;
    __device__ __forceinline__ void operator()(const f32x4 (&acc)[2][2][4][2], const Unit& u, int wr, int wc, int fr, int fq) const {
        const int pn = u.pn, row0 = u.pm * BM + wr * 64 + fr, lc = wc * 32 + 8 * fq;
        if (pn == 4) {
            if (wc < 2) {
                const float* COS = (const float*)(ws + WS_COS); const float* SIN = (const float*)(ws + WS_SIN); bf16_t* KPE = (bf16_t*)(ws + WS_KPE);
#pragma unroll
                for (int ai = 0; ai < 2; ++ai)
#pragma unroll
                    for (int m = 0; m < 4; ++m) { const int row = row0 + ai * HALF + m * 16;
                        f32x4 v0 = acc[ai][0][m][0], v1 = acc[ai][0][m][1];
                        const f32x4 cs = *(const f32x4*)(COS + (size_t)row * 32 + wc * 16 + 4 * fq), sn = *(const f32x4*)(SIN + (size_t)row * 32 + wc * 16 + 4 * fq);
                        rope8(v0, v1, cs, sn);
                        *(u32x4*)(KPE + (size_t)row * 64 + lc) = pack8(v0, v1);
                        if (m & 1) asm volatile("" ::: "memory"); }
            }
        } else if (pn >= 13 && pn < 21) {
            _Float16* HF = (_Float16*)(ws + WS_HF);
            typedef _Float16 h8 __attribute__((ext_vector_type(8)));
#pragma unroll
            for (int ai = 0; ai < 2; ++ai)
#pragma unroll
                for (int m = 0; m < 4; ++m) { _Float16* rp = HF + (size_t)(row0 + ai * HALF + m * 16) * 2048 + (pn - 13) * 256 + lc;
#pragma unroll
                    for (int bj = 0; bj < 2; ++bj) { const f32x4 a = acc[ai][bj][m][0], b = acc[ai][bj][m][1];
                        h8 hv = {(_Float16)a[0], (_Float16)a[1], (_Float16)a[2], (_Float16)a[3], (_Float16)b[0], (_Float16)b[1], (_Float16)b[2], (_Float16)b[3]};
                        *(h8*)(rp + bj * HALF) = hv; } }
        } else {
            bf16_t* base; int ldc, act;
            if (pn < 4) { base = (bf16_t*)(ws + WS_CQKV) + pn * 256; ldc = 1024; act = 0; }
            else { const int gi = (pn < 13) ? 0 : ((pn - 13) >> 3), ct = (pn < 13) ? (pn - 5) : ((pn - 13) & 7);
                   base = (bf16_t*)(ws + WS_HQ + (size_t)gi * GSTRIDE) + ct * 256; ldc = 2048; act = (gi <= 1) ? 1 : 2; }
#pragma unroll
            for (int ai = 0; ai < 2; ++ai)
#pragma unroll
                for (int m = 0; m < 4; ++m) { bf16_t* rp = base + (size_t)(row0 + ai * HALF + m * 16) * ldc + lc;
#pragma unroll
                    for (int bj = 0; bj < 2; ++bj) { f32x4 v0 = acc[ai][bj][m][0], v1 = acc[ai][bj][m][1];
                        if (act == 1) { v0 = silu4(v0); v1 = silu4(v1); }
                        else if (act == 2) { v0 = sigm4(v0); v1 = sigm4(v1); }
                        *(u32x4*)(rp + bj * HALF) = pack8(v0, v1); } }
        }
    }
};
struct EpiStore {
    static constexpr bool PERM = true, AFTER_DRAIN = false;
    bf16_t* O; int ldc;
    __device__ __forceinline__ void operator()(const f32x4 (&acc)[2][2][4][2], const Unit& u, int wr, int wc, int fr, int fq) const {
        const int row0 = u.pm * BM + wr * 64 + fr, col0 = u.pn * BM + wc * 32 + 8 * fq;
#pragma unroll
        for (int ai = 0; ai < 2; ++ai)
#pragma unroll
            for (int m = 0; m < 4; ++m) { bf16_t* rp = O + (size_t)(row0 + ai * HALF + m * 16) * ldc + col0;
#pragma unroll
                for (int bj = 0; bj < 2; ++bj) *(u32x4*)(rp + bj * HALF) = pack8(acc[ai][bj][m][0], acc[ai][bj][m][1]); }
    }
};
struct EpiQ {
    static constexpr bool PERM = true, AFTER_DRAIN = false;
    unsigned char* ws;
    __device__ __forceinline__ void operator()(const f32x4 (&acc)[2][2][4][2], const Unit& u, int wr, int wc, int fr, int fq) const {
        const int pn = u.pn, row0 = u.pm * BM + wr * 64 + fr, lc = wc * 32 + 8 * fq;
        if (pn < 8) {
            bf16_t* base = (bf16_t*)(ws + WS_QN) + pn * 256 + lc;
#pragma unroll
            for (int ai = 0; ai < 2; ++ai)
#pragma unroll
                for (int m = 0; m < 4; ++m)
#pragma unroll
                    for (int bj = 0; bj < 2; ++bj) *(u32x4*)(base + (size_t)(row0 + ai * HALF + m * 16) * 2048 + bj * HALF) = pack8(acc[ai][bj][m][0] * QSCALE, acc[ai][bj][m][1] * QSCALE);
        } else {
            const float* COS = (const float*)(ws + WS_COS); const float* SIN = (const float*)(ws + WS_SIN);
            bf16_t* base = (bf16_t*)(ws + WS_QR) + (pn - 8) * 256 + lc; const int p0 = (wc & 1) * 16 + 4 * fq;
#pragma unroll
            for (int ai = 0; ai < 2; ++ai)
#pragma unroll
                for (int m = 0; m < 4; ++m) { const int row = row0 + ai * HALF + m * 16;
                    const f32x4 cs = *(const f32x4*)(COS + (size_t)row * 32 + p0), sn = *(const f32x4*)(SIN + (size_t)row * 32 + p0);
#pragma unroll
                    for (int bj = 0; bj < 2; ++bj) { f32x4 v0 = acc[ai][bj][m][0] * QSCALE, v1 = acc[ai][bj][m][1] * QSCALE; rope8(v0, v1, cs, sn);
                        *(u32x4*)(base + (size_t)row * 1024 + bj * HALF) = pack8(v0, v1); }
                    if (m & 1) asm volatile("" ::: "memory"); }
        }
    }
};
struct EpiGateA {
    static constexpr bool PERM = true, AFTER_DRAIN = false;
    unsigned char* ws;
    __device__ __forceinline__ void operator()(const f32x4 (&acc)[2][2][4][2], const Unit& u, int wr, int wc, int fr, int fq) const {
        const int row0 = u.pm * BM + wr * 64 + fr, col0 = u.pn * BM + wc * 32 + 8 * fq;
        const bf16_t* G = (const bf16_t*)(ws + WS_GA); bf16_t* M1 = (bf16_t*)(ws + WS_M1);
#pragma unroll
        for (int ai = 0; ai < 2; ++ai)
#pragma unroll
            for (int m = 0; m < 4; ++m) { const size_t off = (size_t)(row0 + ai * HALF + m * 16) * 2048 + col0;
#pragma unroll
                for (int bj = 0; bj < 2; ++bj) { const u32x4 g = *(const u32x4*)(G + off + bj * HALF);
                    const f32x4 g0 = {bflo(g.x), bfhi(g.x), bflo(g.y), bfhi(g.y)}, g1 = {bflo(g.z), bfhi(g.z), bflo(g.w), bfhi(g.w)};
                    *(u32x4*)(M1 + off + bj * HALF) = pack8(acc[ai][bj][m][0] * g0, acc[ai][bj][m][1] * g1); }
                if (m & 1) asm volatile("" ::: "memory"); }
    }
};
struct EpiGateB {
    static constexpr bool PERM = true, AFTER_DRAIN = false;
    unsigned char* ws;
    __device__ __forceinline__ void operator()(const f32x4 (&acc)[2][2][4][2], const Unit& u, int wr, int wc, int fr, int fq) const {
        const int row0 = u.pm * BM + wr * 64 + fr, col0 = u.pn * BM + wc * 32 + 8 * fq;
        const bf16_t* G = (const bf16_t*)(ws + WS_GB); const bf16_t* M1 = (const bf16_t*)(ws + WS_M1); bf16_t* O = (bf16_t*)(ws + WS_MRG);
#pragma unroll
        for (int ai = 0; ai < 2; ++ai)
#pragma unroll
            for (int m = 0; m < 4; ++m) { const size_t off = (size_t)(row0 + ai * HALF + m * 16) * 2048 + col0;
#pragma unroll
                for (int bj = 0; bj < 2; ++bj) { const u32x4 g = *(const u32x4*)(G + off + bj * HALF);
                    const f32x4 g0 = {bflo(g.x), bfhi(g.x), bflo(g.y), bfhi(g.y)}, g1 = {bflo(g.z), bfhi(g.z), bflo(g.w), bfhi(g.w)};
                    const u32x4 mv = *(const u32x4*)(M1 + off + bj * HALF); const f32x4 m0 = {bflo(mv.x), bfhi(mv.x), bflo(mv.y), bfhi(mv.y)}, m1 = {bflo(mv.z), bfhi(mv.z), bflo(mv.w), bfhi(mv.w)};
                    *(u32x4*)(O + off + bj * HALF) = pack8(m0 + acc[ai][bj][m][0] * g0, m1 + acc[ai][bj][m][1] * g1); }
                if (m & 1) asm volatile("" ::: "memory"); }
    }
};
struct EpiRes {
    static constexpr bool PERM = true, AFTER_DRAIN = false;
    float* X;
    __device__ __forceinline__ void operator()(const f32x4 (&acc)[2][2][4][2], const Unit& u, int wr, int wc, int fr, int fq) const {
        const int row0 = u.pm * BM + wr * 64 + fr, col0 = u.pn * BM + wc * 32 + 8 * fq;
#pragma unroll
        for (int ai = 0; ai < 2; ++ai)
#pragma unroll
            for (int m = 0; m < 4; ++m) { float* rp = X + (size_t)(row0 + ai * HALF + m * 16) * 2048 + col0;
#pragma unroll
                for (int bj = 0; bj < 2; ++bj) { const f32x4 a = *(const f32x4*)(rp + bj * HALF), b = *(const f32x4*)(rp + bj * HALF + 4);
                    *(f32x4*)(rp + bj * HALF) = a + acc[ai][bj][m][0]; *(f32x4*)(rp + bj * HALF + 4) = b + acc[ai][bj][m][1]; }
                if (m & 1) asm volatile("" ::: "memory"); }
    }
};

__device__ __forceinline__ float dpp_shr1(float fill, float v) { return __builtin_bit_cast(float, __builtin_amdgcn_update_dpp(__builtin_bit_cast(int, fill), __builtin_bit_cast(int, v), 0x111, 0xf, 0xf, false)); }
__device__ __forceinline__ float dpp_shr2(float fill, float v) { return __builtin_bit_cast(float, __builtin_amdgcn_update_dpp(__builtin_bit_cast(int, fill), __builtin_bit_cast(int, v), 0x112, 0xf, 0xf, false)); }
__device__ __forceinline__ float dpp_ror1(float v) { return __builtin_bit_cast(float, __builtin_amdgcn_update_dpp(0, __builtin_bit_cast(int, v), 0x121, 0xf, 0xf, false)); }
__device__ __forceinline__ float dpp_ror2(float v) { return __builtin_bit_cast(float, __builtin_amdgcn_update_dpp(0, __builtin_bit_cast(int, v), 0x122, 0xf, 0xf, false)); }
struct EpiConv {
    static constexpr bool PERM = true, AFTER_DRAIN = false;
    bf16_t* ACT; const float* cw; const float* cb; PG8_LAS float* EX;
    __device__ __forceinline__ void operator()(const f32x4 (&acc)[2][2][4][2], const Unit& u, int wr, int wc, int fr, int fq) const {
        const int lc = wc * 32 + 8 * fq;
        if (fr >= 14) {
#pragma unroll
            for (int ai = 0; ai < 2; ++ai)
#pragma unroll
                for (int bj = 0; bj < 2; ++bj)
#pragma unroll
                    for (int n = 0; n < 2; ++n) *(PG8_LAS f32x4*)(EX + ((2 * ai + wr) * 2 + (fr - 14)) * 256 + bj * HALF + lc + 4 * n) = acc[ai][bj][3][n];
        }
        asm volatile("s_waitcnt lgkmcnt(0)" ::: "memory"); __builtin_amdgcn_s_barrier(); asm volatile("" ::: "memory");
        const int ch0 = u.pn * HALF + lc;
        const int trow0 = u.pm * 254 - 2 + wr * 64 + fr;
#pragma unroll
        for (int n = 0; n < 2; ++n) {
            const int ch = ch0 + 4 * n;
            typedef const __attribute__((address_space(1))) f32x4* gv4; const __attribute__((address_space(1))) float* cwg = (const __attribute__((address_space(1))) float*)cw; const __attribute__((address_space(1))) float* cbg = (const __attribute__((address_space(1))) float*)cb;
            const f32x4 g0 = *(gv4)(cwg + ch), g1 = *(gv4)(cwg + DFF2 + ch), g2 = *(gv4)(cwg + 2 * DFF2 + ch), gb = *(gv4)(cbg + ch);
            const f32x4 u0 = *(gv4)(cwg + DFF + ch), u1 = *(gv4)(cwg + DFF2 + DFF + ch), u2 = *(gv4)(cwg + 2 * DFF2 + DFF + ch), ub = *(gv4)(cbg + DFF + ch);
#pragma unroll
            for (int ai = 0; ai < 2; ++ai) {
                const int b = 2 * ai + wr;
                f32x4 f1g = {0.f, 0.f, 0.f, 0.f}, f2g = f1g, f1u = f1g, f2u = f1g;
                if (b > 0) { const PG8_LAS float* e63 = EX + ((b - 1) * 2 + 1) * 256 + lc + 4 * n; const PG8_LAS float* e2 = EX + ((b - 1) * 2 + (fr == 0 ? 0 : 1)) * 256 + lc + 4 * n;
                    f1g = *(const PG8_LAS f32x4*)e63; f2g = *(const PG8_LAS f32x4*)e2; f1u = *(const PG8_LAS f32x4*)(e63 + HALF); f2u = *(const PG8_LAS f32x4*)(e2 + HALF); }
#pragma unroll
                for (int m = 0; m < 4; ++m) {
                    const f32x4 cg = acc[ai][0][m][n], cu = acc[ai][1][m][n];
                    if (m > 0) { const f32x4 pg = acc[ai][0][m - 1][n], pu = acc[ai][1][m - 1][n];
#pragma unroll
                        for (int i = 0; i < 4; ++i) { f1g[i] = dpp_ror1(pg[i]); f2g[i] = dpp_ror2(pg[i]); f1u[i] = dpp_ror1(pu[i]); f2u[i] = dpp_ror2(pu[i]); } }
                    f32x4 r;
#pragma unroll
                    for (int i = 0; i < 4; ++i) { const float G = gb[i] + g0[i] * dpp_shr2(f2g[i], cg[i]) + g1[i] * dpp_shr1(f1g[i], cg[i]) + g2[i] * cg[i];
                                                  const float U = ub[i] + u0[i] * dpp_shr2(f2u[i], cu[i]) + u1[i] * dpp_shr1(f1u[i], cu[i]) + u2[i] * cu[i];
                                                  r[i] = G * sigm(G) * U; }
                    const int t = trow0 + ai * HALF + m * 16;
                    if (t >= u.pm * 254 && t < S_) { v2u_t w; w.x = cvt_pk_bf16(r[0], r[1]); w.y = cvt_pk_bf16(r[2], r[3]); *(v2u_t*)(ACT + (size_t)t * DFF + ch) = w; }
                }
            }
        }
    }
};
}
#define XB_TMO      128
#define XB_XCNT(j)  (256  + 64 * (j))
#define XB_XSUB(j)  (1280 + 64 * (j))
#define XB_XGEN(j)  (2304 + 64 * (j))
#define XB_TOP      3328
#define XB_TOPGEN   3392
#define XCD_BAR_WORDS 3456
#define XB_SPIN_CAP (1u << 18)

__device__ __forceinline__ unsigned xb_ld(unsigned* p)              { return __hip_atomic_load(p, __ATOMIC_RELAXED, __HIP_MEMORY_SCOPE_AGENT); }
__device__ __forceinline__ unsigned xb_add(unsigned* p, unsigned v) { return __hip_atomic_fetch_add(p, v, __ATOMIC_RELAXED, __HIP_MEMORY_SCOPE_AGENT); }
__device__ __forceinline__ unsigned xb_xcc_id() { return (unsigned)__builtin_amdgcn_s_getreg((3 << 11) | 20) & 0xFu; }
#define XB_SPIN(cond, bar) do { unsigned _sp = 0; while (cond) { __builtin_amdgcn_s_sleep(1); \
    if ((++_sp & 255u) == 0u) { if (xb_ld(&(bar)[XB_TMO])) break; if (_sp > XB_SPIN_CAP) { atomicAdd(&(bar)[XB_TMO], 1u); break; } } } } while (0)

struct XcdBarrier {
    unsigned* bar; unsigned x;
    volatile LAS unsigned* st;
};

__device__ __forceinline__ XcdBarrier xcd_barrier_post(unsigned* bar, volatile LAS unsigned* st) {
    XcdBarrier b; b.bar = bar; b.x = xb_xcc_id(); b.st = st;
    if (threadIdx.x == 0) (void)xb_add(&bar[XB_XCNT(b.x)], 1u);
    return b;
}
__device__ __forceinline__ void xcd_barrier_complete(unsigned* bar, unsigned x, unsigned& nloc, unsigned& nx) {
    const unsigned G = gridDim.x * gridDim.y * gridDim.z;
    unsigned sum, cnt, mine, sp = 0u;
    for (;;) {
        sum = 0u; cnt = 0u; mine = 0u;
#pragma unroll
        for (unsigned j = 0; j < 16; ++j) { const unsigned c = xb_ld(&bar[XB_XCNT(j)]); sum += c; cnt += (c > 0u) ? 1u : 0u; mine = (j == x) ? c : mine; }
        if (sum == G) break;
        __builtin_amdgcn_s_sleep(1);
        if ((++sp & 255u) == 0u) { if (xb_ld(&bar[XB_TMO])) break; if (sp > XB_SPIN_CAP) { atomicAdd(&bar[XB_TMO], 1u); break; } }
    }
    nloc = mine > 0u ? mine : 1u; nx = cnt > 0u ? cnt : 1u;
}

__device__ __forceinline__ void xcd_barrier(const XcdBarrier& b) {
    asm volatile("s_waitcnt vmcnt(0)" ::: "memory");
    __syncthreads();
    if (threadIdx.x == 0) {
        GAS unsigned* gbar_ = (GAS unsigned*)b.bar; unsigned bx_ = b.x; asm volatile("" : "+s"(gbar_), "+s"(bx_)); unsigned* bar = (unsigned*)gbar_;
        __builtin_amdgcn_s_waitcnt(0);
        unsigned nloc = b.st[0], nx = b.st[1];
        if (nloc == 0u) { xcd_barrier_complete(bar, bx_, nloc, nx); b.st[0] = nloc; b.st[1] = nx; }
        const unsigned old = xb_add(&bar[XB_XSUB(bx_)], 1u);
        const unsigned gen = old / nloc;
        if (old + 1u == (gen + 1u) * nloc) {
            __builtin_amdgcn_fence(__ATOMIC_RELEASE, "agent");
            asm volatile("s_waitcnt vmcnt(0)" ::: "memory");
            const unsigned og = xb_add(&bar[XB_TOP], 1u);
            const unsigned tg = og / nx;
            if (og + 1u == (tg + 1u) * nx) xb_add(&bar[XB_TOPGEN], 1u);
            else XB_SPIN(xb_ld(&bar[XB_TOPGEN]) == tg, bar);
            __builtin_amdgcn_fence(__ATOMIC_ACQUIRE, "agent");
            xb_add(&bar[XB_XGEN(bx_)], 1u);
            asm volatile("s_waitcnt vmcnt(0)" ::: "memory");
        } else {
            XB_SPIN(xb_ld(&bar[XB_XGEN(bx_)]) == gen, bar);
            __builtin_amdgcn_fence(__ATOMIC_ACQUIRE, "agent");
            asm volatile("s_waitcnt vmcnt(0)" ::: "memory");
        }
    }
    __syncthreads();
}

__device__ const float c_invf[32] = {
    1.000000000e+00f, 7.498942614e-01f, 5.623413324e-01f, 4.216965139e-01f, 3.162277639e-01f, 2.371373773e-01f, 1.778279394e-01f, 1.333521307e-01f,
    1.000000015e-01f, 7.498941571e-02f, 5.623413250e-02f, 4.216965288e-02f, 3.162277490e-02f, 2.371373773e-02f, 1.778279431e-02f, 1.333521493e-02f,
    9.999999776e-03f, 7.498941850e-03f, 5.623413250e-03f, 4.216964822e-03f, 3.162277630e-03f, 2.371373586e-03f, 1.778279431e-03f, 1.333521446e-03f,
    1.000000047e-03f, 7.498942432e-04f, 5.623413017e-04f, 4.216965172e-04f, 3.162277571e-04f, 2.371373703e-04f, 1.778279402e-04f, 1.333521504e-04f};

template <int KIND> __device__ __forceinline__ int srcmap(int n) {
    if constexpr (KIND == 0) return n;
    else if constexpr (KIND == 1) {
        if (n < 1024) return n;
        if (n < 1088) { const int jj = n - 1024; return 1024 + (jj >> 1) + 32 * (jj & 1); }
        if (n < 1280) return -1;
        if (n < 3328) return 1088 + (n - 1280);
        if (n < 5376) return 3136 + (n - 3328);
        if (n < 7424) return 7232 + (n - 5376);
        if (n < 9472) return 9280 + (n - 7424);
        if (n < 11520) return 11328 + (n - 9472);
        return 5184 + (n - 11520);
    } else if constexpr (KIND == 2) {
        if (n < 2048) return (n >> 7) * 192 + (n & 127);
        const int r = n - 2048, h = r >> 6, jj = r & 63; return h * 192 + 128 + (jj >> 1) + 32 * (jj & 1);
    } else if constexpr (KIND == 3) return (n >> 7) * 256 + (n & 127);
    else if constexpr (KIND == 4) return (n >> 7) * 256 + 128 + (n & 127);
    else { const int j = n >> 8, i = n & 255; return i < 128 ? 128 * j + i : DFF + 128 * j + (i - 128); }
}
template <int KIND> __device__ __forceinline__ void transpose_item(const float* W, int K, int Nsrc, bf16* WT, const float* scale, LAS float* scr, int kb, int nb, int lane) {
    const int k0 = 64 * kb, n0 = 32 * nb, sc = srcmap<KIND>(n0 + (lane & 31));
#pragma unroll 8
    for (int i = 0; i < 32; ++i) { const int kk = 2 * i + (lane >> 5); float v = 0.f;
        if (sc >= 0) { v = ((const GAS float*)W)[(size_t)(k0 + kk) * Nsrc + sc]; if (scale) v *= ((const GAS float*)scale)[k0 + kk]; }
        scr[kk * 33 + (lane & 31)] = v; }
    LDS_WAIT(); asm volatile("" ::: "memory");
    const int c = lane & 7;
#pragma unroll
    for (int j = 0; j < 4; ++j) { const int n = (lane >> 3) + 8 * j; const LAS float* s = scr + (8 * c) * 33 + n;
        v4u o; o.x = pk2(s[0 * 33], s[1 * 33]); o.y = pk2(s[2 * 33], s[3 * 33]); o.z = pk2(s[4 * 33], s[5 * 33]); o.w = pk2(s[6 * 33], s[7 * 33]);
        *(GAS v4u*)(WT + (size_t)(n0 + n) * K + k0 + 8 * c) = o; }
    LDS_WAIT(); asm volatile("" ::: "memory");
}

struct TItem { const float* src; const float* scale; bf16* dst; int K, Nsrc, k0, n0, sc; };
__device__ __forceinline__ int srcmap_rt(int kind, int n) {
    switch (kind) { case 1: return srcmap<1>(n); case 2: return srcmap<2>(n); case 3: return srcmap<3>(n); case 4: return srcmap<4>(n); case 5: return srcmap<5>(n); default: return n; }
}
__device__ __forceinline__ void rms_row_to_bf16(const float* xrow, const float* gain, bf16* orow, float* xcopy, int lane) {
    const GAS f32x4* xr = (const GAS f32x4*)xrow + lane;
    f32x4 v[8]; float s = 0.f;
#pragma unroll
    for (int j = 0; j < 8; ++j) { v[j] = xr[64 * j]; s += (v[j].x * v[j].x + v[j].y * v[j].y) + (v[j].z * v[j].z + v[j].w * v[j].w); }
    const float rstd = 1.0f / sqrtf(wave_sum(s) * (1.f / DM) + EPS);
    if (xcopy) { GAS f32x4* xc = (GAS f32x4*)xcopy + lane;
#pragma unroll
        for (int j = 0; j < 8; ++j) xc[64 * j] = v[j]; }
    GAS v2u* o8 = (GAS v2u*)orow + lane;
#pragma unroll
    for (int j = 0; j < 8; ++j) { const f32x4 g = *((const GAS f32x4*)gain + lane + 64 * j);
        v2u w; w.x = pk2(v[j].x * rstd * g.x, v[j].y * rstd * g.y); w.y = pk2(v[j].z * rstd * g.z, v[j].w * rstd * g.w); o8[64 * j] = w; }
}
__device__ __forceinline__ void rms_row_f32(float* xrow, const float* gain, int lane) {
    GAS f32x4* xr = (GAS f32x4*)xrow + lane;
    f32x4 v[8]; float s = 0.f;
#pragma unroll
    for (int j = 0; j < 8; ++j) { v[j] = xr[64 * j]; s += (v[j].x * v[j].x + v[j].y * v[j].y) + (v[j].z * v[j].z + v[j].w * v[j].w); }
    const float rstd = 1.0f / sqrtf(wave_sum(s) * (1.f / DM) + EPS);
#pragma unroll
    for (int j = 0; j < 8; ++j) { const f32x4 g = *((const GAS f32x4*)gain + lane + 64 * j); xr[64 * j] = v[j] * rstd * g; }
}
__device__ __forceinline__ void sincos_f64(float angf, float& sn, float& cs) {
    const double a = (double)angf;
    const double n = __builtin_rint(a * 0.63661977236758134308);
    double r = __builtin_fma(-n, 1.57079632679489655800e+00, a); r = __builtin_fma(-n, 6.12323399573676603587e-17, r);
    const double r2 = r * r;
    double ps = -1.0 / 1307674368000.0; ps = ps * r2 + 1.0 / 6227020800.0; ps = ps * r2 - 1.0 / 39916800.0; ps = ps * r2 + 1.0 / 362880.0; ps = ps * r2 - 1.0 / 5040.0; ps = ps * r2 + 1.0 / 120.0; ps = ps * r2 - 1.0 / 6.0; ps = ps * r2 * r + r;
    double pc = 1.0 / 20922789888000.0; pc = pc * r2 - 1.0 / 87178291200.0; pc = pc * r2 + 1.0 / 479001600.0; pc = pc * r2 - 1.0 / 3628800.0; pc = pc * r2 + 1.0 / 40320.0; pc = pc * r2 - 1.0 / 720.0; pc = pc * r2 + 1.0 / 24.0; pc = pc * r2 - 0.5; pc = pc * r2 + 1.0;
    const int q = ((int)n) & 3;
    const double s_ = (q == 0) ? ps : (q == 1) ? pc : (q == 2) ? -ps : -pc;
    const double c_ = (q == 0) ? pc : (q == 1) ? -ps : (q == 2) ? -pc : ps;
    sn = (float)s_; cs = (float)c_;
}

__device__ __forceinline__ void latent_norm_row(bf16* row, int lane) {
    v4u a = *(const v4u*)(row + lane * 8), b = *(const v4u*)(row + 512 + lane * 8);
    float fa[8] = {bflo(a.x), bfhi(a.x), bflo(a.y), bfhi(a.y), bflo(a.z), bfhi(a.z), bflo(a.w), bfhi(a.w)};
    float fb[8] = {bflo(b.x), bfhi(b.x), bflo(b.y), bfhi(b.y), bflo(b.z), bfhi(b.z), bflo(b.w), bfhi(b.w)};
    float sa = 0.f, sb = 0.f;
#pragma unroll
    for (int i = 0; i < 8; ++i) { sa += fa[i] * fa[i]; sb += fb[i] * fb[i]; }
    const float ra = 1.0f / sqrtf(wave_sum(sa) * (1.f / 512.f) + EPS), rb = 1.0f / sqrtf(wave_sum(sb) * (1.f / 512.f) + EPS);
    a.x = pk2(fa[0] * ra, fa[1] * ra); a.y = pk2(fa[2] * ra, fa[3] * ra); a.z = pk2(fa[4] * ra, fa[5] * ra); a.w = pk2(fa[6] * ra, fa[7] * ra);
    b.x = pk2(fb[0] * rb, fb[1] * rb); b.y = pk2(fb[2] * rb, fb[3] * rb); b.z = pk2(fb[4] * rb, fb[5] * rb); b.w = pk2(fb[6] * rb, fb[7] * rb);
    *(v4u*)(row + lane * 8) = a; *(v4u*)(row + 512 + lane * 8) = b;
}

__device__ __forceinline__ void attn_naive(unsigned char* ws, LAS float* qs  , int gw, int ngw, int lane) {
    const bf16* QN = (const bf16*)(ws + WS_QN); const bf16* QR = (const bf16*)(ws + WS_QR); const bf16* KN = (const bf16*)(ws + WS_KN);
    const bf16* KPE = (const bf16*)(ws + WS_KPE); const bf16* VT = (const bf16*)(ws + WS_VT); bf16* ATT = (bf16*)(ws + WS_ATT);
    for (int item = gw; item < S_ * NH; item += ngw) {
        const int q = item >> 4, h = item & 15;
        if (lane < 24) { const v4u w = (lane < 16) ? *(const v4u*)(QN + (size_t)q * 2048 + h * 128 + lane * 8) : *(const v4u*)(QR + (size_t)q * 1024 + h * 64 + (lane - 16) * 8);
            LAS float* d = qs + lane * 8; d[0] = bflo(w.x); d[1] = bfhi(w.x); d[2] = bflo(w.y); d[3] = bfhi(w.y); d[4] = bflo(w.z); d[5] = bfhi(w.z); d[6] = bflo(w.w); d[7] = bfhi(w.w); }
        LDS_WAIT(); asm volatile("" ::: "memory");
        float m = -__builtin_inff(), l = 0.f, o0 = 0.f, o1 = 0.f;
        const bf16* v0p = VT + (size_t)(h * 128 + 2 * lane) * S_; const bf16* v1p = v0p + S_;
        for (int j0 = 0; j0 <= q; j0 += 64) {
            const int j = j0 + lane; const bool valid = j <= q; float s = 0.f;
            if (valid) {
                const bf16* kn = KN + (size_t)j * 2048 + h * 128; const bf16* kp = KPE + (size_t)j * 64;
#pragma unroll 4
                for (int c = 0; c < 24; ++c) { const v4u w = (c < 16) ? *(const v4u*)(kn + c * 8) : *(const v4u*)(kp + (c - 16) * 8); const LAS float* qq = qs + c * 8;
                    s += bflo(w.x) * qq[0] + bfhi(w.x) * qq[1] + bflo(w.y) * qq[2] + bfhi(w.y) * qq[3] + bflo(w.z) * qq[4] + bfhi(w.z) * qq[5] + bflo(w.w) * qq[6] + bfhi(w.w) * qq[7]; }
            } else s = -__builtin_inff();
            const float mn = fmaxf(m, wave_max(s)); const float alpha = __builtin_amdgcn_exp2f(m - mn); const float p = valid ? __builtin_amdgcn_exp2f(s - mn) : 0.f;
            l = l * alpha + wave_sum(p); m = mn; o0 *= alpha; o1 *= alpha;
#pragma unroll
            for (int c = 0; c < 8; ++c) { const v4u a = *(const v4u*)(v0p + j0 + c * 8), b = *(const v4u*)(v1p + j0 + c * 8);
                const float p0 = __builtin_bit_cast(float, __builtin_amdgcn_readlane(__builtin_bit_cast(int, p), c * 8 + 0)), p1 = __builtin_bit_cast(float, __builtin_amdgcn_readlane(__builtin_bit_cast(int, p), c * 8 + 1));
                const float p2 = __builtin_bit_cast(float, __builtin_amdgcn_readlane(__builtin_bit_cast(int, p), c * 8 + 2)), p3 = __builtin_bit_cast(float, __builtin_amdgcn_readlane(__builtin_bit_cast(int, p), c * 8 + 3));
                const float p4 = __builtin_bit_cast(float, __builtin_amdgcn_readlane(__builtin_bit_cast(int, p), c * 8 + 4)), p5 = __builtin_bit_cast(float, __builtin_amdgcn_readlane(__builtin_bit_cast(int, p), c * 8 + 5));
                const float p6 = __builtin_bit_cast(float, __builtin_amdgcn_readlane(__builtin_bit_cast(int, p), c * 8 + 6)), p7 = __builtin_bit_cast(float, __builtin_amdgcn_readlane(__builtin_bit_cast(int, p), c * 8 + 7));
                o0 += p0 * bflo(a.x) + p1 * bfhi(a.x) + p2 * bflo(a.y) + p3 * bfhi(a.y) + p4 * bflo(a.z) + p5 * bfhi(a.z) + p6 * bflo(a.w) + p7 * bfhi(a.w);
                o1 += p0 * bflo(b.x) + p1 * bfhi(b.x) + p2 * bflo(b.y) + p3 * bfhi(b.y) + p4 * bflo(b.z) + p5 * bfhi(b.z) + p6 * bflo(b.w) + p7 * bfhi(b.w); }
        }
        const float il = 1.f / l;
        *(unsigned*)(ATT + (size_t)q * 2048 + h * 128 + 2 * lane) = pk2(o0 * il, o1 * il);
        asm volatile("" ::: "memory");
    }
}
__device__ __forceinline__ void hgrn_naive(unsigned char* ws, int layer, int gw, int ngw, int lane) {
    const bf16* HQ = (const bf16*)(ws + WS_HQ); const _Float16* HF = (const _Float16*)(ws + WS_HF); const bf16* VTH = (const bf16*)(ws + WS_VTH);
    const float* LB = (const float*)(ws + WS_LB) + layer * 2048; float* RR = (float*)(ws + WS_RRAW);
    for (int item = gw; item < NH * 128; item += ngw) {
        const int h = item >> 7, e = item & 127, ch = h * 128 + 2 * lane;
        const float lb0 = LB[ch], lb1 = LB[ch + 1];
        float s0 = 0.f, s1 = 0.f;
        const bf16* vp = VTH + (size_t)(h * 128 + e) * S_;
        for (int t0 = 0; t0 < S_; t0 += 8) {
            const v4u vv = *(const v4u*)(vp + t0);
            const float vt[8] = {bflo(vv.x), bfhi(vv.x), bflo(vv.y), bfhi(vv.y), bflo(vv.z), bfhi(vv.z), bflo(vv.w), bfhi(vv.w)};
            float ov = 0.f;
#pragma unroll
            for (int i = 0; i < 8; ++i) { const size_t off = (size_t)(t0 + i) * 2048 + ch;
                const f32x2 z = *(const f32x2*)(HF + off); const unsigned qq = *(const unsigned*)(HQ + off);
                const float f0 = lb0 + (1.f - lb0) * sigm(z.x), f1 = lb1 + (1.f - lb1) * sigm(z.y);
                s0 = fmaxf(f0, 1e-30f) * s0 + (1.f - f0) * vt[i]; s1 = fmaxf(f1, 1e-30f) * s1 + (1.f - f1) * vt[i];
                const float o = wave_sum(bflo(qq) * s0 + bfhi(qq) * s1);
                ov = (lane == i) ? o : ov; }
            if (lane < 8) RR[(size_t)(t0 + lane) * 2048 + h * 128 + e] = ov;
        }
    }
}
__device__ __forceinline__ void hgrn_normgate(unsigned char* ws, const float* gain, int gw, int ngw, int lane) {
    const float* RR = (const float*)(ws + WS_RRAW); const bf16* HG = (const bf16*)(ws + WS_HG); bf16* REC = (bf16*)(ws + WS_REC);
    const f32x2 g = *(const GAS f32x2*)(gain + 2 * lane);
    for (int item = gw; item < S_ * NH; item += ngw) {
        const size_t off = (size_t)item * 128 + 2 * lane;
        const f32x2 v = *(const f32x2*)(RR + off); const unsigned hg = *(const unsigned*)(HG + off);
        const float rstd = 1.0f / sqrtf(wave_sum(v.x * v.x + v.y * v.y) * (1.f / 128.f) + EPS);
        *(unsigned*)(REC + off) = pk2(v.x * rstd * g.x * bflo(hg), v.y * rstd * g.y * bfhi(hg));
    }
}
__device__ __forceinline__ void conv_gate(unsigned char* ws, const float* cw, const float* cb, int gw, int ngw, int lane) {
    const bf16* U = (const bf16*)(ws + WS_U); bf16* ACT = (bf16*)(ws + WS_ACT);
    for (int item = gw; item < (S_ / 16) * 11; item += ngw) {
        const int tb = item / 11, cg = item % 11, c0 = cg * 512 + lane * 8;
        const int ucol = (c0 >> 7) * 256 + (c0 & 127), t0 = tb * 16;
        float wg[3][8], wu[3][8], bg[8], bu[8];
#pragma unroll
        for (int j = 0; j < 3; ++j)
#pragma unroll
            for (int i = 0; i < 8; ++i) { wg[j][i] = ((const GAS float*)cw)[(size_t)j * DFF2 + c0 + i]; wu[j][i] = ((const GAS float*)cw)[(size_t)j * DFF2 + DFF + c0 + i]; }
#pragma unroll
        for (int i = 0; i < 8; ++i) { bg[i] = ((const GAS float*)cb)[c0 + i]; bu[i] = ((const GAS float*)cb)[DFF + c0 + i]; }
        float g2[8], g1[8], u2[8], u1[8];
#pragma unroll
        for (int i = 0; i < 8; ++i) { g2[i] = 0.f; g1[i] = 0.f; u2[i] = 0.f; u1[i] = 0.f; }
        if (t0 > 0) {
            const v4u a = *(const v4u*)(U + (size_t)(t0 - 2) * DFF2 + ucol), b = *(const v4u*)(U + (size_t)(t0 - 2) * DFF2 + ucol + 128);
            const v4u c = *(const v4u*)(U + (size_t)(t0 - 1) * DFF2 + ucol), d = *(const v4u*)(U + (size_t)(t0 - 1) * DFF2 + ucol + 128);
            g2[0] = bflo(a.x); g2[1] = bfhi(a.x); g2[2] = bflo(a.y); g2[3] = bfhi(a.y); g2[4] = bflo(a.z); g2[5] = bfhi(a.z); g2[6] = bflo(a.w); g2[7] = bfhi(a.w);
            u2[0] = bflo(b.x); u2[1] = bfhi(b.x); u2[2] = bflo(b.y); u2[3] = bfhi(b.y); u2[4] = bflo(b.z); u2[5] = bfhi(b.z); u2[6] = bflo(b.w); u2[7] = bfhi(b.w);
            g1[0] = bflo(c.x); g1[1] = bfhi(c.x); g1[2] = bflo(c.y); g1[3] = bfhi(c.y); g1[4] = bflo(c.z); g1[5] = bfhi(c.z); g1[6] = bflo(c.w); g1[7] = bfhi(c.w);
            u1[0] = bflo(d.x); u1[1] = bfhi(d.x); u1[2] = bflo(d.y); u1[3] = bfhi(d.y); u1[4] = bflo(d.z); u1[5] = bfhi(d.z); u1[6] = bflo(d.w); u1[7] = bfhi(d.w);
        }
#pragma unroll 4
        for (int t = t0; t < t0 + 16; ++t) {
            const v4u a = *(const v4u*)(U + (size_t)t * DFF2 + ucol), b = *(const v4u*)(U + (size_t)t * DFF2 + ucol + 128);
            float g0[8], u0[8];
            g0[0] = bflo(a.x); g0[1] = bfhi(a.x); g0[2] = bflo(a.y); g0[3] = bfhi(a.y); g0[4] = bflo(a.z); g0[5] = bfhi(a.z); g0[6] = bflo(a.w); g0[7] = bfhi(a.w);
            u0[0] = bflo(b.x); u0[1] = bfhi(b.x); u0[2] = bflo(b.y); u0[3] = bfhi(b.y); u0[4] = bflo(b.z); u0[5] = bfhi(b.z); u0[6] = bflo(b.w); u0[7] = bfhi(b.w);
            float r[8];
#pragma unroll
            for (int i = 0; i < 8; ++i) { const float G = bg[i] + wg[0][i] * g2[i] + wg[1][i] * g1[i] + wg[2][i] * g0[i]; const float Uu = bu[i] + wu[0][i] * u2[i] + wu[1][i] * u1[i] + wu[2][i] * u0[i];
                r[i] = G * sigm(G) * Uu; g2[i] = g1[i]; g1[i] = g0[i]; u2[i] = u1[i]; u1[i] = u0[i]; }
            v4u o; o.x = pk2(r[0], r[1]); o.y = pk2(r[2], r[3]); o.z = pk2(r[4], r[5]); o.w = pk2(r[6], r[7]);
            *(v4u*)(ACT + (size_t)t * DFF + c0) = o;
        }
    }
}

namespace fa {
typedef float f32x16 __attribute__((ext_vector_type(16)));
constexpr int KBUF = 24576, VBUF = 16384, STG = KBUF + VBUF;
constexpr float THR = 8.0f;
__device__ __forceinline__ float hmax(float a) { return fmaxf(a, __shfl_xor(a, 32)); }
__device__ __forceinline__ float hsum(float a) { return a + __shfl_xor(a, 32); }
__device__ __forceinline__ bf16x8 pk8(const f32x16& p, int b) {
    v4u w; w.x = pg8::cvt_pk_bf16(p[b], p[b + 1]); w.y = pg8::cvt_pk_bf16(p[b + 2], p[b + 3]); w.z = pg8::cvt_pk_bf16(p[b + 4], p[b + 5]); w.w = pg8::cvt_pk_bf16(p[b + 6], p[b + 7]);
    return __builtin_bit_cast(bf16x8, w);
}
__device__ __forceinline__ void attn_fast(unsigned char* ws, LAS unsigned char* lds, int vcu, int G) {
    int tid = threadIdx.x; asm volatile("" : "+v"(tid));
    const int lane = tid & 63, w = __builtin_amdgcn_readfirstlane(tid >> 6), r32 = lane & 31, hi = lane >> 5;
    const bf16* QN = (const bf16*)(ws + WS_QN); const bf16* QR = (const bf16*)(ws + WS_QR); const bf16* KN = (const bf16*)(ws + WS_KN);
    const bf16* KPE = (const bf16*)(ws + WS_KPE); const bf16* VT = (const bf16*)(ws + WS_VT); bf16* ATT = (bf16*)(ws + WS_ATT);
    const int pr = (r32 & 0x13) | ((r32 & 4) << 1) | ((r32 & 8) >> 1);
    const int kfo = hi * 1024 + pr * 16;
    const int fb = (r32 >> 1) & 7, va = (hi ^ (fb & 1)) << 4, vbb = fb >> 1;
    const int vfo = KBUF + r32 * 128 + va;
    const int vrow0 = 16 * w + (lane >> 3), vrow1 = vrow0 + 8;
    const int vsc0 = ((lane & 7) ^ ((vrow0 >> 1) & 7)) * 8, vsc1 = ((lane & 7) ^ ((vrow1 >> 1) & 7)) * 8;
    for (int item = vcu; item < 256; item += G) {
        const int h = item >> 4, sidx = item & 15;
        const bf16* kn_l = KN + (size_t)lane * 2048 + h * 128 + 8 * w;
        const bf16* kp_l = KPE + (size_t)lane * 64 + 8 * w;
        const bf16* v0_l = VT + (size_t)(h * 128 + vrow0) * S_ + vsc0; const bf16* v1_l = VT + (size_t)(h * 128 + vrow1) * S_ + vsc1;
#define FA_ISSUE(t, st) do { const size_t ko_ = (size_t)(t) * 64 * 2048, po_ = (size_t)(t) * 64 * 64; const int to_ = (t) * 64; LAS unsigned char* sb_ = lds + (st) * STG; \
        __builtin_amdgcn_global_load_lds((const unsigned*)(kn_l + ko_), (LAS unsigned*)(sb_ + w * 1024), 16, 0, 0); \
        __builtin_amdgcn_global_load_lds((const unsigned*)(kn_l + ko_ + 64), (LAS unsigned*)(sb_ + (w + 8) * 1024), 16, 0, 0); \
        __builtin_amdgcn_global_load_lds((const unsigned*)(kp_l + po_), (LAS unsigned*)(sb_ + (w + 16) * 1024), 16, 0, 0); \
        __builtin_amdgcn_global_load_lds((const unsigned*)(v0_l + to_), (LAS unsigned*)(sb_ + KBUF + (2 * w) * 1024), 16, 0, 0); \
        __builtin_amdgcn_global_load_lds((const unsigned*)(v1_l + to_), (LAS unsigned*)(sb_ + KBUF + (2 * w + 1) * 1024), 16, 0, 0); } while (0)
        for (int pass = 0; pass < 2; ++pass) {
            const int qb = pass ? sidx : 31 - sidx, q0 = qb * 256, NT = 4 * qb + 4, qw = q0 + 32 * w, q = qw + r32;
            FA_ISSUE(0, 0);
            bf16x8 qr[12];
#pragma unroll
            for (int d0 = 0; d0 < 8; ++d0) qr[d0] = *(const bf16x8*)(QN + (size_t)q * 2048 + h * 128 + d0 * 16 + hi * 8);
#pragma unroll
            for (int d0 = 0; d0 < 4; ++d0) qr[8 + d0] = *(const bf16x8*)(QR + (size_t)q * 1024 + h * 64 + d0 * 16 + hi * 8);
            f32x16 o[4];
#pragma unroll
            for (int e = 0; e < 4; ++e)
#pragma unroll
                for (int r = 0; r < 16; ++r) o[e][r] = 0.f;
            float m = -__builtin_inff(), l = 0.f;
            for (int t = 0; t < NT; ++t) {
                VM_WAIT(); __syncthreads();
                if (t + 1 < NT) FA_ISSUE(t + 1, (t + 1) & 1);
                {
                    const LAS unsigned char* sb = lds + (t & 1) * STG;
                    f32x16 p0, p1;
#pragma unroll
                    for (int r = 0; r < 16; ++r) { p0[r] = 0.f; p1[r] = 0.f; }
                    {
#define FA_KLD(g, A0, A1, B0, B1) do { A0 = *(const LAS bf16x8*)(sb + kfo + (2 * (g)) * 2048); A1 = *(const LAS bf16x8*)(sb + kfo + (2 * (g)) * 2048 + 512); \
                                       B0 = *(const LAS bf16x8*)(sb + kfo + (2 * (g) + 1) * 2048); B1 = *(const LAS bf16x8*)(sb + kfo + (2 * (g) + 1) * 2048 + 512); } while (0)
#define FA_KMM(g, A0, A1, B0, B1) do { p0 = __builtin_amdgcn_mfma_f32_32x32x16_bf16(A0, qr[2 * (g)], p0, 0, 0, 0); p1 = __builtin_amdgcn_mfma_f32_32x32x16_bf16(A1, qr[2 * (g)], p1, 0, 0, 0); \
                                       p0 = __builtin_amdgcn_mfma_f32_32x32x16_bf16(B0, qr[2 * (g) + 1], p0, 0, 0, 0); p1 = __builtin_amdgcn_mfma_f32_32x32x16_bf16(B1, qr[2 * (g) + 1], p1, 0, 0, 0); } while (0)
                        bf16x8 xa0, xa1, xb0, xb1, ya0, ya1, yb0, yb1;
                        FA_KLD(0, xa0, xa1, xb0, xb1); __builtin_amdgcn_sched_barrier(0);
                        FA_KLD(1, ya0, ya1, yb0, yb1); __builtin_amdgcn_sched_barrier(0); FA_KMM(0, xa0, xa1, xb0, xb1); __builtin_amdgcn_sched_barrier(0);
                        FA_KLD(2, xa0, xa1, xb0, xb1); __builtin_amdgcn_sched_barrier(0); FA_KMM(1, ya0, ya1, yb0, yb1); __builtin_amdgcn_sched_barrier(0);
                        FA_KLD(3, ya0, ya1, yb0, yb1); __builtin_amdgcn_sched_barrier(0); FA_KMM(2, xa0, xa1, xb0, xb1); __builtin_amdgcn_sched_barrier(0);
                        FA_KLD(4, xa0, xa1, xb0, xb1); __builtin_amdgcn_sched_barrier(0); FA_KMM(3, ya0, ya1, yb0, yb1); __builtin_amdgcn_sched_barrier(0);
                        FA_KLD(5, ya0, ya1, yb0, yb1); __builtin_amdgcn_sched_barrier(0); FA_KMM(4, xa0, xa1, xb0, xb1); __builtin_amdgcn_sched_barrier(0);
                        FA_KMM(5, ya0, ya1, yb0, yb1);
#undef FA_KLD
#undef FA_KMM
                    }
                    if (64 * t + 63 > qw) {
                        const int kb = 64 * t + 8 * hi - q;
#pragma unroll
                        for (int r = 0; r < 16; ++r) { const int dk = kb + 16 * (r >> 3) + (r & 7); if (dk > 0) p0[r] = -__builtin_inff(); if (dk + 32 > 0) p1[r] = -__builtin_inff(); }
                    }
                    float mx = fmaxf(p0[0], p1[0]);
#pragma unroll
                    for (int r = 1; r < 16; ++r) mx = fmaxf(mx, fmaxf(p0[r], p1[r]));
                    mx = hmax(mx);
                    if (__any(mx > m + THR)) { const float mn = fmaxf(m, mx), alpha = __builtin_amdgcn_exp2f(m - mn); m = mn; l *= alpha;
#pragma unroll
                        for (int e = 0; e < 4; ++e)
#pragma unroll
                            for (int r = 0; r < 16; ++r) o[e][r] *= alpha; }
                    float ps = 0.f;
#pragma unroll
                    for (int r = 0; r < 16; ++r) { p0[r] = __builtin_amdgcn_exp2f(p0[r] - m); p1[r] = __builtin_amdgcn_exp2f(p1[r] - m); ps += p0[r] + p1[r]; }
                    l += ps;
                    const bf16x8 pf0 = pk8(p0, 0), pf1 = pk8(p0, 8), pf2 = pk8(p1, 0), pf3 = pk8(p1, 8);
                    const LAS unsigned char* vb0 = sb + vfo + ((0 ^ vbb) << 5); const LAS unsigned char* vb1 = sb + vfo + ((1 ^ vbb) << 5);
                    const LAS unsigned char* vb2 = sb + vfo + ((2 ^ vbb) << 5); const LAS unsigned char* vb3 = sb + vfo + ((3 ^ vbb) << 5);
#define FA_PVK(vb, pf) do { const bf16x8 a0 = *(const LAS bf16x8*)((vb)), a1 = *(const LAS bf16x8*)((vb) + 4096), a2 = *(const LAS bf16x8*)((vb) + 8192), a3 = *(const LAS bf16x8*)((vb) + 12288); \
                        o[0] = __builtin_amdgcn_mfma_f32_32x32x16_bf16(a0, pf, o[0], 0, 0, 0); o[1] = __builtin_amdgcn_mfma_f32_32x32x16_bf16(a1, pf, o[1], 0, 0, 0); \
                        o[2] = __builtin_amdgcn_mfma_f32_32x32x16_bf16(a2, pf, o[2], 0, 0, 0); o[3] = __builtin_amdgcn_mfma_f32_32x32x16_bf16(a3, pf, o[3], 0, 0, 0); } while (0)
                    FA_PVK(vb0, pf0); FA_PVK(vb1, pf1); FA_PVK(vb2, pf2); FA_PVK(vb3, pf3);
#undef FA_PVK
                }
            }
            const float il = 1.0f / hsum(l);
            bf16* op = ATT + (size_t)q * 2048 + h * 128 + 4 * hi;
#pragma unroll
            for (int e = 0; e < 4; ++e)
#pragma unroll
                for (int g4 = 0; g4 < 4; ++g4) { v2u wv; wv.x = pg8::cvt_pk_bf16(o[e][4 * g4] * il, o[e][4 * g4 + 1] * il); wv.y = pg8::cvt_pk_bf16(o[e][4 * g4 + 2] * il, o[e][4 * g4 + 3] * il);
                    *(v2u*)(op + e * 32 + g4 * 8) = wv; }
            __syncthreads();
        }
#undef FA_ISSUE
    }
}
}

namespace hg {
typedef float f32x16 __attribute__((ext_vector_type(16)));
constexpr int L_TOT = 0, L_KT = 4096;
constexpr int L_QA = 4096, L_QB = 20480, L_KA0 = 28672, L_KA1 = 36864, L_SSP = 53248;
__device__ __forceinline__ float log2_(float x) { return __builtin_amdgcn_logf(x); }
__device__ __forceinline__ float exp2_(float x) { return __builtin_amdgcn_exp2f(x); }
__device__ __forceinline__ bf16x8 pk8(const f32x16& p, int b) {
    v4u w; w.x = pg8::cvt_pk_bf16(p[b], p[b + 1]); w.y = pg8::cvt_pk_bf16(p[b + 2], p[b + 3]); w.z = pg8::cvt_pk_bf16(p[b + 4], p[b + 5]); w.w = pg8::cvt_pk_bf16(p[b + 6], p[b + 7]);
    return __builtin_bit_cast(bf16x8, w);
}
#define HG_GATES(HFp, lbv, t0, h) \
    float kk[16], bl[16]; { float run_ = 0.f; const _Float16* zp_ = (HFp) + (size_t)((t0) + 16 * tg) * 2048 + (h) * 128 + d; \
      _Pragma("unroll") for (int i = 0; i < 16; ++i) { const float z_ = (float)zp_[(size_t)i * 2048]; const float f_ = (lbv) + (1.f - (lbv)) * sigm(z_); kk[i] = 1.f - f_; run_ += log2_(fmaxf(f_, 1e-30f)); bl[i] = run_; } }

__device__ __forceinline__ void pass1(unsigned char* ws, LAS unsigned char* lds, int layer, int vcu, int G) {
    int tid = threadIdx.x; asm volatile("" : "+v"(tid));
    const int lane = tid & 63, w = __builtin_amdgcn_readfirstlane(tid >> 6), d = tid & 127, tg = tid >> 7, r32 = lane & 31, hi = lane >> 5;
    const _Float16* HF = (const _Float16*)(ws + WS_HF); const bf16* VTH = (const bf16*)(ws + WS_VTH); bf16* HU = (bf16*)(ws + WS_HU); float* GAM = (float*)(ws + WS_RRAW);
    const float* LB = (const float*)(ws + WS_LB) + layer * 2048;
    LAS float* tot = (LAS float*)(lds + L_TOT); LAS unsigned char* KT = lds + L_KT;
    const int fsw = (d >> 1) & 7, fsr = (r32 >> 1) & 7, et = w >> 1, dt0 = 2 * (w & 1);
    for (int unit = vcu; unit < NH * 128; unit += G) {
        const int h = unit >> 7, c = unit & 127, t0 = c * 64;
        const float lb = LB[h * 128 + d];
        HG_GATES(HF, lb, t0, h);
        tot[tg * 128 + d] = bl[15];
        __syncthreads();
        float pre = 0.f, all = 0.f;
#pragma unroll
        for (int j = 0; j < 4; ++j) { const float v = tot[j * 128 + d]; pre += (j < tg) ? v : 0.f; all += v; }
        { float kh[16];
#pragma unroll
          for (int i = 0; i < 16; ++i) kh[i] = kk[i] * exp2_(all - (pre + bl[i]));
          v4u c0, c1; c0.x = pk2(kh[0], kh[1]); c0.y = pk2(kh[2], kh[3]); c0.z = pk2(kh[4], kh[5]); c0.w = pk2(kh[6], kh[7]);
          c1.x = pk2(kh[8], kh[9]); c1.y = pk2(kh[10], kh[11]); c1.z = pk2(kh[12], kh[13]); c1.w = pk2(kh[14], kh[15]);
          *(LAS v4u*)(KT + d * 128 + (((2 * tg) ^ fsw) << 4)) = c0; *(LAS v4u*)(KT + d * 128 + (((2 * tg + 1) ^ fsw) << 4)) = c1; }
        if (tg == 0) GAM[(size_t)(h * 128 + c) * 128 + d] = exp2_(all);
        bf16x8 af[4];
#pragma unroll
        for (int ks = 0; ks < 4; ++ks) af[ks] = *(const bf16x8*)(VTH + (size_t)(h * 128 + 32 * et + r32) * S_ + t0 + 16 * ks + 8 * hi);
        __syncthreads();
#pragma unroll
        for (int dd = 0; dd < 2; ++dd) { const int dt = dt0 + dd; f32x16 acc;
#pragma unroll
            for (int r = 0; r < 16; ++r) acc[r] = 0.f;
#pragma unroll
            for (int ks = 0; ks < 4; ++ks) { const bf16x8 bq = *(const LAS bf16x8*)(KT + (32 * dt + r32) * 128 + (((2 * ks + hi) ^ fsr) << 4)); acc = __builtin_amdgcn_mfma_f32_32x32x16_bf16(af[ks], bq, acc, 0, 0, 0); }
            bf16* up = HU + ((size_t)(h * 128 + c) * 128 + 32 * et + 4 * hi) * 128 + 32 * dt + r32;
#pragma unroll
            for (int r = 0; r < 16; ++r) up[(size_t)((r & 3) + 8 * (r >> 2)) * 128] = (bf16)f2bf(acc[r]); }
        __syncthreads();
    }
}
__device__ __forceinline__ void scan(unsigned char* ws, int gtid, int nthr) {
    const bf16* HU = (const bf16*)(ws + WS_HU); const float* GAM = (const float*)(ws + WS_RRAW); bf16* HS = (bf16*)(ws + WS_HS);
    for (int idx = gtid; idx < NH * 128 * 64; idx += nthr) {
        const int h = idx >> 13, e = (idx >> 6) & 127, d = 2 * (idx & 63);
        float s0 = 0.f, s1 = 0.f;
#pragma unroll 8
        for (int c = 0; c < 128; ++c) { const size_t base = ((size_t)(h * 128 + c) * 128 + e) * 128 + d;
            *(unsigned*)(HS + base) = pk2(s0, s1);
            const unsigned u = *(const unsigned*)(HU + base); const f32x2 gm = *(const f32x2*)(GAM + (size_t)(h * 128 + c) * 128 + d);
            s0 = gm.x * s0 + bflo(u); s1 = gm.y * s1 + bfhi(u); }
    }
}
__device__ __forceinline__ void pass3(unsigned char* ws, LAS unsigned char* lds, const float* gain, int layer, int vcu, int G) {
    int tid = threadIdx.x; asm volatile("" : "+v"(tid));
    const int lane = tid & 63, w = __builtin_amdgcn_readfirstlane(tid >> 6), d = tid & 127, tg = tid >> 7, r32 = lane & 31, hi = lane >> 5;
    const _Float16* HF = (const _Float16*)(ws + WS_HF); const bf16* HQ = (const bf16*)(ws + WS_HQ); const bf16* HG = (const bf16*)(ws + WS_HG); const bf16* VTH = (const bf16*)(ws + WS_VTH);
    const bf16* HS = (const bf16*)(ws + WS_HS); bf16* REC = (bf16*)(ws + WS_REC); const float* LB = (const float*)(ws + WS_LB) + layer * 2048;
    LAS float* tot = (LAS float*)(lds + L_TOT); LAS float* SSP = (LAS float*)(lds + L_SSP);
    const int et = w & 3, tb = w >> 2, pr = (r32 & 0x13) | ((r32 & 4) << 1) | ((r32 & 8) >> 1);
    const int eo = (d >> 3) * 16, ei = (d & 7) * 2;
    for (int unit = vcu; unit < NH * 128; unit += G) {
        const int h = unit >> 7, c = unit & 127, t0 = c * 64;
        const float lb = LB[h * 128 + d];
        HG_GATES(HF, lb, t0, h);
        float qv[16];
        { const bf16* qp = HQ + (size_t)(t0 + 16 * tg) * 2048 + h * 128 + d;
#pragma unroll
          for (int i = 0; i < 16; ++i) qv[i] = __builtin_bit_cast(float, (unsigned)qp[(size_t)i * 2048] << 16); }
        tot[tg * 128 + d] = bl[15];
        __syncthreads();
        const float t_0 = tot[d], t_1 = tot[128 + d], t_2 = tot[256 + d];
        const float pre = (tg > 0 ? t_0 : 0.f) + (tg > 1 ? t_1 : 0.f) + (tg > 2 ? t_2 : 0.f), b31 = t_0 + t_1;
#pragma unroll
        for (int i = 0; i < 16; ++i) { const float b = pre + bl[i]; const int row = 16 * tg + i;
            *(LAS bf16*)(lds + L_QA + eo * 64 + row * 16 + ei) = (bf16)f2bf(qv[i] * exp2_(b));
            *(LAS bf16*)(lds + L_KA1 + eo * 64 + row * 16 + ei) = (bf16)f2bf(kk[i] * exp2_(b31 - b));
            if (tg < 2) *(LAS bf16*)(lds + L_KA0 + eo * 32 + row * 16 + ei) = (bf16)f2bf(kk[i] * exp2_(-b));
            else *(LAS bf16*)(lds + L_QB + eo * 32 + (row - 32) * 16 + ei) = (bf16)f2bf(qv[i] * exp2_(b - b31)); }
        __syncthreads();
        f32x16 o;
#pragma unroll
        for (int r = 0; r < 16; ++r) o[r] = 0.f;
        { const bf16* sp = HS + ((size_t)(h * 128 + c) * 128 + 32 * et + r32) * 128 + 8 * hi; const LAS unsigned char* qb_ = lds + L_QA + hi * 1024 + (32 * tb + r32) * 16;
#pragma unroll
          for (int kd = 0; kd < 8; ++kd) { const bf16x8 a = *(const bf16x8*)(sp + 16 * kd); const bf16x8 b = *(const LAS bf16x8*)(qb_ + kd * 2048); o = __builtin_amdgcn_mfma_f32_32x32x16_bf16(a, b, o, 0, 0, 0); } }
        const bf16* vp = VTH + (size_t)(h * 128 + 32 * et + r32) * S_ + t0 + 8 * hi;
        if (tb == 0) {
            f32x16 p;
#pragma unroll
            for (int r = 0; r < 16; ++r) p[r] = 0.f;
            const LAS unsigned char* ka = lds + L_KA0 + hi * 512 + pr * 16; const LAS unsigned char* qa = lds + L_QA + hi * 1024 + r32 * 16;
#pragma unroll
            for (int kd = 0; kd < 8; ++kd) p = __builtin_amdgcn_mfma_f32_32x32x16_bf16(*(const LAS bf16x8*)(ka + kd * 1024), *(const LAS bf16x8*)(qa + kd * 2048), p, 0, 0, 0);
#pragma unroll
            for (int r = 0; r < 16; ++r) if (16 * (r >> 3) + 8 * hi + (r & 7) > r32) p[r] = 0.f;
            o = __builtin_amdgcn_mfma_f32_32x32x16_bf16(*(const bf16x8*)(vp), pk8(p, 0), o, 0, 0, 0);
            o = __builtin_amdgcn_mfma_f32_32x32x16_bf16(*(const bf16x8*)(vp + 16), pk8(p, 8), o, 0, 0, 0);
        } else {
            f32x16 p0, p1;
#pragma unroll
            for (int r = 0; r < 16; ++r) { p0[r] = 0.f; p1[r] = 0.f; }
            const LAS unsigned char* ka = lds + L_KA1 + hi * 1024 + pr * 16; const LAS unsigned char* qa = lds + L_QB + hi * 512 + r32 * 16;
#pragma unroll
            for (int kd = 0; kd < 8; ++kd) { const bf16x8 qf = *(const LAS bf16x8*)(qa + kd * 1024);
                p0 = __builtin_amdgcn_mfma_f32_32x32x16_bf16(*(const LAS bf16x8*)(ka + kd * 2048), qf, p0, 0, 0, 0);
                p1 = __builtin_amdgcn_mfma_f32_32x32x16_bf16(*(const LAS bf16x8*)(ka + kd * 2048 + 512), qf, p1, 0, 0, 0); }
#pragma unroll
            for (int r = 0; r < 16; ++r) if (16 * (r >> 3) + 8 * hi + (r & 7) > r32) p1[r] = 0.f;
            o = __builtin_amdgcn_mfma_f32_32x32x16_bf16(*(const bf16x8*)(vp), pk8(p0, 0), o, 0, 0, 0);
            o = __builtin_amdgcn_mfma_f32_32x32x16_bf16(*(const bf16x8*)(vp + 16), pk8(p0, 8), o, 0, 0, 0);
            o = __builtin_amdgcn_mfma_f32_32x32x16_bf16(*(const bf16x8*)(vp + 32), pk8(p1, 0), o, 0, 0, 0);
            o = __builtin_amdgcn_mfma_f32_32x32x16_bf16(*(const bf16x8*)(vp + 48), pk8(p1, 8), o, 0, 0, 0);
        }
        float ss = 0.f;
#pragma unroll
        for (int r = 0; r < 16; ++r) ss += o[r] * o[r];
        ss += __shfl_xor(ss, 32);
        if (hi == 0) SSP[(tb * 4 + et) * 32 + r32] = ss;
        __syncthreads();
        const float rstd = 1.0f / sqrtf((SSP[(tb * 4 + 0) * 32 + r32] + SSP[(tb * 4 + 1) * 32 + r32] + SSP[(tb * 4 + 2) * 32 + r32] + SSP[(tb * 4 + 3) * 32 + r32]) * (1.f / 128.f) + EPS);
        { const size_t ro = (size_t)(t0 + 32 * tb + r32) * 2048 + h * 128 + 32 * et + 4 * hi;
#pragma unroll
          for (int g4 = 0; g4 < 4; ++g4) { const f32x4 gn = *(const GAS f32x4*)(gain + 32 * et + 4 * hi + 8 * g4); const v2u hv = *(const v2u*)(HG + ro + 8 * g4);
              v2u ov; ov.x = pk2(o[4 * g4] * rstd * gn.x * bflo(hv.x), o[4 * g4 + 1] * rstd * gn.y * bfhi(hv.x)); ov.y = pk2(o[4 * g4 + 2] * rstd * gn.z * bflo(hv.y), o[4 * g4 + 3] * rstd * gn.w * bfhi(hv.y));
              *(v2u*)(REC + ro + 8 * g4) = ov; } }
        __syncthreads();
    }
}
#undef HG_GATES
}

#ifndef PROBE
#define PROBE 0
#endif
#define REPS(k) (((PROBE >> (k)) & 1) + 1)
#define XBAR(b) do { for (int rb_ = 0; rb_ < REPS(8); ++rb_) xcd_barrier(b); } while (0)
#ifndef NAIVE_ATTN
#define NAIVE_ATTN 0
#endif
#ifndef NAIVE_HGRN
#define NAIVE_HGRN 0
#endif
struct Args { const float* in[19]; float* out; unsigned char* ws; };
enum { I_X = 0, I_POS, I_ANG, I_WIN, I_QNG, I_WUQ, I_KVNG, I_WUKV, I_LBL, I_HONG, I_WA, I_WB, I_WO, I_FNG, I_WUP, I_CW, I_CB, I_WDN, I_FING };

__global__ void __launch_bounds__(NTHR, 2) mk_fwd(Args args) {
    extern __shared__ __attribute__((aligned(16))) unsigned char lds_raw[];
    LAS unsigned char* lds = (LAS unsigned char*)lds_raw;
    const int tid = threadIdx.x, lane = tid & 63, wave = __builtin_amdgcn_readfirstlane(tid >> 6);
    const int G = gridDim.x, bx = blockIdx.x, vcu = (G % 8 == 0) ? (bx % 8) * (G / 8) + bx / 8 : bx;
    const int gw = vcu * NWAVES + wave, ngw = G * NWAVES;
    unsigned char* ws = args.ws;
    for (int u = tid; u < (LDS_BYTES - LDSCTL_OFF) / 4; u += NTHR) ((LAS unsigned*)(lds + LDSCTL_OFF))[u] = 0u;
    __syncthreads();
    XcdBarrier bar = xcd_barrier_post((unsigned*)(ws + WS_CTL) + CW_BAR, (volatile LAS unsigned*)(lds + MISC_OFF) + 8);
    float* X = args.out;
    if (tid < 19) ((LAS unsigned long long*)(lds + MISC_OFF + 128))[tid] = ((const __attribute__((address_space(4))) unsigned long long*)__builtin_amdgcn_kernarg_segment_ptr())[tid];
    __syncthreads();
#define INP(i) ((const float*)(((unsigned long long)(unsigned)__builtin_amdgcn_readfirstlane((int)(((LAS const unsigned long long*)(lds + MISC_OFF + 128))[i] >> 32)) << 32) | (unsigned long long)(unsigned)__builtin_amdgcn_readfirstlane((int)(unsigned)((LAS const unsigned long long*)(lds + MISC_OFF + 128))[i])))

    for (int rep = 0; rep < REPS(4); ++rep) {
        LAS float* scr = (LAS float*)(lds + RING_OFF + wave * 16384);
        constexpr int I_IN = 32 * (WINR / 32), I_UQ = 8 * 96, I_K = 8 * 64, I_V = 8 * 64, I_SQ = 32 * 64, I_UP = 32 * 352, I_DN = 88 * 64;
        constexpr int PER_LAYER = I_IN + I_UQ + I_K + I_V + 3 * I_SQ + I_UP + I_DN;
        const float* p_win = INP(I_WIN); const float* p_wuq = INP(I_WUQ); const float* p_wukv = INP(I_WUKV); const float* p_wa = INP(I_WA); const float* p_wb = INP(I_WB);
        const float* p_wo = INP(I_WO); const float* p_wup = INP(I_WUP); const float* p_wdn = INP(I_WDN); const float* p_qg = INP(I_QNG); const float* p_kvg = INP(I_KVNG);
#define T_DECODE(it, T) do { const int l_ = (it) / PER_LAYER; int r_ = (it) % PER_LAYER; unsigned char* wl_ = ws + WS_W + (size_t)l_ * LW; int kind_, nblk_; (T).scale = nullptr; \
        if (r_ < I_IN) { kind_ = 1; nblk_ = WINR / 32; (T).src = p_win + (size_t)l_ * DM * INW; (T).K = DM; (T).Nsrc = INW; (T).dst = (bf16*)(wl_ + LW_IN); } \
        else if ((r_ -= I_IN) < I_UQ) { kind_ = 2; nblk_ = 96; (T).src = p_wuq + (size_t)l_ * QL * 3072; (T).K = QL; (T).Nsrc = 3072; (T).dst = (bf16*)(wl_ + LW_UQ); (T).scale = p_qg + l_ * QL; } \
        else if ((r_ -= I_UQ) < I_K) { kind_ = 3; nblk_ = 64; (T).src = p_wukv + (size_t)l_ * KVL * 4096; (T).K = KVL; (T).Nsrc = 4096; (T).dst = (bf16*)(wl_ + LW_K); (T).scale = p_kvg + l_ * KVL; } \
        else if ((r_ -= I_K) < I_V) { kind_ = 4; nblk_ = 64; (T).src = p_wukv + (size_t)l_ * KVL * 4096; (T).K = KVL; (T).Nsrc = 4096; (T).dst = (bf16*)(wl_ + LW_V); (T).scale = p_kvg + l_ * KVL; } \
        else if ((r_ -= I_V) < I_SQ) { kind_ = 0; nblk_ = 64; (T).src = p_wa + (size_t)l_ * DM * DM; (T).K = DM; (T).Nsrc = DM; (T).dst = (bf16*)(wl_ + LW_A); } \
        else if ((r_ -= I_SQ) < I_SQ) { kind_ = 0; nblk_ = 64; (T).src = p_wb + (size_t)l_ * DM * DM; (T).K = DM; (T).Nsrc = DM; (T).dst = (bf16*)(wl_ + LW_B); } \
        else if ((r_ -= I_SQ) < I_SQ) { kind_ = 0; nblk_ = 64; (T).src = p_wo + (size_t)l_ * DM * DM; (T).K = DM; (T).Nsrc = DM; (T).dst = (bf16*)(wl_ + LW_O); } \
        else if ((r_ -= I_SQ) < I_UP) { kind_ = 5; nblk_ = 352; (T).src = p_wup + (size_t)l_ * DM * DFF2; (T).K = DM; (T).Nsrc = DFF2; (T).dst = (bf16*)(wl_ + LW_UP); } \
        else { r_ -= I_UP; kind_ = 0; nblk_ = 64; (T).src = p_wdn + (size_t)l_ * DFF * DM; (T).K = DFF; (T).Nsrc = DM; (T).dst = (bf16*)(wl_ + LW_DN); } \
        (T).k0 = 64 * (r_ / nblk_); (T).n0 = 32 * (r_ % nblk_); (T).sc = srcmap_rt(kind_, (T).n0 + (lane & 31)); } while (0)
#define T_LOAD(T, V) do { const GAS float* sp_ = (const GAS float*)(T).src + (size_t)((T).k0 + (lane >> 5)) * (T).Nsrc + ((T).sc >= 0 ? (T).sc : 0); \
        _Pragma("unroll") for (int i = 0; i < 32; ++i) (V)[i] = sp_[(size_t)(2 * i) * (T).Nsrc]; } while (0)
#define T_PROC(T, V) do { const bool z_ = (T).sc < 0; \
        if ((T).scale) { const GAS float* gp_ = (const GAS float*)(T).scale + (T).k0 + (lane >> 5); _Pragma("unroll") for (int i = 0; i < 32; ++i) (V)[i] *= gp_[2 * i]; } \
        _Pragma("unroll") for (int i = 0; i < 32; ++i) scr[(2 * i + (lane >> 5)) * 33 + (lane & 31)] = z_ ? 0.f : (V)[i]; \
        LDS_WAIT(); asm volatile("" ::: "memory"); \
        { const int c_ = lane & 7; _Pragma("unroll") for (int j = 0; j < 4; ++j) { const int n_ = (lane >> 3) + 8 * j; const LAS float* s_ = scr + (8 * c_) * 33 + n_; \
            v4u o_; o_.x = pk2(s_[0 * 33], s_[1 * 33]); o_.y = pk2(s_[2 * 33], s_[3 * 33]); o_.z = pk2(s_[4 * 33], s_[5 * 33]); o_.w = pk2(s_[6 * 33], s_[7 * 33]); \
            *(GAS v4u*)((T).dst + (size_t)((T).n0 + n_) * (T).K + (T).k0 + 8 * c_) = o_; } } \
        LDS_WAIT(); asm volatile("" ::: "memory"); } while (0)
        { TItem ta, tb; float va[32], vb[32]; int it = gw; const int NIT = DEPTH * PER_LAYER;
          if (it < NIT) { T_DECODE(it, ta); T_LOAD(ta, va); }
          while (it < NIT) {
              const int it1 = it + ngw; if (it1 < NIT) { T_DECODE(it1, tb); T_LOAD(tb, vb); }
              T_PROC(ta, va);
              if (it1 >= NIT) break;
              const int it2 = it1 + ngw; if (it2 < NIT) { T_DECODE(it2, ta); T_LOAD(ta, va); }
              T_PROC(tb, vb);
              it = it2; } }
#undef T_DECODE
#undef T_LOAD
#undef T_PROC
        { const GAS int* pos = (const GAS int*)INP(I_POS); float* COS = (float*)(ws + WS_COS); float* SIN = (float*)(ws + WS_SIN);
          for (int i = vcu * NTHR + tid; i < S_ * 32; i += G * NTHR) { const float ang = (float)pos[i >> 5] * c_invf[i & 31]; float sn, cs; sincos_f64(ang, sn, cs); COS[i] = cs; SIN[i] = sn; } }
        { const GAS float* lg = (const GAS float*)INP(I_LBL); float* LB = (float*)(ws + WS_LB);
          for (int c = vcu * NTHR + tid; c < 2048; c += G * NTHR) { const float a0 = lg[c], a1 = lg[2048 + c], a2 = lg[4096 + c], a3 = lg[6144 + c];
              const float mx = fmaxf(fmaxf(a0, a1), fmaxf(a2, a3)); const float e0 = expf(a0 - mx), e1 = expf(a1 - mx), e2 = expf(a2 - mx), e3 = expf(a3 - mx); const float inv = 1.f / (e0 + e1 + e2 + e3);
              LB[c] = 0.f; LB[2048 + c] = e1 * inv; LB[4096 + c] = (e1 + e2) * inv; LB[6144 + c] = (e1 + e2 + e3) * inv; } }
        for (int i = vcu * NTHR + tid; i < 2 * DM / 8; i += G * NTHR) *(GAS v4u*)(ws + WS_XN - 2 * DM * 2 + (size_t)i * 16) = (v4u){0u, 0u, 0u, 0u};
        for (int m = gw; m < S_; m += ngw) rms_row_to_bf16(INP(I_X) + (size_t)m * DM, INP(I_ANG), (bf16*)(ws + WS_XN) + (size_t)m * DM, X + (size_t)m * DM, lane);
    }
    XBAR(bar);

    for (int l = 0; l < DEPTH; ++l) {
        unsigned char* wl = ws + WS_W + (size_t)l * LW;
#define lane_l ({ int l_ = (int)threadIdx.x; asm volatile("" : "+v"(l_)); l_ & 63; })
        GAS unsigned char* wsg_ = (GAS unsigned char*)ws; GAS float* xg_ = (GAS float*)X; int Gl = G, bxl = bx, gwl = gw, ngwl = ngw, vcul = vcu;
        asm volatile("" : "+s"(wsg_), "+s"(Gl), "+s"(bxl), "+s"(gwl), "+s"(ngwl), "+s"(vcul), "+s"(xg_));
        unsigned char* wsl = (unsigned char*)wsg_; float* Xl = (float*)xg_;
        for (int rep = 0; rep < REPS(1); ++rep)
        { pg8::Gemm g{(const pg8::bf16_t*)(wsl + WS_XN), (const pg8::bf16_t*)(wl + LW_IN), S_, NNAT, DM, DM, DM}; pg8::StaticOrder S; S.init(S_, NNAT, Gl, bxl);
          pg8::EpiIn E{wsl}; pg8::gemm_phase<pg8::EpiIn, pg8::StaticOrder, true, true>(lds + RING_OFF, g, S, E); }
        { pg8::Gemm g{(const pg8::bf16_t*)(wl + LW_IN) + (size_t)NNAT * DM, (const pg8::bf16_t*)(wsl + WS_XN), 2048, S_, DM, DM, DM}; pg8::StaticOrder S; S.init(2048, S_, Gl, bxl);
          pg8::EpiStore E{(pg8::bf16_t*)(wsl + WS_VTH), S_}; pg8::gemm_phase<pg8::EpiStore, pg8::StaticOrder, true, true>(lds + RING_OFF, g, S, E); }
        XBAR(bar);
        for (int rep = 0; rep < REPS(3); ++rep) for (int m = gwl; m < S_; m += ngwl) latent_norm_row((bf16*)(wsl + WS_CQKV) + (size_t)m * 1024, lane_l);
        XBAR(bar);
        for (int rep = 0; rep < REPS(6); ++rep) {
        { pg8::Gemm g{(const pg8::bf16_t*)(wsl + WS_CQKV), (const pg8::bf16_t*)(wl + LW_UQ), S_, 3072, QL, 1024, QL}; pg8::StaticOrder S; S.init(S_, 3072, Gl, bxl);
          pg8::EpiQ E{wsl}; pg8::gemm_phase<pg8::EpiQ, pg8::StaticOrder, true, true>(lds + RING_OFF, g, S, E); }
        { pg8::Gemm g{(const pg8::bf16_t*)(wsl + WS_CQKV) + 512, (const pg8::bf16_t*)(wl + LW_K), S_, 2048, KVL, 1024, KVL}; pg8::StaticOrder S; S.init(S_, 2048, Gl, bxl);
          pg8::EpiStore E{(pg8::bf16_t*)(wsl + WS_KN), 2048}; pg8::gemm_phase<pg8::EpiStore, pg8::StaticOrder, true, true>(lds + RING_OFF, g, S, E); }
        { pg8::Gemm g{(const pg8::bf16_t*)(wl + LW_V), (const pg8::bf16_t*)(wsl + WS_CQKV) + 512, 2048, S_, KVL, KVL, 1024}; pg8::StaticOrder S; S.init(2048, S_, Gl, bxl);
          pg8::EpiStore E{(pg8::bf16_t*)(wsl + WS_VT), S_}; pg8::gemm_phase<pg8::EpiStore, pg8::StaticOrder, true, true>(lds + RING_OFF, g, S, E); }
        }
#if NAIVE_HGRN
        hgrn_naive(wsl, l, gwl, ngwl, lane_l);
        XBAR(bar);
#else
        for (int rep = 0; rep < REPS(2); ++rep) hg::pass1(wsl, lds + RING_OFF, l, vcul, Gl);
        XBAR(bar);
        for (int rep = 0; rep < REPS(2); ++rep) hg::scan(wsl, vcul * NTHR + (int)threadIdx.x, Gl * NTHR);
        XBAR(bar);
#endif
#if NAIVE_ATTN
        attn_naive(wsl, (LAS float*)(lds + RING_OFF) + wave * 192, gwl, ngwl, lane_l);
#else
        for (int rep = 0; rep < REPS(0); ++rep) fa::attn_fast(wsl, lds + RING_OFF, vcul, Gl);
#endif
#if NAIVE_HGRN
        hgrn_normgate(wsl, INP(I_HONG) + l * 128, gwl, ngwl, lane_l);
#else
        for (int rep = 0; rep < REPS(2); ++rep) hg::pass3(wsl, lds + RING_OFF, INP(I_HONG) + l * 128, l, vcul, Gl);
#endif
        XBAR(bar);
        for (int rep = 0; rep < REPS(7); ++rep) {
        { pg8::Gemm g{(const pg8::bf16_t*)(wsl + WS_ATT), (const pg8::bf16_t*)(wl + LW_A), S_, DM, DM, DM, DM}; pg8::StaticOrder S; S.init(S_, DM, Gl, bxl);
          pg8::EpiGateA E{wsl}; pg8::gemm_phase<pg8::EpiGateA, pg8::StaticOrder, true, true>(lds + RING_OFF, g, S, E); }
        { pg8::Gemm g{(const pg8::bf16_t*)(wsl + WS_REC), (const pg8::bf16_t*)(wl + LW_B), S_, DM, DM, DM, DM}; pg8::StaticOrder S; S.init(S_, DM, Gl, bxl);
          pg8::EpiGateB E{wsl}; pg8::gemm_phase<pg8::EpiGateB, pg8::StaticOrder, true, true>(lds + RING_OFF, g, S, E); }
        }
        XBAR(bar);
        { pg8::Gemm g{(const pg8::bf16_t*)(wsl + WS_MRG), (const pg8::bf16_t*)(wl + LW_O), S_, DM, DM, DM, DM}; pg8::StaticOrder S; S.init(S_, DM, Gl, bxl);
          pg8::EpiRes E{Xl}; pg8::gemm_phase<pg8::EpiRes, pg8::StaticOrder, true, true>(lds + RING_OFF, g, S, E); }
        XBAR(bar);
        for (int rep = 0; rep < REPS(3); ++rep) for (int m = gwl; m < S_; m += ngwl) rms_row_to_bf16(Xl + (size_t)m * DM, INP(I_FNG) + l * DM, (bf16*)(wsl + WS_XN) + (size_t)m * DM, nullptr, lane_l);
        XBAR(bar);
        for (int rep = 0; rep < REPS(5); ++rep)
        { pg8::Gemm g{(const pg8::bf16_t*)(wsl + WS_XN) - 2 * DM, (const pg8::bf16_t*)(wl + LW_UP), 33 * 256, DFF2, DM, DM, DM, 254}; pg8::StaticOrder S; S.init(33 * 256, DFF2, Gl, bxl);
          pg8::EpiConv E{(pg8::bf16_t*)(wsl + WS_ACT), INP(I_CW) + (size_t)l * 3 * DFF2, INP(I_CB) + (size_t)l * DFF2, (PG8_LAS float*)(lds + LDSCTL_OFF + 1024)};
          pg8::gemm_phase<pg8::EpiConv, pg8::StaticOrder, true, true>(lds + RING_OFF, g, S, E); }
        xcd_barrier(bar);
        { pg8::Gemm g{(const pg8::bf16_t*)(wsl + WS_ACT), (const pg8::bf16_t*)(wl + LW_DN), S_, DM, DFF, DFF, DFF}; pg8::StaticOrder S; S.init(S_, DM, Gl, bxl);
          pg8::EpiRes E{Xl}; pg8::gemm_phase<pg8::EpiRes, pg8::StaticOrder, true, true>(lds + RING_OFF, g, S, E); }
        XBAR(bar);
        if (l + 1 < DEPTH) { for (int rep = 0; rep < REPS(3); ++rep) for (int m = gwl; m < S_; m += ngwl) rms_row_to_bf16(Xl + (size_t)m * DM, INP(I_ANG) + (l + 1) * DM, (bf16*)(wsl + WS_XN) + (size_t)m * DM, nullptr, lane_l);
            XBAR(bar); }
        else { for (int m = gwl; m < S_; m += ngwl) rms_row_f32(Xl + (size_t)m * DM, INP(I_FING), lane_l); }
    }
}

#undef lane_l
extern "C" void kernel_launch(void* const* d_in, const int* in_sizes, int n_in, void* d_out, int out_size, void* d_ws, size_t ws_size, hipStream_t stream) {
    static int grid = 0;
    if (grid == 0) {
        if (n_in != 19 || in_sizes[0] != S_ * DM || out_size != S_ * DM || ws_size < WS_END) { fprintf(stderr, "kernel_launch: shape/workspace mismatch (n_in %d, in0 %d, out %d, ws %zu need %zu)\n", n_in, n_in > 0 ? in_sizes[0] : -1, out_size, ws_size, (size_t)WS_END); grid = -1; return; }
        int dev = 0, cus = 0, per_cu = 0;
        if (hipGetDevice(&dev) != hipSuccess || hipDeviceGetAttribute(&cus, hipDeviceAttributeMultiprocessorCount, dev) != hipSuccess) { grid = -1; return; }
        if (hipFuncSetAttribute((const void*)mk_fwd, hipFuncAttributeMaxDynamicSharedMemorySize, LDS_BYTES) != hipSuccess) { fprintf(stderr, "kernel_launch: hipFuncSetAttribute failed\n"); grid = -1; return; }
        if (hipOccupancyMaxActiveBlocksPerMultiprocessor(&per_cu, (const void*)mk_fwd, NTHR, LDS_BYTES) != hipSuccess || per_cu < 1) { fprintf(stderr, "kernel_launch: occupancy query reports %d blocks per CU\n", per_cu); }
        (void)hipGetLastError();
        grid = cus;
    }
    if (grid < 0) return;
    if (hipMemsetAsync((char*)d_ws + WS_CTL, 0, CTL_ZERO_BYTES, stream) != hipSuccess) return;
    Args a{};
    for (int i = 0; i < 19; ++i) a.in[i] = (const float*)d_in[i];
    a.out = (float*)d_out; a.ws = (unsigned char*)d_ws;
    hipLaunchKernelGGL(mk_fwd, dim3(grid), dim3(NTHR), LDS_BYTES, stream, a);
}
```

```cpp
#include <hip/hip_runtime.h>
#include <cstdio>
#include <cstdint>
namespace pg8 {
#define PG8_LAS __attribute__((address_space(3)))
typedef unsigned short bf16_t;
typedef short bf16x8 __attribute__((ext_vector_type(8)));
typedef float f32x4 __attribute__((ext_vector_type(4)));
typedef unsigned u32x4 __attribute__((ext_vector_type(4)));
constexpr int BM = 256, BK = 64, HALF = 128, HTB = HALF * BK * 2  , STAGE_BYTES = 8 * HTB, NXCD = 8, WGM = 8;

__host__ __device__ __forceinline__ int lds_byte(int r, int c) { const int st = (r >> 4) * 2 + (c >> 5), rr = r & 15, cc = c & 31, ob = rr * 64 + cc * 2; return st * 1024 + (ob ^ (((ob >> 9) & 1) << 5)); }
__host__ __device__ __forceinline__ void stage_rc(int b, int& R, int& C) { const int st = b / 1024, sb = b % 1024, swz = sb ^ (((sb >> 9) & 1) << 5); R = (st >> 1) * 16 + swz / 64; C = (st & 1) * 32 + (swz % 64) / 2; }
__host__ __device__ __forceinline__ int perm32(int rho) { const int n = rho >> 4, i = rho & 15; return 8 * (i >> 2) + 4 * n + (i & 3); }

struct Unit { int pm, pn; int kind = 0; };
struct Gemm { const bf16_t* A; const bf16_t* Bt; int M, N, K, lda, ldb; int mstep = BM; };

struct StaticOrder {
    int nM, nN, nwg, G, c;
    __host__ __device__ void init(int M, int N, int G_, int c_) { nM = M / BM; nN = N / BM; nwg = nM * nN; G = G_; c = c_; }
    __host__ __device__ __forceinline__ bool next(int i, Unit& u) const {
        const long L = (long)i * G + c; if (L >= nwg) return false;
        int wgid = (int)L; { const int q = nwg / NXCD, r = nwg % NXCD, xcd = wgid % NXCD, off = wgid / NXCD; wgid = (xcd < r ? xcd * (q + 1) : r * (q + 1) + (xcd - r) * q) + off; }
        const int nig = WGM * nN, gid = wgid / nig, fm = gid * WGM, gsz = (nM - fm) < WGM ? (nM - fm) : WGM;
        u.pm = fm + ((wgid % nig) % gsz); u.pn = (wgid % nig) / gsz; return true;
    }
    __device__ __forceinline__ void a_ready(const Unit&) const {}
    __device__ __forceinline__ void done(const Unit&) const {}
};

struct PairOrder {
    StaticOrder T;
    __host__ __device__ void init(int M, int N, int G_, int c_) { T.init(M, N, G_, c_); }
    __host__ __device__ bool next(int i, Unit& u) const { if (!T.next(i >> 1, u)) return false; u.kind = i & 1; return true; }
    __device__ __forceinline__ void a_ready(const Unit&) const {}
    __device__ __forceinline__ void done(const Unit&) const {}
};

typedef float cvt_f32x2_t __attribute__((ext_vector_type(2))); typedef __bf16 cvt_bf16x2_t __attribute__((ext_vector_type(2)));
__device__ __forceinline__ unsigned cvt_pk_bf16(float lo, float hi) { const cvt_f32x2_t v = {lo, hi}; const cvt_bf16x2_t b = __builtin_convertvector(v, cvt_bf16x2_t); return __builtin_bit_cast(unsigned, b); }
template <class Epi, int WHICH> __device__ __forceinline__ size_t kind_off(const Unit& u) { if constexpr (Epi::CHAIN) return (size_t)u.kind * (WHICH ? Epi::B_KIND : Epi::A_KIND); else return 0; }
template <class Epi, class Sched, bool ALIGN_EPI = false, bool SP2 = false>
__device__ __forceinline__ void gemm_phase(PG8_LAS unsigned char* lds, const Gemm g, const Sched& S, const Epi& E) {
    int tid = threadIdx.x; asm volatile("" : "+v"(tid));
    const int wid = __builtin_amdgcn_readfirstlane(tid >> 6), lane = tid & 63, wr = wid >> 2, wc = wid & 3, fr = lane & 15, fq = lane >> 4;
    const int K = g.K, nt = K / BK;
    unsigned voffA[2], voffB[2];
#pragma unroll
    for (int i = 0; i < 2; ++i) { int R, C; stage_rc(tid * 16 + i * 8192, R, C); const int Rb = Epi::PERM ? ((R & ~31) + perm32(R & 31)) : R;
        voffA[i] = (unsigned)(R * g.lda + C) * 2u; voffB[i] = (unsigned)(Rb * g.ldb + C) * 2u; }
    const size_t kstep = (size_t)(BK * 2);
    const size_t hstepA = (size_t)HALF * g.lda * 2, hstepB = (size_t)HALF * g.ldb * 2;
    const size_t tstepA = (size_t)g.mstep * g.lda * 2, tstepB = 2 * hstepB;
    const unsigned ldsw = (unsigned)wid * 1024u;
    const int aoff = lds_byte(wr * 64 + fr, fq * 8), boff = lds_byte(wc * 32 + fr, fq * 8);
#define PG8_SA(b, h) (((b) * 2 + (h)) * HTB)
#define PG8_SB(b, h) ((4 + (b) * 2 + (h)) * HTB)
#define PG8_STAGE(bufoff, gbase, voff) do { _Pragma("unroll") for (int _i = 0; _i < 2; ++_i) \
        __builtin_amdgcn_global_load_lds((const unsigned*)((const char*)(gbase) + (voff)[_i]), (PG8_LAS unsigned*)(lds + (bufoff) + ldsw + _i * 8192), 16, 0, 0); } while (0)
#define PG8_LDA(dst, b, h) do { _Pragma("unroll") for (int m = 0; m < 4; ++m) _Pragma("unroll") for (int k = 0; k < 2; ++k) dst[m][k] = *(const PG8_LAS bf16x8*)(lds + PG8_SA(b, h) + aoff + m * 2048 + k * 1024); } while (0)
#define PG8_LDB(dst, b, h) do { _Pragma("unroll") for (int n = 0; n < 2; ++n) _Pragma("unroll") for (int k = 0; k < 2; ++k) dst[n][k] = *(const PG8_LAS bf16x8*)(lds + PG8_SB(b, h) + boff + n * 2048 + k * 1024); } while (0)
#define PG8_MMA(ai, bj, At, Bt) do { __builtin_amdgcn_s_setprio(1); _Pragma("unroll") for (int m = 0; m < 4; ++m) _Pragma("unroll") for (int n = 0; n < 2; ++n) _Pragma("unroll") for (int k = 0; k < 2; ++k) \
        acc[ai][bj][m][n] = __builtin_amdgcn_mfma_f32_16x16x32_bf16(Bt[n][k], At[m][k], acc[ai][bj][m][n], 0, 0, 0); __builtin_amdgcn_s_setprio(0); } while (0)
#define PG8_WAIT_V(n) asm volatile("s_waitcnt vmcnt(" #n ")" ::: "memory")
#define PG8_WAIT_L(n) asm volatile("s_waitcnt lgkmcnt(" #n ")" ::: "memory")
#define PG8_BAR __builtin_amdgcn_s_barrier()
#define PG8_SCHED __builtin_amdgcn_sched_barrier(0)
    Unit cur, nxt; int ui = 0;
    if (!S.next(0, cur)) return;
    f32x4 acc[2][2][4][2];
#pragma unroll
    for (int a = 0; a < 2; ++a)
#pragma unroll
        for (int b = 0; b < 2; ++b)
#pragma unroll
            for (int m = 0; m < 4; ++m)
#pragma unroll
                for (int n = 0; n < 2; ++n) acc[a][b][m][n] = (f32x4){0.f, 0.f, 0.f, 0.f};
    bf16x8 At[4][2], B0[2][2], B1[2][2];
#define PG8_KA(u_) kind_off<Epi, 0>(u_)
#define PG8_KB(u_) kind_off<Epi, 1>(u_)
    const char* cA = (const char*)g.A + (size_t)cur.pm * tstepA + PG8_KA(cur); const char* cB = (const char*)g.Bt + (size_t)cur.pn * tstepB + PG8_KB(cur);
    S.a_ready(cur);
    if constexpr (SP2) {
        PG8_STAGE(PG8_SB(0, 0), cB, voffB); PG8_STAGE(PG8_SB(0, 1), cB + hstepB, voffB); PG8_STAGE(PG8_SA(0, 0), cA, voffA); PG8_STAGE(PG8_SA(0, 1), cA + hstepA, voffA);
        if (wr == 1) PG8_BAR;
        PG8_WAIT_V(2); PG8_BAR;
        PG8_STAGE(PG8_SB(1, 0), cB + kstep, voffB); PG8_STAGE(PG8_SA(1, 0), cA + kstep, voffA); PG8_STAGE(PG8_SB(1, 1), cB + hstepB + kstep, voffB);
        PG8_WAIT_V(6); PG8_BAR;
    } else {
        PG8_STAGE(PG8_SB(0, 0), cB, voffB); PG8_STAGE(PG8_SA(0, 0), cA, voffA); PG8_STAGE(PG8_SB(0, 1), cB + hstepB, voffB); PG8_STAGE(PG8_SA(0, 1), cA + hstepA, voffA);
        if (wr == 1) PG8_BAR;
        PG8_WAIT_V(4); PG8_BAR;
        PG8_STAGE(PG8_SB(1, 0), cB + kstep, voffB); PG8_STAGE(PG8_SA(1, 0), cA + kstep, voffA); PG8_STAGE(PG8_SB(1, 1), cB + hstepB + kstep, voffB);
        PG8_WAIT_V(6); PG8_BAR;
    }
    for (;;) {
        const bool has_next = S.next(ui + 1, nxt);
        const char* nA = has_next ? (const char*)g.A + (size_t)nxt.pm * tstepA + PG8_KA(nxt) : cA; const char* nB = has_next ? (const char*)g.Bt + (size_t)nxt.pn * tstepB + PG8_KB(nxt) : cB;
        for (int t = 0; t < nt; t += 2) {
            const bool last = (t == nt - 2);
            const char* a1 = cA + (size_t)(t + 1) * kstep;
            const char* a2 = last ? nA : cA + (size_t)(t + 2) * kstep; const char* b2 = last ? nB : cB + (size_t)(t + 2) * kstep;
            const char* a3 = a2 + kstep; const char* b3 = b2 + kstep;
            if (last && has_next) S.a_ready(nxt);
            if constexpr (SP2) {
            PG8_LDB(B0, 0, 0); PG8_LDB(B1, 0, 1); PG8_SCHED; PG8_LDA(At, 0, 0); PG8_STAGE(PG8_SA(1, 1), a1 + hstepA, voffA);
            PG8_WAIT_V(8); PG8_WAIT_L(0); PG8_BAR; PG8_MMA(0, 0, At, B0); PG8_MMA(0, 1, At, B1); PG8_BAR; PG8_SCHED;
            PG8_LDA(At, 0, 1); PG8_STAGE(PG8_SB(0, 0), b2, voffB); PG8_STAGE(PG8_SB(0, 1), b2 + hstepB, voffB); PG8_STAGE(PG8_SA(0, 0), a2, voffA);
            PG8_WAIT_V(8); PG8_WAIT_L(0); PG8_BAR; PG8_MMA(1, 0, At, B0); PG8_MMA(1, 1, At, B1); PG8_BAR; PG8_SCHED;
            PG8_LDB(B0, 1, 0); PG8_LDB(B1, 1, 1); PG8_SCHED; PG8_LDA(At, 1, 0); PG8_STAGE(PG8_SA(0, 1), a2 + hstepA, voffA);
            PG8_WAIT_V(8); PG8_WAIT_L(0); PG8_BAR; PG8_MMA(0, 0, At, B0); PG8_MMA(0, 1, At, B1); PG8_BAR; PG8_SCHED;
            PG8_LDA(At, 1, 1); PG8_STAGE(PG8_SB(1, 0), b3, voffB); PG8_STAGE(PG8_SB(1, 1), b3 + hstepB, voffB); PG8_STAGE(PG8_SA(1, 0), a3, voffA);
            PG8_WAIT_V(8); PG8_WAIT_L(0); PG8_BAR; PG8_MMA(1, 0, At, B0); PG8_MMA(1, 1, At, B1); PG8_BAR; PG8_SCHED;
            } else {
            PG8_LDB(B0, 0, 0); PG8_SCHED; PG8_LDA(At, 0, 0); PG8_STAGE(PG8_SA(1, 1), a1 + hstepA, voffA);
            PG8_WAIT_L(8); PG8_BAR; PG8_WAIT_L(0); PG8_MMA(0, 0, At, B0); PG8_BAR; PG8_SCHED;
            PG8_LDB(B1, 0, 1); PG8_STAGE(PG8_SB(0, 0), b2, voffB);
            PG8_BAR; PG8_WAIT_L(0); PG8_MMA(0, 1, At, B1); PG8_BAR;
            PG8_LDA(At, 0, 1); PG8_STAGE(PG8_SA(0, 0), a2, voffA);
            PG8_BAR; PG8_WAIT_L(0); PG8_MMA(1, 0, At, B0); PG8_BAR; PG8_SCHED;
            PG8_STAGE(PG8_SB(0, 1), b2 + hstepB, voffB);
            PG8_WAIT_V(6); PG8_BAR; PG8_MMA(1, 1, At, B1); PG8_BAR;
            PG8_LDB(B0, 1, 0); PG8_SCHED; PG8_LDA(At, 1, 0); PG8_STAGE(PG8_SA(0, 1), a2 + hstepA, voffA);
            PG8_WAIT_L(8); PG8_BAR; PG8_WAIT_L(0); PG8_MMA(0, 0, At, B0); PG8_BAR; PG8_SCHED;
            PG8_LDB(B1, 1, 1); PG8_STAGE(PG8_SB(1, 0), b3, voffB);
            PG8_BAR; PG8_WAIT_L(0); PG8_MMA(0, 1, At, B1); PG8_BAR;
            PG8_LDA(At, 1, 1); PG8_STAGE(PG8_SA(1, 0), a3, voffA);
            PG8_BAR; PG8_WAIT_L(0); PG8_MMA(1, 0, At, B0); PG8_BAR; PG8_SCHED;
            PG8_STAGE(PG8_SB(1, 1), b3 + hstepB, voffB);
            PG8_WAIT_V(6); PG8_BAR; PG8_MMA(1, 1, At, B1); PG8_BAR;
            }
        }
        if constexpr (ALIGN_EPI) { if (wr == 0) PG8_BAR; }
        if constexpr (Epi::PRESCALE) E.prescale(acc, cur, wr, wc, fr, fq);
        if constexpr (Epi::CHAIN) { if (cur.kind == 0) E.link(acc, cur, wr, wc, fr, fq); else E(acc, cur, wr, wc, fr, fq); }
        else if constexpr (!Epi::AFTER_DRAIN) { E(acc, cur, wr, wc, fr, fq); S.done(cur); }
        if (!has_next) break;
        if (!Epi::CHAIN || nxt.kind == 0) {
#pragma unroll
        for (int a = 0; a < 2; ++a)
#pragma unroll
            for (int b = 0; b < 2; ++b)
#pragma unroll
                for (int m = 0; m < 4; ++m)
#pragma unroll
                    for (int n = 0; n < 2; ++n) acc[a][b][m][n] = (f32x4){0.f, 0.f, 0.f, 0.f};
        }
        cur = nxt; cA = nA; cB = nB; ++ui;
        if constexpr (ALIGN_EPI) { if (wr == 1) PG8_BAR; }
    }
    PG8_WAIT_V(0);
    if constexpr (!ALIGN_EPI) { if (wr == 0) PG8_BAR; }
    PG8_BAR;
    if constexpr (Epi::AFTER_DRAIN) { E.fused(acc, cur, wr, wc, fr, fq, lds, wid, lane); S.done(cur); }
#undef PG8_KA
#undef PG8_KB
#undef PG8_SA
#undef PG8_SB
#undef PG8_STAGE
#undef PG8_LDA
#undef PG8_LDB
#undef PG8_MMA
#undef PG8_WAIT_V
#undef PG8_WAIT_L
#undef PG8_BAR
#undef PG8_SCHED
}
}

constexpr int S_ = 8192, DM = 2048, DEPTH = 4, NH = 16;
constexpr int QL = 512, KVL = 512, ROPE = 64, NOPE = 128, VD = 128;
constexpr int INW = 13376;
constexpr int DFF = 5632, DFF2 = 11264;
constexpr int NNAT = 11520;
constexpr int WINR = NNAT + 2048;
constexpr float EPS = 1e-6f;
constexpr float LOG2E = 1.4426950408889634f;
constexpr float QSCALE = 0.07216878364870323f * 1.4426950408889634f;
constexpr int NWAVES = 8, NTHR = 512;

constexpr size_t MiB = 1u << 20;
constexpr size_t WS_CTL = 0, CTL_ZERO_BYTES = 128 * 1024;
constexpr size_t WS_COS = 1 * MiB, WS_SIN = 2 * MiB, WS_LB = 3 * MiB, WS_SSQ = 4 * MiB;
constexpr size_t WS_W = 5 * MiB;
constexpr size_t LW_IN = 0, LW_UQ = 53 * MiB, LW_K = 56 * MiB, LW_V = 58 * MiB, LW_A = 60 * MiB, LW_B = 68 * MiB, LW_O = 76 * MiB, LW_UP = 84 * MiB, LW_DN = 128 * MiB, LW = 150 * MiB;
constexpr size_t WS_XN = WS_W + 4 * LW + 1 * MiB;
constexpr size_t WS_MIX = WS_XN + 32 * MiB;
constexpr size_t WS_CQKV = WS_MIX;
constexpr size_t WS_KPE = WS_CQKV + 16 * MiB;
constexpr size_t WS_HQ = WS_KPE + 1 * MiB;
constexpr size_t GSTRIDE = 32 * MiB;
constexpr size_t WS_HG = WS_HQ + GSTRIDE, WS_GA = WS_HQ + 2 * GSTRIDE, WS_GB = WS_HQ + 3 * GSTRIDE;
constexpr size_t WS_HF = WS_HQ + 4 * GSTRIDE;
constexpr size_t WS_VTH = WS_HF + 64 * MiB;
constexpr size_t WS_QN = WS_VTH + 32 * MiB;
constexpr size_t WS_QR = WS_QN + 32 * MiB;
constexpr size_t WS_KN = WS_QR + 16 * MiB;
constexpr size_t WS_VT = WS_KN + 32 * MiB;
constexpr size_t WS_ATT = WS_VT + 32 * MiB;
constexpr size_t WS_REC = WS_ATT + 32 * MiB;
constexpr size_t WS_RRAW = WS_REC + 32 * MiB;
constexpr size_t WS_HU = WS_RRAW + 64 * MiB;
constexpr size_t WS_HS = WS_HU + 128 * MiB;
constexpr size_t WS_M1 = WS_HS + 64 * MiB;
constexpr size_t WS_MRG = WS_M1 + 64 * MiB;
constexpr size_t WS_MIX_END = WS_MRG + 32 * MiB;
constexpr size_t WS_U = WS_MIX;
constexpr size_t WS_ACT = WS_U + 176 * MiB;
static_assert(WS_ACT + 88 * MiB <= WS_MIX_END, "FFN overlay fits the mixer region");
constexpr size_t WS_END = WS_MIX_END;
constexpr size_t WS_LSSQ = WS_LB + 262144, WS_LRQ = WS_LB + 786432, WS_LRKV = WS_LB + 819200;
constexpr size_t WS_RSTD = WS_LB + 65536;
constexpr int CW_CVT = 12288;
constexpr int CW_PAN = 20480;
constexpr int CW_BAR = 4096, CW_QUE = 16384;

constexpr int RING_OFF = 0, RING_BYTES = 131072;
constexpr int LDSCTL_OFF = RING_BYTES, MISC_OFF = LDSCTL_OFF + 320;
constexpr int LDS_BYTES = 147456;

#define GAS __attribute__((address_space(1)))
#define LAS __attribute__((address_space(3)))
typedef unsigned short bf16;
typedef unsigned v4u __attribute__((ext_vector_type(4)));
typedef unsigned v2u __attribute__((ext_vector_type(2)));
typedef float f32x4 __attribute__((ext_vector_type(4)));
typedef float f32x2 __attribute__((ext_vector_type(2)));
typedef short bf16x8 __attribute__((ext_vector_type(8)));
typedef GAS unsigned gu32;
#define LDS_WAIT() asm volatile("s_waitcnt lgkmcnt(0)" ::: "memory")
#define VM_WAIT() asm volatile("s_waitcnt vmcnt(0)" ::: "memory")
__device__ __forceinline__ unsigned f2bf(float f) { unsigned u = __builtin_bit_cast(unsigned, f); return (u + 0x7fffu + ((u >> 16) & 1u)) >> 16; }
__device__ __forceinline__ unsigned pk2(float lo, float hi) { return f2bf(lo) | (f2bf(hi) << 16); }
__device__ __forceinline__ float bflo(unsigned u) { return __builtin_bit_cast(float, u << 16); }
__device__ __forceinline__ float bfhi(unsigned u) { return __builtin_bit_cast(float, u & 0xffff0000u); }
__device__ __forceinline__ float sigm(float x) { return __builtin_amdgcn_rcpf(1.f + __builtin_amdgcn_exp2f(-LOG2E * x)); }
__device__ __forceinline__ float wave_sum(float v) {
#pragma unroll
    for (int o = 1; o < 64; o <<= 1) v += __shfl_xor(v, o);
    return v;
}
__device__ __forceinline__ float wave_max(float v) {
#pragma unroll
    for (int o = 1; o < 64; o <<= 1) v = fmaxf(v, __shfl_xor(v, o));
    return v;
}

namespace pg8 {
typedef unsigned v2u_t __attribute__((ext_vector_type(2)));
__device__ __forceinline__ u32x4 pack8(f32x4 a, f32x4 b) { u32x4 w; w.x = cvt_pk_bf16(a[0], a[1]); w.y = cvt_pk_bf16(a[2], a[3]); w.z = cvt_pk_bf16(b[0], b[1]); w.w = cvt_pk_bf16(b[2], b[3]); return w; }
__device__ __forceinline__ f32x4 silu4(f32x4 v) { f32x4 r; r[0] = v[0] * sigm(v[0]); r[1] = v[1] * sigm(v[1]); r[2] = v[2] * sigm(v[2]); r[3] = v[3] * sigm(v[3]); return r; }
__device__ __forceinline__ f32x4 sigm4(f32x4 v) { f32x4 r; r[0] = sigm(v[0]); r[1] = sigm(v[1]); r[2] = sigm(v[2]); r[3] = sigm(v[3]); return r; }
__device__ __forceinline__ float sum8(const float* p) { const f32x4 a = *(const f32x4*)p, b = *(const f32x4*)(p + 4); return ((a[0] + a[1]) + (a[2] + a[3])) + ((b[0] + b[1]) + (b[2] + b[3])); }
__device__ __forceinline__ void rope8(f32x4& v0, f32x4& v1, const f32x4 cs, const f32x4 sn) {
    f32x4 a, b;
    a[0] = v0[0] * cs[0] - v0[1] * sn[0]; a[1] = v0[1] * cs[0] + v0[0] * sn[0];
    a[2] = v0[2] * cs[1] - v0[3] * sn[1]; a[3] = v0[3] * cs[1] + v0[2] * sn[1];
    b[0] = v1[0] * cs[2] - v1[1] * sn[2]; b[1] = v1[1] * cs[2] + v1[0] * sn[2];
    b[2] = v1[2] * cs[3] - v1[3] * sn[3]; b[3] = v1[3] * cs[3] + v1[2] * sn[3];
    v0 = a; v1 = b;
}


__device__ __forceinline__ void scale_rows(f32x4 (&acc)[2][2][4][2], const float* R, int t0) {
#pragma unroll
    for (int ai = 0; ai < 2; ++ai)
#pragma unroll
        for (int m = 0; m < 4; ++m) { int t = t0 + ai * HALF + m * 16; t = t < 0 ? 0 : (t > S_ - 1 ? S_ - 1 : t); const float r = R[t];
#pragma unroll
            for (int bj = 0; bj < 2; ++bj) { acc[ai][bj][m][0] *= r; acc[ai][bj][m][1] *= r; } }
}
__device__ __forceinline__ void scale_cols(f32x4 (&acc)[2][2][4][2], const float* R, int c0) {
#pragma unroll
    for (int bj = 0; bj < 2; ++bj) { const f32x4 s0 = *(const f32x4*)(R + c0 + bj * HALF), s1 = *(const f32x4*)(R + c0 + bj * HALF + 4);
#pragma unroll
        for (int ai = 0; ai < 2; ++ai)
#pragma unroll
            for (int m = 0; m < 4; ++m) { acc[ai][bj][m][0] *= s0; acc[ai][bj][m][1] *= s1; } }
}
struct EpiIn {
    static constexpr bool PERM = true, AFTER_DRAIN = false, PRESCALE = true, CHAIN = false;
    unsigned char* ws;
    __device__ __forceinline__ void prescale(f32x4 (&acc)[2][2][4][2], const Unit& u, int wr, int wc, int fr, int fq) const { scale_rows(acc, (const float*)(ws + WS_RSTD), u.pm * BM + wr * 64 + fr); }
    __device__ __forceinline__ void operator()(const f32x4 (&acc)[2][2][4][2], const Unit& u, int wr, int wc, int fr, int fq) const {
        const int pn = u.pn, row0 = u.pm * BM + wr * 64 + fr, lc = wc * 32 + 8 * fq;
        if (pn == 4) {
            if (wc < 2) {
                const float* COS = (const float*)(ws + WS_COS); const float* SIN = (const float*)(ws + WS_SIN); bf16_t* KPE = (bf16_t*)(ws + WS_KPE);
#pragma unroll
                for (int ai = 0; ai < 2; ++ai)
#pragma unroll
                    for (int m = 0; m < 4; ++m) { const int row = row0 + ai * HALF + m * 16;
                        f32x4 v0 = acc[ai][0][m][0], v1 = acc[ai][0][m][1];
                        const f32x4 cs = *(const f32x4*)(COS + (size_t)row * 32 + wc * 16 + 4 * fq), sn = *(const f32x4*)(SIN + (size_t)row * 32 + wc * 16 + 4 * fq);
                        rope8(v0, v1, cs, sn);
                        *(u32x4*)(KPE + (size_t)row * 64 + lc) = pack8(v0, v1);
                        if (m & 1) asm volatile("" ::: "memory"); }
            }
        } else if (pn >= 13 && pn < 21) {
            _Float16* HF = (_Float16*)(ws + WS_HF);
            typedef _Float16 h8 __attribute__((ext_vector_type(8)));
#pragma unroll
            for (int ai = 0; ai < 2; ++ai)
#pragma unroll
                for (int m = 0; m < 4; ++m) { _Float16* rp = HF + (size_t)(row0 + ai * HALF + m * 16) * 2048 + (pn - 13) * 256 + lc;
#pragma unroll
                    for (int bj = 0; bj < 2; ++bj) { const f32x4 a = acc[ai][bj][m][0], b = acc[ai][bj][m][1];
                        h8 hv = {(_Float16)a[0], (_Float16)a[1], (_Float16)a[2], (_Float16)a[3], (_Float16)b[0], (_Float16)b[1], (_Float16)b[2], (_Float16)b[3]};
                        *(h8*)(rp + bj * HALF) = hv; } }
        } else {
            bf16_t* base; int ldc, act;
            if (pn < 4) { base = (bf16_t*)(ws + WS_CQKV) + pn * 256; ldc = 1024; act = 0; }
            else { const int gi = (pn < 13) ? 0 : ((pn - 13) >> 3), ct = (pn < 13) ? (pn - 5) : ((pn - 13) & 7);
                   base = (bf16_t*)(ws + WS_HQ + (size_t)gi * GSTRIDE) + ct * 256; ldc = 2048; act = (gi <= 1) ? 1 : 2; }
#pragma unroll
            for (int ai = 0; ai < 2; ++ai)
#pragma unroll
                for (int m = 0; m < 4; ++m) { bf16_t* rp = base + (size_t)(row0 + ai * HALF + m * 16) * ldc + lc;
                    if (pn < 4) {
                        float ss = 0.f;
#pragma unroll
                        for (int bj = 0; bj < 2; ++bj) { const f32x4 a = acc[ai][bj][m][0], b = acc[ai][bj][m][1]; ss += (a[0] * a[0] + a[1] * a[1]) + (a[2] * a[2] + a[3] * a[3]) + (b[0] * b[0] + b[1] * b[1]) + (b[2] * b[2] + b[3] * b[3]); }
                        ss += __shfl_xor(ss, 16); ss += __shfl_xor(ss, 32);
                        if (fq == 0) ((float*)(ws + WS_LSSQ))[(size_t)(row0 + ai * HALF + m * 16) * 16 + pn * 4 + wc] = ss; }
#pragma unroll
                    for (int bj = 0; bj < 2; ++bj) { f32x4 v0 = acc[ai][bj][m][0], v1 = acc[ai][bj][m][1];
                        if (act == 1) { v0 = silu4(v0); v1 = silu4(v1); }
                        else if (act == 2) { v0 = sigm4(v0); v1 = sigm4(v1); }
                        *(u32x4*)(rp + bj * HALF) = pack8(v0, v1); } }
        }
    }
};
struct EpiStore {
    static constexpr bool PERM = true, AFTER_DRAIN = false, PRESCALE = false, CHAIN = false;
    bf16_t* O; int ldc;
    __device__ __forceinline__ void operator()(const f32x4 (&acc)[2][2][4][2], const Unit& u, int wr, int wc, int fr, int fq) const {
        const int row0 = u.pm * BM + wr * 64 + fr, col0 = u.pn * BM + wc * 32 + 8 * fq;
#pragma unroll
        for (int ai = 0; ai < 2; ++ai)
#pragma unroll
            for (int m = 0; m < 4; ++m) { bf16_t* rp = O + (size_t)(row0 + ai * HALF + m * 16) * ldc + col0;
#pragma unroll
                for (int bj = 0; bj < 2; ++bj) *(u32x4*)(rp + bj * HALF) = pack8(acc[ai][bj][m][0], acc[ai][bj][m][1]); }
    }
};
struct EpiStoreRS {
    static constexpr bool PERM = true, AFTER_DRAIN = false, PRESCALE = true, CHAIN = false;
    bf16_t* O; int ldc; const float* R;
    __device__ __forceinline__ void prescale(f32x4 (&acc)[2][2][4][2], const Unit& u, int wr, int wc, int fr, int fq) const { scale_rows(acc, R, u.pm * BM + wr * 64 + fr); }
    __device__ __forceinline__ void operator()(const f32x4 (&acc)[2][2][4][2], const Unit& u, int wr, int wc, int fr, int fq) const {
        const int row0 = u.pm * BM + wr * 64 + fr, col0 = u.pn * BM + wc * 32 + 8 * fq;
#pragma unroll
        for (int ai = 0; ai < 2; ++ai)
#pragma unroll
            for (int m = 0; m < 4; ++m) { bf16_t* rp = O + (size_t)(row0 + ai * HALF + m * 16) * ldc + col0;
#pragma unroll
                for (int bj = 0; bj < 2; ++bj) *(u32x4*)(rp + bj * HALF) = pack8(acc[ai][bj][m][0], acc[ai][bj][m][1]); }
    }
};
struct EpiStoreCS {
    static constexpr bool PERM = true, AFTER_DRAIN = false, PRESCALE = true, CHAIN = false;
    bf16_t* O; int ldc; const float* R;
    __device__ __forceinline__ void prescale(f32x4 (&acc)[2][2][4][2], const Unit& u, int wr, int wc, int fr, int fq) const { scale_cols(acc, R, u.pn * BM + wc * 32 + 8 * fq); }
    __device__ __forceinline__ void operator()(const f32x4 (&acc)[2][2][4][2], const Unit& u, int wr, int wc, int fr, int fq) const {
        const int row0 = u.pm * BM + wr * 64 + fr, col0 = u.pn * BM + wc * 32 + 8 * fq;
#pragma unroll
        for (int ai = 0; ai < 2; ++ai)
#pragma unroll
            for (int m = 0; m < 4; ++m) { bf16_t* rp = O + (size_t)(row0 + ai * HALF + m * 16) * ldc + col0;
#pragma unroll
                for (int bj = 0; bj < 2; ++bj) *(u32x4*)(rp + bj * HALF) = pack8(acc[ai][bj][m][0], acc[ai][bj][m][1]); }
    }
};
struct EpiResN {
    static constexpr bool PERM = true, AFTER_DRAIN = false, PRESCALE = false, CHAIN = false;
    float* X; bf16_t* XG; const float* gain; float* SSQ;
    __device__ __forceinline__ void operator()(const f32x4 (&acc)[2][2][4][2], const Unit& u, int wr, int wc, int fr, int fq) const {
        const int row0 = u.pm * BM + wr * 64 + fr, col0 = u.pn * BM + wc * 32 + 8 * fq;
        f32x4 g[2][2];
#pragma unroll
        for (int bj = 0; bj < 2; ++bj) { g[bj][0] = *(const f32x4*)(gain + col0 + bj * HALF); g[bj][1] = *(const f32x4*)(gain + col0 + bj * HALF + 4); }
#pragma unroll
        for (int ai = 0; ai < 2; ++ai)
#pragma unroll
            for (int m = 0; m < 4; ++m) { const int row = row0 + ai * HALF + m * 16; float* rp = X + (size_t)row * 2048 + col0; float ss = 0.f;
#pragma unroll
                for (int bj = 0; bj < 2; ++bj) { const f32x4 a = *(const f32x4*)(rp + bj * HALF) + acc[ai][bj][m][0], b = *(const f32x4*)(rp + bj * HALF + 4) + acc[ai][bj][m][1];
                    *(f32x4*)(rp + bj * HALF) = a; *(f32x4*)(rp + bj * HALF + 4) = b;
                    ss += (a[0] * a[0] + a[1] * a[1]) + (a[2] * a[2] + a[3] * a[3]) + (b[0] * b[0] + b[1] * b[1]) + (b[2] * b[2] + b[3] * b[3]);
                    *(u32x4*)(XG + (size_t)row * 2048 + col0 + bj * HALF) = pack8(a * g[bj][0], b * g[bj][1]); }
                ss += __shfl_xor(ss, 16); ss += __shfl_xor(ss, 32);
                if (fq == 0) __hip_atomic_store((unsigned*)(SSQ + (size_t)row * 32 + u.pn * 4 + wc), __builtin_bit_cast(unsigned, ss), __ATOMIC_RELAXED, __HIP_MEMORY_SCOPE_AGENT);
                if (m & 1) asm volatile("" ::: "memory"); }
    }
};
struct EpiResFinal {
    static constexpr bool PERM = true, AFTER_DRAIN = true, PRESCALE = false, CHAIN = false;
    float* X; const float* gain; float* SSQ; unsigned* cnt;
    __device__ __forceinline__ void fused(f32x4 (&acc)[2][2][4][2], const Unit& u, int wr, int wc, int fr, int fq, PG8_LAS unsigned char* lds, int wid, int lane) const {
        const int row0 = u.pm * BM + wr * 64 + fr, col0 = u.pn * BM + wc * 32 + 8 * fq;
        PG8_LAS float* S = (PG8_LAS float*)lds;
#pragma unroll
        for (int ai = 0; ai < 2; ++ai)
#pragma unroll
            for (int m = 0; m < 4; ++m) { const int row = row0 + ai * HALF + m * 16; const float* rp = X + (size_t)row * 2048 + col0; float ss = 0.f;
#pragma unroll
                for (int bj = 0; bj < 2; ++bj) { const f32x4 a = *(const f32x4*)(rp + bj * HALF) + acc[ai][bj][m][0], b = *(const f32x4*)(rp + bj * HALF + 4) + acc[ai][bj][m][1];
                    acc[ai][bj][m][0] = a; acc[ai][bj][m][1] = b;
                    ss += (a[0] * a[0] + a[1] * a[1]) + (a[2] * a[2] + a[3] * a[3]) + (b[0] * b[0] + b[1] * b[1]) + (b[2] * b[2] + b[3] * b[3]); }
                ss += __shfl_xor(ss, 16); ss += __shfl_xor(ss, 32);
                if (fq == 0) __hip_atomic_store((unsigned*)(SSQ + (size_t)row * 32 + u.pn * 4 + wc), __builtin_bit_cast(unsigned, ss), __ATOMIC_RELAXED, __HIP_MEMORY_SCOPE_AGENT);
                if (m & 1) asm volatile("" ::: "memory"); }
        asm volatile("s_waitcnt vmcnt(0)" ::: "memory");
        if (lane == 0) (void)__hip_atomic_fetch_add(cnt + u.pm * 32, 1u, __ATOMIC_RELAXED, __HIP_MEMORY_SCOPE_AGENT);
        if (wid == 0) { unsigned sp = 0u; while (__hip_atomic_load(cnt + u.pm * 32, __ATOMIC_RELAXED, __HIP_MEMORY_SCOPE_AGENT) < 64u && ++sp < (1u << 22)) __builtin_amdgcn_s_sleep(1);
                        __builtin_amdgcn_fence(__ATOMIC_ACQUIRE, "agent"); }
        asm volatile("s_waitcnt vmcnt(0) lgkmcnt(0)" ::: "memory"); __builtin_amdgcn_s_barrier(); asm volatile("" ::: "memory");
#pragma unroll 1
        for (int it = 0; it < 16; ++it) { const int rl = it * 16 + wid * 2 + (lane >> 5);
            float v = __builtin_bit_cast(float, __hip_atomic_load((unsigned*)(SSQ + (size_t)(u.pm * BM + rl) * 32 + (lane & 31)), __ATOMIC_RELAXED, __HIP_MEMORY_SCOPE_AGENT));
#pragma unroll
            for (int o = 16; o > 0; o >>= 1) v += __shfl_xor(v, o);
            if ((lane & 31) == 0) S[rl] = 1.0f / sqrtf(v * (1.f / 2048.f) + EPS); }
        asm volatile("s_waitcnt lgkmcnt(0)" ::: "memory"); __builtin_amdgcn_s_barrier(); asm volatile("" ::: "memory");
        f32x4 g[2][2];
#pragma unroll
        for (int bj = 0; bj < 2; ++bj) { g[bj][0] = *(const f32x4*)(gain + col0 + bj * HALF); g[bj][1] = *(const f32x4*)(gain + col0 + bj * HALF + 4); }
#pragma unroll
        for (int ai = 0; ai < 2; ++ai)
#pragma unroll
            for (int m = 0; m < 4; ++m) { const int rl = ai * HALF + wr * 64 + m * 16 + fr; const float r = S[rl]; float* rp = X + (size_t)(u.pm * BM + rl) * 2048 + col0;
#pragma unroll
                for (int bj = 0; bj < 2; ++bj) { *(f32x4*)(rp + bj * HALF) = acc[ai][bj][m][0] * r * g[bj][0]; *(f32x4*)(rp + bj * HALF + 4) = acc[ai][bj][m][1] * r * g[bj][1]; } }
    }
};
struct EpiQ {
    static constexpr bool PERM = true, AFTER_DRAIN = false, PRESCALE = true, CHAIN = false;
    unsigned char* ws;
    __device__ __forceinline__ void prescale(f32x4 (&acc)[2][2][4][2], const Unit& u, int wr, int wc, int fr, int fq) const { scale_rows(acc, (const float*)(ws + WS_LRQ), u.pm * BM + wr * 64 + fr); }
    __device__ __forceinline__ void operator()(const f32x4 (&acc)[2][2][4][2], const Unit& u, int wr, int wc, int fr, int fq) const {
        const int pn = u.pn, row0 = u.pm * BM + wr * 64 + fr, lc = wc * 32 + 8 * fq;
        if (pn < 8) {
            bf16_t* base = (bf16_t*)(ws + WS_QN) + pn * 256 + lc;
#pragma unroll
            for (int ai = 0; ai < 2; ++ai)
#pragma unroll
                for (int m = 0; m < 4; ++m)
#pragma unroll
                    for (int bj = 0; bj < 2; ++bj) *(u32x4*)(base + (size_t)(row0 + ai * HALF + m * 16) * 2048 + bj * HALF) = pack8(acc[ai][bj][m][0] * QSCALE, acc[ai][bj][m][1] * QSCALE);
        } else {
            const float* COS = (const float*)(ws + WS_COS); const float* SIN = (const float*)(ws + WS_SIN);
            bf16_t* base = (bf16_t*)(ws + WS_QR) + (pn - 8) * 256 + lc; const int p0 = (wc & 1) * 16 + 4 * fq;
#pragma unroll
            for (int ai = 0; ai < 2; ++ai)
#pragma unroll
                for (int m = 0; m < 4; ++m) { const int row = row0 + ai * HALF + m * 16;
                    const f32x4 cs = *(const f32x4*)(COS + (size_t)row * 32 + p0), sn = *(const f32x4*)(SIN + (size_t)row * 32 + p0);
#pragma unroll
                    for (int bj = 0; bj < 2; ++bj) { f32x4 v0 = acc[ai][bj][m][0] * QSCALE, v1 = acc[ai][bj][m][1] * QSCALE; rope8(v0, v1, cs, sn);
                        *(u32x4*)(base + (size_t)row * 1024 + bj * HALF) = pack8(v0, v1); }
                    if (m & 1) asm volatile("" ::: "memory"); }
        }
    }
};
struct EpiGateA {
    static constexpr bool PERM = true, AFTER_DRAIN = false, PRESCALE = false, CHAIN = false;
    unsigned char* ws;
    __device__ __forceinline__ void operator()(const f32x4 (&acc)[2][2][4][2], const Unit& u, int wr, int wc, int fr, int fq) const {
        const int row0 = u.pm * BM + wr * 64 + fr, col0 = u.pn * BM + wc * 32 + 8 * fq;
        const bf16_t* G = (const bf16_t*)(ws + WS_GA); bf16_t* M1 = (bf16_t*)(ws + WS_M1);
#pragma unroll
        for (int ai = 0; ai < 2; ++ai)
#pragma unroll
            for (int m = 0; m < 4; ++m) { const size_t off = (size_t)(row0 + ai * HALF + m * 16) * 2048 + col0;
#pragma unroll
                for (int bj = 0; bj < 2; ++bj) { const u32x4 g = *(const u32x4*)(G + off + bj * HALF);
                    const f32x4 g0 = {bflo(g.x), bfhi(g.x), bflo(g.y), bfhi(g.y)}, g1 = {bflo(g.z), bfhi(g.z), bflo(g.w), bfhi(g.w)};
                    *(u32x4*)(M1 + off + bj * HALF) = pack8(acc[ai][bj][m][0] * g0, acc[ai][bj][m][1] * g1); }
                if (m & 1) asm volatile("" ::: "memory"); }
    }
};
struct EpiGateB {
    static constexpr bool PERM = true, AFTER_DRAIN = false, PRESCALE = false, CHAIN = false;
    unsigned char* ws;
    __device__ __forceinline__ void operator()(const f32x4 (&acc)[2][2][4][2], const Unit& u, int wr, int wc, int fr, int fq) const {
        const int row0 = u.pm * BM + wr * 64 + fr, col0 = u.pn * BM + wc * 32 + 8 * fq;
        const bf16_t* G = (const bf16_t*)(ws + WS_GB); const bf16_t* M1 = (const bf16_t*)(ws + WS_M1); bf16_t* O = (bf16_t*)(ws + WS_MRG);
#pragma unroll
        for (int ai = 0; ai < 2; ++ai)
#pragma unroll
            for (int m = 0; m < 4; ++m) { const size_t off = (size_t)(row0 + ai * HALF + m * 16) * 2048 + col0;
#pragma unroll
                for (int bj = 0; bj < 2; ++bj) { const u32x4 g = *(const u32x4*)(G + off + bj * HALF);
                    const f32x4 g0 = {bflo(g.x), bfhi(g.x), bflo(g.y), bfhi(g.y)}, g1 = {bflo(g.z), bfhi(g.z), bflo(g.w), bfhi(g.w)};
                    const u32x4 mv = *(const u32x4*)(M1 + off + bj * HALF); const f32x4 m0 = {bflo(mv.x), bfhi(mv.x), bflo(mv.y), bfhi(mv.y)}, m1 = {bflo(mv.z), bfhi(mv.z), bflo(mv.w), bfhi(mv.w)};
                    *(u32x4*)(O + off + bj * HALF) = pack8(m0 + acc[ai][bj][m][0] * g0, m1 + acc[ai][bj][m][1] * g1); }
                if (m & 1) asm volatile("" ::: "memory"); }
    }
};
struct EpiGateAB {
    static constexpr bool PERM = true, AFTER_DRAIN = false, PRESCALE = false, CHAIN = true;
    static constexpr size_t A_KIND = (WS_REC - WS_ATT), B_KIND = (LW_B - LW_A);
    unsigned char* ws;
    __device__ __forceinline__ void link(f32x4 (&acc)[2][2][4][2], const Unit& u, int wr, int wc, int fr, int fq) const {
        const int row0 = u.pm * BM + wr * 64 + fr, col0 = u.pn * BM + wc * 32 + 8 * fq;
        const bf16_t* GA = (const bf16_t*)(ws + WS_GA); const bf16_t* GB = (const bf16_t*)(ws + WS_GB);
#pragma unroll
        for (int ai = 0; ai < 2; ++ai)
#pragma unroll
            for (int m = 0; m < 4; ++m) { const size_t off = (size_t)(row0 + ai * HALF + m * 16) * 2048 + col0;
#pragma unroll
                for (int bj = 0; bj < 2; ++bj) { const u32x4 a = *(const u32x4*)(GA + off + bj * HALF), b = *(const u32x4*)(GB + off + bj * HALF);
                    const f32x4 a0 = {bflo(a.x), bfhi(a.x), bflo(a.y), bfhi(a.y)}, a1 = {bflo(a.z), bfhi(a.z), bflo(a.w), bfhi(a.w)};
                    f32x4 r0, r1;
                    r0[0] = __builtin_amdgcn_rcpf(fmaxf(bflo(b.x), 1e-30f)); r0[1] = __builtin_amdgcn_rcpf(fmaxf(bfhi(b.x), 1e-30f)); r0[2] = __builtin_amdgcn_rcpf(fmaxf(bflo(b.y), 1e-30f)); r0[3] = __builtin_amdgcn_rcpf(fmaxf(bfhi(b.y), 1e-30f));
                    r1[0] = __builtin_amdgcn_rcpf(fmaxf(bflo(b.z), 1e-30f)); r1[1] = __builtin_amdgcn_rcpf(fmaxf(bfhi(b.z), 1e-30f)); r1[2] = __builtin_amdgcn_rcpf(fmaxf(bflo(b.w), 1e-30f)); r1[3] = __builtin_amdgcn_rcpf(fmaxf(bfhi(b.w), 1e-30f));
                    acc[ai][bj][m][0] *= a0 * r0; acc[ai][bj][m][1] *= a1 * r1; }
                if (m & 1) asm volatile("" ::: "memory"); }
    }
    __device__ __forceinline__ void operator()(const f32x4 (&acc)[2][2][4][2], const Unit& u, int wr, int wc, int fr, int fq) const {
        const int row0 = u.pm * BM + wr * 64 + fr, col0 = u.pn * BM + wc * 32 + 8 * fq;
        const bf16_t* G = (const bf16_t*)(ws + WS_GB); bf16_t* O = (bf16_t*)(ws + WS_MRG);
#pragma unroll
        for (int ai = 0; ai < 2; ++ai)
#pragma unroll
            for (int m = 0; m < 4; ++m) { const size_t off = (size_t)(row0 + ai * HALF + m * 16) * 2048 + col0;
#pragma unroll
                for (int bj = 0; bj < 2; ++bj) { const u32x4 g = *(const u32x4*)(G + off + bj * HALF);
                    const f32x4 g0 = {bflo(g.x), bfhi(g.x), bflo(g.y), bfhi(g.y)}, g1 = {bflo(g.z), bfhi(g.z), bflo(g.w), bfhi(g.w)};
                    *(u32x4*)(O + off + bj * HALF) = pack8(acc[ai][bj][m][0] * g0, acc[ai][bj][m][1] * g1); }
                if (m & 1) asm volatile("" ::: "memory"); }
    }
};
struct EpiRes {
    static constexpr bool PERM = true, AFTER_DRAIN = false, PRESCALE = false, CHAIN = false;
    float* X;
    __device__ __forceinline__ void operator()(const f32x4 (&acc)[2][2][4][2], const Unit& u, int wr, int wc, int fr, int fq) const {
        const int row0 = u.pm * BM + wr * 64 + fr, col0 = u.pn * BM + wc * 32 + 8 * fq;
#pragma unroll
        for (int ai = 0; ai < 2; ++ai)
#pragma unroll
            for (int m = 0; m < 4; ++m) { float* rp = X + (size_t)(row0 + ai * HALF + m * 16) * 2048 + col0;
#pragma unroll
                for (int bj = 0; bj < 2; ++bj) { const f32x4 a = *(const f32x4*)(rp + bj * HALF), b = *(const f32x4*)(rp + bj * HALF + 4);
                    *(f32x4*)(rp + bj * HALF) = a + acc[ai][bj][m][0]; *(f32x4*)(rp + bj * HALF + 4) = b + acc[ai][bj][m][1]; }
                if (m & 1) asm volatile("" ::: "memory"); }
    }
};

__device__ __forceinline__ float dpp_shr1(float fill, float v) { return __builtin_bit_cast(float, __builtin_amdgcn_update_dpp(__builtin_bit_cast(int, fill), __builtin_bit_cast(int, v), 0x111, 0xf, 0xf, false)); }
__device__ __forceinline__ float dpp_shr2(float fill, float v) { return __builtin_bit_cast(float, __builtin_amdgcn_update_dpp(__builtin_bit_cast(int, fill), __builtin_bit_cast(int, v), 0x112, 0xf, 0xf, false)); }
__device__ __forceinline__ float dpp_ror1(float v) { return __builtin_bit_cast(float, __builtin_amdgcn_update_dpp(0, __builtin_bit_cast(int, v), 0x121, 0xf, 0xf, false)); }
__device__ __forceinline__ float dpp_ror2(float v) { return __builtin_bit_cast(float, __builtin_amdgcn_update_dpp(0, __builtin_bit_cast(int, v), 0x122, 0xf, 0xf, false)); }
struct EpiConv {
    static constexpr bool PERM = true, AFTER_DRAIN = false, PRESCALE = true, CHAIN = false;
    bf16_t* ACT; const float* cw; const float* cb; PG8_LAS float* EX; const float* R;
    __device__ __forceinline__ void prescale(f32x4 (&acc)[2][2][4][2], const Unit& u, int wr, int wc, int fr, int fq) const { scale_rows(acc, R, u.pm * 254 - 2 + wr * 64 + fr); }
    __device__ __forceinline__ void operator()(const f32x4 (&acc)[2][2][4][2], const Unit& u, int wr, int wc, int fr, int fq) const {
        const int lc = wc * 32 + 8 * fq;
        if (fr >= 14) {
#pragma unroll
            for (int ai = 0; ai < 2; ++ai)
#pragma unroll
                for (int bj = 0; bj < 2; ++bj)
#pragma unroll
                    for (int n = 0; n < 2; ++n) *(PG8_LAS f32x4*)(EX + ((2 * ai + wr) * 2 + (fr - 14)) * 256 + bj * HALF + lc + 4 * n) = acc[ai][bj][3][n];
        }
        asm volatile("s_waitcnt lgkmcnt(0)" ::: "memory"); __builtin_amdgcn_s_barrier(); asm volatile("" ::: "memory");
        const int ch0 = u.pn * HALF + lc;
        const int trow0 = u.pm * 254 - 2 + wr * 64 + fr;
#pragma unroll
        for (int n = 0; n < 2; ++n) {
            const int ch = ch0 + 4 * n;
            typedef const __attribute__((address_space(1))) f32x4* gv4; const __attribute__((address_space(1))) float* cwg = (const __attribute__((address_space(1))) float*)cw; const __attribute__((address_space(1))) float* cbg = (const __attribute__((address_space(1))) float*)cb;
            const f32x4 g0 = *(gv4)(cwg + ch), g1 = *(gv4)(cwg + DFF2 + ch), g2 = *(gv4)(cwg + 2 * DFF2 + ch), gb = *(gv4)(cbg + ch);
            const f32x4 u0 = *(gv4)(cwg + DFF + ch), u1 = *(gv4)(cwg + DFF2 + DFF + ch), u2 = *(gv4)(cwg + 2 * DFF2 + DFF + ch), ub = *(gv4)(cbg + DFF + ch);
#pragma unroll
            for (int ai = 0; ai < 2; ++ai) {
                const int b = 2 * ai + wr;
                f32x4 f1g = {0.f, 0.f, 0.f, 0.f}, f2g = f1g, f1u = f1g, f2u = f1g;
                if (b > 0) { const PG8_LAS float* e63 = EX + ((b - 1) * 2 + 1) * 256 + lc + 4 * n; const PG8_LAS float* e2 = EX + ((b - 1) * 2 + (fr == 0 ? 0 : 1)) * 256 + lc + 4 * n;
                    f1g = *(const PG8_LAS f32x4*)e63; f2g = *(const PG8_LAS f32x4*)e2; f1u = *(const PG8_LAS f32x4*)(e63 + HALF); f2u = *(const PG8_LAS f32x4*)(e2 + HALF); }
#pragma unroll
                for (int m = 0; m < 4; ++m) {
                    const f32x4 cg = acc[ai][0][m][n], cu = acc[ai][1][m][n];
                    if (m > 0) { const f32x4 pg = acc[ai][0][m - 1][n], pu = acc[ai][1][m - 1][n];
#pragma unroll
                        for (int i = 0; i < 4; ++i) { f1g[i] = dpp_ror1(pg[i]); f2g[i] = dpp_ror2(pg[i]); f1u[i] = dpp_ror1(pu[i]); f2u[i] = dpp_ror2(pu[i]); } }
                    f32x4 r;
#pragma unroll
                    for (int i = 0; i < 4; ++i) { const float G = gb[i] + g0[i] * dpp_shr2(f2g[i], cg[i]) + g1[i] * dpp_shr1(f1g[i], cg[i]) + g2[i] * cg[i];
                                                  const float U = ub[i] + u0[i] * dpp_shr2(f2u[i], cu[i]) + u1[i] * dpp_shr1(f1u[i], cu[i]) + u2[i] * cu[i];
                                                  r[i] = G * sigm(G) * U; }
                    const int t = trow0 + ai * HALF + m * 16;
                    if (t >= u.pm * 254 && t < S_) { v2u_t w; w.x = cvt_pk_bf16(r[0], r[1]); w.y = cvt_pk_bf16(r[2], r[3]); *(v2u_t*)(ACT + (size_t)t * DFF + ch) = w; }
                }
            }
        }
    }
};
}
#define XB_TMO      128
#define XB_XCNT(j)  (256  + 64 * (j))
#define XB_XSUB(j)  (1280 + 64 * (j))
#define XB_XGEN(j)  (2304 + 64 * (j))
#define XB_TOP      3328
#define XB_TOPGEN   3392
#define XCD_BAR_WORDS 3456
#define XB_SPIN_CAP (1u << 18)

__device__ __forceinline__ unsigned xb_ld(unsigned* p)              { return __hip_atomic_load(p, __ATOMIC_RELAXED, __HIP_MEMORY_SCOPE_AGENT); }
__device__ __forceinline__ unsigned xb_add(unsigned* p, unsigned v) { return __hip_atomic_fetch_add(p, v, __ATOMIC_RELAXED, __HIP_MEMORY_SCOPE_AGENT); }
__device__ __forceinline__ unsigned xb_xcc_id() { return (unsigned)__builtin_amdgcn_s_getreg((3 << 11) | 20) & 0xFu; }
#define XB_SPIN(cond, bar) do { unsigned _sp = 0; while (cond) { __builtin_amdgcn_s_sleep(1); \
    if ((++_sp & 255u) == 0u) { if (xb_ld(&(bar)[XB_TMO])) break; if (_sp > XB_SPIN_CAP) { atomicAdd(&(bar)[XB_TMO], 1u); break; } } } } while (0)

struct XcdBarrier {
    unsigned* bar; unsigned x;
    volatile LAS unsigned* st;
};

__device__ __forceinline__ XcdBarrier xcd_barrier_post(unsigned* bar, volatile LAS unsigned* st) {
    XcdBarrier b; b.bar = bar; b.x = xb_xcc_id(); b.st = st;
    if (threadIdx.x == 0) (void)xb_add(&bar[XB_XCNT(b.x)], 1u);
    return b;
}
__device__ __forceinline__ void xcd_barrier_complete(unsigned* bar, unsigned x, unsigned& nloc, unsigned& nx) {
    const unsigned G = gridDim.x * gridDim.y * gridDim.z;
    unsigned sum, cnt, mine, sp = 0u;
    for (;;) {
        sum = 0u; cnt = 0u; mine = 0u;
#pragma unroll
        for (unsigned j = 0; j < 16; ++j) { const unsigned c = xb_ld(&bar[XB_XCNT(j)]); sum += c; cnt += (c > 0u) ? 1u : 0u; mine = (j == x) ? c : mine; }
        if (sum == G) break;
        __builtin_amdgcn_s_sleep(1);
        if ((++sp & 255u) == 0u) { if (xb_ld(&bar[XB_TMO])) break; if (sp > XB_SPIN_CAP) { atomicAdd(&bar[XB_TMO], 1u); break; } }
    }
    nloc = mine > 0u ? mine : 1u; nx = cnt > 0u ? cnt : 1u;
}

__device__ __forceinline__ void xcd_barrier(const XcdBarrier& b) {
    asm volatile("s_waitcnt vmcnt(0)" ::: "memory");
    __syncthreads();
    if (threadIdx.x == 0) {
        GAS unsigned* gbar_ = (GAS unsigned*)b.bar; unsigned bx_ = b.x; asm volatile("" : "+s"(gbar_), "+s"(bx_)); unsigned* bar = (unsigned*)gbar_;
        __builtin_amdgcn_s_waitcnt(0);
        unsigned nloc = b.st[0], nx = b.st[1];
        if (nloc == 0u) { xcd_barrier_complete(bar, bx_, nloc, nx); b.st[0] = nloc; b.st[1] = nx; }
        const unsigned old = xb_add(&bar[XB_XSUB(bx_)], 1u);
        const unsigned gen = old / nloc;
        if (old + 1u == (gen + 1u) * nloc) {
            __builtin_amdgcn_fence(__ATOMIC_RELEASE, "agent");
            asm volatile("s_waitcnt vmcnt(0)" ::: "memory");
            const unsigned og = xb_add(&bar[XB_TOP], 1u);
            const unsigned tg = og / nx;
            if (og + 1u == (tg + 1u) * nx) xb_add(&bar[XB_TOPGEN], 1u);
            else XB_SPIN(xb_ld(&bar[XB_TOPGEN]) == tg, bar);
            __builtin_amdgcn_fence(__ATOMIC_ACQUIRE, "agent");
            xb_add(&bar[XB_XGEN(bx_)], 1u);
            asm volatile("s_waitcnt vmcnt(0)" ::: "memory");
        } else {
            XB_SPIN(xb_ld(&bar[XB_XGEN(bx_)]) == gen, bar);
            __builtin_amdgcn_fence(__ATOMIC_ACQUIRE, "agent");
            asm volatile("s_waitcnt vmcnt(0)" ::: "memory");
        }
    }
    __syncthreads();
}

__device__ const float c_invf[32] = {
    1.000000000e+00f, 7.498942614e-01f, 5.623413324e-01f, 4.216965139e-01f, 3.162277639e-01f, 2.371373773e-01f, 1.778279394e-01f, 1.333521307e-01f,
    1.000000015e-01f, 7.498941571e-02f, 5.623413250e-02f, 4.216965288e-02f, 3.162277490e-02f, 2.371373773e-02f, 1.778279431e-02f, 1.333521493e-02f,
    9.999999776e-03f, 7.498941850e-03f, 5.623413250e-03f, 4.216964822e-03f, 3.162277630e-03f, 2.371373586e-03f, 1.778279431e-03f, 1.333521446e-03f,
    1.000000047e-03f, 7.498942432e-04f, 5.623413017e-04f, 4.216965172e-04f, 3.162277571e-04f, 2.371373703e-04f, 1.778279402e-04f, 1.333521504e-04f};

template <int KIND> __device__ __forceinline__ int srcmap(int n) {
    if constexpr (KIND == 0) return n;
    else if constexpr (KIND == 1) {
        if (n < 1024) return n;
        if (n < 1088) { const int jj = n - 1024; return 1024 + (jj >> 1) + 32 * (jj & 1); }
        if (n < 1280) return -1;
        if (n < 3328) return 1088 + (n - 1280);
        if (n < 5376) return 3136 + (n - 3328);
        if (n < 7424) return 7232 + (n - 5376);
        if (n < 9472) return 9280 + (n - 7424);
        if (n < 11520) return 11328 + (n - 9472);
        return 5184 + (n - 11520);
    } else if constexpr (KIND == 2) {
        if (n < 2048) return (n >> 7) * 192 + (n & 127);
        const int r = n - 2048, h = r >> 6, jj = r & 63; return h * 192 + 128 + (jj >> 1) + 32 * (jj & 1);
    } else if constexpr (KIND == 3) return (n >> 7) * 256 + (n & 127);
    else if constexpr (KIND == 4) return (n >> 7) * 256 + 128 + (n & 127);
    else { const int j = n >> 8, i = n & 255; return i < 128 ? 128 * j + i : DFF + 128 * j + (i - 128); }
}
template <int KIND> __device__ __forceinline__ void transpose_item(const float* W, int K, int Nsrc, bf16* WT, const float* scale, LAS float* scr, int kb, int nb, int lane) {
    const int k0 = 64 * kb, n0 = 32 * nb, sc = srcmap<KIND>(n0 + (lane & 31));
#pragma unroll 8
    for (int i = 0; i < 32; ++i) { const int kk = 2 * i + (lane >> 5); float v = 0.f;
        if (sc >= 0) { v = ((const GAS float*)W)[(size_t)(k0 + kk) * Nsrc + sc]; if (scale) v *= ((const GAS float*)scale)[k0 + kk]; }
        scr[kk * 33 + (lane & 31)] = v; }
    LDS_WAIT(); asm volatile("" ::: "memory");
    const int c = lane & 7;
#pragma unroll
    for (int j = 0; j < 4; ++j) { const int n = (lane >> 3) + 8 * j; const LAS float* s = scr + (8 * c) * 33 + n;
        v4u o; o.x = pk2(s[0 * 33], s[1 * 33]); o.y = pk2(s[2 * 33], s[3 * 33]); o.z = pk2(s[4 * 33], s[5 * 33]); o.w = pk2(s[6 * 33], s[7 * 33]);
        *(GAS v4u*)(WT + (size_t)(n0 + n) * K + k0 + 8 * c) = o; }
    LDS_WAIT(); asm volatile("" ::: "memory");
}

struct TItem { const float* src; const float* scale; bf16* dst; int K, Nsrc, k0, n0, sc; };
__device__ __forceinline__ int srcmap_rt(int kind, int n) {
    switch (kind) { case 1: return srcmap<1>(n); case 2: return srcmap<2>(n); case 3: return srcmap<3>(n); case 4: return srcmap<4>(n); case 5: return srcmap<5>(n); default: return n; }
}
__device__ __forceinline__ void rms_row_to_bf16(const float* xrow, const float* gain, bf16* orow, float* xcopy, int lane, float* rstd_out = nullptr) {
    const GAS f32x4* xr = (const GAS f32x4*)xrow + lane;
    f32x4 v[8]; float s = 0.f;
#pragma unroll
    for (int j = 0; j < 8; ++j) { v[j] = xr[64 * j]; s += (v[j].x * v[j].x + v[j].y * v[j].y) + (v[j].z * v[j].z + v[j].w * v[j].w); }
    float rstd = 1.0f / sqrtf(wave_sum(s) * (1.f / DM) + EPS);
    if (rstd_out) { if (lane == 0) *rstd_out = rstd; rstd = 1.f; }
    if (xcopy) { GAS f32x4* xc = (GAS f32x4*)xcopy + lane;
#pragma unroll
        for (int j = 0; j < 8; ++j) xc[64 * j] = v[j]; }
    GAS v2u* o8 = (GAS v2u*)orow + lane;
#pragma unroll
    for (int j = 0; j < 8; ++j) { const f32x4 g = *((const GAS f32x4*)gain + lane + 64 * j);
        v2u w; w.x = pk2(v[j].x * rstd * g.x, v[j].y * rstd * g.y); w.y = pk2(v[j].z * rstd * g.z, v[j].w * rstd * g.w); o8[64 * j] = w; }
}
__device__ __forceinline__ void rms_row_f32(float* xrow, const float* gain, int lane) {
    GAS f32x4* xr = (GAS f32x4*)xrow + lane;
    f32x4 v[8]; float s = 0.f;
#pragma unroll
    for (int j = 0; j < 8; ++j) { v[j] = xr[64 * j]; s += (v[j].x * v[j].x + v[j].y * v[j].y) + (v[j].z * v[j].z + v[j].w * v[j].w); }
    const float rstd = 1.0f / sqrtf(wave_sum(s) * (1.f / DM) + EPS);
#pragma unroll
    for (int j = 0; j < 8; ++j) { const f32x4 g = *((const GAS f32x4*)gain + lane + 64 * j); xr[64 * j] = v[j] * rstd * g; }
}

__device__ __forceinline__ void rstd_phase(unsigned char* ws, int gw, int ngw, int lane) {
    const GAS float* SSQ = (const GAS float*)(ws + WS_SSQ); GAS float* R = (GAS float*)(ws + WS_RSTD);
    for (int item = gw; item < S_ / 2; item += ngw) { const int row = 2 * item + (lane >> 5);
        float v = SSQ[(size_t)row * 32 + (lane & 31)];
#pragma unroll
        for (int o = 16; o > 0; o >>= 1) v += __shfl_xor(v, o);
        if ((lane & 31) == 0) R[row] = 1.0f / sqrtf(v * (1.f / DM) + EPS); }
}
__device__ __forceinline__ void rstd_panel(unsigned char* ws, int pm, int wave, int lane) {
    GAS unsigned* SSQ = (GAS unsigned*)(ws + WS_SSQ); GAS float* R = (GAS float*)(ws + WS_RSTD);
#pragma unroll 1
    for (int it = 0; it < 16; ++it) { const int row = pm * 256 + it * 16 + wave * 2 + (lane >> 5);
        float v = __builtin_bit_cast(float, __hip_atomic_load((unsigned*)(SSQ + (size_t)row * 32 + (lane & 31)), __ATOMIC_RELAXED, __HIP_MEMORY_SCOPE_AGENT));
#pragma unroll
        for (int o = 16; o > 0; o >>= 1) v += __shfl_xor(v, o);
        if ((lane & 31) == 0) R[row] = 1.0f / sqrtf(v * (1.f / DM) + EPS); }
}
__device__ __forceinline__ void sincos_f64(float angf, float& sn, float& cs) {
    const double a = (double)angf;
    const double n = __builtin_rint(a * 0.63661977236758134308);
    double r = __builtin_fma(-n, 1.57079632679489655800e+00, a); r = __builtin_fma(-n, 6.12323399573676603587e-17, r);
    const double r2 = r * r;
    double ps = -1.0 / 1307674368000.0; ps = ps * r2 + 1.0 / 6227020800.0; ps = ps * r2 - 1.0 / 39916800.0; ps = ps * r2 + 1.0 / 362880.0; ps = ps * r2 - 1.0 / 5040.0; ps = ps * r2 + 1.0 / 120.0; ps = ps * r2 - 1.0 / 6.0; ps = ps * r2 * r + r;
    double pc = 1.0 / 20922789888000.0; pc = pc * r2 - 1.0 / 87178291200.0; pc = pc * r2 + 1.0 / 479001600.0; pc = pc * r2 - 1.0 / 3628800.0; pc = pc * r2 + 1.0 / 40320.0; pc = pc * r2 - 1.0 / 720.0; pc = pc * r2 + 1.0 / 24.0; pc = pc * r2 - 0.5; pc = pc * r2 + 1.0;
    const int q = ((int)n) & 3;
    const double s_ = (q == 0) ? ps : (q == 1) ? pc : (q == 2) ? -ps : -pc;
    const double c_ = (q == 0) ? pc : (q == 1) ? -ps : (q == 2) ? -pc : ps;
    sn = (float)s_; cs = (float)c_;
}

__device__ __forceinline__ void latent_norm_row(bf16* row, int lane) {
    v4u a = *(const v4u*)(row + lane * 8), b = *(const v4u*)(row + 512 + lane * 8);
    float fa[8] = {bflo(a.x), bfhi(a.x), bflo(a.y), bfhi(a.y), bflo(a.z), bfhi(a.z), bflo(a.w), bfhi(a.w)};
    float fb[8] = {bflo(b.x), bfhi(b.x), bflo(b.y), bfhi(b.y), bflo(b.z), bfhi(b.z), bflo(b.w), bfhi(b.w)};
    float sa = 0.f, sb = 0.f;
#pragma unroll
    for (int i = 0; i < 8; ++i) { sa += fa[i] * fa[i]; sb += fb[i] * fb[i]; }
    const float ra = 1.0f / sqrtf(wave_sum(sa) * (1.f / 512.f) + EPS), rb = 1.0f / sqrtf(wave_sum(sb) * (1.f / 512.f) + EPS);
    a.x = pk2(fa[0] * ra, fa[1] * ra); a.y = pk2(fa[2] * ra, fa[3] * ra); a.z = pk2(fa[4] * ra, fa[5] * ra); a.w = pk2(fa[6] * ra, fa[7] * ra);
    b.x = pk2(fb[0] * rb, fb[1] * rb); b.y = pk2(fb[2] * rb, fb[3] * rb); b.z = pk2(fb[4] * rb, fb[5] * rb); b.w = pk2(fb[6] * rb, fb[7] * rb);
    *(v4u*)(row + lane * 8) = a; *(v4u*)(row + 512 + lane * 8) = b;
}

__device__ __forceinline__ void latent_rstd(unsigned char* ws, int gtid, int nthr) {
    const GAS f32x4* P = (const GAS f32x4*)(ws + WS_LSSQ); GAS float* RQ = (GAS float*)(ws + WS_LRQ); GAS float* RKV = (GAS float*)(ws + WS_LRKV);
    for (int row = gtid; row < S_; row += nthr) { const f32x4 a = P[row * 4], b = P[row * 4 + 1], c = P[row * 4 + 2], d = P[row * 4 + 3];
        const float sq = ((a.x + a.y) + (a.z + a.w)) + ((b.x + b.y) + (b.z + b.w)), sk = ((c.x + c.y) + (c.z + c.w)) + ((d.x + d.y) + (d.z + d.w));
        RQ[row] = 1.0f / sqrtf(sq * (1.f / 512.f) + EPS); RKV[row] = 1.0f / sqrtf(sk * (1.f / 512.f) + EPS); }
}

__device__ __forceinline__ void attn_naive(unsigned char* ws, LAS float* qs  , int gw, int ngw, int lane) {
    const bf16* QN = (const bf16*)(ws + WS_QN); const bf16* QR = (const bf16*)(ws + WS_QR); const bf16* KN = (const bf16*)(ws + WS_KN);
    const bf16* KPE = (const bf16*)(ws + WS_KPE); const bf16* VT = (const bf16*)(ws + WS_VT); bf16* ATT = (bf16*)(ws + WS_ATT);
    for (int item = gw; item < S_ * NH; item += ngw) {
        const int q = item >> 4, h = item & 15;
        if (lane < 24) { const v4u w = (lane < 16) ? *(const v4u*)(QN + (size_t)q * 2048 + h * 128 + lane * 8) : *(const v4u*)(QR + (size_t)q * 1024 + h * 64 + (lane - 16) * 8);
            LAS float* d = qs + lane * 8; d[0] = bflo(w.x); d[1] = bfhi(w.x); d[2] = bflo(w.y); d[3] = bfhi(w.y); d[4] = bflo(w.z); d[5] = bfhi(w.z); d[6] = bflo(w.w); d[7] = bfhi(w.w); }
        LDS_WAIT(); asm volatile("" ::: "memory");
        float m = -__builtin_inff(), l = 0.f, o0 = 0.f, o1 = 0.f;
        const bf16* v0p = VT + (size_t)(h * 128 + 2 * lane) * S_; const bf16* v1p = v0p + S_;
        for (int j0 = 0; j0 <= q; j0 += 64) {
            const int j = j0 + lane; const bool valid = j <= q; float s = 0.f;
            if (valid) {
                const bf16* kn = KN + (size_t)j * 2048 + h * 128; const bf16* kp = KPE + (size_t)j * 64;
#pragma unroll 4
                for (int c = 0; c < 24; ++c) { const v4u w = (c < 16) ? *(const v4u*)(kn + c * 8) : *(const v4u*)(kp + (c - 16) * 8); const LAS float* qq = qs + c * 8;
                    s += bflo(w.x) * qq[0] + bfhi(w.x) * qq[1] + bflo(w.y) * qq[2] + bfhi(w.y) * qq[3] + bflo(w.z) * qq[4] + bfhi(w.z) * qq[5] + bflo(w.w) * qq[6] + bfhi(w.w) * qq[7]; }
            } else s = -__builtin_inff();
            const float mn = fmaxf(m, wave_max(s)); const float alpha = __builtin_amdgcn_exp2f(m - mn); const float p = valid ? __builtin_amdgcn_exp2f(s - mn) : 0.f;
            l = l * alpha + wave_sum(p); m = mn; o0 *= alpha; o1 *= alpha;
#pragma unroll
            for (int c = 0; c < 8; ++c) { const v4u a = *(const v4u*)(v0p + j0 + c * 8), b = *(const v4u*)(v1p + j0 + c * 8);
                const float p0 = __builtin_bit_cast(float, __builtin_amdgcn_readlane(__builtin_bit_cast(int, p), c * 8 + 0)), p1 = __builtin_bit_cast(float, __builtin_amdgcn_readlane(__builtin_bit_cast(int, p), c * 8 + 1));
                const float p2 = __builtin_bit_cast(float, __builtin_amdgcn_readlane(__builtin_bit_cast(int, p), c * 8 + 2)), p3 = __builtin_bit_cast(float, __builtin_amdgcn_readlane(__builtin_bit_cast(int, p), c * 8 + 3));
                const float p4 = __builtin_bit_cast(float, __builtin_amdgcn_readlane(__builtin_bit_cast(int, p), c * 8 + 4)), p5 = __builtin_bit_cast(float, __builtin_amdgcn_readlane(__builtin_bit_cast(int, p), c * 8 + 5));
                const float p6 = __builtin_bit_cast(float, __builtin_amdgcn_readlane(__builtin_bit_cast(int, p), c * 8 + 6)), p7 = __builtin_bit_cast(float, __builtin_amdgcn_readlane(__builtin_bit_cast(int, p), c * 8 + 7));
                o0 += p0 * bflo(a.x) + p1 * bfhi(a.x) + p2 * bflo(a.y) + p3 * bfhi(a.y) + p4 * bflo(a.z) + p5 * bfhi(a.z) + p6 * bflo(a.w) + p7 * bfhi(a.w);
                o1 += p0 * bflo(b.x) + p1 * bfhi(b.x) + p2 * bflo(b.y) + p3 * bfhi(b.y) + p4 * bflo(b.z) + p5 * bfhi(b.z) + p6 * bflo(b.w) + p7 * bfhi(b.w); }
        }
        const float il = 1.f / l;
        *(unsigned*)(ATT + (size_t)q * 2048 + h * 128 + 2 * lane) = pk2(o0 * il, o1 * il);
        asm volatile("" ::: "memory");
    }
}
__device__ __forceinline__ void hgrn_naive(unsigned char* ws, int layer, int gw, int ngw, int lane) {
    const bf16* HQ = (const bf16*)(ws + WS_HQ); const _Float16* HF = (const _Float16*)(ws + WS_HF); const bf16* VTH = (const bf16*)(ws + WS_VTH);
    const float* LB = (const float*)(ws + WS_LB) + layer * 2048; float* RR = (float*)(ws + WS_RRAW);
    for (int item = gw; item < NH * 128; item += ngw) {
        const int h = item >> 7, e = item & 127, ch = h * 128 + 2 * lane;
        const float lb0 = LB[ch], lb1 = LB[ch + 1];
        float s0 = 0.f, s1 = 0.f;
        const bf16* vp = VTH + (size_t)(h * 128 + e) * S_;
        for (int t0 = 0; t0 < S_; t0 += 8) {
            const v4u vv = *(const v4u*)(vp + t0);
            const float vt[8] = {bflo(vv.x), bfhi(vv.x), bflo(vv.y), bfhi(vv.y), bflo(vv.z), bfhi(vv.z), bflo(vv.w), bfhi(vv.w)};
            float ov = 0.f;
#pragma unroll
            for (int i = 0; i < 8; ++i) { const size_t off = (size_t)(t0 + i) * 2048 + ch;
                const f32x2 z = *(const f32x2*)(HF + off); const unsigned qq = *(const unsigned*)(HQ + off);
                const float f0 = lb0 + (1.f - lb0) * sigm(z.x), f1 = lb1 + (1.f - lb1) * sigm(z.y);
                s0 = fmaxf(f0, 1e-30f) * s0 + (1.f - f0) * vt[i]; s1 = fmaxf(f1, 1e-30f) * s1 + (1.f - f1) * vt[i];
                const float o = wave_sum(bflo(qq) * s0 + bfhi(qq) * s1);
                ov = (lane == i) ? o : ov; }
            if (lane < 8) RR[(size_t)(t0 + lane) * 2048 + h * 128 + e] = ov;
        }
    }
}
__device__ __forceinline__ void hgrn_normgate(unsigned char* ws, const float* gain, int gw, int ngw, int lane) {
    const float* RR = (const float*)(ws + WS_RRAW); const bf16* HG = (const bf16*)(ws + WS_HG); bf16* REC = (bf16*)(ws + WS_REC);
    const f32x2 g = *(const GAS f32x2*)(gain + 2 * lane);
    for (int item = gw; item < S_ * NH; item += ngw) {
        const size_t off = (size_t)item * 128 + 2 * lane;
        const f32x2 v = *(const f32x2*)(RR + off); const unsigned hg = *(const unsigned*)(HG + off);
        const float rstd = 1.0f / sqrtf(wave_sum(v.x * v.x + v.y * v.y) * (1.f / 128.f) + EPS);
        *(unsigned*)(REC + off) = pk2(v.x * rstd * g.x * bflo(hg), v.y * rstd * g.y * bfhi(hg));
    }
}
__device__ __forceinline__ void conv_gate(unsigned char* ws, const float* cw, const float* cb, int gw, int ngw, int lane) {
    const bf16* U = (const bf16*)(ws + WS_U); bf16* ACT = (bf16*)(ws + WS_ACT);
    for (int item = gw; item < (S_ / 16) * 11; item += ngw) {
        const int tb = item / 11, cg = item % 11, c0 = cg * 512 + lane * 8;
        const int ucol = (c0 >> 7) * 256 + (c0 & 127), t0 = tb * 16;
        float wg[3][8], wu[3][8], bg[8], bu[8];
#pragma unroll
        for (int j = 0; j < 3; ++j)
#pragma unroll
            for (int i = 0; i < 8; ++i) { wg[j][i] = ((const GAS float*)cw)[(size_t)j * DFF2 + c0 + i]; wu[j][i] = ((const GAS float*)cw)[(size_t)j * DFF2 + DFF + c0 + i]; }
#pragma unroll
        for (int i = 0; i < 8; ++i) { bg[i] = ((const GAS float*)cb)[c0 + i]; bu[i] = ((const GAS float*)cb)[DFF + c0 + i]; }
        float g2[8], g1[8], u2[8], u1[8];
#pragma unroll
        for (int i = 0; i < 8; ++i) { g2[i] = 0.f; g1[i] = 0.f; u2[i] = 0.f; u1[i] = 0.f; }
        if (t0 > 0) {
            const v4u a = *(const v4u*)(U + (size_t)(t0 - 2) * DFF2 + ucol), b = *(const v4u*)(U + (size_t)(t0 - 2) * DFF2 + ucol + 128);
            const v4u c = *(const v4u*)(U + (size_t)(t0 - 1) * DFF2 + ucol), d = *(const v4u*)(U + (size_t)(t0 - 1) * DFF2 + ucol + 128);
            g2[0] = bflo(a.x); g2[1] = bfhi(a.x); g2[2] = bflo(a.y); g2[3] = bfhi(a.y); g2[4] = bflo(a.z); g2[5] = bfhi(a.z); g2[6] = bflo(a.w); g2[7] = bfhi(a.w);
            u2[0] = bflo(b.x); u2[1] = bfhi(b.x); u2[2] = bflo(b.y); u2[3] = bfhi(b.y); u2[4] = bflo(b.z); u2[5] = bfhi(b.z); u2[6] = bflo(b.w); u2[7] = bfhi(b.w);
            g1[0] = bflo(c.x); g1[1] = bfhi(c.x); g1[2] = bflo(c.y); g1[3] = bfhi(c.y); g1[4] = bflo(c.z); g1[5] = bfhi(c.z); g1[6] = bflo(c.w); g1[7] = bfhi(c.w);
            u1[0] = bflo(d.x); u1[1] = bfhi(d.x); u1[2] = bflo(d.y); u1[3] = bfhi(d.y); u1[4] = bflo(d.z); u1[5] = bfhi(d.z); u1[6] = bflo(d.w); u1[7] = bfhi(d.w);
        }
#pragma unroll 4
        for (int t = t0; t < t0 + 16; ++t) {
            const v4u a = *(const v4u*)(U + (size_t)t * DFF2 + ucol), b = *(const v4u*)(U + (size_t)t * DFF2 + ucol + 128);
            float g0[8], u0[8];
            g0[0] = bflo(a.x); g0[1] = bfhi(a.x); g0[2] = bflo(a.y); g0[3] = bfhi(a.y); g0[4] = bflo(a.z); g0[5] = bfhi(a.z); g0[6] = bflo(a.w); g0[7] = bfhi(a.w);
            u0[0] = bflo(b.x); u0[1] = bfhi(b.x); u0[2] = bflo(b.y); u0[3] = bfhi(b.y); u0[4] = bflo(b.z); u0[5] = bfhi(b.z); u0[6] = bflo(b.w); u0[7] = bfhi(b.w);
            float r[8];
#pragma unroll
            for (int i = 0; i < 8; ++i) { const float G = bg[i] + wg[0][i] * g2[i] + wg[1][i] * g1[i] + wg[2][i] * g0[i]; const float Uu = bu[i] + wu[0][i] * u2[i] + wu[1][i] * u1[i] + wu[2][i] * u0[i];
                r[i] = G * sigm(G) * Uu; g2[i] = g1[i]; g1[i] = g0[i]; u2[i] = u1[i]; u1[i] = u0[i]; }
            v4u o; o.x = pk2(r[0], r[1]); o.y = pk2(r[2], r[3]); o.z = pk2(r[4], r[5]); o.w = pk2(r[6], r[7]);
            *(v4u*)(ACT + (size_t)t * DFF + c0) = o;
        }
    }
}

namespace fa {
typedef float f32x16 __attribute__((ext_vector_type(16)));
constexpr int KBUF = 24576, VBUF = 16384, STG = KBUF + VBUF;
constexpr float THR = 8.0f;
__device__ __forceinline__ float hmax(float a) { return fmaxf(a, __shfl_xor(a, 32)); }
__device__ __forceinline__ float hsum(float a) { return a + __shfl_xor(a, 32); }
__device__ __forceinline__ bf16x8 pk8(const f32x16& p, int b) {
    v4u w; w.x = pg8::cvt_pk_bf16(p[b], p[b + 1]); w.y = pg8::cvt_pk_bf16(p[b + 2], p[b + 3]); w.z = pg8::cvt_pk_bf16(p[b + 4], p[b + 5]); w.w = pg8::cvt_pk_bf16(p[b + 6], p[b + 7]);
    return __builtin_bit_cast(bf16x8, w);
}
__device__ __forceinline__ void attn_fast(unsigned char* ws, LAS unsigned char* lds, unsigned* qcnt  , LAS unsigned* qslot  , unsigned myx) {
    int tid = threadIdx.x; asm volatile("" : "+v"(tid));
    const int lane = tid & 63, w = __builtin_amdgcn_readfirstlane(tid >> 6), r32 = lane & 31, hi = lane >> 5;
    const bf16* QN = (const bf16*)(ws + WS_QN); const bf16* QR = (const bf16*)(ws + WS_QR); const bf16* KN = (const bf16*)(ws + WS_KN);
    const bf16* KPE = (const bf16*)(ws + WS_KPE); const bf16* VT = (const bf16*)(ws + WS_VT); bf16* ATT = (bf16*)(ws + WS_ATT);
    const int pr = (r32 & 0x13) | ((r32 & 4) << 1) | ((r32 & 8) >> 1);
    const int kfo = hi * 1024 + pr * 16;
    const int fb = (r32 >> 1) & 7, va = (hi ^ (fb & 1)) << 4, vbb = fb >> 1;
    const int vfo = KBUF + r32 * 128 + va;
    const int vrow0 = 16 * w + (lane >> 3), vrow1 = vrow0 + 8;
    const int vsc0 = ((lane & 7) ^ ((vrow0 >> 1) & 7)) * 8, vsc1 = ((lane & 7) ^ ((vrow1 >> 1) & 7)) * 8;
    for (int kq = 0; kq < 8; ++kq) { const unsigned xq = (myx + (unsigned)kq) & 7u;
      for (;;) {
        if (tid == 0) *qslot = __hip_atomic_fetch_add(qcnt + 64 * xq, 1u, __ATOMIC_RELAXED, __HIP_MEMORY_SCOPE_AGENT);
        __syncthreads();
        const unsigned ui = (unsigned)__builtin_amdgcn_readfirstlane((int)*qslot);
        __syncthreads();
        if (ui >= 64u) break;
        const int h = 2 * (int)xq + (int)(ui & 1u);
        const bf16* kn_l = KN + (size_t)lane * 2048 + h * 128 + 8 * w;
        const bf16* kp_l = KPE + (size_t)lane * 64 + 8 * w;
        const bf16* v0_l = VT + (size_t)(h * 128 + vrow0) * S_ + vsc0; const bf16* v1_l = VT + (size_t)(h * 128 + vrow1) * S_ + vsc1;
#define FA_ISSUE(t, st) do { const size_t ko_ = (size_t)(t) * 64 * 2048, po_ = (size_t)(t) * 64 * 64; const int to_ = (t) * 64; LAS unsigned char* sb_ = lds + (st) * STG; \
        __builtin_amdgcn_global_load_lds((const unsigned*)(kn_l + ko_), (LAS unsigned*)(sb_ + w * 1024), 16, 0, 0); \
        __builtin_amdgcn_global_load_lds((const unsigned*)(kn_l + ko_ + 64), (LAS unsigned*)(sb_ + (w + 8) * 1024), 16, 0, 0); \
        __builtin_amdgcn_global_load_lds((const unsigned*)(kp_l + po_), (LAS unsigned*)(sb_ + (w + 16) * 1024), 16, 0, 0); \
        __builtin_amdgcn_global_load_lds((const unsigned*)(v0_l + to_), (LAS unsigned*)(sb_ + KBUF + (2 * w) * 1024), 16, 0, 0); \
        __builtin_amdgcn_global_load_lds((const unsigned*)(v1_l + to_), (LAS unsigned*)(sb_ + KBUF + (2 * w + 1) * 1024), 16, 0, 0); } while (0)
        {
            const int qb = 31 - (int)(ui >> 1), q0 = qb * 256, NT = 4 * qb + 4, qw = q0 + 32 * w, q = qw + r32;
            FA_ISSUE(0, 0);
            bf16x8 qr[12];
#pragma unroll
            for (int d0 = 0; d0 < 8; ++d0) qr[d0] = *(const bf16x8*)(QN + (size_t)q * 2048 + h * 128 + d0 * 16 + hi * 8);
#pragma unroll
            for (int d0 = 0; d0 < 4; ++d0) qr[8 + d0] = *(const bf16x8*)(QR + (size_t)q * 1024 + h * 64 + d0 * 16 + hi * 8);
            f32x16 o[4];
#pragma unroll
            for (int e = 0; e < 4; ++e)
#pragma unroll
                for (int r = 0; r < 16; ++r) o[e][r] = 0.f;
            float m = -__builtin_inff(), l = 0.f;
            for (int t = 0; t < NT; ++t) {
                VM_WAIT(); __syncthreads();
                if (t + 1 < NT) FA_ISSUE(t + 1, (t + 1) & 1);
                {
                    const LAS unsigned char* sb = lds + (t & 1) * STG;
                    f32x16 p0, p1;
#pragma unroll
                    for (int r = 0; r < 16; ++r) { p0[r] = 0.f; p1[r] = 0.f; }
                    {
#define FA_KLD(g, A0, A1, B0, B1) do { A0 = *(const LAS bf16x8*)(sb + kfo + (2 * (g)) * 2048); A1 = *(const LAS bf16x8*)(sb + kfo + (2 * (g)) * 2048 + 512); \
                                       B0 = *(const LAS bf16x8*)(sb + kfo + (2 * (g) + 1) * 2048); B1 = *(const LAS bf16x8*)(sb + kfo + (2 * (g) + 1) * 2048 + 512); } while (0)
#define FA_KMM(g, A0, A1, B0, B1) do { p0 = __builtin_amdgcn_mfma_f32_32x32x16_bf16(A0, qr[2 * (g)], p0, 0, 0, 0); p1 = __builtin_amdgcn_mfma_f32_32x32x16_bf16(A1, qr[2 * (g)], p1, 0, 0, 0); \
                                       p0 = __builtin_amdgcn_mfma_f32_32x32x16_bf16(B0, qr[2 * (g) + 1], p0, 0, 0, 0); p1 = __builtin_amdgcn_mfma_f32_32x32x16_bf16(B1, qr[2 * (g) + 1], p1, 0, 0, 0); } while (0)
                        bf16x8 xa0, xa1, xb0, xb1, ya0, ya1, yb0, yb1;
                        FA_KLD(0, xa0, xa1, xb0, xb1); __builtin_amdgcn_sched_barrier(0);
                        FA_KLD(1, ya0, ya1, yb0, yb1); __builtin_amdgcn_sched_barrier(0); FA_KMM(0, xa0, xa1, xb0, xb1); __builtin_amdgcn_sched_barrier(0);
                        FA_KLD(2, xa0, xa1, xb0, xb1); __builtin_amdgcn_sched_barrier(0); FA_KMM(1, ya0, ya1, yb0, yb1); __builtin_amdgcn_sched_barrier(0);
                        FA_KLD(3, ya0, ya1, yb0, yb1); __builtin_amdgcn_sched_barrier(0); FA_KMM(2, xa0, xa1, xb0, xb1); __builtin_amdgcn_sched_barrier(0);
                        FA_KLD(4, xa0, xa1, xb0, xb1); __builtin_amdgcn_sched_barrier(0); FA_KMM(3, ya0, ya1, yb0, yb1); __builtin_amdgcn_sched_barrier(0);
                        FA_KLD(5, ya0, ya1, yb0, yb1); __builtin_amdgcn_sched_barrier(0); FA_KMM(4, xa0, xa1, xb0, xb1); __builtin_amdgcn_sched_barrier(0);
                        FA_KMM(5, ya0, ya1, yb0, yb1);
#undef FA_KLD
#undef FA_KMM
                    }
                    if (64 * t + 63 > qw) {
                        const int kb = 64 * t + 8 * hi - q;
#pragma unroll
                        for (int r = 0; r < 16; ++r) { const int dk = kb + 16 * (r >> 3) + (r & 7); if (dk > 0) p0[r] = -__builtin_inff(); if (dk + 32 > 0) p1[r] = -__builtin_inff(); }
                    }
                    float mx = fmaxf(p0[0], p1[0]);
#pragma unroll
                    for (int r = 1; r < 16; ++r) mx = fmaxf(mx, fmaxf(p0[r], p1[r]));
                    mx = hmax(mx);
                    if (__any(mx > m + THR)) { const float mn = fmaxf(m, mx), alpha = __builtin_amdgcn_exp2f(m - mn); m = mn; l *= alpha;
#pragma unroll
                        for (int e = 0; e < 4; ++e)
#pragma unroll
                            for (int r = 0; r < 16; ++r) o[e][r] *= alpha; }
                    float ps = 0.f;
#pragma unroll
                    for (int r = 0; r < 16; ++r) { p0[r] = __builtin_amdgcn_exp2f(p0[r] - m); p1[r] = __builtin_amdgcn_exp2f(p1[r] - m); ps += p0[r] + p1[r]; }
                    l += ps;
                    const bf16x8 pf0 = pk8(p0, 0), pf1 = pk8(p0, 8), pf2 = pk8(p1, 0), pf3 = pk8(p1, 8);
                    const LAS unsigned char* vb0 = sb + vfo + ((0 ^ vbb) << 5); const LAS unsigned char* vb1 = sb + vfo + ((1 ^ vbb) << 5);
                    const LAS unsigned char* vb2 = sb + vfo + ((2 ^ vbb) << 5); const LAS unsigned char* vb3 = sb + vfo + ((3 ^ vbb) << 5);
#define FA_PVK(vb, pf) do { const bf16x8 a0 = *(const LAS bf16x8*)((vb)), a1 = *(const LAS bf16x8*)((vb) + 4096), a2 = *(const LAS bf16x8*)((vb) + 8192), a3 = *(const LAS bf16x8*)((vb) + 12288); \
                        o[0] = __builtin_amdgcn_mfma_f32_32x32x16_bf16(a0, pf, o[0], 0, 0, 0); o[1] = __builtin_amdgcn_mfma_f32_32x32x16_bf16(a1, pf, o[1], 0, 0, 0); \
                        o[2] = __builtin_amdgcn_mfma_f32_32x32x16_bf16(a2, pf, o[2], 0, 0, 0); o[3] = __builtin_amdgcn_mfma_f32_32x32x16_bf16(a3, pf, o[3], 0, 0, 0); } while (0)
                    FA_PVK(vb0, pf0); FA_PVK(vb1, pf1); FA_PVK(vb2, pf2); FA_PVK(vb3, pf3);
#undef FA_PVK
                }
            }
            const float il = 1.0f / hsum(l);
            bf16* op = ATT + (size_t)q * 2048 + h * 128 + 4 * hi;
#pragma unroll
            for (int e = 0; e < 4; ++e)
#pragma unroll
                for (int g4 = 0; g4 < 4; ++g4) { v2u wv; wv.x = pg8::cvt_pk_bf16(o[e][4 * g4] * il, o[e][4 * g4 + 1] * il); wv.y = pg8::cvt_pk_bf16(o[e][4 * g4 + 2] * il, o[e][4 * g4 + 3] * il);
                    *(v2u*)(op + e * 32 + g4 * 8) = wv; }
            __syncthreads();
        }
#undef FA_ISSUE
      }
    }
}
}

namespace fa16 {
typedef float f32x4_ __attribute__((ext_vector_type(4)));
constexpr int KBUF = 24576, VBUF = 16384, STG = KBUF + VBUF;
constexpr float THR = 8.0f;
__device__ __forceinline__ float gmax(float a) { a = fmaxf(a, __shfl_xor(a, 16)); return fmaxf(a, __shfl_xor(a, 32)); }
__device__ __forceinline__ float gsum(float a) { a += __shfl_xor(a, 16); return a + __shfl_xor(a, 32); }
__device__ __forceinline__ bf16x8 pk44(const f32x4_& a, const f32x4_& b) {
    v4u w; w.x = pg8::cvt_pk_bf16(a[0], a[1]); w.y = pg8::cvt_pk_bf16(a[2], a[3]); w.z = pg8::cvt_pk_bf16(b[0], b[1]); w.w = pg8::cvt_pk_bf16(b[2], b[3]);
    return __builtin_bit_cast(bf16x8, w);
}
__device__ __forceinline__ void attn_fast(unsigned char* ws, LAS unsigned char* lds, unsigned* qcnt  , LAS unsigned* qslot  , unsigned myx) {
    int tid = threadIdx.x; asm volatile("" : "+v"(tid));
    const int lane = tid & 63, w = __builtin_amdgcn_readfirstlane(tid >> 6), n16 = lane & 15, g = lane >> 4;
    const bf16* QN = (const bf16*)(ws + WS_QN); const bf16* QR = (const bf16*)(ws + WS_QR); const bf16* KN = (const bf16*)(ws + WS_KN);
    const bf16* KPE = (const bf16*)(ws + WS_KPE); const bf16* VT = (const bf16*)(ws + WS_VT); bf16* ATT = (bf16*)(ws + WS_ATT);
    const int krow = 8 * (n16 >> 2) + (n16 & 3);
    const int kfo0 = g * 1024 + ((krow ^ ((g & 1) << 2)) * 16), kfo1 = g * 1024 + (((krow + 4) ^ ((g & 1) << 2)) * 16);
    const int fv0 = (n16 >> 1) & 7;
    const int vfo0 = KBUF + n16 * 128 + (((0 + g) ^ fv0) << 4), vfo1 = KBUF + n16 * 128 + (((4 + g) ^ fv0) << 4);
    const int ksrc = lane ^ ((w & 1) << 2);
    const int vrow0 = 16 * w + (lane >> 3), vrow1 = vrow0 + 8;
    const int vsc0 = ((lane & 7) ^ ((vrow0 >> 1) & 7)) * 8, vsc1 = ((lane & 7) ^ ((vrow1 >> 1) & 7)) * 8;
    int mode = 0, bi = 7; bool any = false;
    for (;;) {
        unsigned xq = myx, ui = 64u;
        if (mode == 0) {
            if (tid == 0) qslot[0] = __hip_atomic_fetch_add(qcnt + 64 * myx, 1u, __ATOMIC_RELAXED, __HIP_MEMORY_SCOPE_AGENT);
            __syncthreads();
            ui = (unsigned)__builtin_amdgcn_readfirstlane((int)qslot[0]);
            __syncthreads();
            if (ui >= 64u) { mode = 1; bi = 7; any = true; continue; }
        } else {
            if (bi >= 7) {
                if (!any) break;
                if (tid < 7) qslot[1 + tid] = __hip_atomic_fetch_add(qcnt + 64 * ((myx + 1u + (unsigned)tid) & 7u), 1u, __ATOMIC_RELAXED, __HIP_MEMORY_SCOPE_AGENT);
                __syncthreads();
                bi = 0; any = false; }
            while (bi < 7) { const unsigned v = (unsigned)__builtin_amdgcn_readfirstlane((int)qslot[1 + bi]); ++bi; if (v < 64u) { ui = v; xq = (myx + (unsigned)bi) & 7u; break; } }
            if (ui >= 64u) { __syncthreads(); continue; }
            any = true;
        }
        const int h = 2 * (int)xq + (int)(ui & 1u);
        const bf16* kn_l = KN + (size_t)ksrc * 2048 + h * 128 + 8 * w;
        const bf16* kp_l = KPE + (size_t)ksrc * 64 + 8 * w;
        const bf16* v0_l = VT + (size_t)(h * 128 + vrow0) * S_ + vsc0; const bf16* v1_l = VT + (size_t)(h * 128 + vrow1) * S_ + vsc1;
#define FA_ISSUE(t, st) do { const size_t ko_ = (size_t)(t) * 64 * 2048, po_ = (size_t)(t) * 64 * 64; const int to_ = (t) * 64; LAS unsigned char* sb_ = lds + (st) * STG; \
        __builtin_amdgcn_global_load_lds((const unsigned*)(kn_l + ko_), (LAS unsigned*)(sb_ + w * 1024), 16, 0, 0); \
        __builtin_amdgcn_global_load_lds((const unsigned*)(kn_l + ko_ + 64), (LAS unsigned*)(sb_ + (w + 8) * 1024), 16, 0, 0); \
        __builtin_amdgcn_global_load_lds((const unsigned*)(kp_l + po_), (LAS unsigned*)(sb_ + (w + 16) * 1024), 16, 0, 0); \
        __builtin_amdgcn_global_load_lds((const unsigned*)(v0_l + to_), (LAS unsigned*)(sb_ + KBUF + (2 * w) * 1024), 16, 0, 0); \
        __builtin_amdgcn_global_load_lds((const unsigned*)(v1_l + to_), (LAS unsigned*)(sb_ + KBUF + (2 * w + 1) * 1024), 16, 0, 0); } while (0)
        {
            const int qb256 = 31 - (int)(ui >> 1), q0 = qb256 * 256, NT = 4 * qb256 + 4, qw = q0 + 32 * w;
            FA_ISSUE(0, 0);
            bf16x8 qr[2][6];
#pragma unroll
            for (int qb = 0; qb < 2; ++qb) { const size_t qrow = (size_t)(qw + 16 * qb + n16);
#pragma unroll
                for (int kd = 0; kd < 4; ++kd) qr[qb][kd] = *(const bf16x8*)(QN + qrow * 2048 + h * 128 + kd * 32 + g * 8);
#pragma unroll
                for (int kd = 0; kd < 2; ++kd) qr[qb][4 + kd] = *(const bf16x8*)(QR + qrow * 1024 + h * 64 + kd * 32 + g * 8); }
            f32x4_ o[8][2];
#pragma unroll
            for (int e = 0; e < 8; ++e)
#pragma unroll
                for (int qb = 0; qb < 2; ++qb) o[e][qb] = (f32x4_){0.f, 0.f, 0.f, 0.f};
            float m0 = -__builtin_inff(), m1 = -__builtin_inff(), l0 = 0.f, l1 = 0.f;
            if (w >= 4) __builtin_amdgcn_s_setprio(1);
            for (int t = 0; t < NT; ++t) {
                VM_WAIT(); __syncthreads();
                if (t + 1 < NT) FA_ISSUE(t + 1, (t + 1) & 1);
                if (64 * t <= qw + 31) {
                    const LAS unsigned char* sb = lds + (t & 1) * STG;
                    f32x4_ st[4][2];
#pragma unroll
                    for (int kb = 0; kb < 4; ++kb) { st[kb][0] = (f32x4_){0.f, 0.f, 0.f, 0.f}; st[kb][1] = (f32x4_){0.f, 0.f, 0.f, 0.f}; }
                    {
#define F16_KLD(kd, A, B, C, D) do { A = *(const LAS bf16x8*)(sb + kfo0 + (kd) * 4096); B = *(const LAS bf16x8*)(sb + kfo1 + (kd) * 4096); \
                                     C = *(const LAS bf16x8*)(sb + kfo0 + (kd) * 4096 + 512); D = *(const LAS bf16x8*)(sb + kfo1 + (kd) * 4096 + 512); } while (0)
#define F16_KMM(kd, A, B, C, D) do { \
        st[0][0] = __builtin_amdgcn_mfma_f32_16x16x32_bf16(A, qr[0][kd], st[0][0], 0, 0, 0); st[0][1] = __builtin_amdgcn_mfma_f32_16x16x32_bf16(A, qr[1][kd], st[0][1], 0, 0, 0); \
        st[1][0] = __builtin_amdgcn_mfma_f32_16x16x32_bf16(B, qr[0][kd], st[1][0], 0, 0, 0); st[1][1] = __builtin_amdgcn_mfma_f32_16x16x32_bf16(B, qr[1][kd], st[1][1], 0, 0, 0); \
        st[2][0] = __builtin_amdgcn_mfma_f32_16x16x32_bf16(C, qr[0][kd], st[2][0], 0, 0, 0); st[2][1] = __builtin_amdgcn_mfma_f32_16x16x32_bf16(C, qr[1][kd], st[2][1], 0, 0, 0); \
        st[3][0] = __builtin_amdgcn_mfma_f32_16x16x32_bf16(D, qr[0][kd], st[3][0], 0, 0, 0); st[3][1] = __builtin_amdgcn_mfma_f32_16x16x32_bf16(D, qr[1][kd], st[3][1], 0, 0, 0); } while (0)
                        bf16x8 xa, xb, xc, xd, ya, yb, yc, yd;
                        F16_KLD(0, xa, xb, xc, xd); __builtin_amdgcn_sched_barrier(0);
                        F16_KLD(1, ya, yb, yc, yd); __builtin_amdgcn_sched_barrier(0); F16_KMM(0, xa, xb, xc, xd); __builtin_amdgcn_sched_barrier(0);
                        F16_KLD(2, xa, xb, xc, xd); __builtin_amdgcn_sched_barrier(0); F16_KMM(1, ya, yb, yc, yd); __builtin_amdgcn_sched_barrier(0);
                        F16_KLD(3, ya, yb, yc, yd); __builtin_amdgcn_sched_barrier(0); F16_KMM(2, xa, xb, xc, xd); __builtin_amdgcn_sched_barrier(0);
                        F16_KLD(4, xa, xb, xc, xd); __builtin_amdgcn_sched_barrier(0); F16_KMM(3, ya, yb, yc, yd); __builtin_amdgcn_sched_barrier(0);
                        F16_KLD(5, ya, yb, yc, yd); __builtin_amdgcn_sched_barrier(0); F16_KMM(4, xa, xb, xc, xd); __builtin_amdgcn_sched_barrier(0);
                        F16_KMM(5, ya, yb, yc, yd);
#undef F16_KLD
#undef F16_KMM
                    }
                    if (64 * t + 63 > qw) {
                        const int kq0 = 64 * t + 8 * g - (qw + n16);
#pragma unroll
                        for (int kb = 0; kb < 4; ++kb)
#pragma unroll
                            for (int r = 0; r < 4; ++r) { const int dk = kq0 + 32 * (kb >> 1) + 4 * (kb & 1) + r; if (dk > 0) st[kb][0][r] = -__builtin_inff(); if (dk - 16 > 0) st[kb][1][r] = -__builtin_inff(); }
                    }
                    float mx0 = fmaxf(fmaxf(st[0][0][0], st[0][0][1]), fmaxf(st[0][0][2], st[0][0][3])), mx1 = fmaxf(fmaxf(st[0][1][0], st[0][1][1]), fmaxf(st[0][1][2], st[0][1][3]));
#pragma unroll
                    for (int kb = 1; kb < 4; ++kb) { mx0 = fmaxf(mx0, fmaxf(fmaxf(st[kb][0][0], st[kb][0][1]), fmaxf(st[kb][0][2], st[kb][0][3]))); mx1 = fmaxf(mx1, fmaxf(fmaxf(st[kb][1][0], st[kb][1][1]), fmaxf(st[kb][1][2], st[kb][1][3]))); }
                    mx0 = gmax(mx0); mx1 = gmax(mx1);
                    if (__any(mx0 > m0 + THR || mx1 > m1 + THR)) {
                        const float mn0 = fmaxf(m0, mx0), mn1 = fmaxf(m1, mx1), a0 = __builtin_amdgcn_exp2f(m0 - mn0), a1 = __builtin_amdgcn_exp2f(m1 - mn1); m0 = mn0; m1 = mn1; l0 *= a0; l1 *= a1;
#pragma unroll
                        for (int e = 0; e < 8; ++e) { o[e][0] *= a0; o[e][1] *= a1; } }
                    float ps0 = 0.f, ps1 = 0.f;
#pragma unroll
                    for (int kb = 0; kb < 4; ++kb)
#pragma unroll
                        for (int r = 0; r < 4; ++r) { st[kb][0][r] = __builtin_amdgcn_exp2f(st[kb][0][r] - m0); st[kb][1][r] = __builtin_amdgcn_exp2f(st[kb][1][r] - m1); ps0 += st[kb][0][r]; ps1 += st[kb][1][r]; }
                    l0 += ps0; l1 += ps1;
                    const bf16x8 pf00 = pk44(st[0][0], st[1][0]), pf01 = pk44(st[2][0], st[3][0]), pf10 = pk44(st[0][1], st[1][1]), pf11 = pk44(st[2][1], st[3][1]);
#pragma unroll
                    for (int e = 0; e < 8; ++e) {
                        const bf16x8 v0 = *(const LAS bf16x8*)(sb + vfo0 + e * 2048), v1 = *(const LAS bf16x8*)(sb + vfo1 + e * 2048);
                        o[e][0] = __builtin_amdgcn_mfma_f32_16x16x32_bf16(v0, pf00, o[e][0], 0, 0, 0); o[e][1] = __builtin_amdgcn_mfma_f32_16x16x32_bf16(v0, pf10, o[e][1], 0, 0, 0);
                        o[e][0] = __builtin_amdgcn_mfma_f32_16x16x32_bf16(v1, pf01, o[e][0], 0, 0, 0); o[e][1] = __builtin_amdgcn_mfma_f32_16x16x32_bf16(v1, pf11, o[e][1], 0, 0, 0); }
                }
            }
            __builtin_amdgcn_s_setprio(0);
            const float il0 = 1.0f / gsum(l0), il1 = 1.0f / gsum(l1);
#pragma unroll
            for (int qb = 0; qb < 2; ++qb) { bf16* op = ATT + (size_t)(qw + 16 * qb + n16) * 2048 + h * 128 + 4 * g; const float il = qb ? il1 : il0;
#pragma unroll
                for (int e = 0; e < 8; ++e) { v2u wv; wv.x = pg8::cvt_pk_bf16(o[e][qb][0] * il, o[e][qb][1] * il); wv.y = pg8::cvt_pk_bf16(o[e][qb][2] * il, o[e][qb][3] * il); *(v2u*)(op + e * 16) = wv; } }
            __syncthreads();
        }
#undef FA_ISSUE
    }
}
}

namespace hg {
typedef float f32x16 __attribute__((ext_vector_type(16)));
constexpr int L_TOT = 0, L_KT = 4096;
constexpr int L_QA = 4096, L_QB = 20480, L_KA0 = 28672, L_KA1 = 36864, L_SSP = 53248;
__device__ __forceinline__ float log2_(float x) { return __builtin_amdgcn_logf(x); }
__device__ __forceinline__ float exp2_(float x) { return __builtin_amdgcn_exp2f(x); }
__device__ __forceinline__ bf16x8 pk8(const f32x16& p, int b) {
    v4u w; w.x = pg8::cvt_pk_bf16(p[b], p[b + 1]); w.y = pg8::cvt_pk_bf16(p[b + 2], p[b + 3]); w.z = pg8::cvt_pk_bf16(p[b + 4], p[b + 5]); w.w = pg8::cvt_pk_bf16(p[b + 6], p[b + 7]);
    return __builtin_bit_cast(bf16x8, w);
}
#define HG_GATES(HFp, lbv, t0, h) \
    float kk[16], bl[16]; { float run_ = 0.f; const _Float16* zp_ = (HFp) + (size_t)((t0) + 16 * tg) * 2048 + (h) * 128 + d; \
      _Pragma("unroll") for (int i = 0; i < 16; ++i) { const float z_ = (float)zp_[(size_t)i * 2048]; const float f_ = (lbv) + (1.f - (lbv)) * sigm(z_); kk[i] = 1.f - f_; run_ += log2_(fmaxf(f_, 1e-30f)); bl[i] = run_; } }

__device__ __forceinline__ void pass1(unsigned char* ws, LAS unsigned char* lds, int layer, int vcu, int G) {
    int tid = threadIdx.x; asm volatile("" : "+v"(tid));
    const int lane = tid & 63, w = __builtin_amdgcn_readfirstlane(tid >> 6), d = tid & 127, tg = tid >> 7, r32 = lane & 31, hi = lane >> 5;
    const _Float16* HF = (const _Float16*)(ws + WS_HF); const bf16* VTH = (const bf16*)(ws + WS_VTH); bf16* HU = (bf16*)(ws + WS_HU); float* GAM = (float*)(ws + WS_RRAW);
    const float* LB = (const float*)(ws + WS_LB) + layer * 2048;
    LAS float* tot = (LAS float*)(lds + L_TOT); LAS unsigned char* KT = lds + L_KT;
    const int fsw = (d >> 1) & 7, fsr = (r32 >> 1) & 7, et = w >> 1, dt0 = 2 * (w & 1);
    _Float16 zr[16];
#define HG_RAWZ(unit_) do { const int h_ = (unit_) >> 7, t0_ = ((unit_) & 127) * 64; const size_t o_ = (size_t)(t0_ + 16 * tg) * 2048 + h_ * 128 + d; \
        _Pragma("unroll") for (int i = 0; i < 16; ++i) zr[i] = HF[o_ + (size_t)i * 2048]; } while (0)
    if (vcu < NH * 128) HG_RAWZ(vcu);
    for (int unit = vcu; unit < NH * 128; unit += G) {
        const int h = unit >> 7, c = unit & 127, t0 = c * 64;
        const float lb = LB[h * 128 + d];
        bf16x8 af[4];
#pragma unroll
        for (int ks = 0; ks < 4; ++ks) af[ks] = *(const bf16x8*)(VTH + (size_t)(h * 128 + 32 * et + r32) * S_ + t0 + 16 * ks + 8 * hi);
        float kk[16], bl[16];
        { float run = 0.f;
#pragma unroll
          for (int i = 0; i < 16; ++i) { const float f_ = lb + (1.f - lb) * sigm((float)zr[i]); kk[i] = 1.f - f_; run += log2_(fmaxf(f_, 1e-30f)); bl[i] = run; } }
        tot[tg * 128 + d] = bl[15];
        __syncthreads();
        float pre = 0.f, all = 0.f;
#pragma unroll
        for (int j = 0; j < 4; ++j) { const float v = tot[j * 128 + d]; pre += (j < tg) ? v : 0.f; all += v; }
        { float kh[16];
#pragma unroll
          for (int i = 0; i < 16; ++i) kh[i] = kk[i] * exp2_(all - (pre + bl[i]));
          v4u c0, c1; c0.x = pg8::cvt_pk_bf16(kh[0], kh[1]); c0.y = pg8::cvt_pk_bf16(kh[2], kh[3]); c0.z = pg8::cvt_pk_bf16(kh[4], kh[5]); c0.w = pg8::cvt_pk_bf16(kh[6], kh[7]);
          c1.x = pg8::cvt_pk_bf16(kh[8], kh[9]); c1.y = pg8::cvt_pk_bf16(kh[10], kh[11]); c1.z = pg8::cvt_pk_bf16(kh[12], kh[13]); c1.w = pg8::cvt_pk_bf16(kh[14], kh[15]);
          *(LAS v4u*)(KT + d * 128 + (((2 * tg) ^ fsw) << 4)) = c0; *(LAS v4u*)(KT + d * 128 + (((2 * tg + 1) ^ fsw) << 4)) = c1; }
        if (tg == 0) GAM[(size_t)(h * 128 + c) * 128 + d] = exp2_(all);
        if (unit + G < NH * 128) HG_RAWZ(unit + G);
        __syncthreads();
#pragma unroll
        for (int dd = 0; dd < 2; ++dd) { const int dt = dt0 + dd; f32x16 acc;
#pragma unroll
            for (int r = 0; r < 16; ++r) acc[r] = 0.f;
#pragma unroll
            for (int ks = 0; ks < 4; ++ks) { const bf16x8 aq = *(const LAS bf16x8*)(KT + (32 * dt + r32) * 128 + (((2 * ks + hi) ^ fsr) << 4)); acc = __builtin_amdgcn_mfma_f32_32x32x16_bf16(aq, af[ks], acc, 0, 0, 0); }
            bf16* up = HU + ((size_t)(h * 128 + c) * 128 + 32 * et + r32) * 128 + 32 * dt + 4 * hi;
#pragma unroll
            for (int g4 = 0; g4 < 4; ++g4) { v2u wv; wv.x = pg8::cvt_pk_bf16(acc[4 * g4], acc[4 * g4 + 1]); wv.y = pg8::cvt_pk_bf16(acc[4 * g4 + 2], acc[4 * g4 + 3]); *(v2u*)(up + 8 * g4) = wv; } }
        __syncthreads();
    }
#undef HG_RAWZ
}
__device__ __forceinline__ void scan(unsigned char* ws, LAS unsigned char* lds, int vcu, int G) {
    const int tid = threadIdx.x;
    const bf16* HU = (const bf16*)(ws + WS_HU); const float* GAM = (const float*)(ws + WS_RRAW); bf16* HS = (bf16*)(ws + WS_HS);
    LAS float* gl = (LAS float*)lds;
    for (int item = vcu; item < NH * 16; item += G) {
        const int h = item >> 4, e = 8 * (item & 15) + (tid >> 6), d = 2 * (tid & 63);
        __syncthreads();
        { const GAS f32x4* gsrc = (const GAS f32x4*)(GAM + (size_t)h * 128 * 128);
#pragma unroll
          for (int i = 0; i < 8; ++i) *(LAS f32x4*)(gl + 4 * (tid + 512 * i)) = gsrc[tid + 512 * i]; }
        __syncthreads();
        float s0 = 0.f, s1 = 0.f;
#pragma unroll 8
        for (int c = 0; c < 128; ++c) { const size_t base = ((size_t)(h * 128 + c) * 128 + e) * 128 + d;
            *(unsigned*)(HS + base) = pg8::cvt_pk_bf16(s0, s1);
            const unsigned u = *(const unsigned*)(HU + base); const f32x2 gm = *(const LAS f32x2*)(gl + c * 128 + d);
            s0 = gm.x * s0 + bflo(u); s1 = gm.y * s1 + bfhi(u); }
    }
}

constexpr size_t WS_HP = WS_HU, WS_HT = WS_HU + 64 * MiB, WS_HSG = WS_HU + 80 * MiB;
constexpr size_t WS_GAMG = WS_RRAW, WS_DLOG = WS_RRAW + 2 * MiB;
constexpr int L_GT = 2048;
__device__ __forceinline__ void passA(unsigned char* ws, LAS unsigned char* lds, int layer, int vcu, int G) {
    int tid = threadIdx.x; asm volatile("" : "+v"(tid));
    const int lane = tid & 63, w = __builtin_amdgcn_readfirstlane(tid >> 6), d = tid & 127, tg = w >> 1, r32 = lane & 31, hi = lane >> 5;
    const _Float16* HF = (const _Float16*)(ws + WS_HF); const bf16* VTH = (const bf16*)(ws + WS_VTH); bf16* HP = (bf16*)(ws + WS_HP); bf16* HT = (bf16*)(ws + WS_HT);
    float* GAMG = (float*)(ws + WS_GAMG); float* DLOG = (float*)(ws + WS_DLOG);
    const float* LB = (const float*)(ws + WS_LB) + layer * 2048;
    LAS float* tot = (LAS float*)(lds + L_TOT); LAS float* gt = (LAS float*)(lds + L_GT); LAS unsigned char* KT = lds + L_KT;
    const int fsw = (d >> 1) & 7, fsr = (r32 >> 1) & 7, et = w >> 1, dt0 = 2 * (w & 1);
    _Float16 zr[16];
#define HG_RAWZ(h_, c_) do { const size_t o_ = (size_t)((c_) * 64 + 16 * tg) * 2048 + (h_) * 128 + d; \
        _Pragma("unroll") for (int i = 0; i < 16; ++i) zr[i] = HF[o_ + (size_t)i * 2048]; } while (0)
    if (vcu < NH * 32) HG_RAWZ(vcu >> 5, 4 * (vcu & 31));
    for (int unit = vcu; unit < NH * 32; unit += G) {
        const int h = unit >> 5, gq = unit & 31;
        const float lb = LB[h * 128 + d];
        f32x16 acc0, acc1;
#pragma unroll
        for (int r = 0; r < 16; ++r) { acc0[r] = 0.f; acc1[r] = 0.f; }
        float dsum = 0.f;
#pragma unroll 1
        for (int j = 0; j < 4; ++j) {
            const int c = 4 * gq + j, t0 = c * 64;
            bf16x8 af[4];
#pragma unroll
            for (int ks = 0; ks < 4; ++ks) af[ks] = *(const bf16x8*)(VTH + (size_t)(h * 128 + 32 * et + r32) * S_ + t0 + 16 * ks + 8 * hi);
            float kk[16], bl[16];
            { float run = 0.f;
#pragma unroll
              for (int i = 0; i < 16; ++i) { const float f_ = lb + (1.f - lb) * sigm((float)zr[i]); kk[i] = 1.f - f_; run += log2_(fmaxf(f_, 1e-30f)); bl[i] = run; } }
            tot[tg * 128 + d] = bl[15];
            __syncthreads();
            float pre = 0.f, all = 0.f;
#pragma unroll
            for (int jj = 0; jj < 4; ++jj) { const float v = tot[jj * 128 + d]; pre += (jj < tg) ? v : 0.f; all += v; }
            { float kh[16];
#pragma unroll
              for (int i = 0; i < 16; ++i) kh[i] = kk[i] * exp2_(all - (pre + bl[i]));
              v4u c0, c1; c0.x = pg8::cvt_pk_bf16(kh[0], kh[1]); c0.y = pg8::cvt_pk_bf16(kh[2], kh[3]); c0.z = pg8::cvt_pk_bf16(kh[4], kh[5]); c0.w = pg8::cvt_pk_bf16(kh[6], kh[7]);
              c1.x = pg8::cvt_pk_bf16(kh[8], kh[9]); c1.y = pg8::cvt_pk_bf16(kh[10], kh[11]); c1.z = pg8::cvt_pk_bf16(kh[12], kh[13]); c1.w = pg8::cvt_pk_bf16(kh[14], kh[15]);
              *(LAS v4u*)(KT + d * 128 + (((2 * tg) ^ fsw) << 4)) = c0; *(LAS v4u*)(KT + d * 128 + (((2 * tg + 1) ^ fsw) << 4)) = c1; }
            if (tg == 0) gt[d] = exp2_(all);
            dsum += all;
            { const int un = unit + G; if (j < 3) HG_RAWZ(h, c + 1); else if (un < NH * 32) HG_RAWZ(un >> 5, 4 * (un & 31)); }
            __syncthreads();
#pragma unroll
            for (int dd = 0; dd < 2; ++dd) { const int dt = dt0 + dd; f32x16 a = dd ? acc1 : acc0;
                if (j > 0) {
#pragma unroll
                    for (int g4 = 0; g4 < 4; ++g4) { const f32x4 gm = *(const LAS f32x4*)(gt + 32 * dt + 8 * g4 + 4 * hi); a[4 * g4] *= gm.x; a[4 * g4 + 1] *= gm.y; a[4 * g4 + 2] *= gm.z; a[4 * g4 + 3] *= gm.w; }
                }
#pragma unroll
                for (int ks = 0; ks < 4; ++ks) { const bf16x8 aq = *(const LAS bf16x8*)(KT + (32 * dt + r32) * 128 + (((2 * ks + hi) ^ fsr) << 4)); a = __builtin_amdgcn_mfma_f32_32x32x16_bf16(aq, af[ks], a, 0, 0, 0); }
                if (dd) acc1 = a; else acc0 = a; }
            __syncthreads();
        }
#pragma unroll
        for (int dd = 0; dd < 2; ++dd) { const int dt = dt0 + dd; const f32x16 a = dd ? acc1 : acc0;
            bf16* tp = HT + ((size_t)(h * 32 + gq) * 128 + 32 * et + r32) * 128 + 32 * dt + 4 * hi;
#pragma unroll
            for (int g4 = 0; g4 < 4; ++g4) { v2u wv; wv.x = pg8::cvt_pk_bf16(a[4 * g4], a[4 * g4 + 1]); wv.y = pg8::cvt_pk_bf16(a[4 * g4 + 2], a[4 * g4 + 3]); *(v2u*)(tp + 8 * g4) = wv; } }
        if (tg == 0) GAMG[(size_t)(h * 32 + gq) * 128 + d] = exp2_(dsum);
    }
#undef HG_RAWZ
}
__device__ __forceinline__ void scanG(unsigned char* ws, int gtid, int nthr) {
    const bf16* HT = (const bf16*)(ws + WS_HT); const float* GAMG = (const float*)(ws + WS_GAMG); bf16* SG = (bf16*)(ws + WS_HSG);
    for (int idx = gtid; idx < NH * 128 * 64; idx += nthr) {
        const int h = idx >> 13, e = (idx >> 6) & 127, d = 2 * (idx & 63);
        float s0 = 0.f, s1 = 0.f;
#pragma unroll 8
        for (int g = 0; g < 32; ++g) { const size_t base = ((size_t)(h * 32 + g) * 128 + e) * 128 + d;
            *(unsigned*)(SG + base) = pg8::cvt_pk_bf16(s0, s1);
            const unsigned u = *(const unsigned*)(HT + base); const f32x2 gm = *(const f32x2*)(GAMG + (size_t)(h * 32 + g) * 128 + d);
            s0 = gm.x * s0 + bflo(u); s1 = gm.y * s1 + bfhi(u); }
    }
}
__device__ __forceinline__ void pass3(unsigned char* ws, LAS unsigned char* lds, const float* gain, int layer, unsigned* qc  , LAS unsigned* qs, unsigned myx) {
    int tid = threadIdx.x; asm volatile("" : "+v"(tid));
    const int lane = tid & 63, w = __builtin_amdgcn_readfirstlane(tid >> 6), d = tid & 127, tg = tid >> 7, r32 = lane & 31, hi = lane >> 5;
    const _Float16* HF = (const _Float16*)(ws + WS_HF); const bf16* HQ = (const bf16*)(ws + WS_HQ); const bf16* HG = (const bf16*)(ws + WS_HG); const bf16* VTH = (const bf16*)(ws + WS_VTH);
    const bf16* SG = (const bf16*)(ws + WS_HSG); const bf16* HP = (const bf16*)(ws + WS_HP); const float* DLOG = (const float*)(ws + WS_DLOG); LAS float* etab = (LAS float*)(lds + L_GT); bf16* REC = (bf16*)(ws + WS_REC); const float* LB = (const float*)(ws + WS_LB) + layer * 2048;
    LAS float* tot = (LAS float*)(lds + L_TOT); LAS float* SSP = (LAS float*)(lds + L_SSP);
    const int et = w & 3, tb = w >> 2, pr = (r32 & 0x13) | ((r32 & 4) << 1) | ((r32 & 8) >> 1);
    const int eo = (d >> 3) * 16, ei = (d & 7) * 2;
    f32x4 gn[4];
#pragma unroll
    for (int g4 = 0; g4 < 4; ++g4) gn[g4] = *(const GAS f32x4*)(gain + 32 * et + 4 * hi + 8 * g4);
    _Float16 zr[16]; bf16 qr_[16];
#define HG_RAW(unit_) do { const int h_ = (unit_) >> 7, t0_ = ((unit_) & 127) * 64; const size_t o_ = (size_t)(t0_ + 16 * tg) * 2048 + h_ * 128 + d; \
        _Pragma("unroll") for (int i = 0; i < 16; ++i) { zr[i] = HF[o_ + (size_t)i * 2048]; qr_[i] = HQ[o_ + (size_t)i * 2048]; } } while (0)
    int kq_ = 0;
#define P3_CLAIM_SYNC(dst) do { int cv__ = 2048; while (kq_ < 8) { const unsigned cx__ = (myx + (unsigned)kq_) & 7u; const unsigned ca__ = __hip_atomic_fetch_add(qc + 64 * cx__, 1u, __ATOMIC_RELAXED, __HIP_MEMORY_SCOPE_AGENT); \
        if (ca__ < 256u) { cv__ = (int)(cx__ * 256u + ca__); break; } ++kq_; } (dst) = cv__; } while (0)
    if (tid == 0) { int a_, b_; P3_CLAIM_SYNC(a_); P3_CLAIM_SYNC(b_); qs[0] = (unsigned)a_; qs[1] = (unsigned)b_; }
    __syncthreads();
    int unit = __builtin_amdgcn_readfirstlane((int)qs[0]), nxt = __builtin_amdgcn_readfirstlane((int)qs[1]);
    __syncthreads();
    if (unit < NH * 128) HG_RAW(unit);
    while (unit < NH * 128) {
        unsigned claim = 256u; unsigned cx_ = 0u; if (tid == 0 && kq_ < 8) { cx_ = (myx + (unsigned)kq_) & 7u; claim = __hip_atomic_fetch_add(qc + 64 * cx_, 1u, __ATOMIC_RELAXED, __HIP_MEMORY_SCOPE_AGENT); }
        const int h = unit >> 7, c = unit & 127, t0 = c * 64;
        const float lb = LB[h * 128 + d];
        bf16x8 sf[8], pfr[8], vf[4]; v2u hgv[4]; const int jg = c & 3;
        const float dlg = DLOG[(size_t)(h * 128 + c) * 128 + d];
        { const bf16* sp = SG + ((size_t)(h * 32 + (c >> 2)) * 128 + 32 * et + r32) * 128 + 8 * hi; const bf16* pp = HP + ((size_t)(h * 128 + c) * 128 + 32 * et + r32) * 128 + 8 * hi;
#pragma unroll
          for (int kd = 0; kd < 8; ++kd) { sf[kd] = *(const bf16x8*)(sp + 16 * kd); if (jg) pfr[kd] = *(const bf16x8*)(pp + 16 * kd); else pfr[kd] = sf[kd]; }
          const bf16* vp = VTH + (size_t)(h * 128 + 32 * et + r32) * S_ + t0 + 8 * hi;
#pragma unroll
          for (int ks = 0; ks < 4; ++ks) vf[ks] = *(const bf16x8*)(vp + 16 * ks);
          const size_t ro = (size_t)(t0 + 32 * tb + r32) * 2048 + h * 128 + 32 * et + 4 * hi;
#pragma unroll
          for (int g4 = 0; g4 < 4; ++g4) hgv[g4] = *(const v2u*)(HG + ro + 8 * g4); }
        float kk[16], bl[16], qv[16];
        { float run = 0.f;
#pragma unroll
          for (int i = 0; i < 16; ++i) { const float f_ = lb + (1.f - lb) * sigm((float)zr[i]); kk[i] = 1.f - f_; run += log2_(fmaxf(f_, 1e-30f)); bl[i] = run; qv[i] = __builtin_bit_cast(float, (unsigned)qr_[i] << 16); } }
        tot[tg * 128 + d] = bl[15]; if (tg == 0) etab[d] = exp2_(dlg);
        __syncthreads();
        const float t_0 = tot[d], t_1 = tot[128 + d], t_2 = tot[256 + d];
        const float pre = (tg > 0 ? t_0 : 0.f) + (tg > 1 ? t_1 : 0.f) + (tg > 2 ? t_2 : 0.f), b31 = t_0 + t_1;
#pragma unroll
        for (int i = 0; i < 16; ++i) { const float b = pre + bl[i]; const int row = 16 * tg + i;
            *(LAS bf16*)(lds + L_QA + eo * 64 + row * 16 + ei) = (bf16)f2bf(qv[i] * exp2_(b));
            *(LAS bf16*)(lds + L_KA1 + eo * 64 + row * 16 + ei) = (bf16)f2bf(kk[i] * exp2_(b31 - b));
            if (tg < 2) *(LAS bf16*)(lds + L_KA0 + eo * 32 + row * 16 + ei) = (bf16)f2bf(kk[i] * exp2_(-b));
            else *(LAS bf16*)(lds + L_QB + eo * 32 + (row - 32) * 16 + ei) = (bf16)f2bf(qv[i] * exp2_(b - b31)); }
        if (nxt < NH * 128) HG_RAW(nxt);
        if (tid == 0) { int v_; if (claim < 256u) v_ = (int)(cx_ * 256u + claim); else { if (kq_ < 8) ++kq_; P3_CLAIM_SYNC(v_); } *qs = (unsigned)v_; }
        __syncthreads();
        const int nn = __builtin_amdgcn_readfirstlane((int)*qs);
        f32x16 o;
#pragma unroll
        for (int r = 0; r < 16; ++r) o[r] = 0.f;
        if (jg) {
#pragma unroll
            for (int kd = 0; kd < 8; ++kd) { const f32x4 e0 = *(const LAS f32x4*)(etab + 16 * kd + 8 * hi), e1 = *(const LAS f32x4*)(etab + 16 * kd + 8 * hi + 4);
                const v4u sv = __builtin_bit_cast(v4u, sf[kd]), pv = __builtin_bit_cast(v4u, pfr[kd]); v4u ov;
                ov.x = pg8::cvt_pk_bf16(e0.x * bflo(sv.x) + bflo(pv.x), e0.y * bfhi(sv.x) + bfhi(pv.x)); ov.y = pg8::cvt_pk_bf16(e0.z * bflo(sv.y) + bflo(pv.y), e0.w * bfhi(sv.y) + bfhi(pv.y));
                ov.z = pg8::cvt_pk_bf16(e1.x * bflo(sv.z) + bflo(pv.z), e1.y * bfhi(sv.z) + bfhi(pv.z)); ov.w = pg8::cvt_pk_bf16(e1.z * bflo(sv.w) + bflo(pv.w), e1.w * bfhi(sv.w) + bfhi(pv.w));
                sf[kd] = __builtin_bit_cast(bf16x8, ov); } }
        { const LAS unsigned char* qb_ = lds + L_QA + hi * 1024 + (32 * tb + r32) * 16;
#pragma unroll
          for (int kd = 0; kd < 8; ++kd) { const bf16x8 b = *(const LAS bf16x8*)(qb_ + kd * 2048); o = __builtin_amdgcn_mfma_f32_32x32x16_bf16(sf[kd], b, o, 0, 0, 0); } }
        if (tb == 0) {
            f32x16 p;
#pragma unroll
            for (int r = 0; r < 16; ++r) p[r] = 0.f;
            const LAS unsigned char* ka = lds + L_KA0 + hi * 512 + pr * 16; const LAS unsigned char* qa = lds + L_QA + hi * 1024 + r32 * 16;
#pragma unroll
            for (int kd = 0; kd < 8; ++kd) p = __builtin_amdgcn_mfma_f32_32x32x16_bf16(*(const LAS bf16x8*)(ka + kd * 1024), *(const LAS bf16x8*)(qa + kd * 2048), p, 0, 0, 0);
#pragma unroll
            for (int r = 0; r < 16; ++r) if (16 * (r >> 3) + 8 * hi + (r & 7) > r32) p[r] = 0.f;
            o = __builtin_amdgcn_mfma_f32_32x32x16_bf16(vf[0], pk8(p, 0), o, 0, 0, 0);
            o = __builtin_amdgcn_mfma_f32_32x32x16_bf16(vf[1], pk8(p, 8), o, 0, 0, 0);
        } else {
            f32x16 p0, p1;
#pragma unroll
            for (int r = 0; r < 16; ++r) { p0[r] = 0.f; p1[r] = 0.f; }
            const LAS unsigned char* ka = lds + L_KA1 + hi * 1024 + pr * 16; const LAS unsigned char* qa = lds + L_QB + hi * 512 + r32 * 16;
#pragma unroll
            for (int kd = 0; kd < 8; ++kd) { const bf16x8 qf = *(const LAS bf16x8*)(qa + kd * 1024);
                p0 = __builtin_amdgcn_mfma_f32_32x32x16_bf16(*(const LAS bf16x8*)(ka + kd * 2048), qf, p0, 0, 0, 0);
                p1 = __builtin_amdgcn_mfma_f32_32x32x16_bf16(*(const LAS bf16x8*)(ka + kd * 2048 + 512), qf, p1, 0, 0, 0); }
#pragma unroll
            for (int r = 0; r < 16; ++r) if (16 * (r >> 3) + 8 * hi + (r & 7) > r32) p1[r] = 0.f;
            o = __builtin_amdgcn_mfma_f32_32x32x16_bf16(vf[0], pk8(p0, 0), o, 0, 0, 0);
            o = __builtin_amdgcn_mfma_f32_32x32x16_bf16(vf[1], pk8(p0, 8), o, 0, 0, 0);
            o = __builtin_amdgcn_mfma_f32_32x32x16_bf16(vf[2], pk8(p1, 0), o, 0, 0, 0);
            o = __builtin_amdgcn_mfma_f32_32x32x16_bf16(vf[3], pk8(p1, 8), o, 0, 0, 0);
        }
        float ss = 0.f;
#pragma unroll
        for (int r = 0; r < 16; ++r) ss += o[r] * o[r];
        ss += __shfl_xor(ss, 32);
        if (hi == 0) SSP[(tb * 4 + et) * 32 + r32] = ss;
        __syncthreads();
        const float rstd = 1.0f / sqrtf((SSP[(tb * 4 + 0) * 32 + r32] + SSP[(tb * 4 + 1) * 32 + r32] + SSP[(tb * 4 + 2) * 32 + r32] + SSP[(tb * 4 + 3) * 32 + r32]) * (1.f / 128.f) + EPS);
        { const size_t ro = (size_t)(t0 + 32 * tb + r32) * 2048 + h * 128 + 32 * et + 4 * hi;
#pragma unroll
          for (int g4 = 0; g4 < 4; ++g4) { const v2u hv = hgv[g4];
              v2u ov; ov.x = pg8::cvt_pk_bf16(o[4 * g4] * rstd * gn[g4].x * bflo(hv.x), o[4 * g4 + 1] * rstd * gn[g4].y * bfhi(hv.x)); ov.y = pg8::cvt_pk_bf16(o[4 * g4 + 2] * rstd * gn[g4].z * bflo(hv.y), o[4 * g4 + 3] * rstd * gn[g4].w * bfhi(hv.y));
              *(v2u*)(REC + ro + 8 * g4) = ov; } }
        __syncthreads();
        unit = nxt; nxt = nn;
    }
#undef HG_RAW
#undef P3_CLAIM_SYNC
}
__device__ __forceinline__ void scanG2(unsigned char* ws, int t) {
    asm volatile("" : "+v"(t));
    const bf16* HT = (const bf16*)(ws + WS_HT); const float* GAMG = (const float*)(ws + WS_GAMG); bf16* SG = (bf16*)(ws + WS_HSG);
    const int i0 = t, i1 = t + NH * 128 * 32;
    const int h0 = i0 >> 13, e0 = (i0 >> 6) & 127, h1 = i1 >> 13, e1 = (i1 >> 6) & 127, d = 2 * (t & 63);
    float a0 = 0.f, a1 = 0.f, b0 = 0.f, b1 = 0.f;
#pragma unroll 4
    for (int g = 0; g < 32; ++g) { const size_t ba = ((size_t)(h0 * 32 + g) * 128 + e0) * 128 + d, bb = ((size_t)(h1 * 32 + g) * 128 + e1) * 128 + d;
        *(unsigned*)(SG + ba) = pg8::cvt_pk_bf16(a0, a1); *(unsigned*)(SG + bb) = pg8::cvt_pk_bf16(b0, b1);
        const unsigned ua = *(const unsigned*)(HT + ba), ub = *(const unsigned*)(HT + bb);
        const f32x2 ga = *(const f32x2*)(GAMG + (size_t)(h0 * 32 + g) * 128 + d), gb = *(const f32x2*)(GAMG + (size_t)(h1 * 32 + g) * 128 + d);
        a0 = ga.x * a0 + bflo(ua); a1 = ga.y * a1 + bfhi(ua); b0 = gb.x * b0 + bflo(ub); b1 = gb.y * b1 + bfhi(ub); }
}
constexpr int L_SI = 57344, L_KT3 = 90112;
constexpr int G_QA = 4096, G_QB = 20736, G_KA0 = 29184, G_KA1 = 37632, G_SSP = 54272, G64 = 1040, G32 = 528;
__device__ __forceinline__ void pass3g(unsigned char* ws, LAS unsigned char* lds, const float* gain, int layer, int vcu, int G) {
    int tid = threadIdx.x; asm volatile("" : "+v"(tid));
    const int lane = tid & 63, w = __builtin_amdgcn_readfirstlane(tid >> 6), d = tid & 127, tg = tid >> 7, r32 = lane & 31, hi = lane >> 5;
    const _Float16* HF = (const _Float16*)(ws + WS_HF); const bf16* HQ = (const bf16*)(ws + WS_HQ); const bf16* HG = (const bf16*)(ws + WS_HG); const bf16* VTH = (const bf16*)(ws + WS_VTH);
    const bf16* SG = (const bf16*)(ws + WS_HSG); bf16* REC = (bf16*)(ws + WS_REC); const float* LB = (const float*)(ws + WS_LB) + layer * 2048;
    LAS float* tot = (LAS float*)(lds + L_TOT); LAS float* gt = (LAS float*)(lds + L_GT); LAS float* SSP = (LAS float*)(lds + G_SSP); LAS unsigned char* KT = lds + L_KT3; LAS unsigned char* SI = lds + L_SI;
    const int et = w & 3, tb = w >> 2, pr = (r32 & 0x13) | ((r32 & 4) << 1) | ((r32 & 8) >> 1), dt0 = 2 * tb;
    const int eg = d >> 3, ei = (d & 7) * 2;
    const int fsw = (d >> 1) & 7, fsr = (r32 >> 1) & 7, erow = 32 * et + r32, esw = erow & 15;
    _Float16 zr[16]; bf16 qr_[16];
#define HG_RAW(h_, c_) do { const size_t o_ = (size_t)((c_) * 64 + 16 * tg) * 2048 + (h_) * 128 + d; \
        _Pragma("unroll") for (int i = 0; i < 16; ++i) { zr[i] = HF[o_ + (size_t)i * 2048]; qr_[i] = HQ[o_ + (size_t)i * 2048]; } } while (0)
    if (vcu < NH * 32) HG_RAW(vcu >> 5, 4 * (vcu & 31));
    for (int unit = vcu; unit < NH * 32; unit += G) {
        const int nxt = unit + G;
        const int h = unit >> 5, gq = unit & 31;
        const float lb = LB[h * 128 + d];
        f32x16 acc0, acc1;
#pragma unroll
        for (int dd = 0; dd < 2; ++dd) { const bf16* tp = SG + ((size_t)(h * 32 + gq) * 128 + erow) * 128 + 32 * (dt0 + dd) + 4 * hi; f32x16 a;
#pragma unroll
            for (int g4 = 0; g4 < 4; ++g4) { const v2u u = *(const v2u*)(tp + 8 * g4); a[4 * g4] = bflo(u.x); a[4 * g4 + 1] = bfhi(u.x); a[4 * g4 + 2] = bflo(u.y); a[4 * g4 + 3] = bfhi(u.y); }
            if (dd) acc1 = a; else acc0 = a; }
#pragma unroll 1
        for (int j = 0; j < 4; ++j) {
            const int c = 4 * gq + j, t0 = c * 64;
            bf16x8 vf[4]; v2u hgv[4];
            { const bf16* vp = VTH + (size_t)(h * 128 + erow) * S_ + t0 + 8 * hi;
#pragma unroll
              for (int ks = 0; ks < 4; ++ks) vf[ks] = *(const bf16x8*)(vp + 16 * ks);
              const size_t ro = (size_t)(t0 + 32 * tb + r32) * 2048 + h * 128 + 32 * et + 4 * hi;
#pragma unroll
              for (int g4 = 0; g4 < 4; ++g4) hgv[g4] = *(const v2u*)(HG + ro + 8 * g4); }
            float kk[16], bl[16], qv[16];
            { float run = 0.f;
#pragma unroll
              for (int i = 0; i < 16; ++i) { const float f_ = lb + (1.f - lb) * sigm((float)zr[i]); kk[i] = 1.f - f_; run += log2_(fmaxf(f_, 1e-30f)); bl[i] = run; qv[i] = __builtin_bit_cast(float, (unsigned)qr_[i] << 16); } }
            tot[tg * 128 + d] = bl[15];
#pragma unroll
            for (int dd = 0; dd < 2; ++dd) { const f32x16 a = dd ? acc1 : acc0;
#pragma unroll
                for (int g4 = 0; g4 < 4; ++g4) { v2u wv; wv.x = pg8::cvt_pk_bf16(a[4 * g4], a[4 * g4 + 1]); wv.y = pg8::cvt_pk_bf16(a[4 * g4 + 2], a[4 * g4 + 3]);
                    *(LAS v2u*)(SI + erow * 256 + (((4 * (dt0 + dd) + g4) ^ esw) << 4) + 8 * hi) = wv; } }
            __syncthreads();
            const float t_0 = tot[d], t_1 = tot[128 + d], t_2 = tot[256 + d], t_3 = tot[384 + d];
            const float pre = (tg > 0 ? t_0 : 0.f) + (tg > 1 ? t_1 : 0.f) + (tg > 2 ? t_2 : 0.f), b31 = t_0 + t_1, all = (t_0 + t_1) + (t_2 + t_3);
            { v4u c0, c1;
#pragma unroll
              for (int i2 = 0; i2 < 8; ++i2) { float kh2[2];
#pragma unroll
                for (int u = 0; u < 2; ++u) { const int i = 2 * i2 + u; const float b = pre + bl[i]; const int row = 16 * tg + i;
                  *(LAS bf16*)(lds + G_QA + eg * G64 + row * 16 + ei) = (bf16)pg8::cvt_pk_bf16(qv[i] * exp2_(b), 0.f);
                  *(LAS bf16*)(lds + G_KA1 + eg * G64 + row * 16 + ei) = (bf16)pg8::cvt_pk_bf16(kk[i] * exp2_(b31 - b), 0.f);
                  if (tg < 2) *(LAS bf16*)(lds + G_KA0 + eg * G32 + row * 16 + ei) = (bf16)pg8::cvt_pk_bf16(kk[i] * exp2_(-b), 0.f);
                  else *(LAS bf16*)(lds + G_QB + eg * G32 + (row - 32) * 16 + ei) = (bf16)pg8::cvt_pk_bf16(qv[i] * exp2_(b - b31), 0.f);
                  kh2[u] = kk[i] * exp2_(all - b); }
                const unsigned pw = pg8::cvt_pk_bf16(kh2[0], kh2[1]);
                if (i2 < 4) c0[i2] = pw; else c1[i2 - 4] = pw; }
              *(LAS v4u*)(KT + d * 128 + (((2 * tg) ^ fsw) << 4)) = c0; *(LAS v4u*)(KT + d * 128 + (((2 * tg + 1) ^ fsw) << 4)) = c1; }
            if (tg == 0) gt[d] = exp2_(all);
            if (j < 3) HG_RAW(h, c + 1); else if (nxt < NH * 32) { int nx_ = nxt; asm volatile("" : "+s"(nx_)); HG_RAW(nx_ >> 5, 4 * (nx_ & 31)); }
            __syncthreads();
            f32x16 o;
#pragma unroll
            for (int r = 0; r < 16; ++r) o[r] = 0.f;
            { const LAS unsigned char* qb_ = lds + G_QA + hi * G64 + (32 * tb + r32) * 16; const LAS unsigned char* sr_ = SI + erow * 256;
#pragma unroll
              for (int kd = 0; kd < 8; ++kd) { const bf16x8 a = *(const LAS bf16x8*)(sr_ + (((2 * kd + hi) ^ esw) << 4)); const bf16x8 b = *(const LAS bf16x8*)(qb_ + kd * (2 * G64)); o = __builtin_amdgcn_mfma_f32_32x32x16_bf16(a, b, o, 0, 0, 0); } }
            __builtin_amdgcn_sched_barrier(0);
            if (tb == 0) {
                f32x16 p;
#pragma unroll
                for (int r = 0; r < 16; ++r) p[r] = 0.f;
                const LAS unsigned char* ka = lds + G_KA0 + hi * G32 + pr * 16; const LAS unsigned char* qa = lds + G_QA + hi * G64 + r32 * 16;
#pragma unroll
                for (int kd = 0; kd < 8; ++kd) p = __builtin_amdgcn_mfma_f32_32x32x16_bf16(*(const LAS bf16x8*)(ka + kd * (2 * G32)), *(const LAS bf16x8*)(qa + kd * (2 * G64)), p, 0, 0, 0);
#pragma unroll
                for (int r = 0; r < 16; ++r) if (16 * (r >> 3) + 8 * hi + (r & 7) > r32) p[r] = 0.f;
                o = __builtin_amdgcn_mfma_f32_32x32x16_bf16(vf[0], pk8(p, 0), o, 0, 0, 0);
                o = __builtin_amdgcn_mfma_f32_32x32x16_bf16(vf[1], pk8(p, 8), o, 0, 0, 0);
            } else {
                f32x16 p0, p1;
#pragma unroll
                for (int r = 0; r < 16; ++r) { p0[r] = 0.f; p1[r] = 0.f; }
                const LAS unsigned char* ka = lds + G_KA1 + hi * G64 + pr * 16; const LAS unsigned char* qa = lds + G_QB + hi * G32 + r32 * 16;
#pragma unroll
                for (int kd = 0; kd < 8; ++kd) { const bf16x8 qf = *(const LAS bf16x8*)(qa + kd * (2 * G32));
                    p0 = __builtin_amdgcn_mfma_f32_32x32x16_bf16(*(const LAS bf16x8*)(ka + kd * (2 * G64)), qf, p0, 0, 0, 0);
                    p1 = __builtin_amdgcn_mfma_f32_32x32x16_bf16(*(const LAS bf16x8*)(ka + kd * (2 * G64) + 512), qf, p1, 0, 0, 0); }
#pragma unroll
                for (int r = 0; r < 16; ++r) if (16 * (r >> 3) + 8 * hi + (r & 7) > r32) p1[r] = 0.f;
                o = __builtin_amdgcn_mfma_f32_32x32x16_bf16(vf[0], pk8(p0, 0), o, 0, 0, 0);
                o = __builtin_amdgcn_mfma_f32_32x32x16_bf16(vf[1], pk8(p0, 8), o, 0, 0, 0);
                o = __builtin_amdgcn_mfma_f32_32x32x16_bf16(vf[2], pk8(p1, 0), o, 0, 0, 0);
                o = __builtin_amdgcn_mfma_f32_32x32x16_bf16(vf[3], pk8(p1, 8), o, 0, 0, 0);
            }
            __builtin_amdgcn_sched_barrier(0);
            if (j < 3) {
#pragma unroll
                for (int dd = 0; dd < 2; ++dd) { const int dt = dt0 + dd; f32x16 a = dd ? acc1 : acc0;
#pragma unroll
                    for (int g4 = 0; g4 < 4; ++g4) { const f32x4 gm = *(const LAS f32x4*)(gt + 32 * dt + 8 * g4 + 4 * hi); a[4 * g4] *= gm.x; a[4 * g4 + 1] *= gm.y; a[4 * g4 + 2] *= gm.z; a[4 * g4 + 3] *= gm.w; }
#pragma unroll
                    for (int ks = 0; ks < 4; ++ks) { const bf16x8 aq = *(const LAS bf16x8*)(KT + (32 * dt + r32) * 128 + (((2 * ks + hi) ^ fsr) << 4)); a = __builtin_amdgcn_mfma_f32_32x32x16_bf16(aq, vf[ks], a, 0, 0, 0); }
                    if (dd) acc1 = a; else acc0 = a; } }
            __builtin_amdgcn_sched_barrier(0);
            float ss = 0.f;
#pragma unroll
            for (int r = 0; r < 16; ++r) ss += o[r] * o[r];
            ss += __shfl_xor(ss, 32);
            if (hi == 0) SSP[(tb * 4 + et) * 32 + r32] = ss;
            __syncthreads();
            const float rstd = 1.0f / sqrtf((SSP[(tb * 4 + 0) * 32 + r32] + SSP[(tb * 4 + 1) * 32 + r32] + SSP[(tb * 4 + 2) * 32 + r32] + SSP[(tb * 4 + 3) * 32 + r32]) * (1.f / 128.f) + EPS);
            { const size_t ro = (size_t)(t0 + 32 * tb + r32) * 2048 + h * 128 + 32 * et + 4 * hi;
#pragma unroll
              for (int g4 = 0; g4 < 4; ++g4) { const v2u hv = hgv[g4]; const f32x4 gnv = *(const GAS f32x4*)(gain + 32 * et + 4 * hi + 8 * g4);
                  v2u ov; ov.x = pg8::cvt_pk_bf16(o[4 * g4] * rstd * gnv.x * bflo(hv.x), o[4 * g4 + 1] * rstd * gnv.y * bfhi(hv.x)); ov.y = pg8::cvt_pk_bf16(o[4 * g4 + 2] * rstd * gnv.z * bflo(hv.y), o[4 * g4 + 3] * rstd * gnv.w * bfhi(hv.y));
                  *(v2u*)(REC + ro + 8 * g4) = ov; } }
        }
    }
#undef HG_RAW
}
#undef HG_GATES
}

enum { I_X = 0, I_POS, I_ANG, I_WIN, I_QNG, I_WUQ, I_KVNG, I_WUKV, I_LBL, I_HONG, I_WA, I_WB, I_WO, I_FNG, I_WUP, I_CW, I_CB, I_WDN, I_FING };
constexpr int CV_SH1 = 112, CV_SH7 = 120, CV_N1 = 96 * CV_SH1, CV_N7 = CV_N1 + 84 * CV_SH7;
constexpr int CV_IN = 32 * (WINR / 32), CV_UQ = 8 * 96, CV_K = 8 * 64, CV_V = 8 * 64, CV_SQ = 32 * 64, CV_UP = 32 * 352, CV_DN = 88 * 64;
constexpr int CV_PER_LAYER = CV_IN + CV_UQ + CV_K + CV_V + 3 * CV_SQ + CV_UP + CV_DN;
__device__ __forceinline__ const float* inp_ptr(LAS unsigned char* lds, int i) {
    const unsigned long long v = ((LAS const unsigned long long*)(lds + MISC_OFF + 128))[i];
    return (const float*)(((unsigned long long)(unsigned)__builtin_amdgcn_readfirstlane((int)(v >> 32)) << 32) | (unsigned long long)(unsigned)__builtin_amdgcn_readfirstlane((int)(unsigned)v));
}
__device__ __forceinline__ void cvt_layer(unsigned char* ws, LAS unsigned char* lds, int l_, int first, int last, int stride) {
    int tid = threadIdx.x; asm volatile("" : "+v"(tid));
    const int lane = tid & 63, wave = __builtin_amdgcn_readfirstlane(tid >> 6);
    LAS float* scr = (LAS float*)(lds + RING_OFF + wave * 16384);
    const float* p_win = inp_ptr(lds, I_WIN); const float* p_wuq = inp_ptr(lds, I_WUQ); const float* p_wukv = inp_ptr(lds, I_WUKV); const float* p_wa = inp_ptr(lds, I_WA); const float* p_wb = inp_ptr(lds, I_WB);
    const float* p_wo = inp_ptr(lds, I_WO); const float* p_wup = inp_ptr(lds, I_WUP); const float* p_wdn = inp_ptr(lds, I_WDN); const float* p_qg = inp_ptr(lds, I_QNG); const float* p_kvg = inp_ptr(lds, I_KVNG);
    unsigned char* wl_ = ws + WS_W + (size_t)l_ * LW;
#define T_CLAIM(it) do { unsigned v_ = 0u; if (lane == 0) v_ = __hip_atomic_fetch_add(qc, 1u, __ATOMIC_RELAXED, __HIP_MEMORY_SCOPE_AGENT); (it) = __builtin_amdgcn_readfirstlane((int)v_); } while (0)
#define T_DECODE(it, T) do { int r_ = (it); int kind_, nblk_; (T).scale = nullptr; \
        if (r_ < CV_IN) { kind_ = 1; nblk_ = WINR / 32; (T).src = p_win + (size_t)l_ * DM * INW; (T).K = DM; (T).Nsrc = INW; (T).dst = (bf16*)(wl_ + LW_IN); } \
        else if ((r_ -= CV_IN) < CV_UQ) { kind_ = 2; nblk_ = 96; (T).src = p_wuq + (size_t)l_ * QL * 3072; (T).K = QL; (T).Nsrc = 3072; (T).dst = (bf16*)(wl_ + LW_UQ); (T).scale = p_qg + l_ * QL; } \
        else if ((r_ -= CV_UQ) < CV_K) { kind_ = 3; nblk_ = 64; (T).src = p_wukv + (size_t)l_ * KVL * 4096; (T).K = KVL; (T).Nsrc = 4096; (T).dst = (bf16*)(wl_ + LW_K); (T).scale = p_kvg + l_ * KVL; } \
        else if ((r_ -= CV_K) < CV_V) { kind_ = 4; nblk_ = 64; (T).src = p_wukv + (size_t)l_ * KVL * 4096; (T).K = KVL; (T).Nsrc = 4096; (T).dst = (bf16*)(wl_ + LW_V); (T).scale = p_kvg + l_ * KVL; } \
        else if ((r_ -= CV_V) < CV_SQ) { kind_ = 0; nblk_ = 64; (T).src = p_wa + (size_t)l_ * DM * DM; (T).K = DM; (T).Nsrc = DM; (T).dst = (bf16*)(wl_ + LW_A); } \
        else if ((r_ -= CV_SQ) < CV_SQ) { kind_ = 0; nblk_ = 64; (T).src = p_wb + (size_t)l_ * DM * DM; (T).K = DM; (T).Nsrc = DM; (T).dst = (bf16*)(wl_ + LW_B); } \
        else if ((r_ -= CV_SQ) < CV_SQ) { kind_ = 0; nblk_ = 64; (T).src = p_wo + (size_t)l_ * DM * DM; (T).K = DM; (T).Nsrc = DM; (T).dst = (bf16*)(wl_ + LW_O); } \
        else if ((r_ -= CV_SQ) < CV_UP) { kind_ = 5; nblk_ = 352; (T).src = p_wup + (size_t)l_ * DM * DFF2; (T).K = DM; (T).Nsrc = DFF2; (T).dst = (bf16*)(wl_ + LW_UP); } \
        else { r_ -= CV_UP; kind_ = 0; nblk_ = 64; (T).src = p_wdn + (size_t)l_ * DFF * DM; (T).K = DFF; (T).Nsrc = DM; (T).dst = (bf16*)(wl_ + LW_DN); } \
        (T).k0 = 64 * (r_ / nblk_); (T).n0 = 32 * (r_ % nblk_); (T).sc = srcmap_rt(kind_, (T).n0 + (lane & 31)); } while (0)
#define T_LOAD(T, V) do { const GAS float* sp_ = (const GAS float*)(T).src + (size_t)((T).k0 + (lane >> 5)) * (T).Nsrc + ((T).sc >= 0 ? (T).sc : 0); \
        _Pragma("unroll") for (int i = 0; i < 32; ++i) (V)[i] = __builtin_nontemporal_load(sp_ + (size_t)(2 * i) * (T).Nsrc); } while (0)
#define T_PROC(T, V) do { const bool z_ = (T).sc < 0; \
        if ((T).scale) { const GAS float* gp_ = (const GAS float*)(T).scale + (T).k0 + (lane >> 5); _Pragma("unroll") for (int i = 0; i < 32; ++i) (V)[i] *= gp_[2 * i]; } \
        _Pragma("unroll") for (int i = 0; i < 32; ++i) scr[(2 * i + (lane >> 5)) * 33 + (lane & 31)] = z_ ? 0.f : (V)[i]; \
        LDS_WAIT(); asm volatile("" ::: "memory"); \
        { const int c_ = lane & 7; _Pragma("unroll") for (int j = 0; j < 4; ++j) { const int n_ = (lane >> 3) + 8 * j; const LAS float* s_ = scr + (8 * c_) * 33 + n_; \
            v4u o_; o_.x = pk2(s_[0 * 33], s_[1 * 33]); o_.y = pk2(s_[2 * 33], s_[3 * 33]); o_.z = pk2(s_[4 * 33], s_[5 * 33]); o_.w = pk2(s_[6 * 33], s_[7 * 33]); \
            *(GAS v4u*)((T).dst + (size_t)((T).n0 + n_) * (T).K + (T).k0 + 8 * c_) = o_; } } \
        LDS_WAIT(); asm volatile("" ::: "memory"); } while (0)
    TItem ta, tb; float va[32], vb[32]; int it = first;
    if (it < last) { T_DECODE(it, ta); T_LOAD(ta, va); }
    while (it < last) {
        const int it1 = it + stride; if (it1 < last) { T_DECODE(it1, tb); T_LOAD(tb, vb); }
        T_PROC(ta, va);
        if (it1 >= last) break;
        const int it2 = it1 + stride; if (it2 < last) { T_DECODE(it2, ta); T_LOAD(ta, va); }
        T_PROC(tb, vb);
        it = it2; }
#undef T_CLAIM
#undef T_DECODE
#undef T_LOAD
#undef T_PROC
}

#ifndef PROBE
#define PROBE 0
#endif
#ifndef PROBE_T
#define PROBE_T 0
#endif
#define TSCALE 4
#define TICK(k) do { if (PROBE_T) { const unsigned long long now_ = __builtin_amdgcn_s_memrealtime(); if (PROBE_T == (k)) tacc += now_ - tprev; tprev = now_; } } while (0)
#define REPS(k) (((PROBE >> (k)) & 1) + 1)
#define XBAR(b) do { for (int rb_ = 0; rb_ < REPS(8); ++rb_) xcd_barrier(b); } while (0)
#ifndef NAIVE_ATTN
#define NAIVE_ATTN 0
#endif
#ifndef NAIVE_HGRN
#define NAIVE_HGRN 0
#endif
struct Args { const float* in[19]; float* out; unsigned char* ws; };

__global__ void __launch_bounds__(NTHR, 2) mk_fwd(Args args) {
    extern __shared__ __attribute__((aligned(16))) unsigned char lds_raw[];
    LAS unsigned char* lds = (LAS unsigned char*)lds_raw;
    const int tid = threadIdx.x, lane = tid & 63, wave = __builtin_amdgcn_readfirstlane(tid >> 6);
    const int G = gridDim.x, bx = blockIdx.x, vcu = (G % 8 == 0) ? (bx % 8) * (G / 8) + bx / 8 : bx;
    const int gw = vcu * NWAVES + wave, ngw = G * NWAVES;
    unsigned char* ws = args.ws;
    for (int u = tid; u < (LDS_BYTES - LDSCTL_OFF) / 4; u += NTHR) ((LAS unsigned*)(lds + LDSCTL_OFF))[u] = 0u;
    __syncthreads();
    XcdBarrier bar = xcd_barrier_post((unsigned*)(ws + WS_CTL) + CW_BAR, (volatile LAS unsigned*)(lds + MISC_OFF) + 8);
    float* X = args.out;
    unsigned long long tacc = 0ull, tprev = PROBE_T ? __builtin_amdgcn_s_memrealtime() : 0ull;
    if (tid < 19) ((LAS unsigned long long*)(lds + MISC_OFF + 128))[tid] = ((const __attribute__((address_space(4))) unsigned long long*)__builtin_amdgcn_kernarg_segment_ptr())[tid];
    __syncthreads();
#define INP(i) ((const float*)(((unsigned long long)(unsigned)__builtin_amdgcn_readfirstlane((int)(((LAS const unsigned long long*)(lds + MISC_OFF + 128))[i] >> 32)) << 32) | (unsigned long long)(unsigned)__builtin_amdgcn_readfirstlane((int)(unsigned)((LAS const unsigned long long*)(lds + MISC_OFF + 128))[i])))

    for (int rep = 0; rep < REPS(4); ++rep) {
        cvt_layer(ws, lds, 0, gw, CV_PER_LAYER, ngw);
        { const GAS int* pos = (const GAS int*)INP(I_POS); float* COS = (float*)(ws + WS_COS); float* SIN = (float*)(ws + WS_SIN);
          for (int i = vcu * NTHR + tid; i < S_ * 32; i += G * NTHR) { const float ang = (float)pos[i >> 5] * c_invf[i & 31]; float sn, cs; sincos_f64(ang, sn, cs); COS[i] = cs; SIN[i] = sn; } }
        { const GAS float* lg = (const GAS float*)INP(I_LBL); float* LB = (float*)(ws + WS_LB);
          for (int c = vcu * NTHR + tid; c < 2048; c += G * NTHR) { const float a0 = lg[c], a1 = lg[2048 + c], a2 = lg[4096 + c], a3 = lg[6144 + c];
              const float mx = fmaxf(fmaxf(a0, a1), fmaxf(a2, a3)); const float e0 = expf(a0 - mx), e1 = expf(a1 - mx), e2 = expf(a2 - mx), e3 = expf(a3 - mx); const float inv = 1.f / (e0 + e1 + e2 + e3);
              LB[c] = 0.f; LB[2048 + c] = e1 * inv; LB[4096 + c] = (e1 + e2) * inv; LB[6144 + c] = (e1 + e2 + e3) * inv; } }
        for (int i = vcu * NTHR + tid; i < 2 * DM / 8; i += G * NTHR) *(GAS v4u*)(ws + WS_XN - 2 * DM * 2 + (size_t)i * 16) = (v4u){0u, 0u, 0u, 0u};
        for (int m = gw; m < S_; m += ngw) rms_row_to_bf16(INP(I_X) + (size_t)m * DM, INP(I_ANG), (bf16*)(ws + WS_XN) + (size_t)m * DM, X + (size_t)m * DM, lane, (float*)(ws + WS_RSTD) + m);
    }
    XBAR(bar); TICK(1);

    for (int l = 0; l < DEPTH; ++l) {
        unsigned char* wl = ws + WS_W + (size_t)l * LW;
#define lane_l ({ int l_ = (int)threadIdx.x; asm volatile("" : "+v"(l_)); l_ & 63; })
        GAS unsigned char* wsg_ = (GAS unsigned char*)ws; GAS float* xg_ = (GAS float*)X; int Gl = G, bxl = bx, gwl = gw, ngwl = ngw, vcul = vcu;
        asm volatile("" : "+s"(wsg_), "+s"(Gl), "+s"(bxl), "+s"(gwl), "+s"(ngwl), "+s"(vcul), "+s"(xg_));
        unsigned char* wsl = (unsigned char*)wsg_; float* Xl = (float*)xg_;
        for (int rep = 0; rep < REPS(1); ++rep)
        { pg8::Gemm g{(const pg8::bf16_t*)(wsl + WS_XN), (const pg8::bf16_t*)(wl + LW_IN), S_, NNAT, DM, DM, DM}; pg8::StaticOrder S; S.init(S_, NNAT, Gl, bxl);
          pg8::EpiIn E{wsl}; pg8::gemm_phase<pg8::EpiIn, pg8::StaticOrder, true, true>(lds + RING_OFF, g, S, E); }
        TICK(2);
        { pg8::Gemm g{(const pg8::bf16_t*)(wl + LW_IN) + (size_t)NNAT * DM, (const pg8::bf16_t*)(wsl + WS_XN), 2048, S_, DM, DM, DM}; pg8::StaticOrder S; S.init(2048, S_, Gl, bxl);
          pg8::EpiStoreCS E{(pg8::bf16_t*)(wsl + WS_VTH), S_, (const float*)(wsl + WS_RSTD)}; pg8::gemm_phase<pg8::EpiStoreCS, pg8::StaticOrder, true, true>(lds + RING_OFF, g, S, E); }
        if (l + 1 < DEPTH) {
            if (Gl == 256 && bxl >= 160) { const int b0_ = (bxl - 160) * CV_SH1; cvt_layer(wsl, lds, l + 1, b0_ + wave, b0_ + CV_SH1, NWAVES); } }
        XBAR(bar); TICK(3);
        for (int rep = 0; rep < REPS(3); ++rep) latent_rstd(wsl, vcul * NTHR + (int)threadIdx.x, Gl * NTHR);
        TICK(4);
        for (int rep = 0; rep < REPS(2); ++rep) hg::passA(wsl, lds + RING_OFF, l, vcul, Gl);
        XBAR(bar); TICK(6);
        for (int rep = 0; rep < REPS(2); ++rep) { if (Gl == 256) { if (bxl >= 128) hg::scanG2(wsl, (bxl - 128) * NTHR + (int)threadIdx.x); } else hg::scanG(wsl, vcul * NTHR + (int)threadIdx.x, Gl * NTHR); }
        TICK(7);
        for (int rep = 0; rep < REPS(6); ++rep) {
        { pg8::Gemm g{(const pg8::bf16_t*)(wsl + WS_CQKV), (const pg8::bf16_t*)(wl + LW_UQ), S_, 3072, QL, 1024, QL}; pg8::StaticOrder S; S.init(S_, 3072, Gl, bxl);
          pg8::EpiQ E{wsl}; pg8::gemm_phase<pg8::EpiQ, pg8::StaticOrder, true, true>(lds + RING_OFF, g, S, E); }
        { pg8::Gemm g{(const pg8::bf16_t*)(wsl + WS_CQKV) + 512, (const pg8::bf16_t*)(wl + LW_K), S_, 2048, KVL, 1024, KVL}; pg8::StaticOrder S; S.init(S_, 2048, Gl, bxl);
          pg8::EpiStoreRS E{(pg8::bf16_t*)(wsl + WS_KN), 2048, (const float*)(wsl + WS_LRKV)}; pg8::gemm_phase<pg8::EpiStoreRS, pg8::StaticOrder, true, true>(lds + RING_OFF, g, S, E); }
        { pg8::Gemm g{(const pg8::bf16_t*)(wl + LW_V), (const pg8::bf16_t*)(wsl + WS_CQKV) + 512, 2048, S_, KVL, KVL, 1024}; pg8::StaticOrder S; S.init(2048, S_, Gl, bxl);
          pg8::EpiStoreCS E{(pg8::bf16_t*)(wsl + WS_VT), S_, (const float*)(wsl + WS_LRKV)}; pg8::gemm_phase<pg8::EpiStoreCS, pg8::StaticOrder, true, true>(lds + RING_OFF, g, S, E); }
        }
        TICK(5);
#if NAIVE_HGRN
        hgrn_naive(wsl, l, gwl, ngwl, lane_l);
        XBAR(bar);
#else
        XBAR(bar);
#endif
#if NAIVE_ATTN
        attn_naive(wsl, (LAS float*)(lds + RING_OFF) + wave * 192, gwl, ngwl, lane_l);
#else
        for (int rep = 0; rep < REPS(0); ++rep) fa16::attn_fast(wsl, lds + RING_OFF, (unsigned*)(wsl + WS_CTL) + CW_QUE + l * 1024, (LAS unsigned*)(lds + MISC_OFF + 64), bar.x);
        TICK(8);
#endif
#if NAIVE_HGRN
        hgrn_normgate(wsl, INP(I_HONG) + l * 128, gwl, ngwl, lane_l);
#else
        for (int rep = 0; rep < REPS(2); ++rep) hg::pass3g(wsl, lds + RING_OFF, INP(I_HONG) + l * 128, l, vcul, Gl);
#endif
        XBAR(bar); TICK(9);
        for (int rep = 0; rep < REPS(7); ++rep) {
        { pg8::Gemm g{(const pg8::bf16_t*)(wsl + WS_ATT), (const pg8::bf16_t*)(wl + LW_A), S_, DM, DM, DM, DM}; pg8::PairOrder S; S.init(S_, DM, Gl, bxl);
          pg8::EpiGateAB E{wsl}; pg8::gemm_phase<pg8::EpiGateAB, pg8::PairOrder, true, true>(lds + RING_OFF, g, S, E); }
        }
        XBAR(bar); TICK(10);
        { pg8::Gemm g{(const pg8::bf16_t*)(wsl + WS_MRG), (const pg8::bf16_t*)(wl + LW_O), S_, DM, DM, DM, DM}; pg8::StaticOrder S; S.init(S_, DM, Gl, bxl);
          pg8::EpiResN E{Xl, (pg8::bf16_t*)(wsl + WS_XN), INP(I_FNG) + l * DM, (float*)(wsl + WS_SSQ)}; pg8::gemm_phase<pg8::EpiResN, pg8::StaticOrder, true, true>(lds + RING_OFF, g, S, E); }
        if (Gl == 256) {
            pg8::StaticOrder S5; S5.init(S_, DM, Gl, bxl); pg8::Unit u5; (void)S5.next(0, u5);
            unsigned* cnt5 = (unsigned*)(wsl + WS_CTL) + CW_PAN + ((2 * l) * 32 + u5.pm) * 32;
            if (threadIdx.x == 0) (void)__hip_atomic_fetch_add(cnt5, 1u, __ATOMIC_RELAXED, __HIP_MEMORY_SCOPE_AGENT);
            if (u5.pn == 0) {
                if (wave == 0) { unsigned sp_ = 0u; while (__hip_atomic_load(cnt5, __ATOMIC_RELAXED, __HIP_MEMORY_SCOPE_AGENT) < 8u && ++sp_ < (1u << 22)) __builtin_amdgcn_s_sleep(1);
                                 __builtin_amdgcn_fence(__ATOMIC_ACQUIRE, "agent"); }
                __syncthreads();
                rstd_panel(wsl, u5.pm, wave, lane_l);
            }
        } else { XBAR(bar); rstd_phase(wsl, gwl, ngwl, lane_l); }
        XBAR(bar); TICK(12);
        for (int rep = 0; rep < REPS(5); ++rep)
        { pg8::Gemm g{(const pg8::bf16_t*)(wsl + WS_XN) - 2 * DM, (const pg8::bf16_t*)(wl + LW_UP), 33 * 256, DFF2, DM, DM, DM, 254}; pg8::StaticOrder S; S.init(33 * 256, DFF2, Gl, bxl);
          pg8::EpiConv E{(pg8::bf16_t*)(wsl + WS_ACT), INP(I_CW) + (size_t)l * 3 * DFF2, INP(I_CB) + (size_t)l * DFF2, (PG8_LAS float*)(lds + LDSCTL_OFF + 1024), (const float*)(wsl + WS_RSTD)};
          pg8::gemm_phase<pg8::EpiConv, pg8::StaticOrder, true, true>(lds + RING_OFF, g, S, E); }
        if (l + 1 < DEPTH) {
            if (Gl == 256 && bxl >= 172) { const int b0_ = CV_N1 + (bxl - 172) * CV_SH7; cvt_layer(wsl, lds, l + 1, b0_ + wave, b0_ + CV_SH7, NWAVES); } }
        xcd_barrier(bar); TICK(13);
        { pg8::Gemm g{(const pg8::bf16_t*)(wsl + WS_ACT), (const pg8::bf16_t*)(wl + LW_DN), S_, DM, DFF, DFF, DFF}; pg8::StaticOrder S; S.init(S_, DM, Gl, bxl);
          if (l + 1 == DEPTH && Gl == 256) {
              pg8::EpiResFinal E{Xl, INP(I_FING), (float*)(wsl + WS_SSQ), (unsigned*)(wsl + WS_CTL) + CW_PAN + (2 * l + 1) * 32 * 32};
              pg8::gemm_phase<pg8::EpiResFinal, pg8::StaticOrder, true, true>(lds + RING_OFF, g, S, E); }
          else {
          pg8::EpiResN E{Xl, (pg8::bf16_t*)(wsl + WS_XN), (l + 1 < DEPTH) ? INP(I_ANG) + (l + 1) * DM : INP(I_FING), (float*)(wsl + WS_SSQ)};
          pg8::gemm_phase<pg8::EpiResN, pg8::StaticOrder, true, true>(lds + RING_OFF, g, S, E); } }
        if (l + 1 < DEPTH && Gl == 256) {
            pg8::StaticOrder S9; S9.init(S_, DM, Gl, bxl); pg8::Unit u9; (void)S9.next(0, u9);
            unsigned* cnt9 = (unsigned*)(wsl + WS_CTL) + CW_PAN + ((2 * l + 1) * 32 + u9.pm) * 32;
            if (threadIdx.x == 0) (void)__hip_atomic_fetch_add(cnt9, 1u, __ATOMIC_RELAXED, __HIP_MEMORY_SCOPE_AGENT);
            TICK(14);
            cvt_layer(wsl, lds, l + 1, CV_N7 + gwl, CV_PER_LAYER, ngwl);
            if (u9.pn == 0) {
                if (wave == 0) { unsigned sp_ = 0u; while (__hip_atomic_load(cnt9, __ATOMIC_RELAXED, __HIP_MEMORY_SCOPE_AGENT) < 8u && ++sp_ < (1u << 22)) __builtin_amdgcn_s_sleep(1);
                                 __builtin_amdgcn_fence(__ATOMIC_ACQUIRE, "agent"); }
                __syncthreads();
                rstd_panel(wsl, u9.pm, wave, lane_l);
            }
            XBAR(bar);
        } else if (l + 1 == DEPTH && Gl == 256) { TICK(14);
        } else {
            XBAR(bar); TICK(14);
            if (l + 1 < DEPTH) { rstd_phase(wsl, gwl, ngwl, lane_l);
                cvt_layer(wsl, lds, l + 1, gwl, CV_PER_LAYER, ngwl);
                XBAR(bar); }
            else { for (int m = gwl; m < S_; m += ngwl) rms_row_f32(Xl + (size_t)m * DM, INP(I_FING), lane_l); }
        }
        TICK(15);
    }
    if (PROBE_T && blockIdx.x == 0) { const unsigned long long t0_ = __builtin_amdgcn_s_memrealtime(); while (__builtin_amdgcn_s_memrealtime() - t0_ < TSCALE * tacc) __builtin_amdgcn_s_sleep(8); }
}

#undef lane_l
extern "C" void kernel_launch(void* const* d_in, const int* in_sizes, int n_in, void* d_out, int out_size, void* d_ws, size_t ws_size, hipStream_t stream) {
    static int grid = 0;
    if (grid == 0) {
        if (n_in != 19 || in_sizes[0] != S_ * DM || out_size != S_ * DM || ws_size < WS_END) { fprintf(stderr, "kernel_launch: shape/workspace mismatch (n_in %d, in0 %d, out %d, ws %zu need %zu)\n", n_in, n_in > 0 ? in_sizes[0] : -1, out_size, ws_size, (size_t)WS_END); grid = -1; return; }
        int dev = 0, cus = 0, per_cu = 0;
        if (hipGetDevice(&dev) != hipSuccess || hipDeviceGetAttribute(&cus, hipDeviceAttributeMultiprocessorCount, dev) != hipSuccess) { grid = -1; return; }
        if (hipFuncSetAttribute((const void*)mk_fwd, hipFuncAttributeMaxDynamicSharedMemorySize, LDS_BYTES) != hipSuccess) { fprintf(stderr, "kernel_launch: hipFuncSetAttribute failed\n"); grid = -1; return; }
        if (hipOccupancyMaxActiveBlocksPerMultiprocessor(&per_cu, (const void*)mk_fwd, NTHR, LDS_BYTES) != hipSuccess || per_cu < 1) { fprintf(stderr, "kernel_launch: occupancy query reports %d blocks per CU\n", per_cu); }
        (void)hipGetLastError();
        grid = cus;
    }
    if (grid < 0) return;
    if (hipMemsetAsync((char*)d_ws + WS_CTL, 0, CTL_ZERO_BYTES, stream) != hipSuccess) return;
    Args a{};
    for (int i = 0; i < 19; ++i) a.in[i] = (const float*)d_in[i];
    a.out = (float*)d_out; a.ws = (unsigned char*)d_ws;
    hipLaunchKernelGGL(mk_fwd, dim3(grid), dim3(NTHR), LDS_BYTES, stream, a);
}
```

```cpp
#include <hip/hip_runtime.h>
#include <cstdio>
#include <cstdint>
namespace pg8 {
#define PG8_LAS __attribute__((address_space(3)))
typedef unsigned short bf16_t;
typedef short bf16x8 __attribute__((ext_vector_type(8)));
typedef float f32x4 __attribute__((ext_vector_type(4)));
typedef unsigned u32x4 __attribute__((ext_vector_type(4)));
constexpr int BM = 256, BK = 64, HALF = 128, HTB = HALF * BK * 2  , STAGE_BYTES = 8 * HTB, NXCD = 8, WGM = 8;

__host__ __device__ __forceinline__ int lds_byte(int r, int c) { const int st = (r >> 4) * 2 + (c >> 5), rr = r & 15, cc = c & 31, ob = rr * 64 + cc * 2; return st * 1024 + (ob ^ (((ob >> 9) & 1) << 5)); }
__host__ __device__ __forceinline__ void stage_rc(int b, int& R, int& C) { const int st = b / 1024, sb = b % 1024, swz = sb ^ (((sb >> 9) & 1) << 5); R = (st >> 1) * 16 + swz / 64; C = (st & 1) * 32 + (swz % 64) / 2; }
__host__ __device__ __forceinline__ int perm32(int rho) { const int n = rho >> 4, i = rho & 15; return 8 * (i >> 2) + 4 * n + (i & 3); }

struct Unit { int pm, pn; int kind = 0; };
struct Gemm { const bf16_t* A; const bf16_t* Bt; int M, N, K, lda, ldb; int mstep = BM; };

struct StaticOrder {
    int nM, nN, nwg, G, c;
    __host__ __device__ void init(int M, int N, int G_, int c_) { nM = M / BM; nN = N / BM; nwg = nM * nN; G = G_; c = c_; }
    __host__ __device__ __forceinline__ bool next(int i, Unit& u) const {
        const long L = (long)i * G + c; if (L >= nwg) return false;
        int wgid = (int)L; { const int q = nwg / NXCD, r = nwg % NXCD, xcd = wgid % NXCD, off = wgid / NXCD; wgid = (xcd < r ? xcd * (q + 1) : r * (q + 1) + (xcd - r) * q) + off; }
        const int nig = WGM * nN, gid = wgid / nig, fm = gid * WGM, gsz = (nM - fm) < WGM ? (nM - fm) : WGM;
        u.pm = fm + ((wgid % nig) % gsz); u.pn = (wgid % nig) / gsz; return true;
    }
    __device__ __forceinline__ void a_ready(const Unit&) const {}
    __device__ __forceinline__ void done(const Unit&) const {}
};

struct PairOrder {
    StaticOrder T;
    __host__ __device__ void init(int M, int N, int G_, int c_) { T.init(M, N, G_, c_); }
    __host__ __device__ bool next(int i, Unit& u) const { if (!T.next(i >> 1, u)) return false; u.kind = i & 1; return true; }
    __device__ __forceinline__ void a_ready(const Unit&) const {}
    __device__ __forceinline__ void done(const Unit&) const {}
};

typedef float cvt_f32x2_t __attribute__((ext_vector_type(2))); typedef __bf16 cvt_bf16x2_t __attribute__((ext_vector_type(2)));
__device__ __forceinline__ unsigned cvt_pk_bf16(float lo, float hi) { const cvt_f32x2_t v = {lo, hi}; const cvt_bf16x2_t b = __builtin_convertvector(v, cvt_bf16x2_t); return __builtin_bit_cast(unsigned, b); }
template <class Epi, int WHICH> __device__ __forceinline__ size_t kind_off(const Unit& u) { if constexpr (Epi::CHAIN) return (size_t)u.kind * (WHICH ? Epi::B_KIND : Epi::A_KIND); else return 0; }
template <class Epi, class Sched, bool ALIGN_EPI = false, bool SP2 = false>
__device__ __forceinline__ void gemm_phase(PG8_LAS unsigned char* lds, const Gemm g, const Sched& S, const Epi& E) {
    int tid = threadIdx.x; asm volatile("" : "+v"(tid));
    const int wid = __builtin_amdgcn_readfirstlane(tid >> 6), lane = tid & 63, wr = wid >> 2, wc = wid & 3, fr = lane & 15, fq = lane >> 4;
    const int K = g.K, nt = K / BK;
    unsigned voffA[2], voffB[2];
#pragma unroll
    for (int i = 0; i < 2; ++i) { int R, C; stage_rc(tid * 16 + i * 8192, R, C); const int Rb = Epi::PERM ? ((R & ~31) + perm32(R & 31)) : R;
        voffA[i] = (unsigned)(R * g.lda + C) * 2u; voffB[i] = (unsigned)(Rb * g.ldb + C) * 2u; }
    const size_t kstep = (size_t)(BK * 2);
    const size_t hstepA = (size_t)HALF * g.lda * 2, hstepB = (size_t)HALF * g.ldb * 2;
    const size_t tstepA = (size_t)g.mstep * g.lda * 2, tstepB = 2 * hstepB;
    const unsigned ldsw = (unsigned)wid * 1024u;
    const int aoff = lds_byte(wr * 64 + fr, fq * 8), boff = lds_byte(wc * 32 + fr, fq * 8);
#define PG8_SA(b, h) (((b) * 2 + (h)) * HTB)
#define PG8_SB(b, h) ((4 + (b) * 2 + (h)) * HTB)
#define PG8_STAGE(bufoff, gbase, voff) do { _Pragma("unroll") for (int _i = 0; _i < 2; ++_i) \
        __builtin_amdgcn_global_load_lds((const unsigned*)((const char*)(gbase) + (voff)[_i]), (PG8_LAS unsigned*)(lds + (bufoff) + ldsw + _i * 8192), 16, 0, 0); } while (0)
#define PG8_LDA(dst, b, h) do { _Pragma("unroll") for (int m = 0; m < 4; ++m) _Pragma("unroll") for (int k = 0; k < 2; ++k) dst[m][k] = *(const PG8_LAS bf16x8*)(lds + PG8_SA(b, h) + aoff + m * 2048 + k * 1024); } while (0)
#define PG8_LDB(dst, b, h) do { _Pragma("unroll") for (int n = 0; n < 2; ++n) _Pragma("unroll") for (int k = 0; k < 2; ++k) dst[n][k] = *(const PG8_LAS bf16x8*)(lds + PG8_SB(b, h) + boff + n * 2048 + k * 1024); } while (0)
#define PG8_MMA(ai, bj, At, Bt) do { __builtin_amdgcn_s_setprio(1); _Pragma("unroll") for (int m = 0; m < 4; ++m) _Pragma("unroll") for (int n = 0; n < 2; ++n) _Pragma("unroll") for (int k = 0; k < 2; ++k) \
        acc[ai][bj][m][n] = __builtin_amdgcn_mfma_f32_16x16x32_bf16(Bt[n][k], At[m][k], acc[ai][bj][m][n], 0, 0, 0); __builtin_amdgcn_s_setprio(0); } while (0)
#define PG8_WAIT_V(n) asm volatile("s_waitcnt vmcnt(" #n ")" ::: "memory")
#define PG8_WAIT_L(n) asm volatile("s_waitcnt lgkmcnt(" #n ")" ::: "memory")
#define PG8_BAR __builtin_amdgcn_s_barrier()
#define PG8_SCHED __builtin_amdgcn_sched_barrier(0)
    Unit cur, nxt; int ui = 0;
    if (!S.next(0, cur)) return;
    f32x4 acc[2][2][4][2];
#pragma unroll
    for (int a = 0; a < 2; ++a)
#pragma unroll
        for (int b = 0; b < 2; ++b)
#pragma unroll
            for (int m = 0; m < 4; ++m)
#pragma unroll
                for (int n = 0; n < 2; ++n) acc[a][b][m][n] = (f32x4){0.f, 0.f, 0.f, 0.f};
    bf16x8 At[4][2], B0[2][2], B1[2][2];
#define PG8_KA(u_) kind_off<Epi, 0>(u_)
#define PG8_KB(u_) kind_off<Epi, 1>(u_)
    const char* cA = (const char*)g.A + (size_t)cur.pm * tstepA + PG8_KA(cur); const char* cB = (const char*)g.Bt + (size_t)cur.pn * tstepB + PG8_KB(cur);
    S.a_ready(cur);
    if constexpr (SP2) {
        PG8_STAGE(PG8_SB(0, 0), cB, voffB); PG8_STAGE(PG8_SB(0, 1), cB + hstepB, voffB); PG8_STAGE(PG8_SA(0, 0), cA, voffA); PG8_STAGE(PG8_SA(0, 1), cA + hstepA, voffA);
        if (wr == 1) PG8_BAR;
        PG8_WAIT_V(2); PG8_BAR;
        PG8_STAGE(PG8_SB(1, 0), cB + kstep, voffB); PG8_STAGE(PG8_SA(1, 0), cA + kstep, voffA); PG8_STAGE(PG8_SB(1, 1), cB + hstepB + kstep, voffB);
        PG8_WAIT_V(6); PG8_BAR;
    } else {
        PG8_STAGE(PG8_SB(0, 0), cB, voffB); PG8_STAGE(PG8_SA(0, 0), cA, voffA); PG8_STAGE(PG8_SB(0, 1), cB + hstepB, voffB); PG8_STAGE(PG8_SA(0, 1), cA + hstepA, voffA);
        if (wr == 1) PG8_BAR;
        PG8_WAIT_V(4); PG8_BAR;
        PG8_STAGE(PG8_SB(1, 0), cB + kstep, voffB); PG8_STAGE(PG8_SA(1, 0), cA + kstep, voffA); PG8_STAGE(PG8_SB(1, 1), cB + hstepB + kstep, voffB);
        PG8_WAIT_V(6); PG8_BAR;
    }
    for (;;) {
        const bool has_next = S.next(ui + 1, nxt);
        const char* nA = has_next ? (const char*)g.A + (size_t)nxt.pm * tstepA + PG8_KA(nxt) : cA; const char* nB = has_next ? (const char*)g.Bt + (size_t)nxt.pn * tstepB + PG8_KB(nxt) : cB;
        for (int t = 0; t < nt; t += 2) {
            const bool last = (t == nt - 2);
            const char* a1 = cA + (size_t)(t + 1) * kstep;
            const char* a2 = last ? nA : cA + (size_t)(t + 2) * kstep; const char* b2 = last ? nB : cB + (size_t)(t + 2) * kstep;
            const char* a3 = a2 + kstep; const char* b3 = b2 + kstep;
            if (last && has_next) S.a_ready(nxt);
            if constexpr (SP2) {
            PG8_LDB(B0, 0, 0); PG8_LDB(B1, 0, 1); PG8_SCHED; PG8_LDA(At, 0, 0); PG8_STAGE(PG8_SA(1, 1), a1 + hstepA, voffA);
            PG8_WAIT_V(8); PG8_WAIT_L(0); PG8_BAR; PG8_MMA(0, 0, At, B0); PG8_MMA(0, 1, At, B1); PG8_BAR; PG8_SCHED;
            PG8_LDA(At, 0, 1); PG8_STAGE(PG8_SB(0, 0), b2, voffB); PG8_STAGE(PG8_SB(0, 1), b2 + hstepB, voffB); PG8_STAGE(PG8_SA(0, 0), a2, voffA);
            PG8_WAIT_V(8); PG8_WAIT_L(0); PG8_BAR; PG8_MMA(1, 0, At, B0); PG8_MMA(1, 1, At, B1); PG8_BAR; PG8_SCHED;
            PG8_LDB(B0, 1, 0); PG8_LDB(B1, 1, 1); PG8_SCHED; PG8_LDA(At, 1, 0); PG8_STAGE(PG8_SA(0, 1), a2 + hstepA, voffA);
            PG8_WAIT_V(8); PG8_WAIT_L(0); PG8_BAR; PG8_MMA(0, 0, At, B0); PG8_MMA(0, 1, At, B1); PG8_BAR; PG8_SCHED;
            PG8_LDA(At, 1, 1); PG8_STAGE(PG8_SB(1, 0), b3, voffB); PG8_STAGE(PG8_SB(1, 1), b3 + hstepB, voffB); PG8_STAGE(PG8_SA(1, 0), a3, voffA);
            PG8_WAIT_V(8); PG8_WAIT_L(0); PG8_BAR; PG8_MMA(1, 0, At, B0); PG8_MMA(1, 1, At, B1); PG8_BAR; PG8_SCHED;
            } else {
            PG8_LDB(B0, 0, 0); PG8_SCHED; PG8_LDA(At, 0, 0); PG8_STAGE(PG8_SA(1, 1), a1 + hstepA, voffA);
            PG8_WAIT_L(8); PG8_BAR; PG8_WAIT_L(0); PG8_MMA(0, 0, At, B0); PG8_BAR; PG8_SCHED;
            PG8_LDB(B1, 0, 1); PG8_STAGE(PG8_SB(0, 0), b2, voffB);
            PG8_BAR; PG8_WAIT_L(0); PG8_MMA(0, 1, At, B1); PG8_BAR;
            PG8_LDA(At, 0, 1); PG8_STAGE(PG8_SA(0, 0), a2, voffA);
            PG8_BAR; PG8_WAIT_L(0); PG8_MMA(1, 0, At, B0); PG8_BAR; PG8_SCHED;
            PG8_STAGE(PG8_SB(0, 1), b2 + hstepB, voffB);
            PG8_WAIT_V(6); PG8_BAR; PG8_MMA(1, 1, At, B1); PG8_BAR;
            PG8_LDB(B0, 1, 0); PG8_SCHED; PG8_LDA(At, 1, 0); PG8_STAGE(PG8_SA(0, 1), a2 + hstepA, voffA);
            PG8_WAIT_L(8); PG8_BAR; PG8_WAIT_L(0); PG8_MMA(0, 0, At, B0); PG8_BAR; PG8_SCHED;
            PG8_LDB(B1, 1, 1); PG8_STAGE(PG8_SB(1, 0), b3, voffB);
            PG8_BAR; PG8_WAIT_L(0); PG8_MMA(0, 1, At, B1); PG8_BAR;
            PG8_LDA(At, 1, 1); PG8_STAGE(PG8_SA(1, 0), a3, voffA);
            PG8_BAR; PG8_WAIT_L(0); PG8_MMA(1, 0, At, B0); PG8_BAR; PG8_SCHED;
            PG8_STAGE(PG8_SB(1, 1), b3 + hstepB, voffB);
            PG8_WAIT_V(6); PG8_BAR; PG8_MMA(1, 1, At, B1); PG8_BAR;
            }
        }
        if constexpr (ALIGN_EPI) { if (wr == 0) PG8_BAR; }
        if constexpr (Epi::PRESCALE) E.prescale(acc, cur, wr, wc, fr, fq);
        if constexpr (Epi::CHAIN) { if (cur.kind == 0) E.link(acc, cur, wr, wc, fr, fq); else E(acc, cur, wr, wc, fr, fq); }
        else if constexpr (!Epi::AFTER_DRAIN) { E(acc, cur, wr, wc, fr, fq); S.done(cur); }
        if (!has_next) break;
        if (!Epi::CHAIN || nxt.kind == 0) {
#pragma unroll
        for (int a = 0; a < 2; ++a)
#pragma unroll
            for (int b = 0; b < 2; ++b)
#pragma unroll
                for (int m = 0; m < 4; ++m)
#pragma unroll
                    for (int n = 0; n < 2; ++n) acc[a][b][m][n] = (f32x4){0.f, 0.f, 0.f, 0.f};
        }
        cur = nxt; cA = nA; cB = nB; ++ui;
        if constexpr (ALIGN_EPI) { if (wr == 1) PG8_BAR; }
    }
    PG8_WAIT_V(0);
    if constexpr (!ALIGN_EPI) { if (wr == 0) PG8_BAR; }
    PG8_BAR;
    if constexpr (Epi::AFTER_DRAIN) { E.fused(acc, cur, wr, wc, fr, fq, lds, wid, lane); S.done(cur); }
#undef PG8_KA
#undef PG8_KB
#undef PG8_SA
#undef PG8_SB
#undef PG8_STAGE
#undef PG8_LDA
#undef PG8_LDB
#undef PG8_MMA
#undef PG8_WAIT_V
#undef PG8_WAIT_L
#undef PG8_BAR
#undef PG8_SCHED
}
}

constexpr int S_ = 8192, DM = 2048, DEPTH = 4, NH = 16;
constexpr int QL = 512, KVL = 512, ROPE = 64, NOPE = 128, VD = 128;
constexpr int INW = 13376;
constexpr int DFF = 5632, DFF2 = 11264;
constexpr int NNAT = 11520;
constexpr int WINR = NNAT + 2048;
constexpr float EPS = 1e-6f;
constexpr float LOG2E = 1.4426950408889634f;
constexpr float QSCALE = 0.07216878364870323f * 1.4426950408889634f;
constexpr int NWAVES = 8, NTHR = 512;

constexpr size_t MiB = 1u << 20;
constexpr size_t WS_CTL = 0, CTL_ZERO_BYTES = 128 * 1024;
constexpr size_t WS_COS = 1 * MiB, WS_SIN = 2 * MiB, WS_LB = 3 * MiB, WS_SSQ = 4 * MiB;
constexpr size_t WS_W = 5 * MiB;
constexpr size_t LW_IN = 0, LW_UQ = 53 * MiB, LW_K = 56 * MiB, LW_V = 58 * MiB, LW_A = 60 * MiB, LW_B = 68 * MiB, LW_O = 76 * MiB, LW_UP = 84 * MiB, LW_DN = 128 * MiB, LW = 150 * MiB;
constexpr size_t WS_XN = WS_W + 4 * LW + 1 * MiB;
constexpr size_t WS_MIX = WS_XN + 32 * MiB;
constexpr size_t WS_CQKV = WS_MIX;
constexpr size_t WS_KPE = WS_CQKV + 16 * MiB;
constexpr size_t WS_HQ = WS_KPE + 1 * MiB;
constexpr size_t GSTRIDE = 32 * MiB;
constexpr size_t WS_HG = WS_HQ + GSTRIDE, WS_GA = WS_HQ + 2 * GSTRIDE, WS_GB = WS_HQ + 3 * GSTRIDE;
constexpr size_t WS_HF = WS_HQ + 4 * GSTRIDE;
constexpr size_t WS_VTH = WS_HF + 64 * MiB;
constexpr size_t WS_QN = WS_VTH + 32 * MiB;
constexpr size_t WS_QR = WS_QN + 32 * MiB;
constexpr size_t WS_KN = WS_QR + 16 * MiB;
constexpr size_t WS_VT = WS_KN + 32 * MiB;
constexpr size_t WS_ATT = WS_VT + 32 * MiB;
constexpr size_t WS_REC = WS_ATT + 32 * MiB;
constexpr size_t WS_RRAW = WS_REC + 32 * MiB;
constexpr size_t WS_HU = WS_RRAW + 64 * MiB;
constexpr size_t WS_HS = WS_HU + 128 * MiB;
constexpr size_t WS_M1 = WS_HS + 64 * MiB;
constexpr size_t WS_MRG = WS_M1 + 64 * MiB;
constexpr size_t WS_MIX_END = WS_MRG + 32 * MiB;
constexpr size_t WS_U = WS_MIX;
constexpr size_t WS_ACT = WS_U + 176 * MiB;
static_assert(WS_ACT + 88 * MiB <= WS_MIX_END, "FFN overlay fits the mixer region");
constexpr size_t WS_END = WS_MIX_END;
constexpr size_t WS_LSSQ = WS_LB + 262144, WS_LRQ = WS_LB + 786432, WS_LRKV = WS_LB + 819200;
constexpr size_t WS_RSTD = WS_LB + 65536;
constexpr int CW_CVT = 12288;
constexpr int CW_PAN = 20480;
constexpr int CW_BAR = 4096, CW_QUE = 16384;

constexpr int RING_OFF = 0, RING_BYTES = 131072;
constexpr int LDSCTL_OFF = RING_BYTES, MISC_OFF = LDSCTL_OFF + 320;
constexpr int LDS_BYTES = 147456;

#define GAS __attribute__((address_space(1)))
#define LAS __attribute__((address_space(3)))
typedef unsigned short bf16;
typedef unsigned v4u __attribute__((ext_vector_type(4)));
typedef unsigned v2u __attribute__((ext_vector_type(2)));
typedef float f32x4 __attribute__((ext_vector_type(4)));
typedef float f32x2 __attribute__((ext_vector_type(2)));
typedef short bf16x8 __attribute__((ext_vector_type(8)));
typedef GAS unsigned gu32;
#define LDS_WAIT() asm volatile("s_waitcnt lgkmcnt(0)" ::: "memory")
#define VM_WAIT() asm volatile("s_waitcnt vmcnt(0)" ::: "memory")
__device__ __forceinline__ unsigned f2bf(float f) { unsigned u = __builtin_bit_cast(unsigned, f); return (u + 0x7fffu + ((u >> 16) & 1u)) >> 16; }
__device__ __forceinline__ unsigned pk2(float lo, float hi) { return f2bf(lo) | (f2bf(hi) << 16); }
__device__ __forceinline__ float bflo(unsigned u) { return __builtin_bit_cast(float, u << 16); }
__device__ __forceinline__ float bfhi(unsigned u) { return __builtin_bit_cast(float, u & 0xffff0000u); }
__device__ __forceinline__ float sigm(float x) { return __builtin_amdgcn_rcpf(1.f + __builtin_amdgcn_exp2f(-LOG2E * x)); }
__device__ __forceinline__ float wave_sum(float v) {
#pragma unroll
    for (int o = 1; o < 64; o <<= 1) v += __shfl_xor(v, o);
    return v;
}
__device__ __forceinline__ float wave_max(float v) {
#pragma unroll
    for (int o = 1; o < 64; o <<= 1) v = fmaxf(v, __shfl_xor(v, o));
    return v;
}

namespace pg8 {
typedef unsigned v2u_t __attribute__((ext_vector_type(2)));
__device__ __forceinline__ u32x4 pack8(f32x4 a, f32x4 b) { u32x4 w; w.x = cvt_pk_bf16(a[0], a[1]); w.y = cvt_pk_bf16(a[2], a[3]); w.z = cvt_pk_bf16(b[0], b[1]); w.w = cvt_pk_bf16(b[2], b[3]); return w; }
__device__ __forceinline__ f32x4 silu4(f32x4 v) { f32x4 r; r[0] = v[0] * sigm(v[0]); r[1] = v[1] * sigm(v[1]); r[2] = v[2] * sigm(v[2]); r[3] = v[3] * sigm(v[3]); return r; }
__device__ __forceinline__ f32x4 sigm4(f32x4 v) { f32x4 r; r[0] = sigm(v[0]); r[1] = sigm(v[1]); r[2] = sigm(v[2]); r[3] = sigm(v[3]); return r; }
__device__ __forceinline__ float sum8(const float* p) { const f32x4 a = *(const f32x4*)p, b = *(const f32x4*)(p + 4); return ((a[0] + a[1]) + (a[2] + a[3])) + ((b[0] + b[1]) + (b[2] + b[3])); }
__device__ __forceinline__ void rope8(f32x4& v0, f32x4& v1, const f32x4 cs, const f32x4 sn) {
    f32x4 a, b;
    a[0] = v0[0] * cs[0] - v0[1] * sn[0]; a[1] = v0[1] * cs[0] + v0[0] * sn[0];
    a[2] = v0[2] * cs[1] - v0[3] * sn[1]; a[3] = v0[3] * cs[1] + v0[2] * sn[1];
    b[0] = v1[0] * cs[2] - v1[1] * sn[2]; b[1] = v1[1] * cs[2] + v1[0] * sn[2];
    b[2] = v1[2] * cs[3] - v1[3] * sn[3]; b[3] = v1[3] * cs[3] + v1[2] * sn[3];
    v0 = a; v1 = b;
}


__device__ __forceinline__ void scale_rows(f32x4 (&acc)[2][2][4][2], const float* R, int t0) {
#pragma unroll
    for (int ai = 0; ai < 2; ++ai)
#pragma unroll
        for (int m = 0; m < 4; ++m) { int t = t0 + ai * HALF + m * 16; t = t < 0 ? 0 : (t > S_ - 1 ? S_ - 1 : t); const float r = R[t];
#pragma unroll
            for (int bj = 0; bj < 2; ++bj) { acc[ai][bj][m][0] *= r; acc[ai][bj][m][1] *= r; } }
}
__device__ __forceinline__ void scale_cols(f32x4 (&acc)[2][2][4][2], const float* R, int c0) {
#pragma unroll
    for (int bj = 0; bj < 2; ++bj) { const f32x4 s0 = *(const f32x4*)(R + c0 + bj * HALF), s1 = *(const f32x4*)(R + c0 + bj * HALF + 4);
#pragma unroll
        for (int ai = 0; ai < 2; ++ai)
#pragma unroll
            for (int m = 0; m < 4; ++m) { acc[ai][bj][m][0] *= s0; acc[ai][bj][m][1] *= s1; } }
}
struct EpiIn {
    static constexpr bool PERM = true, AFTER_DRAIN = false, PRESCALE = true, CHAIN = false;
    unsigned char* ws;
    __device__ __forceinline__ void prescale(f32x4 (&acc)[2][2][4][2], const Unit& u, int wr, int wc, int fr, int fq) const { scale_rows(acc, (const float*)(ws + WS_RSTD), u.pm * BM + wr * 64 + fr); }
    __device__ __forceinline__ void operator()(const f32x4 (&acc)[2][2][4][2], const Unit& u, int wr, int wc, int fr, int fq) const {
        const int pn = u.pn, row0 = u.pm * BM + wr * 64 + fr, lc = wc * 32 + 8 * fq;
        if (pn == 4) {
            if (wc < 2) {
                const float* COS = (const float*)(ws + WS_COS); const float* SIN = (const float*)(ws + WS_SIN); bf16_t* KPE = (bf16_t*)(ws + WS_KPE);
#pragma unroll
                for (int ai = 0; ai < 2; ++ai)
#pragma unroll
                    for (int m = 0; m < 4; ++m) { const int row = row0 + ai * HALF + m * 16;
                        f32x4 v0 = acc[ai][0][m][0], v1 = acc[ai][0][m][1];
                        const f32x4 cs = *(const f32x4*)(COS + (size_t)row * 32 + wc * 16 + 4 * fq), sn = *(const f32x4*)(SIN + (size_t)row * 32 + wc * 16 + 4 * fq);
                        rope8(v0, v1, cs, sn);
                        *(u32x4*)(KPE + (size_t)row * 64 + lc) = pack8(v0, v1);
                        if (m & 1) asm volatile("" ::: "memory"); }
            }
        } else if (pn >= 13 && pn < 21) {
            _Float16* HF = (_Float16*)(ws + WS_HF);
            typedef _Float16 h8 __attribute__((ext_vector_type(8)));
#pragma unroll
            for (int ai = 0; ai < 2; ++ai)
#pragma unroll
                for (int m = 0; m < 4; ++m) { _Float16* rp = HF + (size_t)(row0 + ai * HALF + m * 16) * 2048 + (pn - 13) * 256 + lc;
#pragma unroll
                    for (int bj = 0; bj < 2; ++bj) { const f32x4 a = acc[ai][bj][m][0], b = acc[ai][bj][m][1];
                        h8 hv = {(_Float16)a[0], (_Float16)a[1], (_Float16)a[2], (_Float16)a[3], (_Float16)b[0], (_Float16)b[1], (_Float16)b[2], (_Float16)b[3]};
                        *(h8*)(rp + bj * HALF) = hv; } }
        } else {
            bf16_t* base; int ldc, act;
            if (pn < 4) { base = (bf16_t*)(ws + WS_CQKV) + pn * 256; ldc = 1024; act = 0; }
            else { const int gi = (pn < 13) ? 0 : ((pn - 13) >> 3), ct = (pn < 13) ? (pn - 5) : ((pn - 13) & 7);
                   base = (bf16_t*)(ws + WS_HQ + (size_t)gi * GSTRIDE) + ct * 256; ldc = 2048; act = (gi <= 1) ? 1 : 2; }
#pragma unroll
            for (int ai = 0; ai < 2; ++ai)
#pragma unroll
                for (int m = 0; m < 4; ++m) { bf16_t* rp = base + (size_t)(row0 + ai * HALF + m * 16) * ldc + lc;
                    if (pn < 4) {
                        float ss = 0.f;
#pragma unroll
                        for (int bj = 0; bj < 2; ++bj) { const f32x4 a = acc[ai][bj][m][0], b = acc[ai][bj][m][1]; ss += (a[0] * a[0] + a[1] * a[1]) + (a[2] * a[2] + a[3] * a[3]) + (b[0] * b[0] + b[1] * b[1]) + (b[2] * b[2] + b[3] * b[3]); }
                        ss += __shfl_xor(ss, 16); ss += __shfl_xor(ss, 32);
                        if (fq == 0) ((float*)(ws + WS_LSSQ))[(size_t)(row0 + ai * HALF + m * 16) * 16 + pn * 4 + wc] = ss; }
#pragma unroll
                    for (int bj = 0; bj < 2; ++bj) { f32x4 v0 = acc[ai][bj][m][0], v1 = acc[ai][bj][m][1];
                        if (act == 1) { v0 = silu4(v0); v1 = silu4(v1); }
                        else if (act == 2) { v0 = sigm4(v0); v1 = sigm4(v1); }
                        *(u32x4*)(rp + bj * HALF) = pack8(v0, v1); } }
        }
    }
};
struct EpiStore {
    static constexpr bool PERM = true, AFTER_DRAIN = false, PRESCALE = false, CHAIN = false;
    bf16_t* O; int ldc;
    __device__ __forceinline__ void operator()(const f32x4 (&acc)[2][2][4][2], const Unit& u, int wr, int wc, int fr, int fq) const {
        const int row0 = u.pm * BM + wr * 64 + fr, col0 = u.pn * BM + wc * 32 + 8 * fq;
#pragma unroll
        for (int ai = 0; ai < 2; ++ai)
#pragma unroll
            for (int m = 0; m < 4; ++m) { bf16_t* rp = O + (size_t)(row0 + ai * HALF + m * 16) * ldc + col0;
#pragma unroll
                for (int bj = 0; bj < 2; ++bj) *(u32x4*)(rp + bj * HALF) = pack8(acc[ai][bj][m][0], acc[ai][bj][m][1]); }
    }
};
struct EpiStoreRS {
    static constexpr bool PERM = true, AFTER_DRAIN = false, PRESCALE = true, CHAIN = false;
    bf16_t* O; int ldc; const float* R;
    __device__ __forceinline__ void prescale(f32x4 (&acc)[2][2][4][2], const Unit& u, int wr, int wc, int fr, int fq) const { scale_rows(acc, R, u.pm * BM + wr * 64 + fr); }
    __device__ __forceinline__ void operator()(const f32x4 (&acc)[2][2][4][2], const Unit& u, int wr, int wc, int fr, int fq) const {
        const int row0 = u.pm * BM + wr * 64 + fr, col0 = u.pn * BM + wc * 32 + 8 * fq;
#pragma unroll
        for (int ai = 0; ai < 2; ++ai)
#pragma unroll
            for (int m = 0; m < 4; ++m) { bf16_t* rp = O + (size_t)(row0 + ai * HALF + m * 16) * ldc + col0;
#pragma unroll
                for (int bj = 0; bj < 2; ++bj) *(u32x4*)(rp + bj * HALF) = pack8(acc[ai][bj][m][0], acc[ai][bj][m][1]); }
    }
};
struct EpiStoreCS {
    static constexpr bool PERM = true, AFTER_DRAIN = false, PRESCALE = true, CHAIN = false;
    bf16_t* O; int ldc; const float* R;
    __device__ __forceinline__ void prescale(f32x4 (&acc)[2][2][4][2], const Unit& u, int wr, int wc, int fr, int fq) const { scale_cols(acc, R, u.pn * BM + wc * 32 + 8 * fq); }
    __device__ __forceinline__ void operator()(const f32x4 (&acc)[2][2][4][2], const Unit& u, int wr, int wc, int fr, int fq) const {
        const int row0 = u.pm * BM + wr * 64 + fr, col0 = u.pn * BM + wc * 32 + 8 * fq;
#pragma unroll
        for (int ai = 0; ai < 2; ++ai)
#pragma unroll
            for (int m = 0; m < 4; ++m) { bf16_t* rp = O + (size_t)(row0 + ai * HALF + m * 16) * ldc + col0;
#pragma unroll
                for (int bj = 0; bj < 2; ++bj) *(u32x4*)(rp + bj * HALF) = pack8(acc[ai][bj][m][0], acc[ai][bj][m][1]); }
    }
};
struct EpiResN {
    static constexpr bool PERM = true, AFTER_DRAIN = false, PRESCALE = false, CHAIN = false;
    float* X; bf16_t* XG; const float* gain; float* SSQ;
    __device__ __forceinline__ void operator()(const f32x4 (&acc)[2][2][4][2], const Unit& u, int wr, int wc, int fr, int fq) const {
        const int row0 = u.pm * BM + wr * 64 + fr, col0 = u.pn * BM + wc * 32 + 8 * fq;
        f32x4 g[2][2];
#pragma unroll
        for (int bj = 0; bj < 2; ++bj) { g[bj][0] = *(const f32x4*)(gain + col0 + bj * HALF); g[bj][1] = *(const f32x4*)(gain + col0 + bj * HALF + 4); }
#pragma unroll
        for (int ai = 0; ai < 2; ++ai)
#pragma unroll
            for (int m = 0; m < 4; ++m) { const int row = row0 + ai * HALF + m * 16; float* rp = X + (size_t)row * 2048 + col0; float ss = 0.f;
#pragma unroll
                for (int bj = 0; bj < 2; ++bj) { const f32x4 a = *(const f32x4*)(rp + bj * HALF) + acc[ai][bj][m][0], b = *(const f32x4*)(rp + bj * HALF + 4) + acc[ai][bj][m][1];
                    *(f32x4*)(rp + bj * HALF) = a; *(f32x4*)(rp + bj * HALF + 4) = b;
                    ss += (a[0] * a[0] + a[1] * a[1]) + (a[2] * a[2] + a[3] * a[3]) + (b[0] * b[0] + b[1] * b[1]) + (b[2] * b[2] + b[3] * b[3]);
                    *(u32x4*)(XG + (size_t)row * 2048 + col0 + bj * HALF) = pack8(a * g[bj][0], b * g[bj][1]); }
                ss += __shfl_xor(ss, 16); ss += __shfl_xor(ss, 32);
                if (fq == 0) __hip_atomic_store((unsigned*)(SSQ + (size_t)row * 32 + u.pn * 4 + wc), __builtin_bit_cast(unsigned, ss), __ATOMIC_RELAXED, __HIP_MEMORY_SCOPE_AGENT);
                if (m & 1) asm volatile("" ::: "memory"); }
    }
};
struct EpiResN0 {
    static constexpr bool PERM = true, AFTER_DRAIN = false, PRESCALE = false, CHAIN = false;
    float* X; bf16_t* XG; const float* gain; float* SSQ; const float* Xin;
    __device__ __forceinline__ void operator()(const f32x4 (&acc)[2][2][4][2], const Unit& u, int wr, int wc, int fr, int fq) const {
        const int row0 = u.pm * BM + wr * 64 + fr, col0 = u.pn * BM + wc * 32 + 8 * fq;
        f32x4 g[2][2];
#pragma unroll
        for (int bj = 0; bj < 2; ++bj) { g[bj][0] = *(const f32x4*)(gain + col0 + bj * HALF); g[bj][1] = *(const f32x4*)(gain + col0 + bj * HALF + 4); }
#pragma unroll
        for (int ai = 0; ai < 2; ++ai)
#pragma unroll
            for (int m = 0; m < 4; ++m) { const int row = row0 + ai * HALF + m * 16; float* rp = X + (size_t)row * 2048 + col0; const float* rq = Xin + (size_t)row * 2048 + col0; float ss = 0.f;
#pragma unroll
                for (int bj = 0; bj < 2; ++bj) { const f32x4 a = *(const f32x4*)(rq + bj * HALF) + acc[ai][bj][m][0], b = *(const f32x4*)(rq + bj * HALF + 4) + acc[ai][bj][m][1];
                    *(f32x4*)(rp + bj * HALF) = a; *(f32x4*)(rp + bj * HALF + 4) = b;
                    ss += (a[0] * a[0] + a[1] * a[1]) + (a[2] * a[2] + a[3] * a[3]) + (b[0] * b[0] + b[1] * b[1]) + (b[2] * b[2] + b[3] * b[3]);
                    *(u32x4*)(XG + (size_t)row * 2048 + col0 + bj * HALF) = pack8(a * g[bj][0], b * g[bj][1]); }
                ss += __shfl_xor(ss, 16); ss += __shfl_xor(ss, 32);
                if (fq == 0) __hip_atomic_store((unsigned*)(SSQ + (size_t)row * 32 + u.pn * 4 + wc), __builtin_bit_cast(unsigned, ss), __ATOMIC_RELAXED, __HIP_MEMORY_SCOPE_AGENT);
                if (m & 1) asm volatile("" ::: "memory"); }
    }
};
struct EpiResFinal {
    static constexpr bool PERM = true, AFTER_DRAIN = true, PRESCALE = false, CHAIN = false;
    float* X; const float* gain; float* SSQ; unsigned* cnt;
    __device__ __forceinline__ void fused(f32x4 (&acc)[2][2][4][2], const Unit& u, int wr, int wc, int fr, int fq, PG8_LAS unsigned char* lds, int wid, int lane) const {
        const int row0 = u.pm * BM + wr * 64 + fr, col0 = u.pn * BM + wc * 32 + 8 * fq;
        PG8_LAS float* S = (PG8_LAS float*)lds;
#pragma unroll
        for (int ai = 0; ai < 2; ++ai)
#pragma unroll
            for (int m = 0; m < 4; ++m) { const int row = row0 + ai * HALF + m * 16; const float* rp = X + (size_t)row * 2048 + col0; float ss = 0.f;
#pragma unroll
                for (int bj = 0; bj < 2; ++bj) { const f32x4 a = *(const f32x4*)(rp + bj * HALF) + acc[ai][bj][m][0], b = *(const f32x4*)(rp + bj * HALF + 4) + acc[ai][bj][m][1];
                    acc[ai][bj][m][0] = a; acc[ai][bj][m][1] = b;
                    ss += (a[0] * a[0] + a[1] * a[1]) + (a[2] * a[2] + a[3] * a[3]) + (b[0] * b[0] + b[1] * b[1]) + (b[2] * b[2] + b[3] * b[3]); }
                ss += __shfl_xor(ss, 16); ss += __shfl_xor(ss, 32);
                if (fq == 0) __hip_atomic_store((unsigned*)(SSQ + (size_t)row * 32 + u.pn * 4 + wc), __builtin_bit_cast(unsigned, ss), __ATOMIC_RELAXED, __HIP_MEMORY_SCOPE_AGENT);
                if (m & 1) asm volatile("" ::: "memory"); }
        asm volatile("s_waitcnt vmcnt(0)" ::: "memory");
        if (lane == 0) (void)__hip_atomic_fetch_add(cnt + u.pm * 32, 1u, __ATOMIC_RELAXED, __HIP_MEMORY_SCOPE_AGENT);
        if (wid == 0) { unsigned sp = 0u; while (__hip_atomic_load(cnt + u.pm * 32, __ATOMIC_RELAXED, __HIP_MEMORY_SCOPE_AGENT) < 64u && ++sp < (1u << 22)) __builtin_amdgcn_s_sleep(1);
                        __builtin_amdgcn_fence(__ATOMIC_ACQUIRE, "agent"); }
        asm volatile("s_waitcnt vmcnt(0) lgkmcnt(0)" ::: "memory"); __builtin_amdgcn_s_barrier(); asm volatile("" ::: "memory");
#pragma unroll 1
        for (int it = 0; it < 16; ++it) { const int rl = it * 16 + wid * 2 + (lane >> 5);
            float v = __builtin_bit_cast(float, __hip_atomic_load((unsigned*)(SSQ + (size_t)(u.pm * BM + rl) * 32 + (lane & 31)), __ATOMIC_RELAXED, __HIP_MEMORY_SCOPE_AGENT));
#pragma unroll
            for (int o = 16; o > 0; o >>= 1) v += __shfl_xor(v, o);
            if ((lane & 31) == 0) S[rl] = 1.0f / sqrtf(v * (1.f / 2048.f) + EPS); }
        asm volatile("s_waitcnt lgkmcnt(0)" ::: "memory"); __builtin_amdgcn_s_barrier(); asm volatile("" ::: "memory");
        f32x4 g[2][2];
#pragma unroll
        for (int bj = 0; bj < 2; ++bj) { g[bj][0] = *(const f32x4*)(gain + col0 + bj * HALF); g[bj][1] = *(const f32x4*)(gain + col0 + bj * HALF + 4); }
#pragma unroll
        for (int ai = 0; ai < 2; ++ai)
#pragma unroll
            for (int m = 0; m < 4; ++m) { const int rl = ai * HALF + wr * 64 + m * 16 + fr; const float r = S[rl]; float* rp = X + (size_t)(u.pm * BM + rl) * 2048 + col0;
#pragma unroll
                for (int bj = 0; bj < 2; ++bj) { *(f32x4*)(rp + bj * HALF) = acc[ai][bj][m][0] * r * g[bj][0]; *(f32x4*)(rp + bj * HALF + 4) = acc[ai][bj][m][1] * r * g[bj][1]; } }
    }
};
struct EpiQ {
    static constexpr bool PERM = true, AFTER_DRAIN = false, PRESCALE = true, CHAIN = false;
    unsigned char* ws;
    __device__ __forceinline__ void prescale(f32x4 (&acc)[2][2][4][2], const Unit& u, int wr, int wc, int fr, int fq) const { scale_rows(acc, (const float*)(ws + WS_LRQ), u.pm * BM + wr * 64 + fr); }
    __device__ __forceinline__ void operator()(const f32x4 (&acc)[2][2][4][2], const Unit& u, int wr, int wc, int fr, int fq) const {
        const int pn = u.pn, row0 = u.pm * BM + wr * 64 + fr, lc = wc * 32 + 8 * fq;
        if (pn < 8) {
            bf16_t* base = (bf16_t*)(ws + WS_QN) + pn * 256 + lc;
#pragma unroll
            for (int ai = 0; ai < 2; ++ai)
#pragma unroll
                for (int m = 0; m < 4; ++m)
#pragma unroll
                    for (int bj = 0; bj < 2; ++bj) *(u32x4*)(base + (size_t)(row0 + ai * HALF + m * 16) * 2048 + bj * HALF) = pack8(acc[ai][bj][m][0] * QSCALE, acc[ai][bj][m][1] * QSCALE);
        } else {
            const float* COS = (const float*)(ws + WS_COS); const float* SIN = (const float*)(ws + WS_SIN);
            bf16_t* base = (bf16_t*)(ws + WS_QR) + (pn - 8) * 256 + lc; const int p0 = (wc & 1) * 16 + 4 * fq;
#pragma unroll
            for (int ai = 0; ai < 2; ++ai)
#pragma unroll
                for (int m = 0; m < 4; ++m) { const int row = row0 + ai * HALF + m * 16;
                    const f32x4 cs = *(const f32x4*)(COS + (size_t)row * 32 + p0), sn = *(const f32x4*)(SIN + (size_t)row * 32 + p0);
#pragma unroll
                    for (int bj = 0; bj < 2; ++bj) { f32x4 v0 = acc[ai][bj][m][0] * QSCALE, v1 = acc[ai][bj][m][1] * QSCALE; rope8(v0, v1, cs, sn);
                        *(u32x4*)(base + (size_t)row * 1024 + bj * HALF) = pack8(v0, v1); }
                    if (m & 1) asm volatile("" ::: "memory"); }
        }
    }
};
struct EpiGateA {
    static constexpr bool PERM = true, AFTER_DRAIN = false, PRESCALE = false, CHAIN = false;
    unsigned char* ws;
    __device__ __forceinline__ void operator()(const f32x4 (&acc)[2][2][4][2], const Unit& u, int wr, int wc, int fr, int fq) const {
        const int row0 = u.pm * BM + wr * 64 + fr, col0 = u.pn * BM + wc * 32 + 8 * fq;
        const bf16_t* G = (const bf16_t*)(ws + WS_GA); bf16_t* M1 = (bf16_t*)(ws + WS_M1);
#pragma unroll
        for (int ai = 0; ai < 2; ++ai)
#pragma unroll
            for (int m = 0; m < 4; ++m) { const size_t off = (size_t)(row0 + ai * HALF + m * 16) * 2048 + col0;
#pragma unroll
                for (int bj = 0; bj < 2; ++bj) { const u32x4 g = *(const u32x4*)(G + off + bj * HALF);
                    const f32x4 g0 = {bflo(g.x), bfhi(g.x), bflo(g.y), bfhi(g.y)}, g1 = {bflo(g.z), bfhi(g.z), bflo(g.w), bfhi(g.w)};
                    *(u32x4*)(M1 + off + bj * HALF) = pack8(acc[ai][bj][m][0] * g0, acc[ai][bj][m][1] * g1); }
                if (m & 1) asm volatile("" ::: "memory"); }
    }
};
struct EpiGateB {
    static constexpr bool PERM = true, AFTER_DRAIN = false, PRESCALE = false, CHAIN = false;
    unsigned char* ws;
    __device__ __forceinline__ void operator()(const f32x4 (&acc)[2][2][4][2], const Unit& u, int wr, int wc, int fr, int fq) const {
        const int row0 = u.pm * BM + wr * 64 + fr, col0 = u.pn * BM + wc * 32 + 8 * fq;
        const bf16_t* G = (const bf16_t*)(ws + WS_GB); const bf16_t* M1 = (const bf16_t*)(ws + WS_M1); bf16_t* O = (bf16_t*)(ws + WS_MRG);
#pragma unroll
        for (int ai = 0; ai < 2; ++ai)
#pragma unroll
            for (int m = 0; m < 4; ++m) { const size_t off = (size_t)(row0 + ai * HALF + m * 16) * 2048 + col0;
#pragma unroll
                for (int bj = 0; bj < 2; ++bj) { const u32x4 g = *(const u32x4*)(G + off + bj * HALF);
                    const f32x4 g0 = {bflo(g.x), bfhi(g.x), bflo(g.y), bfhi(g.y)}, g1 = {bflo(g.z), bfhi(g.z), bflo(g.w), bfhi(g.w)};
                    const u32x4 mv = *(const u32x4*)(M1 + off + bj * HALF); const f32x4 m0 = {bflo(mv.x), bfhi(mv.x), bflo(mv.y), bfhi(mv.y)}, m1 = {bflo(mv.z), bfhi(mv.z), bflo(mv.w), bfhi(mv.w)};
                    *(u32x4*)(O + off + bj * HALF) = pack8(m0 + acc[ai][bj][m][0] * g0, m1 + acc[ai][bj][m][1] * g1); }
                if (m & 1) asm volatile("" ::: "memory"); }
    }
};
struct EpiGateAB {
    static constexpr bool PERM = true, AFTER_DRAIN = false, PRESCALE = false, CHAIN = true;
    static constexpr size_t A_KIND = (WS_REC - WS_ATT), B_KIND = (LW_B - LW_A);
    unsigned char* ws;
    __device__ __forceinline__ void link(f32x4 (&acc)[2][2][4][2], const Unit& u, int wr, int wc, int fr, int fq) const {
        const int row0 = u.pm * BM + wr * 64 + fr, col0 = u.pn * BM + wc * 32 + 8 * fq;
        const bf16_t* GA = (const bf16_t*)(ws + WS_GA); const bf16_t* GB = (const bf16_t*)(ws + WS_GB);
#pragma unroll
        for (int ai = 0; ai < 2; ++ai)
#pragma unroll
            for (int m = 0; m < 4; ++m) { const size_t off = (size_t)(row0 + ai * HALF + m * 16) * 2048 + col0;
#pragma unroll
                for (int bj = 0; bj < 2; ++bj) { const u32x4 a = *(const u32x4*)(GA + off + bj * HALF), b = *(const u32x4*)(GB + off + bj * HALF);
                    const f32x4 a0 = {bflo(a.x), bfhi(a.x), bflo(a.y), bfhi(a.y)}, a1 = {bflo(a.z), bfhi(a.z), bflo(a.w), bfhi(a.w)};
                    f32x4 r0, r1;
                    r0[0] = __builtin_amdgcn_rcpf(fmaxf(bflo(b.x), 1e-30f)); r0[1] = __builtin_amdgcn_rcpf(fmaxf(bfhi(b.x), 1e-30f)); r0[2] = __builtin_amdgcn_rcpf(fmaxf(bflo(b.y), 1e-30f)); r0[3] = __builtin_amdgcn_rcpf(fmaxf(bfhi(b.y), 1e-30f));
                    r1[0] = __builtin_amdgcn_rcpf(fmaxf(bflo(b.z), 1e-30f)); r1[1] = __builtin_amdgcn_rcpf(fmaxf(bfhi(b.z), 1e-30f)); r1[2] = __builtin_amdgcn_rcpf(fmaxf(bflo(b.w), 1e-30f)); r1[3] = __builtin_amdgcn_rcpf(fmaxf(bfhi(b.w), 1e-30f));
                    acc[ai][bj][m][0] *= a0 * r0; acc[ai][bj][m][1] *= a1 * r1; }
                if (m & 1) asm volatile("" ::: "memory"); }
    }
    __device__ __forceinline__ void operator()(const f32x4 (&acc)[2][2][4][2], const Unit& u, int wr, int wc, int fr, int fq) const {
        const int row0 = u.pm * BM + wr * 64 + fr, col0 = u.pn * BM + wc * 32 + 8 * fq;
        const bf16_t* G = (const bf16_t*)(ws + WS_GB); bf16_t* O = (bf16_t*)(ws + WS_MRG);
#pragma unroll
        for (int ai = 0; ai < 2; ++ai)
#pragma unroll
            for (int m = 0; m < 4; ++m) { const size_t off = (size_t)(row0 + ai * HALF + m * 16) * 2048 + col0;
#pragma unroll
                for (int bj = 0; bj < 2; ++bj) { const u32x4 g = *(const u32x4*)(G + off + bj * HALF);
                    const f32x4 g0 = {bflo(g.x), bfhi(g.x), bflo(g.y), bfhi(g.y)}, g1 = {bflo(g.z), bfhi(g.z), bflo(g.w), bfhi(g.w)};
                    *(u32x4*)(O + off + bj * HALF) = pack8(acc[ai][bj][m][0] * g0, acc[ai][bj][m][1] * g1); }
                if (m & 1) asm volatile("" ::: "memory"); }
    }
};
struct EpiRes {
    static constexpr bool PERM = true, AFTER_DRAIN = false, PRESCALE = false, CHAIN = false;
    float* X;
    __device__ __forceinline__ void operator()(const f32x4 (&acc)[2][2][4][2], const Unit& u, int wr, int wc, int fr, int fq) const {
        const int row0 = u.pm * BM + wr * 64 + fr, col0 = u.pn * BM + wc * 32 + 8 * fq;
#pragma unroll
        for (int ai = 0; ai < 2; ++ai)
#pragma unroll
            for (int m = 0; m < 4; ++m) { float* rp = X + (size_t)(row0 + ai * HALF + m * 16) * 2048 + col0;
#pragma unroll
                for (int bj = 0; bj < 2; ++bj) { const f32x4 a = *(const f32x4*)(rp + bj * HALF), b = *(const f32x4*)(rp + bj * HALF + 4);
                    *(f32x4*)(rp + bj * HALF) = a + acc[ai][bj][m][0]; *(f32x4*)(rp + bj * HALF + 4) = b + acc[ai][bj][m][1]; }
                if (m & 1) asm volatile("" ::: "memory"); }
    }
};

__device__ __forceinline__ float dpp_shr1(float fill, float v) { return __builtin_bit_cast(float, __builtin_amdgcn_update_dpp(__builtin_bit_cast(int, fill), __builtin_bit_cast(int, v), 0x111, 0xf, 0xf, false)); }
__device__ __forceinline__ float dpp_shr2(float fill, float v) { return __builtin_bit_cast(float, __builtin_amdgcn_update_dpp(__builtin_bit_cast(int, fill), __builtin_bit_cast(int, v), 0x112, 0xf, 0xf, false)); }
__device__ __forceinline__ float dpp_ror1(float v) { return __builtin_bit_cast(float, __builtin_amdgcn_update_dpp(0, __builtin_bit_cast(int, v), 0x121, 0xf, 0xf, false)); }
__device__ __forceinline__ float dpp_ror2(float v) { return __builtin_bit_cast(float, __builtin_amdgcn_update_dpp(0, __builtin_bit_cast(int, v), 0x122, 0xf, 0xf, false)); }
struct EpiConv {
    static constexpr bool PERM = true, AFTER_DRAIN = false, PRESCALE = true, CHAIN = false;
    bf16_t* ACT; const float* cw; const float* cb; PG8_LAS float* EX; const float* R;
    __device__ __forceinline__ void prescale(f32x4 (&acc)[2][2][4][2], const Unit& u, int wr, int wc, int fr, int fq) const { scale_rows(acc, R, u.pm * 254 - 2 + wr * 64 + fr); }
    __device__ __forceinline__ void operator()(const f32x4 (&acc)[2][2][4][2], const Unit& u, int wr, int wc, int fr, int fq) const {
        const int lc = wc * 32 + 8 * fq;
        if (fr >= 14) {
#pragma unroll
            for (int ai = 0; ai < 2; ++ai)
#pragma unroll
                for (int bj = 0; bj < 2; ++bj)
#pragma unroll
                    for (int n = 0; n < 2; ++n) *(PG8_LAS f32x4*)(EX + ((2 * ai + wr) * 2 + (fr - 14)) * 256 + bj * HALF + lc + 4 * n) = acc[ai][bj][3][n];
        }
        asm volatile("s_waitcnt lgkmcnt(0)" ::: "memory"); __builtin_amdgcn_s_barrier(); asm volatile("" ::: "memory");
        const int ch0 = u.pn * HALF + lc;
        const int trow0 = u.pm * 254 - 2 + wr * 64 + fr;
#pragma unroll
        for (int n = 0; n < 2; ++n) {
            const int ch = ch0 + 4 * n;
            typedef const __attribute__((address_space(1))) f32x4* gv4; const __attribute__((address_space(1))) float* cwg = (const __attribute__((address_space(1))) float*)cw; const __attribute__((address_space(1))) float* cbg = (const __attribute__((address_space(1))) float*)cb;
            const f32x4 g0 = *(gv4)(cwg + ch), g1 = *(gv4)(cwg + DFF2 + ch), g2 = *(gv4)(cwg + 2 * DFF2 + ch), gb = *(gv4)(cbg + ch);
            const f32x4 u0 = *(gv4)(cwg + DFF + ch), u1 = *(gv4)(cwg + DFF2 + DFF + ch), u2 = *(gv4)(cwg + 2 * DFF2 + DFF + ch), ub = *(gv4)(cbg + DFF + ch);
#pragma unroll
            for (int ai = 0; ai < 2; ++ai) {
                const int b = 2 * ai + wr;
                f32x4 f1g = {0.f, 0.f, 0.f, 0.f}, f2g = f1g, f1u = f1g, f2u = f1g;
                if (b > 0) { const PG8_LAS float* e63 = EX + ((b - 1) * 2 + 1) * 256 + lc + 4 * n; const PG8_LAS float* e2 = EX + ((b - 1) * 2 + (fr == 0 ? 0 : 1)) * 256 + lc + 4 * n;
                    f1g = *(const PG8_LAS f32x4*)e63; f2g = *(const PG8_LAS f32x4*)e2; f1u = *(const PG8_LAS f32x4*)(e63 + HALF); f2u = *(const PG8_LAS f32x4*)(e2 + HALF); }
#pragma unroll
                for (int m = 0; m < 4; ++m) {
                    const f32x4 cg = acc[ai][0][m][n], cu = acc[ai][1][m][n];
                    if (m > 0) { const f32x4 pg = acc[ai][0][m - 1][n], pu = acc[ai][1][m - 1][n];
#pragma unroll
                        for (int i = 0; i < 4; ++i) { f1g[i] = dpp_ror1(pg[i]); f2g[i] = dpp_ror2(pg[i]); f1u[i] = dpp_ror1(pu[i]); f2u[i] = dpp_ror2(pu[i]); } }
                    f32x4 r;
#pragma unroll
                    for (int i = 0; i < 4; ++i) { const float G = gb[i] + g0[i] * dpp_shr2(f2g[i], cg[i]) + g1[i] * dpp_shr1(f1g[i], cg[i]) + g2[i] * cg[i];
                                                  const float U = ub[i] + u0[i] * dpp_shr2(f2u[i], cu[i]) + u1[i] * dpp_shr1(f1u[i], cu[i]) + u2[i] * cu[i];
                                                  r[i] = G * sigm(G) * U; }
                    const int t = trow0 + ai * HALF + m * 16;
                    if (t >= u.pm * 254 && t < S_) { v2u_t w; w.x = cvt_pk_bf16(r[0], r[1]); w.y = cvt_pk_bf16(r[2], r[3]); *(v2u_t*)(ACT + (size_t)t * DFF + ch) = w; }
                }
            }
        }
    }
};
}
#define XB_TMO      128
#define XB_XCNT(j)  (256  + 64 * (j))
#define XB_XSUB(j)  (1280 + 64 * (j))
#define XB_XGEN(j)  (2304 + 64 * (j))
#define XB_TOP      3328
#define XB_TOPGEN   3392
#define XCD_BAR_WORDS 3456
#define XB_SPIN_CAP (1u << 18)

__device__ __forceinline__ unsigned xb_ld(unsigned* p)              { return __hip_atomic_load(p, __ATOMIC_RELAXED, __HIP_MEMORY_SCOPE_AGENT); }
__device__ __forceinline__ unsigned xb_add(unsigned* p, unsigned v) { return __hip_atomic_fetch_add(p, v, __ATOMIC_RELAXED, __HIP_MEMORY_SCOPE_AGENT); }
__device__ __forceinline__ unsigned xb_xcc_id() { return (unsigned)__builtin_amdgcn_s_getreg((3 << 11) | 20) & 0xFu; }
#define XB_SPIN(cond, bar) do { unsigned _sp = 0; while (cond) { __builtin_amdgcn_s_sleep(1); \
    if ((++_sp & 255u) == 0u) { if (xb_ld(&(bar)[XB_TMO])) break; if (_sp > XB_SPIN_CAP) { atomicAdd(&(bar)[XB_TMO], 1u); break; } } } } while (0)

struct XcdBarrier {
    unsigned* bar; unsigned x;
    volatile LAS unsigned* st;
};

__device__ __forceinline__ XcdBarrier xcd_barrier_post(unsigned* bar, volatile LAS unsigned* st) {
    XcdBarrier b; b.bar = bar; b.x = xb_xcc_id(); b.st = st;
    if (threadIdx.x == 0) (void)xb_add(&bar[XB_XCNT(b.x)], 1u);
    return b;
}
__device__ __forceinline__ void xcd_barrier_complete(unsigned* bar, unsigned x, unsigned& nloc, unsigned& nx) {
    const unsigned G = gridDim.x * gridDim.y * gridDim.z;
    unsigned sum, cnt, mine, sp = 0u;
    for (;;) {
        sum = 0u; cnt = 0u; mine = 0u;
#pragma unroll
        for (unsigned j = 0; j < 16; ++j) { const unsigned c = xb_ld(&bar[XB_XCNT(j)]); sum += c; cnt += (c > 0u) ? 1u : 0u; mine = (j == x) ? c : mine; }
        if (sum == G) break;
        __builtin_amdgcn_s_sleep(1);
        if ((++sp & 255u) == 0u) { if (xb_ld(&bar[XB_TMO])) break; if (sp > XB_SPIN_CAP) { atomicAdd(&bar[XB_TMO], 1u); break; } }
    }
    nloc = mine > 0u ? mine : 1u; nx = cnt > 0u ? cnt : 1u;
}

__device__ __forceinline__ void xcd_barrier(const XcdBarrier& b) {
    asm volatile("s_waitcnt vmcnt(0)" ::: "memory");
    __syncthreads();
    if (threadIdx.x == 0) {
        GAS unsigned* gbar_ = (GAS unsigned*)b.bar; unsigned bx_ = b.x; asm volatile("" : "+s"(gbar_), "+s"(bx_)); unsigned* bar = (unsigned*)gbar_;
        __builtin_amdgcn_s_waitcnt(0);
        unsigned nloc = b.st[0], nx = b.st[1];
        if (nloc == 0u) { xcd_barrier_complete(bar, bx_, nloc, nx); b.st[0] = nloc; b.st[1] = nx; }
        const unsigned old = xb_add(&bar[XB_XSUB(bx_)], 1u);
        const unsigned gen = old / nloc;
        if (old + 1u == (gen + 1u) * nloc) {
            __builtin_amdgcn_fence(__ATOMIC_RELEASE, "agent");
            asm volatile("s_waitcnt vmcnt(0)" ::: "memory");
            const unsigned og = xb_add(&bar[XB_TOP], 1u);
            const unsigned tg = og / nx;
            if (og + 1u == (tg + 1u) * nx) xb_add(&bar[XB_TOPGEN], 1u);
            else XB_SPIN(xb_ld(&bar[XB_TOPGEN]) == tg, bar);
            __builtin_amdgcn_fence(__ATOMIC_ACQUIRE, "agent");
            xb_add(&bar[XB_XGEN(bx_)], 1u);
            asm volatile("s_waitcnt vmcnt(0)" ::: "memory");
        } else {
            XB_SPIN(xb_ld(&bar[XB_XGEN(bx_)]) == gen, bar);
            __builtin_amdgcn_fence(__ATOMIC_ACQUIRE, "agent");
            asm volatile("s_waitcnt vmcnt(0)" ::: "memory");
        }
    }
    __syncthreads();
}

__device__ const float c_invf[32] = {
    1.000000000e+00f, 7.498942614e-01f, 5.623413324e-01f, 4.216965139e-01f, 3.162277639e-01f, 2.371373773e-01f, 1.778279394e-01f, 1.333521307e-01f,
    1.000000015e-01f, 7.498941571e-02f, 5.623413250e-02f, 4.216965288e-02f, 3.162277490e-02f, 2.371373773e-02f, 1.778279431e-02f, 1.333521493e-02f,
    9.999999776e-03f, 7.498941850e-03f, 5.623413250e-03f, 4.216964822e-03f, 3.162277630e-03f, 2.371373586e-03f, 1.778279431e-03f, 1.333521446e-03f,
    1.000000047e-03f, 7.498942432e-04f, 5.623413017e-04f, 4.216965172e-04f, 3.162277571e-04f, 2.371373703e-04f, 1.778279402e-04f, 1.333521504e-04f};

template <int KIND> __device__ __forceinline__ int srcmap(int n) {
    if constexpr (KIND == 0) return n;
    else if constexpr (KIND == 1) {
        if (n < 1024) return n;
        if (n < 1088) { const int jj = n - 1024; return 1024 + (jj >> 1) + 32 * (jj & 1); }
        if (n < 1280) return -1;
        if (n < 3328) return 1088 + (n - 1280);
        if (n < 5376) return 3136 + (n - 3328);
        if (n < 7424) return 7232 + (n - 5376);
        if (n < 9472) return 9280 + (n - 7424);
        if (n < 11520) return 11328 + (n - 9472);
        return 5184 + (n - 11520);
    } else if constexpr (KIND == 2) {
        if (n < 2048) return (n >> 7) * 192 + (n & 127);
        const int r = n - 2048, h = r >> 6, jj = r & 63; return h * 192 + 128 + (jj >> 1) + 32 * (jj & 1);
    } else if constexpr (KIND == 3) return (n >> 7) * 256 + (n & 127);
    else if constexpr (KIND == 4) return (n >> 7) * 256 + 128 + (n & 127);
    else { const int j = n >> 8, i = n & 255; return i < 128 ? 128 * j + i : DFF + 128 * j + (i - 128); }
}
template <int KIND> __device__ __forceinline__ void transpose_item(const float* W, int K, int Nsrc, bf16* WT, const float* scale, LAS float* scr, int kb, int nb, int lane) {
    const int k0 = 64 * kb, n0 = 32 * nb, sc = srcmap<KIND>(n0 + (lane & 31));
#pragma unroll 8
    for (int i = 0; i < 32; ++i) { const int kk = 2 * i + (lane >> 5); float v = 0.f;
        if (sc >= 0) { v = ((const GAS float*)W)[(size_t)(k0 + kk) * Nsrc + sc]; if (scale) v *= ((const GAS float*)scale)[k0 + kk]; }
        scr[kk * 33 + (lane & 31)] = v; }
    LDS_WAIT(); asm volatile("" ::: "memory");
    const int c = lane & 7;
#pragma unroll
    for (int j = 0; j < 4; ++j) { const int n = (lane >> 3) + 8 * j; const LAS float* s = scr + (8 * c) * 33 + n;
        v4u o; o.x = pk2(s[0 * 33], s[1 * 33]); o.y = pk2(s[2 * 33], s[3 * 33]); o.z = pk2(s[4 * 33], s[5 * 33]); o.w = pk2(s[6 * 33], s[7 * 33]);
        *(GAS v4u*)(WT + (size_t)(n0 + n) * K + k0 + 8 * c) = o; }
    LDS_WAIT(); asm volatile("" ::: "memory");
}

struct TItem { const float* src; const float* scale; bf16* dst; int K, Nsrc, k0, n0, sc; };
__device__ __forceinline__ int srcmap_rt(int kind, int n) {
    switch (kind) { case 1: return srcmap<1>(n); case 2: return srcmap<2>(n); case 3: return srcmap<3>(n); case 4: return srcmap<4>(n); case 5: return srcmap<5>(n); default: return n; }
}
__device__ __forceinline__ void rms_row_to_bf16(const float* xrow, const float* gain, bf16* orow, float* xcopy, int lane, float* rstd_out = nullptr) {
    const GAS f32x4* xr = (const GAS f32x4*)xrow + lane;
    f32x4 v[8]; float s = 0.f;
#pragma unroll
    for (int j = 0; j < 8; ++j) { v[j] = xr[64 * j]; s += (v[j].x * v[j].x + v[j].y * v[j].y) + (v[j].z * v[j].z + v[j].w * v[j].w); }
    float rstd = 1.0f / sqrtf(wave_sum(s) * (1.f / DM) + EPS);
    if (rstd_out) { if (lane == 0) *rstd_out = rstd; rstd = 1.f; }
    if (xcopy) { GAS f32x4* xc = (GAS f32x4*)xcopy + lane;
#pragma unroll
        for (int j = 0; j < 8; ++j) xc[64 * j] = v[j]; }
    GAS v2u* o8 = (GAS v2u*)orow + lane;
#pragma unroll
    for (int j = 0; j < 8; ++j) { const f32x4 g = *((const GAS f32x4*)gain + lane + 64 * j);
        v2u w; w.x = pk2(v[j].x * rstd * g.x, v[j].y * rstd * g.y); w.y = pk2(v[j].z * rstd * g.z, v[j].w * rstd * g.w); o8[64 * j] = w; }
}
__device__ __forceinline__ void rms_row_f32(float* xrow, const float* gain, int lane) {
    GAS f32x4* xr = (GAS f32x4*)xrow + lane;
    f32x4 v[8]; float s = 0.f;
#pragma unroll
    for (int j = 0; j < 8; ++j) { v[j] = xr[64 * j]; s += (v[j].x * v[j].x + v[j].y * v[j].y) + (v[j].z * v[j].z + v[j].w * v[j].w); }
    const float rstd = 1.0f / sqrtf(wave_sum(s) * (1.f / DM) + EPS);
#pragma unroll
    for (int j = 0; j < 8; ++j) { const f32x4 g = *((const GAS f32x4*)gain + lane + 64 * j); xr[64 * j] = v[j] * rstd * g; }
}

__device__ __forceinline__ void rstd_phase(unsigned char* ws, int gw, int ngw, int lane) {
    const GAS float* SSQ = (const GAS float*)(ws + WS_SSQ); GAS float* R = (GAS float*)(ws + WS_RSTD);
    for (int item = gw; item < S_ / 2; item += ngw) { const int row = 2 * item + (lane >> 5);
        float v = SSQ[(size_t)row * 32 + (lane & 31)];
#pragma unroll
        for (int o = 16; o > 0; o >>= 1) v += __shfl_xor(v, o);
        if ((lane & 31) == 0) R[row] = 1.0f / sqrtf(v * (1.f / DM) + EPS); }
}
__device__ __forceinline__ void rstd_panel(unsigned char* ws, int pm, int wave, int lane) {
    GAS unsigned* SSQ = (GAS unsigned*)(ws + WS_SSQ); GAS float* R = (GAS float*)(ws + WS_RSTD);
#pragma unroll 1
    for (int it = 0; it < 16; ++it) { const int row = pm * 256 + it * 16 + wave * 2 + (lane >> 5);
        float v = __builtin_bit_cast(float, __hip_atomic_load((unsigned*)(SSQ + (size_t)row * 32 + (lane & 31)), __ATOMIC_RELAXED, __HIP_MEMORY_SCOPE_AGENT));
#pragma unroll
        for (int o = 16; o > 0; o >>= 1) v += __shfl_xor(v, o);
        if ((lane & 31) == 0) R[row] = 1.0f / sqrtf(v * (1.f / DM) + EPS); }
}
__device__ __forceinline__ void sincos_f64(float angf, float& sn, float& cs) {
    const double a = (double)angf;
    const double n = __builtin_rint(a * 0.63661977236758134308);
    double r = __builtin_fma(-n, 1.57079632679489655800e+00, a); r = __builtin_fma(-n, 6.12323399573676603587e-17, r);
    const double r2 = r * r;
    double ps = -1.0 / 1307674368000.0; ps = ps * r2 + 1.0 / 6227020800.0; ps = ps * r2 - 1.0 / 39916800.0; ps = ps * r2 + 1.0 / 362880.0; ps = ps * r2 - 1.0 / 5040.0; ps = ps * r2 + 1.0 / 120.0; ps = ps * r2 - 1.0 / 6.0; ps = ps * r2 * r + r;
    double pc = 1.0 / 20922789888000.0; pc = pc * r2 - 1.0 / 87178291200.0; pc = pc * r2 + 1.0 / 479001600.0; pc = pc * r2 - 1.0 / 3628800.0; pc = pc * r2 + 1.0 / 40320.0; pc = pc * r2 - 1.0 / 720.0; pc = pc * r2 + 1.0 / 24.0; pc = pc * r2 - 0.5; pc = pc * r2 + 1.0;
    const int q = ((int)n) & 3;
    const double s_ = (q == 0) ? ps : (q == 1) ? pc : (q == 2) ? -ps : -pc;
    const double c_ = (q == 0) ? pc : (q == 1) ? -ps : (q == 2) ? -pc : ps;
    sn = (float)s_; cs = (float)c_;
}

__device__ __forceinline__ void latent_norm_row(bf16* row, int lane) {
    v4u a = *(const v4u*)(row + lane * 8), b = *(const v4u*)(row + 512 + lane * 8);
    float fa[8] = {bflo(a.x), bfhi(a.x), bflo(a.y), bfhi(a.y), bflo(a.z), bfhi(a.z), bflo(a.w), bfhi(a.w)};
    float fb[8] = {bflo(b.x), bfhi(b.x), bflo(b.y), bfhi(b.y), bflo(b.z), bfhi(b.z), bflo(b.w), bfhi(b.w)};
    float sa = 0.f, sb = 0.f;
#pragma unroll
    for (int i = 0; i < 8; ++i) { sa += fa[i] * fa[i]; sb += fb[i] * fb[i]; }
    const float ra = 1.0f / sqrtf(wave_sum(sa) * (1.f / 512.f) + EPS), rb = 1.0f / sqrtf(wave_sum(sb) * (1.f / 512.f) + EPS);
    a.x = pk2(fa[0] * ra, fa[1] * ra); a.y = pk2(fa[2] * ra, fa[3] * ra); a.z = pk2(fa[4] * ra, fa[5] * ra); a.w = pk2(fa[6] * ra, fa[7] * ra);
    b.x = pk2(fb[0] * rb, fb[1] * rb); b.y = pk2(fb[2] * rb, fb[3] * rb); b.z = pk2(fb[4] * rb, fb[5] * rb); b.w = pk2(fb[6] * rb, fb[7] * rb);
    *(v4u*)(row + lane * 8) = a; *(v4u*)(row + 512 + lane * 8) = b;
}

__device__ __forceinline__ void latent_rstd(unsigned char* ws, int gtid, int nthr) {
    const GAS f32x4* P = (const GAS f32x4*)(ws + WS_LSSQ); GAS float* RQ = (GAS float*)(ws + WS_LRQ); GAS float* RKV = (GAS float*)(ws + WS_LRKV);
    for (int row = gtid; row < S_; row += nthr) { const f32x4 a = P[row * 4], b = P[row * 4 + 1], c = P[row * 4 + 2], d = P[row * 4 + 3];
        const float sq = ((a.x + a.y) + (a.z + a.w)) + ((b.x + b.y) + (b.z + b.w)), sk = ((c.x + c.y) + (c.z + c.w)) + ((d.x + d.y) + (d.z + d.w));
        RQ[row] = 1.0f / sqrtf(sq * (1.f / 512.f) + EPS); RKV[row] = 1.0f / sqrtf(sk * (1.f / 512.f) + EPS); }
}

__device__ __forceinline__ void attn_naive(unsigned char* ws, LAS float* qs  , int gw, int ngw, int lane) {
    const bf16* QN = (const bf16*)(ws + WS_QN); const bf16* QR = (const bf16*)(ws + WS_QR); const bf16* KN = (const bf16*)(ws + WS_KN);
    const bf16* KPE = (const bf16*)(ws + WS_KPE); const bf16* VT = (const bf16*)(ws + WS_VT); bf16* ATT = (bf16*)(ws + WS_ATT);
    for (int item = gw; item < S_ * NH; item += ngw) {
        const int q = item >> 4, h = item & 15;
        if (lane < 24) { const v4u w = (lane < 16) ? *(const v4u*)(QN + (size_t)q * 2048 + h * 128 + lane * 8) : *(const v4u*)(QR + (size_t)q * 1024 + h * 64 + (lane - 16) * 8);
            LAS float* d = qs + lane * 8; d[0] = bflo(w.x); d[1] = bfhi(w.x); d[2] = bflo(w.y); d[3] = bfhi(w.y); d[4] = bflo(w.z); d[5] = bfhi(w.z); d[6] = bflo(w.w); d[7] = bfhi(w.w); }
        LDS_WAIT(); asm volatile("" ::: "memory");
        float m = -__builtin_inff(), l = 0.f, o0 = 0.f, o1 = 0.f;
        const bf16* v0p = VT + (size_t)(h * 128 + 2 * lane) * S_; const bf16* v1p = v0p + S_;
        for (int j0 = 0; j0 <= q; j0 += 64) {
            const int j = j0 + lane; const bool valid = j <= q; float s = 0.f;
            if (valid) {
                const bf16* kn = KN + (size_t)j * 2048 + h * 128; const bf16* kp = KPE + (size_t)j * 64;
#pragma unroll 4
                for (int c = 0; c < 24; ++c) { const v4u w = (c < 16) ? *(const v4u*)(kn + c * 8) : *(const v4u*)(kp + (c - 16) * 8); const LAS float* qq = qs + c * 8;
                    s += bflo(w.x) * qq[0] + bfhi(w.x) * qq[1] + bflo(w.y) * qq[2] + bfhi(w.y) * qq[3] + bflo(w.z) * qq[4] + bfhi(w.z) * qq[5] + bflo(w.w) * qq[6] + bfhi(w.w) * qq[7]; }
            } else s = -__builtin_inff();
            const float mn = fmaxf(m, wave_max(s)); const float alpha = __builtin_amdgcn_exp2f(m - mn); const float p = valid ? __builtin_amdgcn_exp2f(s - mn) : 0.f;
            l = l * alpha + wave_sum(p); m = mn; o0 *= alpha; o1 *= alpha;
#pragma unroll
            for (int c = 0; c < 8; ++c) { const v4u a = *(const v4u*)(v0p + j0 + c * 8), b = *(const v4u*)(v1p + j0 + c * 8);
                const float p0 = __builtin_bit_cast(float, __builtin_amdgcn_readlane(__builtin_bit_cast(int, p), c * 8 + 0)), p1 = __builtin_bit_cast(float, __builtin_amdgcn_readlane(__builtin_bit_cast(int, p), c * 8 + 1));
                const float p2 = __builtin_bit_cast(float, __builtin_amdgcn_readlane(__builtin_bit_cast(int, p), c * 8 + 2)), p3 = __builtin_bit_cast(float, __builtin_amdgcn_readlane(__builtin_bit_cast(int, p), c * 8 + 3));
                const float p4 = __builtin_bit_cast(float, __builtin_amdgcn_readlane(__builtin_bit_cast(int, p), c * 8 + 4)), p5 = __builtin_bit_cast(float, __builtin_amdgcn_readlane(__builtin_bit_cast(int, p), c * 8 + 5));
                const float p6 = __builtin_bit_cast(float, __builtin_amdgcn_readlane(__builtin_bit_cast(int, p), c * 8 + 6)), p7 = __builtin_bit_cast(float, __builtin_amdgcn_readlane(__builtin_bit_cast(int, p), c * 8 + 7));
                o0 += p0 * bflo(a.x) + p1 * bfhi(a.x) + p2 * bflo(a.y) + p3 * bfhi(a.y) + p4 * bflo(a.z) + p5 * bfhi(a.z) + p6 * bflo(a.w) + p7 * bfhi(a.w);
                o1 += p0 * bflo(b.x) + p1 * bfhi(b.x) + p2 * bflo(b.y) + p3 * bfhi(b.y) + p4 * bflo(b.z) + p5 * bfhi(b.z) + p6 * bflo(b.w) + p7 * bfhi(b.w); }
        }
        const float il = 1.f / l;
        *(unsigned*)(ATT + (size_t)q * 2048 + h * 128 + 2 * lane) = pk2(o0 * il, o1 * il);
        asm volatile("" ::: "memory");
    }
}
__device__ __forceinline__ void hgrn_naive(unsigned char* ws, int layer, int gw, int ngw, int lane) {
    const bf16* HQ = (const bf16*)(ws + WS_HQ); const _Float16* HF = (const _Float16*)(ws + WS_HF); const bf16* VTH = (const bf16*)(ws + WS_VTH);
    const float* LB = (const float*)(ws + WS_LB) + layer * 2048; float* RR = (float*)(ws + WS_RRAW);
    for (int item = gw; item < NH * 128; item += ngw) {
        const int h = item >> 7, e = item & 127, ch = h * 128 + 2 * lane;
        const float lb0 = LB[ch], lb1 = LB[ch + 1];
        float s0 = 0.f, s1 = 0.f;
        const bf16* vp = VTH + (size_t)(h * 128 + e) * S_;
        for (int t0 = 0; t0 < S_; t0 += 8) {
            const v4u vv = *(const v4u*)(vp + t0);
            const float vt[8] = {bflo(vv.x), bfhi(vv.x), bflo(vv.y), bfhi(vv.y), bflo(vv.z), bfhi(vv.z), bflo(vv.w), bfhi(vv.w)};
            float ov = 0.f;
#pragma unroll
            for (int i = 0; i < 8; ++i) { const size_t off = (size_t)(t0 + i) * 2048 + ch;
                const f32x2 z = *(const f32x2*)(HF + off); const unsigned qq = *(const unsigned*)(HQ + off);
                const float f0 = lb0 + (1.f - lb0) * sigm(z.x), f1 = lb1 + (1.f - lb1) * sigm(z.y);
                s0 = fmaxf(f0, 1e-30f) * s0 + (1.f - f0) * vt[i]; s1 = fmaxf(f1, 1e-30f) * s1 + (1.f - f1) * vt[i];
                const float o = wave_sum(bflo(qq) * s0 + bfhi(qq) * s1);
                ov = (lane == i) ? o : ov; }
            if (lane < 8) RR[(size_t)(t0 + lane) * 2048 + h * 128 + e] = ov;
        }
    }
}
__device__ __forceinline__ void hgrn_normgate(unsigned char* ws, const float* gain, int gw, int ngw, int lane) {
    const float* RR = (const float*)(ws + WS_RRAW); const bf16* HG = (const bf16*)(ws + WS_HG); bf16* REC = (bf16*)(ws + WS_REC);
    const f32x2 g = *(const GAS f32x2*)(gain + 2 * lane);
    for (int item = gw; item < S_ * NH; item += ngw) {
        const size_t off = (size_t)item * 128 + 2 * lane;
        const f32x2 v = *(const f32x2*)(RR + off); const unsigned hg = *(const unsigned*)(HG + off);
        const float rstd = 1.0f / sqrtf(wave_sum(v.x * v.x + v.y * v.y) * (1.f / 128.f) + EPS);
        *(unsigned*)(REC + off) = pk2(v.x * rstd * g.x * bflo(hg), v.y * rstd * g.y * bfhi(hg));
    }
}
__device__ __forceinline__ void conv_gate(unsigned char* ws, const float* cw, const float* cb, int gw, int ngw, int lane) {
    const bf16* U = (const bf16*)(ws + WS_U); bf16* ACT = (bf16*)(ws + WS_ACT);
    for (int item = gw; item < (S_ / 16) * 11; item += ngw) {
        const int tb = item / 11, cg = item % 11, c0 = cg * 512 + lane * 8;
        const int ucol = (c0 >> 7) * 256 + (c0 & 127), t0 = tb * 16;
        float wg[3][8], wu[3][8], bg[8], bu[8];
#pragma unroll
        for (int j = 0; j < 3; ++j)
#pragma unroll
            for (int i = 0; i < 8; ++i) { wg[j][i] = ((const GAS float*)cw)[(size_t)j * DFF2 + c0 + i]; wu[j][i] = ((const GAS float*)cw)[(size_t)j * DFF2 + DFF + c0 + i]; }
#pragma unroll
        for (int i = 0; i < 8; ++i) { bg[i] = ((const GAS float*)cb)[c0 + i]; bu[i] = ((const GAS float*)cb)[DFF + c0 + i]; }
        float g2[8], g1[8], u2[8], u1[8];
#pragma unroll
        for (int i = 0; i < 8; ++i) { g2[i] = 0.f; g1[i] = 0.f; u2[i] = 0.f; u1[i] = 0.f; }
        if (t0 > 0) {
            const v4u a = *(const v4u*)(U + (size_t)(t0 - 2) * DFF2 + ucol), b = *(const v4u*)(U + (size_t)(t0 - 2) * DFF2 + ucol + 128);
            const v4u c = *(const v4u*)(U + (size_t)(t0 - 1) * DFF2 + ucol), d = *(const v4u*)(U + (size_t)(t0 - 1) * DFF2 + ucol + 128);
            g2[0] = bflo(a.x); g2[1] = bfhi(a.x); g2[2] = bflo(a.y); g2[3] = bfhi(a.y); g2[4] = bflo(a.z); g2[5] = bfhi(a.z); g2[6] = bflo(a.w); g2[7] = bfhi(a.w);
            u2[0] = bflo(b.x); u2[1] = bfhi(b.x); u2[2] = bflo(b.y); u2[3] = bfhi(b.y); u2[4] = bflo(b.z); u2[5] = bfhi(b.z); u2[6] = bflo(b.w); u2[7] = bfhi(b.w);
            g1[0] = bflo(c.x); g1[1] = bfhi(c.x); g1[2] = bflo(c.y); g1[3] = bfhi(c.y); g1[4] = bflo(c.z); g1[5] = bfhi(c.z); g1[6] = bflo(c.w); g1[7] = bfhi(c.w);
            u1[0] = bflo(d.x); u1[1] = bfhi(d.x); u1[2] = bflo(d.y); u1[3] = bfhi(d.y); u1[4] = bflo(d.z); u1[5] = bfhi(d.z); u1[6] = bflo(d.w); u1[7] = bfhi(d.w);
        }
#pragma unroll 4
        for (int t = t0; t < t0 + 16; ++t) {
            const v4u a = *(const v4u*)(U + (size_t)t * DFF2 + ucol), b = *(const v4u*)(U + (size_t)t * DFF2 + ucol + 128);
            float g0[8], u0[8];
            g0[0] = bflo(a.x); g0[1] = bfhi(a.x); g0[2] = bflo(a.y); g0[3] = bfhi(a.y); g0[4] = bflo(a.z); g0[5] = bfhi(a.z); g0[6] = bflo(a.w); g0[7] = bfhi(a.w);
            u0[0] = bflo(b.x); u0[1] = bfhi(b.x); u0[2] = bflo(b.y); u0[3] = bfhi(b.y); u0[4] = bflo(b.z); u0[5] = bfhi(b.z); u0[6] = bflo(b.w); u0[7] = bfhi(b.w);
            float r[8];
#pragma unroll
            for (int i = 0; i < 8; ++i) { const float G = bg[i] + wg[0][i] * g2[i] + wg[1][i] * g1[i] + wg[2][i] * g0[i]; const float Uu = bu[i] + wu[0][i] * u2[i] + wu[1][i] * u1[i] + wu[2][i] * u0[i];
                r[i] = G * sigm(G) * Uu; g2[i] = g1[i]; g1[i] = g0[i]; u2[i] = u1[i]; u1[i] = u0[i]; }
            v4u o; o.x = pk2(r[0], r[1]); o.y = pk2(r[2], r[3]); o.z = pk2(r[4], r[5]); o.w = pk2(r[6], r[7]);
            *(v4u*)(ACT + (size_t)t * DFF + c0) = o;
        }
    }
}

namespace fa {
typedef float f32x16 __attribute__((ext_vector_type(16)));
constexpr int KBUF = 24576, VBUF = 16384, STG = KBUF + VBUF;
constexpr float THR = 8.0f;
__device__ __forceinline__ float hmax(float a) { return fmaxf(a, __shfl_xor(a, 32)); }
__device__ __forceinline__ float hsum(float a) { return a + __shfl_xor(a, 32); }
__device__ __forceinline__ bf16x8 pk8(const f32x16& p, int b) {
    v4u w; w.x = pg8::cvt_pk_bf16(p[b], p[b + 1]); w.y = pg8::cvt_pk_bf16(p[b + 2], p[b + 3]); w.z = pg8::cvt_pk_bf16(p[b + 4], p[b + 5]); w.w = pg8::cvt_pk_bf16(p[b + 6], p[b + 7]);
    return __builtin_bit_cast(bf16x8, w);
}
__device__ __forceinline__ void attn_fast(unsigned char* ws, LAS unsigned char* lds, unsigned* qcnt  , LAS unsigned* qslot  , unsigned myx) {
    int tid = threadIdx.x; asm volatile("" : "+v"(tid));
    const int lane = tid & 63, w = __builtin_amdgcn_readfirstlane(tid >> 6), r32 = lane & 31, hi = lane >> 5;
    const bf16* QN = (const bf16*)(ws + WS_QN); const bf16* QR = (const bf16*)(ws + WS_QR); const bf16* KN = (const bf16*)(ws + WS_KN);
    const bf16* KPE = (const bf16*)(ws + WS_KPE); const bf16* VT = (const bf16*)(ws + WS_VT); bf16* ATT = (bf16*)(ws + WS_ATT);
    const int pr = (r32 & 0x13) | ((r32 & 4) << 1) | ((r32 & 8) >> 1);
    const int kfo = hi * 1024 + pr * 16;
    const int fb = (r32 >> 1) & 7, va = (hi ^ (fb & 1)) << 4, vbb = fb >> 1;
    const int vfo = KBUF + r32 * 128 + va;
    const int vrow0 = 16 * w + (lane >> 3), vrow1 = vrow0 + 8;
    const int vsc0 = ((lane & 7) ^ ((vrow0 >> 1) & 7)) * 8, vsc1 = ((lane & 7) ^ ((vrow1 >> 1) & 7)) * 8;
    for (int kq = 0; kq < 8; ++kq) { const unsigned xq = (myx + (unsigned)kq) & 7u;
      for (;;) {
        if (tid == 0) *qslot = __hip_atomic_fetch_add(qcnt + 64 * xq, 1u, __ATOMIC_RELAXED, __HIP_MEMORY_SCOPE_AGENT);
        __syncthreads();
        const unsigned ui = (unsigned)__builtin_amdgcn_readfirstlane((int)*qslot);
        __syncthreads();
        if (ui >= 64u) break;
        const int h = 2 * (int)xq + (int)(ui & 1u);
        const bf16* kn_l = KN + (size_t)lane * 2048 + h * 128 + 8 * w;
        const bf16* kp_l = KPE + (size_t)lane * 64 + 8 * w;
        const bf16* v0_l = VT + (size_t)(h * 128 + vrow0) * S_ + vsc0; const bf16* v1_l = VT + (size_t)(h * 128 + vrow1) * S_ + vsc1;
#define FA_ISSUE(t, st) do { const size_t ko_ = (size_t)(t) * 64 * 2048, po_ = (size_t)(t) * 64 * 64; const int to_ = (t) * 64; LAS unsigned char* sb_ = lds + (st) * STG; \
        __builtin_amdgcn_global_load_lds((const unsigned*)(kn_l + ko_), (LAS unsigned*)(sb_ + w * 1024), 16, 0, 0); \
        __builtin_amdgcn_global_load_lds((const unsigned*)(kn_l + ko_ + 64), (LAS unsigned*)(sb_ + (w + 8) * 1024), 16, 0, 0); \
        __builtin_amdgcn_global_load_lds((const unsigned*)(kp_l + po_), (LAS unsigned*)(sb_ + (w + 16) * 1024), 16, 0, 0); \
        __builtin_amdgcn_global_load_lds((const unsigned*)(v0_l + to_), (LAS unsigned*)(sb_ + KBUF + (2 * w) * 1024), 16, 0, 0); \
        __builtin_amdgcn_global_load_lds((const unsigned*)(v1_l + to_), (LAS unsigned*)(sb_ + KBUF + (2 * w + 1) * 1024), 16, 0, 0); } while (0)
        {
            const int qb = 31 - (int)(ui >> 1), q0 = qb * 256, NT = 4 * qb + 4, qw = q0 + 32 * w, q = qw + r32;
            FA_ISSUE(0, 0);
            bf16x8 qr[12];
#pragma unroll
            for (int d0 = 0; d0 < 8; ++d0) qr[d0] = *(const bf16x8*)(QN + (size_t)q * 2048 + h * 128 + d0 * 16 + hi * 8);
#pragma unroll
            for (int d0 = 0; d0 < 4; ++d0) qr[8 + d0] = *(const bf16x8*)(QR + (size_t)q * 1024 + h * 64 + d0 * 16 + hi * 8);
            f32x16 o[4];
#pragma unroll
            for (int e = 0; e < 4; ++e)
#pragma unroll
                for (int r = 0; r < 16; ++r) o[e][r] = 0.f;
            float m = -__builtin_inff(), l = 0.f;
            for (int t = 0; t < NT; ++t) {
                VM_WAIT(); __syncthreads();
                if (t + 1 < NT) FA_ISSUE(t + 1, (t + 1) & 1);
                {
                    const LAS unsigned char* sb = lds + (t & 1) * STG;
                    f32x16 p0, p1;
#pragma unroll
                    for (int r = 0; r < 16; ++r) { p0[r] = 0.f; p1[r] = 0.f; }
                    {
#define FA_KLD(g, A0, A1, B0, B1) do { A0 = *(const LAS bf16x8*)(sb + kfo + (2 * (g)) * 2048); A1 = *(const LAS bf16x8*)(sb + kfo + (2 * (g)) * 2048 + 512); \
                                       B0 = *(const LAS bf16x8*)(sb + kfo + (2 * (g) + 1) * 2048); B1 = *(const LAS bf16x8*)(sb + kfo + (2 * (g) + 1) * 2048 + 512); } while (0)
#define FA_KMM(g, A0, A1, B0, B1) do { p0 = __builtin_amdgcn_mfma_f32_32x32x16_bf16(A0, qr[2 * (g)], p0, 0, 0, 0); p1 = __builtin_amdgcn_mfma_f32_32x32x16_bf16(A1, qr[2 * (g)], p1, 0, 0, 0); \
                                       p0 = __builtin_amdgcn_mfma_f32_32x32x16_bf16(B0, qr[2 * (g) + 1], p0, 0, 0, 0); p1 = __builtin_amdgcn_mfma_f32_32x32x16_bf16(B1, qr[2 * (g) + 1], p1, 0, 0, 0); } while (0)
                        bf16x8 xa0, xa1, xb0, xb1, ya0, ya1, yb0, yb1;
                        FA_KLD(0, xa0, xa1, xb0, xb1); __builtin_amdgcn_sched_barrier(0);
                        FA_KLD(1, ya0, ya1, yb0, yb1); __builtin_amdgcn_sched_barrier(0); FA_KMM(0, xa0, xa1, xb0, xb1); __builtin_amdgcn_sched_barrier(0);
                        FA_KLD(2, xa0, xa1, xb0, xb1); __builtin_amdgcn_sched_barrier(0); FA_KMM(1, ya0, ya1, yb0, yb1); __builtin_amdgcn_sched_barrier(0);
                        FA_KLD(3, ya0, ya1, yb0, yb1); __builtin_amdgcn_sched_barrier(0); FA_KMM(2, xa0, xa1, xb0, xb1); __builtin_amdgcn_sched_barrier(0);
                        FA_KLD(4, xa0, xa1, xb0, xb1); __builtin_amdgcn_sched_barrier(0); FA_KMM(3, ya0, ya1, yb0, yb1); __builtin_amdgcn_sched_barrier(0);
                        FA_KLD(5, ya0, ya1, yb0, yb1); __builtin_amdgcn_sched_barrier(0); FA_KMM(4, xa0, xa1, xb0, xb1); __builtin_amdgcn_sched_barrier(0);
                        FA_KMM(5, ya0, ya1, yb0, yb1);
#undef FA_KLD
#undef FA_KMM
                    }
                    if (64 * t + 63 > qw) {
                        const int kb = 64 * t + 8 * hi - q;
#pragma unroll
                        for (int r = 0; r < 16; ++r) { const int dk = kb + 16 * (r >> 3) + (r & 7); if (dk > 0) p0[r] = -__builtin_inff(); if (dk + 32 > 0) p1[r] = -__builtin_inff(); }
                    }
                    float mx = fmaxf(p0[0], p1[0]);
#pragma unroll
                    for (int r = 1; r < 16; ++r) mx = fmaxf(mx, fmaxf(p0[r], p1[r]));
                    mx = hmax(mx);
                    if (__any(mx > m + THR)) { const float mn = fmaxf(m, mx), alpha = __builtin_amdgcn_exp2f(m - mn); m = mn; l *= alpha;
#pragma unroll
                        for (int e = 0; e < 4; ++e)
#pragma unroll
                            for (int r = 0; r < 16; ++r) o[e][r] *= alpha; }
                    float ps = 0.f;
#pragma unroll
                    for (int r = 0; r < 16; ++r) { p0[r] = __builtin_amdgcn_exp2f(p0[r] - m); p1[r] = __builtin_amdgcn_exp2f(p1[r] - m); ps += p0[r] + p1[r]; }
                    l += ps;
                    const bf16x8 pf0 = pk8(p0, 0), pf1 = pk8(p0, 8), pf2 = pk8(p1, 0), pf3 = pk8(p1, 8);
                    const LAS unsigned char* vb0 = sb + vfo + ((0 ^ vbb) << 5); const LAS unsigned char* vb1 = sb + vfo + ((1 ^ vbb) << 5);
                    const LAS unsigned char* vb2 = sb + vfo + ((2 ^ vbb) << 5); const LAS unsigned char* vb3 = sb + vfo + ((3 ^ vbb) << 5);
#define FA_PVK(vb, pf) do { const bf16x8 a0 = *(const LAS bf16x8*)((vb)), a1 = *(const LAS bf16x8*)((vb) + 4096), a2 = *(const LAS bf16x8*)((vb) + 8192), a3 = *(const LAS bf16x8*)((vb) + 12288); \
                        o[0] = __builtin_amdgcn_mfma_f32_32x32x16_bf16(a0, pf, o[0], 0, 0, 0); o[1] = __builtin_amdgcn_mfma_f32_32x32x16_bf16(a1, pf, o[1], 0, 0, 0); \
                        o[2] = __builtin_amdgcn_mfma_f32_32x32x16_bf16(a2, pf, o[2], 0, 0, 0); o[3] = __builtin_amdgcn_mfma_f32_32x32x16_bf16(a3, pf, o[3], 0, 0, 0); } while (0)
                    FA_PVK(vb0, pf0); FA_PVK(vb1, pf1); FA_PVK(vb2, pf2); FA_PVK(vb3, pf3);
#undef FA_PVK
                }
            }
            const float il = 1.0f / hsum(l);
            bf16* op = ATT + (size_t)q * 2048 + h * 128 + 4 * hi;
#pragma unroll
            for (int e = 0; e < 4; ++e)
#pragma unroll
                for (int g4 = 0; g4 < 4; ++g4) { v2u wv; wv.x = pg8::cvt_pk_bf16(o[e][4 * g4] * il, o[e][4 * g4 + 1] * il); wv.y = pg8::cvt_pk_bf16(o[e][4 * g4 + 2] * il, o[e][4 * g4 + 3] * il);
                    *(v2u*)(op + e * 32 + g4 * 8) = wv; }
            __syncthreads();
        }
#undef FA_ISSUE
      }
    }
}
}

namespace fa16 {
typedef float f32x4_ __attribute__((ext_vector_type(4)));
constexpr int KBUF = 24576, VBUF = 16384, STG = KBUF + VBUF;
constexpr float THR = 8.0f;
__device__ __forceinline__ float gmax(float a) { a = fmaxf(a, __shfl_xor(a, 16)); return fmaxf(a, __shfl_xor(a, 32)); }
__device__ __forceinline__ float gsum(float a) { a += __shfl_xor(a, 16); return a + __shfl_xor(a, 32); }
__device__ __forceinline__ bf16x8 pk44(const f32x4_& a, const f32x4_& b) {
    v4u w; w.x = pg8::cvt_pk_bf16(a[0], a[1]); w.y = pg8::cvt_pk_bf16(a[2], a[3]); w.z = pg8::cvt_pk_bf16(b[0], b[1]); w.w = pg8::cvt_pk_bf16(b[2], b[3]);
    return __builtin_bit_cast(bf16x8, w);
}
__device__ __forceinline__ void attn_fast(unsigned char* ws, LAS unsigned char* lds, unsigned* qcnt  , LAS unsigned* qslot  , unsigned myx) {
    int tid = threadIdx.x; asm volatile("" : "+v"(tid));
    const int lane = tid & 63, w = __builtin_amdgcn_readfirstlane(tid >> 6), n16 = lane & 15, g = lane >> 4;
    const bf16* QN = (const bf16*)(ws + WS_QN); const bf16* QR = (const bf16*)(ws + WS_QR); const bf16* KN = (const bf16*)(ws + WS_KN);
    const bf16* KPE = (const bf16*)(ws + WS_KPE); const bf16* VT = (const bf16*)(ws + WS_VT); bf16* ATT = (bf16*)(ws + WS_ATT);
    const int krow = 8 * (n16 >> 2) + (n16 & 3);
    const int kfo0 = g * 1024 + ((krow ^ ((g & 1) << 2)) * 16), kfo1 = g * 1024 + (((krow + 4) ^ ((g & 1) << 2)) * 16);
    const int fv0 = (n16 >> 1) & 7;
    const int vfo0 = KBUF + n16 * 128 + (((0 + g) ^ fv0) << 4), vfo1 = KBUF + n16 * 128 + (((4 + g) ^ fv0) << 4);
    const int ksrc = lane ^ ((w & 1) << 2);
    const int vrow0 = 16 * w + (lane >> 3), vrow1 = vrow0 + 8;
    const int vsc0 = ((lane & 7) ^ ((vrow0 >> 1) & 7)) * 8, vsc1 = ((lane & 7) ^ ((vrow1 >> 1) & 7)) * 8;
    int mode = 0, bi = 7; bool any = false;
    __syncthreads();
    for (;;) {
        unsigned xq = myx, ui = 64u;
        if (mode == 0) {
            ui = (unsigned)__builtin_amdgcn_readfirstlane((int)qslot[0]);
            if (ui >= 64u) { mode = 1; bi = 7; any = true; continue; }
        } else {
            if (bi >= 7) {
                if (!any) break;
                if (tid < 7) qslot[1 + tid] = __hip_atomic_fetch_add(qcnt + 64 * ((myx + 1u + (unsigned)tid) & 7u), 1u, __ATOMIC_RELAXED, __HIP_MEMORY_SCOPE_AGENT);
                __syncthreads();
                bi = 0; any = false; }
            while (bi < 7) { const unsigned v = (unsigned)__builtin_amdgcn_readfirstlane((int)qslot[1 + bi]); ++bi; if (v < 64u) { ui = v; xq = (myx + (unsigned)bi) & 7u; break; } }
            if (ui >= 64u) { __syncthreads(); continue; }
            any = true;
        }
        const int h = 2 * (int)xq + (int)(ui & 1u);
        const bf16* kn_l = KN + (size_t)ksrc * 2048 + h * 128 + 8 * w;
        const bf16* kp_l = KPE + (size_t)ksrc * 64 + 8 * w;
        const bf16* v0_l = VT + (size_t)(h * 128 + vrow0) * S_ + vsc0; const bf16* v1_l = VT + (size_t)(h * 128 + vrow1) * S_ + vsc1;
#define FA_ISSUE(t, st) do { const size_t ko_ = (size_t)(t) * 64 * 2048, po_ = (size_t)(t) * 64 * 64; const int to_ = (t) * 64; LAS unsigned char* sb_ = lds + (st) * STG; \
        __builtin_amdgcn_global_load_lds((const unsigned*)(kn_l + ko_), (LAS unsigned*)(sb_ + w * 1024), 16, 0, 0); \
        __builtin_amdgcn_global_load_lds((const unsigned*)(kn_l + ko_ + 64), (LAS unsigned*)(sb_ + (w + 8) * 1024), 16, 0, 0); \
        __builtin_amdgcn_global_load_lds((const unsigned*)(kp_l + po_), (LAS unsigned*)(sb_ + (w + 16) * 1024), 16, 0, 0); \
        __builtin_amdgcn_global_load_lds((const unsigned*)(v0_l + to_), (LAS unsigned*)(sb_ + KBUF + (2 * w) * 1024), 16, 0, 0); \
        __builtin_amdgcn_global_load_lds((const unsigned*)(v1_l + to_), (LAS unsigned*)(sb_ + KBUF + (2 * w + 1) * 1024), 16, 0, 0); } while (0)
        {
            const int qb256 = 31 - (int)(ui >> 1), q0 = qb256 * 256, NT = 4 * qb256 + 4, qw = q0 + 32 * w;
            FA_ISSUE(0, 0);
            bf16x8 qr[2][6];
#pragma unroll
            for (int qb = 0; qb < 2; ++qb) { const size_t qrow = (size_t)(qw + 16 * qb + n16);
#pragma unroll
                for (int kd = 0; kd < 4; ++kd) qr[qb][kd] = *(const bf16x8*)(QN + qrow * 2048 + h * 128 + kd * 32 + g * 8);
#pragma unroll
                for (int kd = 0; kd < 2; ++kd) qr[qb][4 + kd] = *(const bf16x8*)(QR + qrow * 1024 + h * 64 + kd * 32 + g * 8); }
            f32x4_ o[8][2];
#pragma unroll
            for (int e = 0; e < 8; ++e)
#pragma unroll
                for (int qb = 0; qb < 2; ++qb) o[e][qb] = (f32x4_){0.f, 0.f, 0.f, 0.f};
            float m0 = -__builtin_inff(), m1 = -__builtin_inff(), l0 = 0.f, l1 = 0.f;
            unsigned nclaim = 64u; const int tclaim = NT > 9 ? NT - 9 : 0;
            if (w >= 4) __builtin_amdgcn_s_setprio(1);
            for (int t = 0; t < NT; ++t) {
                VM_WAIT(); __syncthreads();
                if (t + 1 < NT) FA_ISSUE(t + 1, (t + 1) & 1);
                if (t == tclaim && mode == 0 && tid == 0) nclaim = __hip_atomic_fetch_add(qcnt + 64 * myx, 1u, __ATOMIC_RELAXED, __HIP_MEMORY_SCOPE_AGENT);
                if (64 * t <= qw + 31) {
                    const LAS unsigned char* sb = lds + (t & 1) * STG;
                    f32x4_ st[4][2];
#pragma unroll
                    for (int kb = 0; kb < 4; ++kb) { st[kb][0] = (f32x4_){0.f, 0.f, 0.f, 0.f}; st[kb][1] = (f32x4_){0.f, 0.f, 0.f, 0.f}; }
                    {
#define F16_KLD(kd, A, B, C, D) do { A = *(const LAS bf16x8*)(sb + kfo0 + (kd) * 4096); B = *(const LAS bf16x8*)(sb + kfo1 + (kd) * 4096); \
                                     C = *(const LAS bf16x8*)(sb + kfo0 + (kd) * 4096 + 512); D = *(const LAS bf16x8*)(sb + kfo1 + (kd) * 4096 + 512); } while (0)
#define F16_KMM(kd, A, B, C, D) do { \
        st[0][0] = __builtin_amdgcn_mfma_f32_16x16x32_bf16(A, qr[0][kd], st[0][0], 0, 0, 0); st[0][1] = __builtin_amdgcn_mfma_f32_16x16x32_bf16(A, qr[1][kd], st[0][1], 0, 0, 0); \
        st[1][0] = __builtin_amdgcn_mfma_f32_16x16x32_bf16(B, qr[0][kd], st[1][0], 0, 0, 0); st[1][1] = __builtin_amdgcn_mfma_f32_16x16x32_bf16(B, qr[1][kd], st[1][1], 0, 0, 0); \
        st[2][0] = __builtin_amdgcn_mfma_f32_16x16x32_bf16(C, qr[0][kd], st[2][0], 0, 0, 0); st[2][1] = __builtin_amdgcn_mfma_f32_16x16x32_bf16(C, qr[1][kd], st[2][1], 0, 0, 0); \
        st[3][0] = __builtin_amdgcn_mfma_f32_16x16x32_bf16(D, qr[0][kd], st[3][0], 0, 0, 0); st[3][1] = __builtin_amdgcn_mfma_f32_16x16x32_bf16(D, qr[1][kd], st[3][1], 0, 0, 0); } while (0)
                        bf16x8 xa, xb, xc, xd, ya, yb, yc, yd;
                        F16_KLD(0, xa, xb, xc, xd); __builtin_amdgcn_sched_barrier(0);
                        F16_KLD(1, ya, yb, yc, yd); __builtin_amdgcn_sched_barrier(0); F16_KMM(0, xa, xb, xc, xd); __builtin_amdgcn_sched_barrier(0);
                        F16_KLD(2, xa, xb, xc, xd); __builtin_amdgcn_sched_barrier(0); F16_KMM(1, ya, yb, yc, yd); __builtin_amdgcn_sched_barrier(0);
                        F16_KLD(3, ya, yb, yc, yd); __builtin_amdgcn_sched_barrier(0); F16_KMM(2, xa, xb, xc, xd); __builtin_amdgcn_sched_barrier(0);
                        F16_KLD(4, xa, xb, xc, xd); __builtin_amdgcn_sched_barrier(0); F16_KMM(3, ya, yb, yc, yd); __builtin_amdgcn_sched_barrier(0);
                        F16_KLD(5, ya, yb, yc, yd); __builtin_amdgcn_sched_barrier(0); F16_KMM(4, xa, xb, xc, xd); __builtin_amdgcn_sched_barrier(0);
                        F16_KMM(5, ya, yb, yc, yd);
#undef F16_KLD
#undef F16_KMM
                    }
                    if (64 * t + 63 > qw) {
                        const int kq0 = 64 * t + 8 * g - (qw + n16);
#pragma unroll
                        for (int kb = 0; kb < 4; ++kb)
#pragma unroll
                            for (int r = 0; r < 4; ++r) { const int dk = kq0 + 32 * (kb >> 1) + 4 * (kb & 1) + r; if (dk > 0) st[kb][0][r] = -__builtin_inff(); if (dk - 16 > 0) st[kb][1][r] = -__builtin_inff(); }
                    }
                    float mx0 = fmaxf(fmaxf(st[0][0][0], st[0][0][1]), fmaxf(st[0][0][2], st[0][0][3])), mx1 = fmaxf(fmaxf(st[0][1][0], st[0][1][1]), fmaxf(st[0][1][2], st[0][1][3]));
#pragma unroll
                    for (int kb = 1; kb < 4; ++kb) { mx0 = fmaxf(mx0, fmaxf(fmaxf(st[kb][0][0], st[kb][0][1]), fmaxf(st[kb][0][2], st[kb][0][3]))); mx1 = fmaxf(mx1, fmaxf(fmaxf(st[kb][1][0], st[kb][1][1]), fmaxf(st[kb][1][2], st[kb][1][3]))); }
                    mx0 = gmax(mx0); mx1 = gmax(mx1);
                    if (__any(mx0 > m0 + THR || mx1 > m1 + THR)) {
                        const float mn0 = fmaxf(m0, mx0), mn1 = fmaxf(m1, mx1), a0 = __builtin_amdgcn_exp2f(m0 - mn0), a1 = __builtin_amdgcn_exp2f(m1 - mn1); m0 = mn0; m1 = mn1; l0 *= a0; l1 *= a1;
#pragma unroll
                        for (int e = 0; e < 8; ++e) { o[e][0] *= a0; o[e][1] *= a1; } }
                    float ps0 = 0.f, ps1 = 0.f;
#pragma unroll
                    for (int kb = 0; kb < 4; ++kb)
#pragma unroll
                        for (int r = 0; r < 4; ++r) { st[kb][0][r] = __builtin_amdgcn_exp2f(st[kb][0][r] - m0); st[kb][1][r] = __builtin_amdgcn_exp2f(st[kb][1][r] - m1); ps0 += st[kb][0][r]; ps1 += st[kb][1][r]; }
                    l0 += ps0; l1 += ps1;
                    const bf16x8 pf00 = pk44(st[0][0], st[1][0]), pf01 = pk44(st[2][0], st[3][0]), pf10 = pk44(st[0][1], st[1][1]), pf11 = pk44(st[2][1], st[3][1]);
#pragma unroll
                    for (int e = 0; e < 8; ++e) {
                        const bf16x8 v0 = *(const LAS bf16x8*)(sb + vfo0 + e * 2048), v1 = *(const LAS bf16x8*)(sb + vfo1 + e * 2048);
                        o[e][0] = __builtin_amdgcn_mfma_f32_16x16x32_bf16(v0, pf00, o[e][0], 0, 0, 0); o[e][1] = __builtin_amdgcn_mfma_f32_16x16x32_bf16(v0, pf10, o[e][1], 0, 0, 0);
                        o[e][0] = __builtin_amdgcn_mfma_f32_16x16x32_bf16(v1, pf01, o[e][0], 0, 0, 0); o[e][1] = __builtin_amdgcn_mfma_f32_16x16x32_bf16(v1, pf11, o[e][1], 0, 0, 0); }
                }
            }
            __builtin_amdgcn_s_setprio(0);
            const float il0 = 1.0f / gsum(l0), il1 = 1.0f / gsum(l1);
#pragma unroll
            for (int qb = 0; qb < 2; ++qb) { bf16* op = ATT + (size_t)(qw + 16 * qb + n16) * 2048 + h * 128 + 4 * g; const float il = qb ? il1 : il0;
#pragma unroll
                for (int e = 0; e < 8; ++e) { v2u wv; wv.x = pg8::cvt_pk_bf16(o[e][qb][0] * il, o[e][qb][1] * il); wv.y = pg8::cvt_pk_bf16(o[e][qb][2] * il, o[e][qb][3] * il); *(v2u*)(op + e * 16) = wv; } }
            if (mode == 0 && tid == 0) qslot[0] = nclaim;
            __syncthreads();
        }
#undef FA_ISSUE
    }
}
}

namespace hg {
typedef float f32x16 __attribute__((ext_vector_type(16)));
constexpr int L_TOT = 0, L_KT = 4096;
constexpr int L_QA = 4096, L_QB = 20480, L_KA0 = 28672, L_KA1 = 36864, L_SSP = 53248;
__device__ __forceinline__ float log2_(float x) { return __builtin_amdgcn_logf(x); }
__device__ __forceinline__ float exp2_(float x) { return __builtin_amdgcn_exp2f(x); }
__device__ __forceinline__ bf16x8 pk8(const f32x16& p, int b) {
    v4u w; w.x = pg8::cvt_pk_bf16(p[b], p[b + 1]); w.y = pg8::cvt_pk_bf16(p[b + 2], p[b + 3]); w.z = pg8::cvt_pk_bf16(p[b + 4], p[b + 5]); w.w = pg8::cvt_pk_bf16(p[b + 6], p[b + 7]);
    return __builtin_bit_cast(bf16x8, w);
}
#define HG_GATES(HFp, lbv, t0, h) \
    float kk[16], bl[16]; { float run_ = 0.f; const _Float16* zp_ = (HFp) + (size_t)((t0) + 16 * tg) * 2048 + (h) * 128 + d; \
      _Pragma("unroll") for (int i = 0; i < 16; ++i) { const float z_ = (float)zp_[(size_t)i * 2048]; const float f_ = (lbv) + (1.f - (lbv)) * sigm(z_); kk[i] = 1.f - f_; run_ += log2_(fmaxf(f_, 1e-30f)); bl[i] = run_; } }

__device__ __forceinline__ void pass1(unsigned char* ws, LAS unsigned char* lds, int layer, int vcu, int G) {
    int tid = threadIdx.x; asm volatile("" : "+v"(tid));
    const int lane = tid & 63, w = __builtin_amdgcn_readfirstlane(tid >> 6), d = tid & 127, tg = tid >> 7, r32 = lane & 31, hi = lane >> 5;
    const _Float16* HF = (const _Float16*)(ws + WS_HF); const bf16* VTH = (const bf16*)(ws + WS_VTH); bf16* HU = (bf16*)(ws + WS_HU); float* GAM = (float*)(ws + WS_RRAW);
    const float* LB = (const float*)(ws + WS_LB) + layer * 2048;
    LAS float* tot = (LAS float*)(lds + L_TOT); LAS unsigned char* KT = lds + L_KT;
    const int fsw = (d >> 1) & 7, fsr = (r32 >> 1) & 7, et = w >> 1, dt0 = 2 * (w & 1);
    _Float16 zr[16];
#define HG_RAWZ(unit_) do { const int h_ = (unit_) >> 7, t0_ = ((unit_) & 127) * 64; const size_t o_ = (size_t)(t0_ + 16 * tg) * 2048 + h_ * 128 + d; \
        _Pragma("unroll") for (int i = 0; i < 16; ++i) zr[i] = HF[o_ + (size_t)i * 2048]; } while (0)
    if (vcu < NH * 128) HG_RAWZ(vcu);
    for (int unit = vcu; unit < NH * 128; unit += G) {
        const int h = unit >> 7, c = unit & 127, t0 = c * 64;
        const float lb = LB[h * 128 + d];
        bf16x8 af[4];
#pragma unroll
        for (int ks = 0; ks < 4; ++ks) af[ks] = *(const bf16x8*)(VTH + (size_t)(h * 128 + 32 * et + r32) * S_ + t0 + 16 * ks + 8 * hi);
        float kk[16], bl[16];
        { float run = 0.f;
#pragma unroll
          for (int i = 0; i < 16; ++i) { const float f_ = lb + (1.f - lb) * sigm((float)zr[i]); kk[i] = 1.f - f_; run += log2_(fmaxf(f_, 1e-30f)); bl[i] = run; } }
        tot[tg * 128 + d] = bl[15];
        __syncthreads();
        float pre = 0.f, all = 0.f;
#pragma unroll
        for (int j = 0; j < 4; ++j) { const float v = tot[j * 128 + d]; pre += (j < tg) ? v : 0.f; all += v; }
        { float kh[16];
#pragma unroll
          for (int i = 0; i < 16; ++i) kh[i] = kk[i] * exp2_(all - (pre + bl[i]));
          v4u c0, c1; c0.x = pg8::cvt_pk_bf16(kh[0], kh[1]); c0.y = pg8::cvt_pk_bf16(kh[2], kh[3]); c0.z = pg8::cvt_pk_bf16(kh[4], kh[5]); c0.w = pg8::cvt_pk_bf16(kh[6], kh[7]);
          c1.x = pg8::cvt_pk_bf16(kh[8], kh[9]); c1.y = pg8::cvt_pk_bf16(kh[10], kh[11]); c1.z = pg8::cvt_pk_bf16(kh[12], kh[13]); c1.w = pg8::cvt_pk_bf16(kh[14], kh[15]);
          *(LAS v4u*)(KT + d * 128 + (((2 * tg) ^ fsw) << 4)) = c0; *(LAS v4u*)(KT + d * 128 + (((2 * tg + 1) ^ fsw) << 4)) = c1; }
        if (tg == 0) GAM[(size_t)(h * 128 + c) * 128 + d] = exp2_(all);
        if (unit + G < NH * 128) HG_RAWZ(unit + G);
        __syncthreads();
#pragma unroll
        for (int dd = 0; dd < 2; ++dd) { const int dt = dt0 + dd; f32x16 acc;
#pragma unroll
            for (int r = 0; r < 16; ++r) acc[r] = 0.f;
#pragma unroll
            for (int ks = 0; ks < 4; ++ks) { const bf16x8 aq = *(const LAS bf16x8*)(KT + (32 * dt + r32) * 128 + (((2 * ks + hi) ^ fsr) << 4)); acc = __builtin_amdgcn_mfma_f32_32x32x16_bf16(aq, af[ks], acc, 0, 0, 0); }
            bf16* up = HU + ((size_t)(h * 128 + c) * 128 + 32 * et + r32) * 128 + 32 * dt + 4 * hi;
#pragma unroll
            for (int g4 = 0; g4 < 4; ++g4) { v2u wv; wv.x = pg8::cvt_pk_bf16(acc[4 * g4], acc[4 * g4 + 1]); wv.y = pg8::cvt_pk_bf16(acc[4 * g4 + 2], acc[4 * g4 + 3]); *(v2u*)(up + 8 * g4) = wv; } }
        __syncthreads();
    }
#undef HG_RAWZ
}
__device__ __forceinline__ void scan(unsigned char* ws, LAS unsigned char* lds, int vcu, int G) {
    const int tid = threadIdx.x;
    const bf16* HU = (const bf16*)(ws + WS_HU); const float* GAM = (const float*)(ws + WS_RRAW); bf16* HS = (bf16*)(ws + WS_HS);
    LAS float* gl = (LAS float*)lds;
    for (int item = vcu; item < NH * 16; item += G) {
        const int h = item >> 4, e = 8 * (item & 15) + (tid >> 6), d = 2 * (tid & 63);
        __syncthreads();
        { const GAS f32x4* gsrc = (const GAS f32x4*)(GAM + (size_t)h * 128 * 128);
#pragma unroll
          for (int i = 0; i < 8; ++i) *(LAS f32x4*)(gl + 4 * (tid + 512 * i)) = gsrc[tid + 512 * i]; }
        __syncthreads();
        float s0 = 0.f, s1 = 0.f;
#pragma unroll 8
        for (int c = 0; c < 128; ++c) { const size_t base = ((size_t)(h * 128 + c) * 128 + e) * 128 + d;
            *(unsigned*)(HS + base) = pg8::cvt_pk_bf16(s0, s1);
            const unsigned u = *(const unsigned*)(HU + base); const f32x2 gm = *(const LAS f32x2*)(gl + c * 128 + d);
            s0 = gm.x * s0 + bflo(u); s1 = gm.y * s1 + bfhi(u); }
    }
}

constexpr size_t WS_HP = WS_HU, WS_HT = WS_HU + 64 * MiB, WS_HSG = WS_HU + 80 * MiB;
constexpr size_t WS_GAMG = WS_RRAW, WS_DLOG = WS_RRAW + 2 * MiB;
constexpr int L_GT = 2048;
__device__ __forceinline__ void passA(unsigned char* ws, LAS unsigned char* lds, int layer, int vcu, int G) {
    int tid = threadIdx.x; asm volatile("" : "+v"(tid));
    const int lane = tid & 63, w = __builtin_amdgcn_readfirstlane(tid >> 6), d = tid & 127, tg = w >> 1, r32 = lane & 31, hi = lane >> 5;
    const _Float16* HF = (const _Float16*)(ws + WS_HF); const bf16* VTH = (const bf16*)(ws + WS_VTH); bf16* HP = (bf16*)(ws + WS_HP); bf16* HT = (bf16*)(ws + WS_HT);
    float* GAMG = (float*)(ws + WS_GAMG); float* DLOG = (float*)(ws + WS_DLOG);
    const float* LB = (const float*)(ws + WS_LB) + layer * 2048;
    LAS float* tot = (LAS float*)(lds + L_TOT); LAS float* gt = (LAS float*)(lds + L_GT); LAS unsigned char* KT = lds + L_KT;
    const int fsw = (d >> 1) & 7, fsr = (r32 >> 1) & 7, et = w >> 1, dt0 = 2 * (w & 1);
    _Float16 zr[16];
#define HG_RAWZ(h_, c_) do { const size_t o_ = (size_t)((c_) * 64 + 16 * tg) * 2048 + (h_) * 128 + d; \
        _Pragma("unroll") for (int i = 0; i < 16; ++i) zr[i] = HF[o_ + (size_t)i * 2048]; } while (0)
    if (vcu < NH * 32) HG_RAWZ(vcu >> 5, 4 * (vcu & 31));
    for (int unit = vcu; unit < NH * 32; unit += G) {
        const int h = unit >> 5, gq = unit & 31;
        const float lb = LB[h * 128 + d];
        f32x16 acc0, acc1;
#pragma unroll
        for (int r = 0; r < 16; ++r) { acc0[r] = 0.f; acc1[r] = 0.f; }
        float dsum = 0.f;
#pragma unroll 1
        for (int j = 0; j < 4; ++j) {
            const int c = 4 * gq + j, t0 = c * 64;
            bf16x8 af[4];
#pragma unroll
            for (int ks = 0; ks < 4; ++ks) af[ks] = *(const bf16x8*)(VTH + (size_t)(h * 128 + 32 * et + r32) * S_ + t0 + 16 * ks + 8 * hi);
            float kk[16], bl[16];
            { float run = 0.f;
#pragma unroll
              for (int i = 0; i < 16; ++i) { const float f_ = lb + (1.f - lb) * sigm((float)zr[i]); kk[i] = 1.f - f_; run += log2_(fmaxf(f_, 1e-30f)); bl[i] = run; } }
            tot[tg * 128 + d] = bl[15];
            __syncthreads();
            float pre = 0.f, all = 0.f;
#pragma unroll
            for (int jj = 0; jj < 4; ++jj) { const float v = tot[jj * 128 + d]; pre += (jj < tg) ? v : 0.f; all += v; }
            { float kh[16];
#pragma unroll
              for (int i = 0; i < 16; ++i) kh[i] = kk[i] * exp2_(all - (pre + bl[i]));
              v4u c0, c1; c0.x = pg8::cvt_pk_bf16(kh[0], kh[1]); c0.y = pg8::cvt_pk_bf16(kh[2], kh[3]); c0.z = pg8::cvt_pk_bf16(kh[4], kh[5]); c0.w = pg8::cvt_pk_bf16(kh[6], kh[7]);
              c1.x = pg8::cvt_pk_bf16(kh[8], kh[9]); c1.y = pg8::cvt_pk_bf16(kh[10], kh[11]); c1.z = pg8::cvt_pk_bf16(kh[12], kh[13]); c1.w = pg8::cvt_pk_bf16(kh[14], kh[15]);
              *(LAS v4u*)(KT + d * 128 + (((2 * tg) ^ fsw) << 4)) = c0; *(LAS v4u*)(KT + d * 128 + (((2 * tg + 1) ^ fsw) << 4)) = c1; }
            if (tg == 0) gt[d] = exp2_(all);
            dsum += all;
            { const int un = unit + G; if (j < 3) HG_RAWZ(h, c + 1); else if (un < NH * 32) HG_RAWZ(un >> 5, 4 * (un & 31)); }
            __syncthreads();
#pragma unroll
            for (int dd = 0; dd < 2; ++dd) { const int dt = dt0 + dd; f32x16 a = dd ? acc1 : acc0;
                if (j > 0) {
#pragma unroll
                    for (int g4 = 0; g4 < 4; ++g4) { const f32x4 gm = *(const LAS f32x4*)(gt + 32 * dt + 8 * g4 + 4 * hi); a[4 * g4] *= gm.x; a[4 * g4 + 1] *= gm.y; a[4 * g4 + 2] *= gm.z; a[4 * g4 + 3] *= gm.w; }
                }
#pragma unroll
                for (int ks = 0; ks < 4; ++ks) { const bf16x8 aq = *(const LAS bf16x8*)(KT + (32 * dt + r32) * 128 + (((2 * ks + hi) ^ fsr) << 4)); a = __builtin_amdgcn_mfma_f32_32x32x16_bf16(aq, af[ks], a, 0, 0, 0); }
                if (dd) acc1 = a; else acc0 = a; }
            __syncthreads();
        }
#pragma unroll
        for (int dd = 0; dd < 2; ++dd) { const int dt = dt0 + dd; const f32x16 a = dd ? acc1 : acc0;
            bf16* tp = HT + ((size_t)(h * 32 + gq) * 128 + 32 * et + r32) * 128 + 32 * dt + 4 * hi;
#pragma unroll
            for (int g4 = 0; g4 < 4; ++g4) { v2u wv; wv.x = pg8::cvt_pk_bf16(a[4 * g4], a[4 * g4 + 1]); wv.y = pg8::cvt_pk_bf16(a[4 * g4 + 2], a[4 * g4 + 3]); *(v2u*)(tp + 8 * g4) = wv; } }
        if (tg == 0) GAMG[(size_t)(h * 32 + gq) * 128 + d] = exp2_(dsum);
    }
#undef HG_RAWZ
}
__device__ __forceinline__ void scanG(unsigned char* ws, int gtid, int nthr) {
    const bf16* HT = (const bf16*)(ws + WS_HT); const float* GAMG = (const float*)(ws + WS_GAMG); bf16* SG = (bf16*)(ws + WS_HSG);
    for (int idx = gtid; idx < NH * 128 * 64; idx += nthr) {
        const int h = idx >> 13, e = (idx >> 6) & 127, d = 2 * (idx & 63);
        float s0 = 0.f, s1 = 0.f;
#pragma unroll 8
        for (int g = 0; g < 32; ++g) { const size_t base = ((size_t)(h * 32 + g) * 128 + e) * 128 + d;
            *(unsigned*)(SG + base) = pg8::cvt_pk_bf16(s0, s1);
            const unsigned u = *(const unsigned*)(HT + base); const f32x2 gm = *(const f32x2*)(GAMG + (size_t)(h * 32 + g) * 128 + d);
            s0 = gm.x * s0 + bflo(u); s1 = gm.y * s1 + bfhi(u); }
    }
}
__device__ __forceinline__ void pass3(unsigned char* ws, LAS unsigned char* lds, const float* gain, int layer, unsigned* qc  , LAS unsigned* qs, unsigned myx) {
    int tid = threadIdx.x; asm volatile("" : "+v"(tid));
    const int lane = tid & 63, w = __builtin_amdgcn_readfirstlane(tid >> 6), d = tid & 127, tg = tid >> 7, r32 = lane & 31, hi = lane >> 5;
    const _Float16* HF = (const _Float16*)(ws + WS_HF); const bf16* HQ = (const bf16*)(ws + WS_HQ); const bf16* HG = (const bf16*)(ws + WS_HG); const bf16* VTH = (const bf16*)(ws + WS_VTH);
    const bf16* SG = (const bf16*)(ws + WS_HSG); const bf16* HP = (const bf16*)(ws + WS_HP); const float* DLOG = (const float*)(ws + WS_DLOG); LAS float* etab = (LAS float*)(lds + L_GT); bf16* REC = (bf16*)(ws + WS_REC); const float* LB = (const float*)(ws + WS_LB) + layer * 2048;
    LAS float* tot = (LAS float*)(lds + L_TOT); LAS float* SSP = (LAS float*)(lds + L_SSP);
    const int et = w & 3, tb = w >> 2, pr = (r32 & 0x13) | ((r32 & 4) << 1) | ((r32 & 8) >> 1);
    const int eo = (d >> 3) * 16, ei = (d & 7) * 2;
    f32x4 gn[4];
#pragma unroll
    for (int g4 = 0; g4 < 4; ++g4) gn[g4] = *(const GAS f32x4*)(gain + 32 * et + 4 * hi + 8 * g4);
    _Float16 zr[16]; bf16 qr_[16];
#define HG_RAW(unit_) do { const int h_ = (unit_) >> 7, t0_ = ((unit_) & 127) * 64; const size_t o_ = (size_t)(t0_ + 16 * tg) * 2048 + h_ * 128 + d; \
        _Pragma("unroll") for (int i = 0; i < 16; ++i) { zr[i] = HF[o_ + (size_t)i * 2048]; qr_[i] = HQ[o_ + (size_t)i * 2048]; } } while (0)
    int kq_ = 0;
#define P3_CLAIM_SYNC(dst) do { int cv__ = 2048; while (kq_ < 8) { const unsigned cx__ = (myx + (unsigned)kq_) & 7u; const unsigned ca__ = __hip_atomic_fetch_add(qc + 64 * cx__, 1u, __ATOMIC_RELAXED, __HIP_MEMORY_SCOPE_AGENT); \
        if (ca__ < 256u) { cv__ = (int)(cx__ * 256u + ca__); break; } ++kq_; } (dst) = cv__; } while (0)
    if (tid == 0) { int a_, b_; P3_CLAIM_SYNC(a_); P3_CLAIM_SYNC(b_); qs[0] = (unsigned)a_; qs[1] = (unsigned)b_; }
    __syncthreads();
    int unit = __builtin_amdgcn_readfirstlane((int)qs[0]), nxt = __builtin_amdgcn_readfirstlane((int)qs[1]);
    __syncthreads();
    if (unit < NH * 128) HG_RAW(unit);
    while (unit < NH * 128) {
        unsigned claim = 256u; unsigned cx_ = 0u; if (tid == 0 && kq_ < 8) { cx_ = (myx + (unsigned)kq_) & 7u; claim = __hip_atomic_fetch_add(qc + 64 * cx_, 1u, __ATOMIC_RELAXED, __HIP_MEMORY_SCOPE_AGENT); }
        const int h = unit >> 7, c = unit & 127, t0 = c * 64;
        const float lb = LB[h * 128 + d];
        bf16x8 sf[8], pfr[8], vf[4]; v2u hgv[4]; const int jg = c & 3;
        const float dlg = DLOG[(size_t)(h * 128 + c) * 128 + d];
        { const bf16* sp = SG + ((size_t)(h * 32 + (c >> 2)) * 128 + 32 * et + r32) * 128 + 8 * hi; const bf16* pp = HP + ((size_t)(h * 128 + c) * 128 + 32 * et + r32) * 128 + 8 * hi;
#pragma unroll
          for (int kd = 0; kd < 8; ++kd) { sf[kd] = *(const bf16x8*)(sp + 16 * kd); if (jg) pfr[kd] = *(const bf16x8*)(pp + 16 * kd); else pfr[kd] = sf[kd]; }
          const bf16* vp = VTH + (size_t)(h * 128 + 32 * et + r32) * S_ + t0 + 8 * hi;
#pragma unroll
          for (int ks = 0; ks < 4; ++ks) vf[ks] = *(const bf16x8*)(vp + 16 * ks);
          const size_t ro = (size_t)(t0 + 32 * tb + r32) * 2048 + h * 128 + 32 * et + 4 * hi;
#pragma unroll
          for (int g4 = 0; g4 < 4; ++g4) hgv[g4] = *(const v2u*)(HG + ro + 8 * g4); }
        float kk[16], bl[16], qv[16];
        { float run = 0.f;
#pragma unroll
          for (int i = 0; i < 16; ++i) { const float f_ = lb + (1.f - lb) * sigm((float)zr[i]); kk[i] = 1.f - f_; run += log2_(fmaxf(f_, 1e-30f)); bl[i] = run; qv[i] = __builtin_bit_cast(float, (unsigned)qr_[i] << 16); } }
        tot[tg * 128 + d] = bl[15]; if (tg == 0) etab[d] = exp2_(dlg);
        __syncthreads();
        const float t_0 = tot[d], t_1 = tot[128 + d], t_2 = tot[256 + d];
        const float pre = (tg > 0 ? t_0 : 0.f) + (tg > 1 ? t_1 : 0.f) + (tg > 2 ? t_2 : 0.f), b31 = t_0 + t_1;
#pragma unroll
        for (int i = 0; i < 16; ++i) { const float b = pre + bl[i]; const int row = 16 * tg + i;
            *(LAS bf16*)(lds + L_QA + eo * 64 + row * 16 + ei) = (bf16)f2bf(qv[i] * exp2_(b));
            *(LAS bf16*)(lds + L_KA1 + eo * 64 + row * 16 + ei) = (bf16)f2bf(kk[i] * exp2_(b31 - b));
            if (tg < 2) *(LAS bf16*)(lds + L_KA0 + eo * 32 + row * 16 + ei) = (bf16)f2bf(kk[i] * exp2_(-b));
            else *(LAS bf16*)(lds + L_QB + eo * 32 + (row - 32) * 16 + ei) = (bf16)f2bf(qv[i] * exp2_(b - b31)); }
        if (nxt < NH * 128) HG_RAW(nxt);
        if (tid == 0) { int v_; if (claim < 256u) v_ = (int)(cx_ * 256u + claim); else { if (kq_ < 8) ++kq_; P3_CLAIM_SYNC(v_); } *qs = (unsigned)v_; }
        __syncthreads();
        const int nn = __builtin_amdgcn_readfirstlane((int)*qs);
        f32x16 o;
#pragma unroll
        for (int r = 0; r < 16; ++r) o[r] = 0.f;
        if (jg) {
#pragma unroll
            for (int kd = 0; kd < 8; ++kd) { const f32x4 e0 = *(const LAS f32x4*)(etab + 16 * kd + 8 * hi), e1 = *(const LAS f32x4*)(etab + 16 * kd + 8 * hi + 4);
                const v4u sv = __builtin_bit_cast(v4u, sf[kd]), pv = __builtin_bit_cast(v4u, pfr[kd]); v4u ov;
                ov.x = pg8::cvt_pk_bf16(e0.x * bflo(sv.x) + bflo(pv.x), e0.y * bfhi(sv.x) + bfhi(pv.x)); ov.y = pg8::cvt_pk_bf16(e0.z * bflo(sv.y) + bflo(pv.y), e0.w * bfhi(sv.y) + bfhi(pv.y));
                ov.z = pg8::cvt_pk_bf16(e1.x * bflo(sv.z) + bflo(pv.z), e1.y * bfhi(sv.z) + bfhi(pv.z)); ov.w = pg8::cvt_pk_bf16(e1.z * bflo(sv.w) + bflo(pv.w), e1.w * bfhi(sv.w) + bfhi(pv.w));
                sf[kd] = __builtin_bit_cast(bf16x8, ov); } }
        { const LAS unsigned char* qb_ = lds + L_QA + hi * 1024 + (32 * tb + r32) * 16;
#pragma unroll
          for (int kd = 0; kd < 8; ++kd) { const bf16x8 b = *(const LAS bf16x8*)(qb_ + kd * 2048); o = __builtin_amdgcn_mfma_f32_32x32x16_bf16(sf[kd], b, o, 0, 0, 0); } }
        if (tb == 0) {
            f32x16 p;
#pragma unroll
            for (int r = 0; r < 16; ++r) p[r] = 0.f;
            const LAS unsigned char* ka = lds + L_KA0 + hi * 512 + pr * 16; const LAS unsigned char* qa = lds + L_QA + hi * 1024 + r32 * 16;
#pragma unroll
            for (int kd = 0; kd < 8; ++kd) p = __builtin_amdgcn_mfma_f32_32x32x16_bf16(*(const LAS bf16x8*)(ka + kd * 1024), *(const LAS bf16x8*)(qa + kd * 2048), p, 0, 0, 0);
#pragma unroll
            for (int r = 0; r < 16; ++r) if (16 * (r >> 3) + 8 * hi + (r & 7) > r32) p[r] = 0.f;
            o = __builtin_amdgcn_mfma_f32_32x32x16_bf16(vf[0], pk8(p, 0), o, 0, 0, 0);
            o = __builtin_amdgcn_mfma_f32_32x32x16_bf16(vf[1], pk8(p, 8), o, 0, 0, 0);
        } else {
            f32x16 p0, p1;
#pragma unroll
            for (int r = 0; r < 16; ++r) { p0[r] = 0.f; p1[r] = 0.f; }
            const LAS unsigned char* ka = lds + L_KA1 + hi * 1024 + pr * 16; const LAS unsigned char* qa = lds + L_QB + hi * 512 + r32 * 16;
#pragma unroll
            for (int kd = 0; kd < 8; ++kd) { const bf16x8 qf = *(const LAS bf16x8*)(qa + kd * 1024);
                p0 = __builtin_amdgcn_mfma_f32_32x32x16_bf16(*(const LAS bf16x8*)(ka + kd * 2048), qf, p0, 0, 0, 0);
                p1 = __builtin_amdgcn_mfma_f32_32x32x16_bf16(*(const LAS bf16x8*)(ka + kd * 2048 + 512), qf, p1, 0, 0, 0); }
#pragma unroll
            for (int r = 0; r < 16; ++r) if (16 * (r >> 3) + 8 * hi + (r & 7) > r32) p1[r] = 0.f;
            o = __builtin_amdgcn_mfma_f32_32x32x16_bf16(vf[0], pk8(p0, 0), o, 0, 0, 0);
            o = __builtin_amdgcn_mfma_f32_32x32x16_bf16(vf[1], pk8(p0, 8), o, 0, 0, 0);
            o = __builtin_amdgcn_mfma_f32_32x32x16_bf16(vf[2], pk8(p1, 0), o, 0, 0, 0);
            o = __builtin_amdgcn_mfma_f32_32x32x16_bf16(vf[3], pk8(p1, 8), o, 0, 0, 0);
        }
        float ss = 0.f;
#pragma unroll
        for (int r = 0; r < 16; ++r) ss += o[r] * o[r];
        ss += __shfl_xor(ss, 32);
        if (hi == 0) SSP[(tb * 4 + et) * 32 + r32] = ss;
        __syncthreads();
        const float rstd = 1.0f / sqrtf((SSP[(tb * 4 + 0) * 32 + r32] + SSP[(tb * 4 + 1) * 32 + r32] + SSP[(tb * 4 + 2) * 32 + r32] + SSP[(tb * 4 + 3) * 32 + r32]) * (1.f / 128.f) + EPS);
        { const size_t ro = (size_t)(t0 + 32 * tb + r32) * 2048 + h * 128 + 32 * et + 4 * hi;
#pragma unroll
          for (int g4 = 0; g4 < 4; ++g4) { const v2u hv = hgv[g4];
              v2u ov; ov.x = pg8::cvt_pk_bf16(o[4 * g4] * rstd * gn[g4].x * bflo(hv.x), o[4 * g4 + 1] * rstd * gn[g4].y * bfhi(hv.x)); ov.y = pg8::cvt_pk_bf16(o[4 * g4 + 2] * rstd * gn[g4].z * bflo(hv.y), o[4 * g4 + 3] * rstd * gn[g4].w * bfhi(hv.y));
              *(v2u*)(REC + ro + 8 * g4) = ov; } }
        __syncthreads();
        unit = nxt; nxt = nn;
    }
#undef HG_RAW
#undef P3_CLAIM_SYNC
}
constexpr int L_SI = 57344, L_KT3 = 90112;
constexpr int G_QA = 4096, G_QB = 20736, G_KA0 = 29184, G_KA1 = 37632, G_SSP = 54272, G64 = 1040, G32 = 528;
__device__ __forceinline__ void pass3g(unsigned char* ws, LAS unsigned char* lds, const float* gain, int layer, int vcu, int G) {
    int tid = threadIdx.x; asm volatile("" : "+v"(tid));
    const int lane = tid & 63, w = __builtin_amdgcn_readfirstlane(tid >> 6), d = tid & 127, tg = tid >> 7, r32 = lane & 31, hi = lane >> 5;
    const _Float16* HF = (const _Float16*)(ws + WS_HF); const bf16* HQ = (const bf16*)(ws + WS_HQ); const bf16* HG = (const bf16*)(ws + WS_HG); const bf16* VTH = (const bf16*)(ws + WS_VTH);
    const bf16* SG = (const bf16*)(ws + WS_HSG); bf16* REC = (bf16*)(ws + WS_REC); const float* LB = (const float*)(ws + WS_LB) + layer * 2048;
    LAS float* tot = (LAS float*)(lds + L_TOT); LAS float* gt = (LAS float*)(lds + L_GT); LAS float* SSP = (LAS float*)(lds + G_SSP); LAS unsigned char* KT = lds + L_KT3; LAS unsigned char* SI = lds + L_SI;
    const int et = w & 3, tb = w >> 2, pr = (r32 & 0x13) | ((r32 & 4) << 1) | ((r32 & 8) >> 1), dt0 = 2 * tb;
    const int eg = d >> 3, ei = (d & 7) * 2;
    const int fsw = (d >> 1) & 7, fsr = (r32 >> 1) & 7, erow = 32 * et + r32, esw = erow & 15;
    _Float16 zr[16]; bf16 qr_[16];
#define HG_RAW(h_, c_) do { const size_t o_ = (size_t)((c_) * 64 + 16 * tg) * 2048 + (h_) * 128 + d; \
        _Pragma("unroll") for (int i = 0; i < 16; ++i) { zr[i] = HF[o_ + (size_t)i * 2048]; qr_[i] = HQ[o_ + (size_t)i * 2048]; } } while (0)
    if (vcu < NH * 32) HG_RAW(vcu >> 5, 4 * (vcu & 31));
    for (int unit = vcu; unit < NH * 32; unit += G) {
        const int nxt = unit + G;
        const int h = unit >> 5, gq = unit & 31;
        const float lb = LB[h * 128 + d];
        f32x16 acc0, acc1;
#pragma unroll
        for (int dd = 0; dd < 2; ++dd) { const bf16* tp = SG + ((size_t)(h * 32 + gq) * 128 + erow) * 128 + 32 * (dt0 + dd) + 4 * hi; f32x16 a;
#pragma unroll
            for (int g4 = 0; g4 < 4; ++g4) { const v2u u = *(const v2u*)(tp + 8 * g4); a[4 * g4] = bflo(u.x); a[4 * g4 + 1] = bfhi(u.x); a[4 * g4 + 2] = bflo(u.y); a[4 * g4 + 3] = bfhi(u.y); }
            if (dd) acc1 = a; else acc0 = a; }
#pragma unroll 1
        for (int j = 0; j < 4; ++j) {
            const int c = 4 * gq + j, t0 = c * 64;
            bf16x8 vf[4]; v2u hgv[4];
            { const bf16* vp = VTH + (size_t)(h * 128 + erow) * S_ + t0 + 8 * hi;
#pragma unroll
              for (int ks = 0; ks < 4; ++ks) vf[ks] = *(const bf16x8*)(vp + 16 * ks);
              const size_t ro = (size_t)(t0 + 32 * tb + r32) * 2048 + h * 128 + 32 * et + 4 * hi;
#pragma unroll
              for (int g4 = 0; g4 < 4; ++g4) hgv[g4] = *(const v2u*)(HG + ro + 8 * g4); }
            float kk[16], bl[16], qv[16];
            { float run = 0.f;
#pragma unroll
              for (int i = 0; i < 16; ++i) { const float f_ = lb + (1.f - lb) * sigm((float)zr[i]); kk[i] = 1.f - f_; run += log2_(fmaxf(f_, 1e-30f)); bl[i] = run; qv[i] = __builtin_bit_cast(float, (unsigned)qr_[i] << 16); } }
            tot[tg * 128 + d] = bl[15];
#pragma unroll
            for (int dd = 0; dd < 2; ++dd) { const f32x16 a = dd ? acc1 : acc0;
#pragma unroll
                for (int g4 = 0; g4 < 4; ++g4) { v2u wv; wv.x = pg8::cvt_pk_bf16(a[4 * g4], a[4 * g4 + 1]); wv.y = pg8::cvt_pk_bf16(a[4 * g4 + 2], a[4 * g4 + 3]);
                    *(LAS v2u*)(SI + erow * 256 + (((4 * (dt0 + dd) + g4) ^ esw) << 4) + 8 * hi) = wv; } }
            __syncthreads();
            const float t_0 = tot[d], t_1 = tot[128 + d], t_2 = tot[256 + d], t_3 = tot[384 + d];
            const float pre = (tg > 0 ? t_0 : 0.f) + (tg > 1 ? t_1 : 0.f) + (tg > 2 ? t_2 : 0.f), b31 = t_0 + t_1, all = (t_0 + t_1) + (t_2 + t_3);
            { v4u c0, c1;
#pragma unroll
              for (int i2 = 0; i2 < 8; ++i2) { float kh2[2];
#pragma unroll
                for (int u = 0; u < 2; ++u) { const int i = 2 * i2 + u; const float b = pre + bl[i]; const int row = 16 * tg + i;
                  *(LAS bf16*)(lds + G_QA + eg * G64 + row * 16 + ei) = (bf16)pg8::cvt_pk_bf16(qv[i] * exp2_(b), 0.f);
                  *(LAS bf16*)(lds + G_KA1 + eg * G64 + row * 16 + ei) = (bf16)pg8::cvt_pk_bf16(kk[i] * exp2_(b31 - b), 0.f);
                  if (tg < 2) *(LAS bf16*)(lds + G_KA0 + eg * G32 + row * 16 + ei) = (bf16)pg8::cvt_pk_bf16(kk[i] * exp2_(-b), 0.f);
                  else *(LAS bf16*)(lds + G_QB + eg * G32 + (row - 32) * 16 + ei) = (bf16)pg8::cvt_pk_bf16(qv[i] * exp2_(b - b31), 0.f);
                  kh2[u] = kk[i] * exp2_(all - b); }
                const unsigned pw = pg8::cvt_pk_bf16(kh2[0], kh2[1]);
                if (i2 < 4) c0[i2] = pw; else c1[i2 - 4] = pw; }
              *(LAS v4u*)(KT + d * 128 + (((2 * tg) ^ fsw) << 4)) = c0; *(LAS v4u*)(KT + d * 128 + (((2 * tg + 1) ^ fsw) << 4)) = c1; }
            if (tg == 0) gt[d] = exp2_(all);
            if (j < 3) HG_RAW(h, c + 1); else if (nxt < NH * 32) { int nx_ = nxt; asm volatile("" : "+s"(nx_)); HG_RAW(nx_ >> 5, 4 * (nx_ & 31)); }
            __syncthreads();
            f32x16 o;
#pragma unroll
            for (int r = 0; r < 16; ++r) o[r] = 0.f;
            { const LAS unsigned char* qb_ = lds + G_QA + hi * G64 + (32 * tb + r32) * 16; const LAS unsigned char* sr_ = SI + erow * 256;
#pragma unroll
              for (int kd = 0; kd < 8; ++kd) { const bf16x8 a = *(const LAS bf16x8*)(sr_ + (((2 * kd + hi) ^ esw) << 4)); const bf16x8 b = *(const LAS bf16x8*)(qb_ + kd * (2 * G64)); o = __builtin_amdgcn_mfma_f32_32x32x16_bf16(a, b, o, 0, 0, 0); } }
            __builtin_amdgcn_sched_barrier(0);
            if (tb == 0) {
                f32x16 p;
#pragma unroll
                for (int r = 0; r < 16; ++r) p[r] = 0.f;
                const LAS unsigned char* ka = lds + G_KA0 + hi * G32 + pr * 16; const LAS unsigned char* qa = lds + G_QA + hi * G64 + r32 * 16;
#pragma unroll
                for (int kd = 0; kd < 8; ++kd) p = __builtin_amdgcn_mfma_f32_32x32x16_bf16(*(const LAS bf16x8*)(ka + kd * (2 * G32)), *(const LAS bf16x8*)(qa + kd * (2 * G64)), p, 0, 0, 0);
#pragma unroll
                for (int r = 0; r < 16; ++r) if (16 * (r >> 3) + 8 * hi + (r & 7) > r32) p[r] = 0.f;
                o = __builtin_amdgcn_mfma_f32_32x32x16_bf16(vf[0], pk8(p, 0), o, 0, 0, 0);
                o = __builtin_amdgcn_mfma_f32_32x32x16_bf16(vf[1], pk8(p, 8), o, 0, 0, 0);
            } else {
                f32x16 p0, p1;
#pragma unroll
                for (int r = 0; r < 16; ++r) { p0[r] = 0.f; p1[r] = 0.f; }
                const LAS unsigned char* ka = lds + G_KA1 + hi * G64 + pr * 16; const LAS unsigned char* qa = lds + G_QB + hi * G32 + r32 * 16;
#pragma unroll
                for (int kd = 0; kd < 8; ++kd) { const bf16x8 qf = *(const LAS bf16x8*)(qa + kd * (2 * G32));
                    p0 = __builtin_amdgcn_mfma_f32_32x32x16_bf16(*(const LAS bf16x8*)(ka + kd * (2 * G64)), qf, p0, 0, 0, 0);
                    p1 = __builtin_amdgcn_mfma_f32_32x32x16_bf16(*(const LAS bf16x8*)(ka + kd * (2 * G64) + 512), qf, p1, 0, 0, 0); }
#pragma unroll
                for (int r = 0; r < 16; ++r) if (16 * (r >> 3) + 8 * hi + (r & 7) > r32) p1[r] = 0.f;
                o = __builtin_amdgcn_mfma_f32_32x32x16_bf16(vf[0], pk8(p0, 0), o, 0, 0, 0);
                o = __builtin_amdgcn_mfma_f32_32x32x16_bf16(vf[1], pk8(p0, 8), o, 0, 0, 0);
                o = __builtin_amdgcn_mfma_f32_32x32x16_bf16(vf[2], pk8(p1, 0), o, 0, 0, 0);
                o = __builtin_amdgcn_mfma_f32_32x32x16_bf16(vf[3], pk8(p1, 8), o, 0, 0, 0);
            }
            __builtin_amdgcn_sched_barrier(0);
            if (j < 3) {
#pragma unroll
                for (int dd = 0; dd < 2; ++dd) { const int dt = dt0 + dd; f32x16 a = dd ? acc1 : acc0;
#pragma unroll
                    for (int g4 = 0; g4 < 4; ++g4) { const f32x4 gm = *(const LAS f32x4*)(gt + 32 * dt + 8 * g4 + 4 * hi); a[4 * g4] *= gm.x; a[4 * g4 + 1] *= gm.y; a[4 * g4 + 2] *= gm.z; a[4 * g4 + 3] *= gm.w; }
#pragma unroll
                    for (int ks = 0; ks < 4; ++ks) { const bf16x8 aq = *(const LAS bf16x8*)(KT + (32 * dt + r32) * 128 + (((2 * ks + hi) ^ fsr) << 4)); a = __builtin_amdgcn_mfma_f32_32x32x16_bf16(aq, vf[ks], a, 0, 0, 0); }
                    if (dd) acc1 = a; else acc0 = a; } }
            __builtin_amdgcn_sched_barrier(0);
            float ss = 0.f;
#pragma unroll
            for (int r = 0; r < 16; ++r) ss += o[r] * o[r];
            ss += __shfl_xor(ss, 32);
            if (hi == 0) SSP[(tb * 4 + et) * 32 + r32] = ss;
            __syncthreads();
            const float rstd = 1.0f / sqrtf((SSP[(tb * 4 + 0) * 32 + r32] + SSP[(tb * 4 + 1) * 32 + r32] + SSP[(tb * 4 + 2) * 32 + r32] + SSP[(tb * 4 + 3) * 32 + r32]) * (1.f / 128.f) + EPS);
            { const size_t ro = (size_t)(t0 + 32 * tb + r32) * 2048 + h * 128 + 32 * et + 4 * hi;
#pragma unroll
              for (int g4 = 0; g4 < 4; ++g4) { const v2u hv = hgv[g4]; const f32x4 gnv = *(const GAS f32x4*)(gain + 32 * et + 4 * hi + 8 * g4);
                  v2u ov; ov.x = pg8::cvt_pk_bf16(o[4 * g4] * rstd * gnv.x * bflo(hv.x), o[4 * g4 + 1] * rstd * gnv.y * bfhi(hv.x)); ov.y = pg8::cvt_pk_bf16(o[4 * g4 + 2] * rstd * gnv.z * bflo(hv.y), o[4 * g4 + 3] * rstd * gnv.w * bfhi(hv.y));
                  *(v2u*)(REC + ro + 8 * g4) = ov; } }
        }
    }
#undef HG_RAW
}
#undef HG_GATES
}

enum { I_X = 0, I_POS, I_ANG, I_WIN, I_QNG, I_WUQ, I_KVNG, I_WUKV, I_LBL, I_HONG, I_WA, I_WB, I_WO, I_FNG, I_WUP, I_CW, I_CB, I_WDN, I_FING };
constexpr int CV_SH1 = 112, CV_SH7 = 120, CV_N1 = 96 * CV_SH1, CV_N7 = CV_N1 + 84 * CV_SH7;
constexpr int CV_IN = 32 * (WINR / 32), CV_UQ = 8 * 96, CV_K = 8 * 64, CV_V = 8 * 64, CV_SQ = 32 * 64, CV_UP = 32 * 352, CV_DN = 88 * 64;
constexpr int CV_PER_LAYER = CV_IN + CV_UQ + CV_K + CV_V + 3 * CV_SQ + CV_UP + CV_DN;
constexpr int CV_T1 = 96 * CV_SH1, CV_T7 = 84 * CV_SH7, CV_UPEND = CV_IN + CV_UQ + CV_K + CV_V + 3 * CV_SQ + CV_UP, CV_ALL = DEPTH * CV_PER_LAYER;
static_assert(CV_IN + CV_T1 >= CV_UPEND - CV_UP && CV_IN + CV_T1 <= CV_UPEND, "T1 covers q/k/v up, merge and out, and ends inside ffn up");
static_assert(CV_UPEND + CV_T7 >= CV_PER_LAYER && CV_UPEND + CV_T7 <= CV_PER_LAYER + CV_IN, "T7 covers ffn down and ends inside the next in-projection");
__device__ __forceinline__ const float* inp_ptr(LAS unsigned char* lds, int i) {
    const unsigned long long v = ((LAS const unsigned long long*)(lds + MISC_OFF + 128))[i];
    return (const float*)(((unsigned long long)(unsigned)__builtin_amdgcn_readfirstlane((int)(v >> 32)) << 32) | (unsigned long long)(unsigned)__builtin_amdgcn_readfirstlane((int)(unsigned)v));
}
__device__ __forceinline__ void cvt_stream(unsigned char* ws, LAS unsigned char* lds, int first, int last, int stride) {
    int tid = threadIdx.x; asm volatile("" : "+v"(tid));
    const int lane = tid & 63, wave = __builtin_amdgcn_readfirstlane(tid >> 6);
    LAS float* scr = (LAS float*)(lds + RING_OFF + wave * 16384);
    const float* p_win = inp_ptr(lds, I_WIN); const float* p_wuq = inp_ptr(lds, I_WUQ); const float* p_wukv = inp_ptr(lds, I_WUKV); const float* p_wa = inp_ptr(lds, I_WA); const float* p_wb = inp_ptr(lds, I_WB);
    const float* p_wo = inp_ptr(lds, I_WO); const float* p_wup = inp_ptr(lds, I_WUP); const float* p_wdn = inp_ptr(lds, I_WDN); const float* p_qg = inp_ptr(lds, I_QNG); const float* p_kvg = inp_ptr(lds, I_KVNG);
#define T_CLAIM(it) do { unsigned v_ = 0u; if (lane == 0) v_ = __hip_atomic_fetch_add(qc, 1u, __ATOMIC_RELAXED, __HIP_MEMORY_SCOPE_AGENT); (it) = __builtin_amdgcn_readfirstlane((int)v_); } while (0)
#define T_DECODE(it, T) do { const int l_ = (it) / CV_PER_LAYER; int r_ = (it) - l_ * CV_PER_LAYER; unsigned char* wl_ = ws + WS_W + (size_t)l_ * LW; int kind_, nblk_; (T).scale = nullptr; \
        if (r_ < CV_IN) { kind_ = 1; nblk_ = WINR / 32; (T).src = p_win + (size_t)l_ * DM * INW; (T).K = DM; (T).Nsrc = INW; (T).dst = (bf16*)(wl_ + LW_IN); } \
        else if ((r_ -= CV_IN) < CV_UQ) { kind_ = 2; nblk_ = 96; (T).src = p_wuq + (size_t)l_ * QL * 3072; (T).K = QL; (T).Nsrc = 3072; (T).dst = (bf16*)(wl_ + LW_UQ); (T).scale = p_qg + l_ * QL; } \
        else if ((r_ -= CV_UQ) < CV_K) { kind_ = 3; nblk_ = 64; (T).src = p_wukv + (size_t)l_ * KVL * 4096; (T).K = KVL; (T).Nsrc = 4096; (T).dst = (bf16*)(wl_ + LW_K); (T).scale = p_kvg + l_ * KVL; } \
        else if ((r_ -= CV_K) < CV_V) { kind_ = 4; nblk_ = 64; (T).src = p_wukv + (size_t)l_ * KVL * 4096; (T).K = KVL; (T).Nsrc = 4096; (T).dst = (bf16*)(wl_ + LW_V); (T).scale = p_kvg + l_ * KVL; } \
        else if ((r_ -= CV_V) < CV_SQ) { kind_ = 0; nblk_ = 64; (T).src = p_wa + (size_t)l_ * DM * DM; (T).K = DM; (T).Nsrc = DM; (T).dst = (bf16*)(wl_ + LW_A); } \
        else if ((r_ -= CV_SQ) < CV_SQ) { kind_ = 0; nblk_ = 64; (T).src = p_wb + (size_t)l_ * DM * DM; (T).K = DM; (T).Nsrc = DM; (T).dst = (bf16*)(wl_ + LW_B); } \
        else if ((r_ -= CV_SQ) < CV_SQ) { kind_ = 0; nblk_ = 64; (T).src = p_wo + (size_t)l_ * DM * DM; (T).K = DM; (T).Nsrc = DM; (T).dst = (bf16*)(wl_ + LW_O); } \
        else if ((r_ -= CV_SQ) < CV_UP) { kind_ = 5; nblk_ = 352; (T).src = p_wup + (size_t)l_ * DM * DFF2; (T).K = DM; (T).Nsrc = DFF2; (T).dst = (bf16*)(wl_ + LW_UP); } \
        else { r_ -= CV_UP; kind_ = 0; nblk_ = 64; (T).src = p_wdn + (size_t)l_ * DFF * DM; (T).K = DFF; (T).Nsrc = DM; (T).dst = (bf16*)(wl_ + LW_DN); } \
        (T).k0 = 64 * (r_ / nblk_); (T).n0 = 32 * (r_ % nblk_); (T).sc = srcmap_rt(kind_, (T).n0 + (lane & 31)); } while (0)
#define T_LOAD(T, V) do { const GAS float* sp_ = (const GAS float*)(T).src + (size_t)((T).k0 + (lane >> 5)) * (T).Nsrc + ((T).sc >= 0 ? (T).sc : 0); \
        _Pragma("unroll") for (int i = 0; i < 32; ++i) (V)[i] = __builtin_nontemporal_load(sp_ + (size_t)(2 * i) * (T).Nsrc); } while (0)
#define T_PROC(T, V) do { const bool z_ = (T).sc < 0; \
        if ((T).scale) { const GAS float* gp_ = (const GAS float*)(T).scale + (T).k0 + (lane >> 5); _Pragma("unroll") for (int i = 0; i < 32; ++i) (V)[i] *= gp_[2 * i]; } \
        _Pragma("unroll") for (int i = 0; i < 32; ++i) scr[(2 * i + (lane >> 5)) * 33 + (lane & 31)] = z_ ? 0.f : (V)[i]; \
        LDS_WAIT(); asm volatile("" ::: "memory"); \
        { const int c_ = lane & 7; _Pragma("unroll") for (int j = 0; j < 4; ++j) { const int n_ = (lane >> 3) + 8 * j; const LAS float* s_ = scr + (8 * c_) * 33 + n_; \
            v4u o_; o_.x = pk2(s_[0 * 33], s_[1 * 33]); o_.y = pk2(s_[2 * 33], s_[3 * 33]); o_.z = pk2(s_[4 * 33], s_[5 * 33]); o_.w = pk2(s_[6 * 33], s_[7 * 33]); \
            *(GAS v4u*)((T).dst + (size_t)((T).n0 + n_) * (T).K + (T).k0 + 8 * c_) = o_; } } \
        LDS_WAIT(); asm volatile("" ::: "memory"); } while (0)
    TItem ta, tb; float va[32], vb[32]; int it = first;
    if (it < last) { T_DECODE(it, ta); T_LOAD(ta, va); }
    while (it < last) {
        const int it1 = it + stride; if (it1 < last) { T_DECODE(it1, tb); T_LOAD(tb, vb); }
        T_PROC(ta, va);
        if (it1 >= last) break;
        const int it2 = it1 + stride; if (it2 < last) { T_DECODE(it2, ta); T_LOAD(ta, va); }
        T_PROC(tb, vb);
        it = it2; }
#undef T_CLAIM
#undef T_DECODE
#undef T_LOAD
#undef T_PROC
}

#ifndef PROBE
#define PROBE 0
#endif
#ifndef PROBE_T
#define PROBE_T 0
#endif
#define TSCALE 4
#define TICK(k) do { if (PROBE_T) { const unsigned long long now_ = __builtin_amdgcn_s_memrealtime(); if (PROBE_T == (k)) tacc += now_ - tprev; tprev = now_; } } while (0)
#define REPS(k) (((PROBE >> (k)) & 1) + 1)
#define XBAR(b) do { for (int rb_ = 0; rb_ < REPS(8); ++rb_) xcd_barrier(b); } while (0)
#ifndef NAIVE_ATTN
#define NAIVE_ATTN 0
#endif
#ifndef NAIVE_HGRN
#define NAIVE_HGRN 0
#endif
struct Args { const float* in[19]; float* out; unsigned char* ws; };

__global__ void __launch_bounds__(NTHR, 2) mk_fwd(Args args) {
    extern __shared__ __attribute__((aligned(16))) unsigned char lds_raw[];
    LAS unsigned char* lds = (LAS unsigned char*)lds_raw;
    const int tid = threadIdx.x, lane = tid & 63, wave = __builtin_amdgcn_readfirstlane(tid >> 6);
    const int G = gridDim.x, bx = blockIdx.x, vcu = (G % 8 == 0) ? (bx % 8) * (G / 8) + bx / 8 : bx;
    const int gw = vcu * NWAVES + wave, ngw = G * NWAVES;
    unsigned char* ws = args.ws;
    for (int u = tid; u < (LDS_BYTES - LDSCTL_OFF) / 4; u += NTHR) ((LAS unsigned*)(lds + LDSCTL_OFF))[u] = 0u;
    __syncthreads();
    XcdBarrier bar = xcd_barrier_post((unsigned*)(ws + WS_CTL) + CW_BAR, (volatile LAS unsigned*)(lds + MISC_OFF) + 8);
    float* X = args.out;
    unsigned long long tacc = 0ull, tprev = PROBE_T ? __builtin_amdgcn_s_memrealtime() : 0ull;
    if (tid < 19) ((LAS unsigned long long*)(lds + MISC_OFF + 128))[tid] = ((const __attribute__((address_space(4))) unsigned long long*)__builtin_amdgcn_kernarg_segment_ptr())[tid];
    __syncthreads();
#define INP(i) ((const float*)(((unsigned long long)(unsigned)__builtin_amdgcn_readfirstlane((int)(((LAS const unsigned long long*)(lds + MISC_OFF + 128))[i] >> 32)) << 32) | (unsigned long long)(unsigned)__builtin_amdgcn_readfirstlane((int)(unsigned)((LAS const unsigned long long*)(lds + MISC_OFF + 128))[i])))

    for (int rep = 0; rep < REPS(4); ++rep) {
        cvt_stream(ws, lds, gw, (G == 256) ? CV_IN : CV_PER_LAYER, ngw);
        { const GAS int* pos = (const GAS int*)INP(I_POS); float* COS = (float*)(ws + WS_COS); float* SIN = (float*)(ws + WS_SIN);
          for (int i = vcu * NTHR + tid; i < S_ * 32; i += G * NTHR) { const float ang = (float)pos[i >> 5] * c_invf[i & 31]; float sn, cs; sincos_f64(ang, sn, cs); COS[i] = cs; SIN[i] = sn; } }
        { const GAS float* lg = (const GAS float*)INP(I_LBL); float* LB = (float*)(ws + WS_LB);
          for (int c = vcu * NTHR + tid; c < 2048; c += G * NTHR) { const float a0 = lg[c], a1 = lg[2048 + c], a2 = lg[4096 + c], a3 = lg[6144 + c];
              const float mx = fmaxf(fmaxf(a0, a1), fmaxf(a2, a3)); const float e0 = expf(a0 - mx), e1 = expf(a1 - mx), e2 = expf(a2 - mx), e3 = expf(a3 - mx); const float inv = 1.f / (e0 + e1 + e2 + e3);
              LB[c] = 0.f; LB[2048 + c] = e1 * inv; LB[4096 + c] = (e1 + e2) * inv; LB[6144 + c] = (e1 + e2 + e3) * inv; } }
        for (int i = vcu * NTHR + tid; i < 2 * DM / 8; i += G * NTHR) *(GAS v4u*)(ws + WS_XN - 2 * DM * 2 + (size_t)i * 16) = (v4u){0u, 0u, 0u, 0u};
        for (int m = gw; m < S_; m += ngw) rms_row_to_bf16(INP(I_X) + (size_t)m * DM, INP(I_ANG), (bf16*)(ws + WS_XN) + (size_t)m * DM, nullptr, lane, (float*)(ws + WS_RSTD) + m);
    }
    XBAR(bar); TICK(1);

    for (int l = 0; l < DEPTH; ++l) {
        unsigned char* wl = ws + WS_W + (size_t)l * LW;
#define lane_l ({ int l_ = (int)threadIdx.x; asm volatile("" : "+v"(l_)); l_ & 63; })
        GAS unsigned char* wsg_ = (GAS unsigned char*)ws; GAS float* xg_ = (GAS float*)X; int Gl = G, bxl = bx, gwl = gw, ngwl = ngw, vcul = vcu;
        asm volatile("" : "+s"(wsg_), "+s"(Gl), "+s"(bxl), "+s"(gwl), "+s"(ngwl), "+s"(vcul), "+s"(xg_));
        unsigned char* wsl = (unsigned char*)wsg_; float* Xl = (float*)xg_;
        for (int rep = 0; rep < REPS(1); ++rep)
        { pg8::Gemm g{(const pg8::bf16_t*)(wsl + WS_XN), (const pg8::bf16_t*)(wl + LW_IN), S_, NNAT, DM, DM, DM}; pg8::StaticOrder S; S.init(S_, NNAT, Gl, bxl);
          pg8::EpiIn E{wsl}; pg8::gemm_phase<pg8::EpiIn, pg8::StaticOrder, true, true>(lds + RING_OFF, g, S, E); }
        TICK(2);
        { pg8::Gemm g{(const pg8::bf16_t*)(wl + LW_IN) + (size_t)NNAT * DM, (const pg8::bf16_t*)(wsl + WS_XN), 2048, S_, DM, DM, DM}; pg8::StaticOrder S; S.init(2048, S_, Gl, bxl);
          pg8::EpiStoreCS E{(pg8::bf16_t*)(wsl + WS_VTH), S_, (const float*)(wsl + WS_RSTD)}; pg8::gemm_phase<pg8::EpiStoreCS, pg8::StaticOrder, true, true>(lds + RING_OFF, g, S, E); }
        if (Gl == 256 && bxl >= 160) { const int b0_ = l * CV_PER_LAYER + CV_IN + (bxl - 160) * CV_SH1; cvt_stream(wsl, lds, b0_ + wave, b0_ + CV_SH1, NWAVES); }
        XBAR(bar); TICK(3);
        for (int rep = 0; rep < REPS(3); ++rep) latent_rstd(wsl, vcul * NTHR + (int)threadIdx.x, Gl * NTHR);
        TICK(4);
        for (int rep = 0; rep < REPS(2); ++rep) hg::passA(wsl, lds + RING_OFF, l, vcul, Gl);
        XBAR(bar); TICK(6);
        for (int rep = 0; rep < REPS(2); ++rep) hg::scanG(wsl, vcul * NTHR + (int)threadIdx.x, Gl * NTHR);
        TICK(7);
        for (int rep = 0; rep < REPS(6); ++rep) {
        { pg8::Gemm g{(const pg8::bf16_t*)(wsl + WS_CQKV), (const pg8::bf16_t*)(wl + LW_UQ), S_, 3072, QL, 1024, QL}; pg8::StaticOrder S; S.init(S_, 3072, Gl, bxl);
          pg8::EpiQ E{wsl}; pg8::gemm_phase<pg8::EpiQ, pg8::StaticOrder, true, true>(lds + RING_OFF, g, S, E); }
        { pg8::Gemm g{(const pg8::bf16_t*)(wsl + WS_CQKV) + 512, (const pg8::bf16_t*)(wl + LW_K), S_, 2048, KVL, 1024, KVL}; pg8::StaticOrder S; S.init(S_, 2048, Gl, bxl);
          pg8::EpiStoreRS E{(pg8::bf16_t*)(wsl + WS_KN), 2048, (const float*)(wsl + WS_LRKV)}; pg8::gemm_phase<pg8::EpiStoreRS, pg8::StaticOrder, true, true>(lds + RING_OFF, g, S, E); }
        { pg8::Gemm g{(const pg8::bf16_t*)(wl + LW_V), (const pg8::bf16_t*)(wsl + WS_CQKV) + 512, 2048, S_, KVL, KVL, 1024}; pg8::StaticOrder S; S.init(2048, S_, Gl, bxl);
          pg8::EpiStoreCS E{(pg8::bf16_t*)(wsl + WS_VT), S_, (const float*)(wsl + WS_LRKV)}; pg8::gemm_phase<pg8::EpiStoreCS, pg8::StaticOrder, true, true>(lds + RING_OFF, g, S, E); }
        }
        TICK(5);
#if NAIVE_HGRN
        hgrn_naive(wsl, l, gwl, ngwl, lane_l);
        XBAR(bar);
#else
        if (threadIdx.x == 0) ((LAS unsigned*)(lds + MISC_OFF + 64))[0] = __hip_atomic_fetch_add((unsigned*)(wsl + WS_CTL) + CW_QUE + l * 1024 + 64 * bar.x, 1u, __ATOMIC_RELAXED, __HIP_MEMORY_SCOPE_AGENT);
        XBAR(bar);
#endif
#if NAIVE_ATTN
        attn_naive(wsl, (LAS float*)(lds + RING_OFF) + wave * 192, gwl, ngwl, lane_l);
#else
        for (int rep = 0; rep < REPS(0); ++rep) fa16::attn_fast(wsl, lds + RING_OFF, (unsigned*)(wsl + WS_CTL) + CW_QUE + l * 1024, (LAS unsigned*)(lds + MISC_OFF + 64), bar.x);
        TICK(8);
#endif
#if NAIVE_HGRN
        hgrn_normgate(wsl, INP(I_HONG) + l * 128, gwl, ngwl, lane_l);
#else
        for (int rep = 0; rep < REPS(2); ++rep) hg::pass3g(wsl, lds + RING_OFF, INP(I_HONG) + l * 128, l, vcul, Gl);
#endif
        XBAR(bar); TICK(9);
        for (int rep = 0; rep < REPS(7); ++rep) {
        { pg8::Gemm g{(const pg8::bf16_t*)(wsl + WS_ATT), (const pg8::bf16_t*)(wl + LW_A), S_, DM, DM, DM, DM}; pg8::PairOrder S; S.init(S_, DM, Gl, bxl);
          pg8::EpiGateAB E{wsl}; pg8::gemm_phase<pg8::EpiGateAB, pg8::PairOrder, true, true>(lds + RING_OFF, g, S, E); }
        }
        XBAR(bar); TICK(10);
        { pg8::Gemm g{(const pg8::bf16_t*)(wsl + WS_MRG), (const pg8::bf16_t*)(wl + LW_O), S_, DM, DM, DM, DM}; pg8::StaticOrder S; S.init(S_, DM, Gl, bxl);
          if (l == 0) { pg8::EpiResN0 E{Xl, (pg8::bf16_t*)(wsl + WS_XN), INP(I_FNG) + l * DM, (float*)(wsl + WS_SSQ), INP(I_X)}; pg8::gemm_phase<pg8::EpiResN0, pg8::StaticOrder, true, true>(lds + RING_OFF, g, S, E); }
          else { pg8::EpiResN E{Xl, (pg8::bf16_t*)(wsl + WS_XN), INP(I_FNG) + l * DM, (float*)(wsl + WS_SSQ)}; pg8::gemm_phase<pg8::EpiResN, pg8::StaticOrder, true, true>(lds + RING_OFF, g, S, E); } }
        if (Gl == 256) {
            pg8::StaticOrder S5; S5.init(S_, DM, Gl, bxl); pg8::Unit u5; (void)S5.next(0, u5);
            unsigned* cnt5 = (unsigned*)(wsl + WS_CTL) + CW_PAN + ((2 * l) * 32 + u5.pm) * 32;
            if (threadIdx.x == 0) (void)__hip_atomic_fetch_add(cnt5, 1u, __ATOMIC_RELAXED, __HIP_MEMORY_SCOPE_AGENT);
            cvt_stream(wsl, lds, l * CV_PER_LAYER + CV_IN + CV_T1 + gwl, l * CV_PER_LAYER + CV_UPEND, ngwl);
            if (u5.pn == 0) {
                if (wave == 0) { unsigned sp_ = 0u; while (__hip_atomic_load(cnt5, __ATOMIC_RELAXED, __HIP_MEMORY_SCOPE_AGENT) < 8u && ++sp_ < (1u << 22)) __builtin_amdgcn_s_sleep(1);
                                 __builtin_amdgcn_fence(__ATOMIC_ACQUIRE, "agent"); }
                __syncthreads();
                rstd_panel(wsl, u5.pm, wave, lane_l);
            }
        } else { XBAR(bar); rstd_phase(wsl, gwl, ngwl, lane_l); }
        XBAR(bar); TICK(12);
        for (int rep = 0; rep < REPS(5); ++rep)
        { pg8::Gemm g{(const pg8::bf16_t*)(wsl + WS_XN) - 2 * DM, (const pg8::bf16_t*)(wl + LW_UP), 33 * 256, DFF2, DM, DM, DM, 254}; pg8::StaticOrder S; S.init(33 * 256, DFF2, Gl, bxl);
          pg8::EpiConv E{(pg8::bf16_t*)(wsl + WS_ACT), INP(I_CW) + (size_t)l * 3 * DFF2, INP(I_CB) + (size_t)l * DFF2, (PG8_LAS float*)(lds + LDSCTL_OFF + 1024), (const float*)(wsl + WS_RSTD)};
          pg8::gemm_phase<pg8::EpiConv, pg8::StaticOrder, true, true>(lds + RING_OFF, g, S, E); }
        if (Gl == 256 && bxl >= 172) { const int b0_ = l * CV_PER_LAYER + CV_UPEND + (bxl - 172) * CV_SH7; const int e0_ = b0_ + CV_SH7 < CV_ALL ? b0_ + CV_SH7 : CV_ALL; cvt_stream(wsl, lds, b0_ + wave, e0_, NWAVES); }
        xcd_barrier(bar); TICK(13);
        { pg8::Gemm g{(const pg8::bf16_t*)(wsl + WS_ACT), (const pg8::bf16_t*)(wl + LW_DN), S_, DM, DFF, DFF, DFF}; pg8::StaticOrder S; S.init(S_, DM, Gl, bxl);
          if (l + 1 == DEPTH && Gl == 256) {
              pg8::EpiResFinal E{Xl, INP(I_FING), (float*)(wsl + WS_SSQ), (unsigned*)(wsl + WS_CTL) + CW_PAN + (2 * l + 1) * 32 * 32};
              pg8::gemm_phase<pg8::EpiResFinal, pg8::StaticOrder, true, true>(lds + RING_OFF, g, S, E); }
          else {
          pg8::EpiResN E{Xl, (pg8::bf16_t*)(wsl + WS_XN), (l + 1 < DEPTH) ? INP(I_ANG) + (l + 1) * DM : INP(I_FING), (float*)(wsl + WS_SSQ)};
          pg8::gemm_phase<pg8::EpiResN, pg8::StaticOrder, true, true>(lds + RING_OFF, g, S, E); } }
        if (l + 1 < DEPTH && Gl == 256) {
            pg8::StaticOrder S9; S9.init(S_, DM, Gl, bxl); pg8::Unit u9; (void)S9.next(0, u9);
            unsigned* cnt9 = (unsigned*)(wsl + WS_CTL) + CW_PAN + ((2 * l + 1) * 32 + u9.pm) * 32;
            if (threadIdx.x == 0) (void)__hip_atomic_fetch_add(cnt9, 1u, __ATOMIC_RELAXED, __HIP_MEMORY_SCOPE_AGENT);
            TICK(14);
            cvt_stream(wsl, lds, l * CV_PER_LAYER + CV_UPEND + CV_T7 + gwl, (l + 1) * CV_PER_LAYER + CV_IN, ngwl);
            if (u9.pn == 0) {
                if (wave == 0) { unsigned sp_ = 0u; while (__hip_atomic_load(cnt9, __ATOMIC_RELAXED, __HIP_MEMORY_SCOPE_AGENT) < 8u && ++sp_ < (1u << 22)) __builtin_amdgcn_s_sleep(1);
                                 __builtin_amdgcn_fence(__ATOMIC_ACQUIRE, "agent"); }
                __syncthreads();
                rstd_panel(wsl, u9.pm, wave, lane_l);
            }
            XBAR(bar);
        } else if (l + 1 == DEPTH && Gl == 256) { TICK(14);
        } else {
            XBAR(bar); TICK(14);
            if (l + 1 < DEPTH) { rstd_phase(wsl, gwl, ngwl, lane_l);
                cvt_stream(wsl, lds, (l + 1) * CV_PER_LAYER + gwl, (l + 2) * CV_PER_LAYER, ngwl);
                XBAR(bar); }
            else { for (int m = gwl; m < S_; m += ngwl) rms_row_f32(Xl + (size_t)m * DM, INP(I_FING), lane_l); }
        }
        TICK(15);
    }
    if (PROBE_T && blockIdx.x == 0) { const unsigned long long t0_ = __builtin_amdgcn_s_memrealtime(); while (__builtin_amdgcn_s_memrealtime() - t0_ < TSCALE * tacc) __builtin_amdgcn_s_sleep(8); }
}

#undef lane_l
extern "C" void kernel_launch(void* const* d_in, const int* in_sizes, int n_in, void* d_out, int out_size, void* d_ws, size_t ws_size, hipStream_t stream) {
    static int grid = 0;
    if (grid == 0) {
        if (n_in != 19 || in_sizes[0] != S_ * DM || out_size != S_ * DM || ws_size < WS_END) { fprintf(stderr, "kernel_launch: shape/workspace mismatch (n_in %d, in0 %d, out %d, ws %zu need %zu)\n", n_in, n_in > 0 ? in_sizes[0] : -1, out_size, ws_size, (size_t)WS_END); grid = -1; return; }
        int dev = 0, cus = 0, per_cu = 0;
        if (hipGetDevice(&dev) != hipSuccess || hipDeviceGetAttribute(&cus, hipDeviceAttributeMultiprocessorCount, dev) != hipSuccess) { grid = -1; return; }
        if (hipFuncSetAttribute((const void*)mk_fwd, hipFuncAttributeMaxDynamicSharedMemorySize, LDS_BYTES) != hipSuccess) { fprintf(stderr, "kernel_launch: hipFuncSetAttribute failed\n"); grid = -1; return; }
        if (hipOccupancyMaxActiveBlocksPerMultiprocessor(&per_cu, (const void*)mk_fwd, NTHR, LDS_BYTES) != hipSuccess || per_cu < 1) { fprintf(stderr, "kernel_launch: occupancy query reports %d blocks per CU\n", per_cu); }
        (void)hipGetLastError();
        grid = cus;
    }
    if (grid < 0) return;
    if (hipMemsetAsync((char*)d_ws + WS_CTL, 0, CTL_ZERO_BYTES, stream) != hipSuccess) return;
    Args a{};
    for (int i = 0; i < 19; ++i) a.in[i] = (const float*)d_in[i];
    a.out = (float*)d_out; a.ws = (unsigned char*)d_ws;
    hipLaunchKernelGGL(mk_fwd, dim3(grid), dim3(NTHR), LDS_BYTES, stream, a);
}
```
